# Optimizing an MI355X kernel written in HIP

```python
import math
import jax
import jax.numpy as jnp
from jax import lax
import numpy as np

D_MODEL = 1024
BATCH = 8
SEQ = 4096
DEPTH = 2

HEAD_DIM = 64
N_MOBA_HEADS = 4
MOBA_BLOCK = 256
MOBA_TOPK = 3
MOBA_Q_CHUNK = 32
N_DIFF_HEADS = 4
DIFF_HEAD_DIM = 32
DIFF_Q_BLOCK = 128
N_POOL_GROUPS = 4
POOL_GROUP = 64
POOL_WINDOWS = (2, 4, 8, 16)
N_DSA_HEADS = 4
N_IDX_HEADS = 4
IDX_HEAD_DIM = 32
DSA_TOPK = 256
DSA_Q_CHUNK = 64
N_BRANCHES = 4
BRANCH_WIDTH = 256
D_FF = 4 * D_MODEL
N_ALIBI_HEADS = N_MOBA_HEADS + N_DIFF_HEADS + N_DSA_HEADS
NORM_EPS = 1e-6
NEG_INF = -1e30

MOBA_W = N_MOBA_HEADS * HEAD_DIM
DIFF_W = N_DIFF_HEADS * 2 * DIFF_HEAD_DIM
POOL_W = N_POOL_GROUPS * POOL_GROUP
DSA_W = N_DSA_HEADS * HEAD_DIM
IDX_Q_W = N_IDX_HEADS * IDX_HEAD_DIM
IN_SPLITS = (MOBA_W, MOBA_W, MOBA_W, DIFF_W, DIFF_W, DIFF_W, POOL_W,
             DSA_W, DSA_W, DSA_W, IDX_Q_W, IDX_HEAD_DIM, N_IDX_HEADS)
IN_PROJ_WIDTH = 3 * MOBA_W + 3 * DIFF_W + POOL_W + 3 * DSA_W + IDX_Q_W + IDX_HEAD_DIM + N_IDX_HEADS

kernel_name = 'hybrid_gated_moba_diff_pool_dsa'


def rms_norm(x, g):
    xf = x.astype(jnp.float32)
    y = xf * lax.rsqrt(jnp.mean(xf * xf, axis=-1, keepdims=True) + NORM_EPS)
    return (y * g.astype(jnp.float32)).astype(x.dtype)


def alibi_slopes():
    n = N_ALIBI_HEADS
    return jnp.asarray(2.0 ** (-8.0 * np.arange(1, n + 1) / n), dtype=jnp.float32)


def _chunks(fn, seq, size):
    starts = jnp.arange(seq // size, dtype=jnp.int32) * size
    out = jnp.moveaxis(lax.map(fn, starts), 0, 1)
    return out.reshape((out.shape[0], seq) + out.shape[3:])


def moba_attention(q, k, v, slopes):
    B, S, H, Dh = q.shape
    f32 = jnp.float32
    q, k, v = q.astype(f32), k.astype(f32), v.astype(f32)
    n_blk = -(-S // MOBA_BLOCK)
    pad = ((0, 0), (0, n_blk * MOBA_BLOCK - S), (0, 0), (0, 0))
    kp, vp = jnp.pad(k, pad), jnp.pad(v, pad)
    kb = kp.reshape(B, n_blk, MOBA_BLOCK, H, Dh).transpose(0, 3, 1, 2, 4)
    vb = vp.reshape(B, n_blk, MOBA_BLOCK, H, Dh).transpose(0, 3, 1, 2, 4)
    k_mean = kb.mean(axis=3)
    n_sel = min(MOBA_TOPK, n_blk)
    scale = Dh ** -0.5
    blk_ids = jnp.arange(n_blk)
    offs = jnp.arange(MOBA_BLOCK)
    b_ix = jnp.arange(B)[:, None, None, None]
    h_ix = jnp.arange(H)[None, None, :, None]
    m = slopes[None, None, :, None]

    def chunk(start):
        qc = lax.dynamic_slice_in_dim(q, start, MOBA_Q_CHUNK, axis=1)
        t = start + jnp.arange(MOBA_Q_CHUNK)
        cur = start // MOBA_BLOCK
        gate = jnp.einsum('bqhd,bhnd->bqhn', qc, k_mean)
        gate = jnp.where(blk_ids < cur, gate, NEG_INF)
        _, sel = lax.top_k(gate, n_sel)
        kg = kb[b_ix, h_ix, sel]
        vg = vb[b_ix, h_ix, sel]
        s_sel = jnp.einsum('bqhd,bqhnkd->bqhnk', qc, kg) * scale
        pos_sel = sel[..., None] * MOBA_BLOCK + offs
        dist_sel = (t[None, :, None, None, None] - pos_sel).astype(f32)
        s_sel = jnp.where((sel < cur)[..., None], s_sel - m[..., None] * dist_sel, NEG_INF)
        k_own = lax.dynamic_slice_in_dim(kp, cur * MOBA_BLOCK, MOBA_BLOCK, axis=1)
        v_own = lax.dynamic_slice_in_dim(vp, cur * MOBA_BLOCK, MOBA_BLOCK, axis=1)
        s_own = jnp.einsum('bqhd,bkhd->bqhk', qc, k_own) * scale
        dist_own = (t[:, None] - (cur * MOBA_BLOCK + offs)[None, :]).astype(f32)[None, :, None, :]
        s_own = jnp.where(dist_own >= 0, s_own - m * dist_own, NEG_INF)
        s_all = jnp.concatenate([s_sel.reshape(B, MOBA_Q_CHUNK, H, n_sel * MOBA_BLOCK), s_own], axis=-1)
        p = jax.nn.softmax(s_all, axis=-1)
        p_sel = p[..., :n_sel * MOBA_BLOCK].reshape(B, MOBA_Q_CHUNK, H, n_sel, MOBA_BLOCK)
        p_own = p[..., n_sel * MOBA_BLOCK:]
        return (jnp.einsum('bqhnk,bqhnkd->bqhd', p_sel, vg)
                + jnp.einsum('bqhk,bkhd->bqhd', p_own, v_own))

    return _chunks(chunk, S, MOBA_Q_CHUNK)


def diff_attention(q, k, v, slopes, lam, lambda_init, subln_g):
    B, S, H, _, dh = q.shape
    f32 = jnp.float32
    q, k, v = q.astype(f32), k.astype(f32), v.astype(f32)
    scale = dh ** -0.5
    s_pos = jnp.arange(S)
    m = slopes[:, None, None, None]

    def block(start):
        qb = lax.dynamic_slice_in_dim(q, start, DIFF_Q_BLOCK, axis=1)
        t = start + jnp.arange(DIFF_Q_BLOCK)
        dist = (t[:, None] - s_pos[None, :]).astype(f32)
        s = jnp.einsum('bqhmd,bshmd->bhmqs', qb, k) * scale
        s = jnp.where(dist >= 0, s - m * dist, NEG_INF)
        p = jax.nn.softmax(s, axis=-1)
        a = p[:, :, 0] - lam * p[:, :, 1]
        return jnp.einsum('bhqs,bshe->bqhe', a, v)

    o = _chunks(block, S, DIFF_Q_BLOCK)
    o = o * lax.rsqrt(jnp.mean(o * o, axis=-1, keepdims=True) + NORM_EPS) * subln_g
    return o * (1.0 - lambda_init)


def pool_mixer(u, w_pool, pool_scale):
    B, S, _ = u.shape
    uf = u.astype(jnp.float32)
    cs = jnp.cumsum(uf, axis=1)
    t = jnp.arange(S)
    outs = []
    for g, w in enumerate(POOL_WINDOWS):
        c_g = cs[..., g * POOL_GROUP:(g + 1) * POOL_GROUP]
        lower = jnp.pad(c_g[:, :S - w], ((0, 0), (w, 0), (0, 0)))
        cnt = jnp.minimum(t + 1, w).astype(jnp.float32)[None, :, None]
        outs.append((c_g - lower) / cnt - uf[..., g * POOL_GROUP:(g + 1) * POOL_GROUP])
    d = jnp.stack(outs, axis=2)
    y = jnp.einsum('bsgc,gce->bsge', d, w_pool).reshape(B, S, POOL_W)
    return (y * pool_scale).astype(u.dtype)


def dsa_attention(q, k, v, iq, ik, iw, slopes):
    B, S, H, Dh = q.shape
    f32 = jnp.float32
    q, k, v = q.astype(f32), k.astype(f32), v.astype(f32)
    iq, ik = iq.astype(f32), ik.astype(f32)
    iw = iw.astype(f32) * N_IDX_HEADS ** -0.5
    n_sel = min(DSA_TOPK, S // 4)
    s_pos = jnp.arange(S)
    b_ix = jnp.arange(B)[:, None, None]
    m = slopes[None, None, :, None]

    def chunk(start):
        qc = lax.dynamic_slice_in_dim(q, start, DSA_Q_CHUNK, axis=1)
        iqc = lax.dynamic_slice_in_dim(iq, start, DSA_Q_CHUNK, axis=1)
        iwc = lax.dynamic_slice_in_dim(iw, start, DSA_Q_CHUNK, axis=1)
        t = start + jnp.arange(DSA_Q_CHUNK)
        rel = jax.nn.relu(jnp.einsum('bqhd,bsd->bqhs', iqc, ik) * IDX_HEAD_DIM ** -0.5)
        score = jnp.einsum('bqhs,bqh->bqs', rel, iwc)
        score = jnp.where(s_pos[None, None, :] <= t[None, :, None], score, NEG_INF)
        _, sel = lax.top_k(score, n_sel)
        kg = k[b_ix, sel]
        vg = v[b_ix, sel]
        dist = (t[None, :, None] - sel).astype(f32)[:, :, None, :]
        s = jnp.einsum('bqhd,bqnhd->bqhn', qc, kg) * Dh ** -0.5
        s = jnp.where(dist >= 0, s - m * dist, NEG_INF)
        p = jax.nn.softmax(s, axis=-1)
        return jnp.einsum('bqhn,bqnhd->bqhd', p, vg)

    return _chunks(chunk, S, DSA_Q_CHUNK)


def hybrid_layer(x, c_act, layer, slopes, w_ada, b_ada, norm1_g, w_in, diff_lambda, diff_subln_g,
                 w_pool, pool_scale, w_gate, b_gate, w_branch, w_out, norm2_g, w_ff1, w_ff2):
    B, S, D = x.shape
    f32 = jnp.float32
    mod = (c_act @ w_ada + b_ada)[:, None, :]
    sh1, sc1, g1, sh2, sc2, g2 = jnp.split(mod, 6, axis=-1)
    h = rms_norm(x, norm1_g) * (1.0 + sc1) + sh1
    proj = h @ w_in
    offsets = np.cumsum(IN_SPLITS)[:-1].tolist()
    aq, ak, av, bq, bk, bv, pu, dq, dk, dv, iq, ik, iw = jnp.split(proj, offsets, axis=-1)
    slopes_a, slopes_b, slopes_d = slopes[0::3], slopes[1::3], slopes[2::3]

    y_a = moba_attention(aq.reshape(B, S, N_MOBA_HEADS, HEAD_DIM), ak.reshape(B, S, N_MOBA_HEADS, HEAD_DIM),
                         av.reshape(B, S, N_MOBA_HEADS, HEAD_DIM), slopes_a).reshape(B, S, MOBA_W)

    lambda_init = 0.8 - 0.6 * math.exp(-0.3 * layer)
    lq1, lk1, lq2, lk2 = diff_lambda.astype(f32)
    lam = jnp.exp(jnp.sum(lq1 * lk1)) - jnp.exp(jnp.sum(lq2 * lk2)) + lambda_init
    qk_shape = (B, S, N_DIFF_HEADS, 2, DIFF_HEAD_DIM)
    y_b = diff_attention(bq.reshape(qk_shape), bk.reshape(qk_shape),
                         bv.reshape(B, S, N_DIFF_HEADS, 2 * DIFF_HEAD_DIM), slopes_b, lam, lambda_init,
                         diff_subln_g.astype(f32)).reshape(B, S, DIFF_W)

    y_c = pool_mixer(pu, w_pool, pool_scale)

    y_d = dsa_attention(dq.reshape(B, S, N_DSA_HEADS, HEAD_DIM), dk.reshape(B, S, N_DSA_HEADS, HEAD_DIM),
                        dv.reshape(B, S, N_DSA_HEADS, HEAD_DIM), iq.reshape(B, S, N_IDX_HEADS, IDX_HEAD_DIM),
                        ik, iw, slopes_d).reshape(B, S, DSA_W)

    terms = []
    for i, y in enumerate((y_a, y_b, y_c, y_d)):
        gate = jax.nn.sigmoid((h @ w_gate[i] + b_gate[i]).astype(f32))
        terms.append(gate * (y.astype(x.dtype) @ w_branch[i]))
    merged = (terms[0] + terms[1] + terms[2] + terms[3]).astype(x.dtype)
    x = x + g1 * (merged @ w_out)

    h2 = rms_norm(x, norm2_g) * (1.0 + sc2) + sh2
    ff = jnp.square(jax.nn.relu(h2 @ w_ff1)) @ w_ff2
    return x + g2 * ff


def setup_inputs(seed: int = 0) -> dict:
    key = jax.random.key(seed)
    ks = jax.random.split(key, 20)
    D = D_MODEL

    def nrm(k, shape, scale):
        return jax.random.normal(k, shape, jnp.float32) * scale

    return {
        'x': nrm(ks[0], (BATCH, SEQ, D), 1.0),
        'c': nrm(ks[1], (BATCH, D), 1.0),
        'w_ada': nrm(ks[2], (DEPTH, D, 6 * D), 0.5 * D ** -0.5),
        'b_ada': nrm(ks[3], (DEPTH, 6 * D), 0.02),
        'norm1_g': 1.0 + nrm(ks[4], (DEPTH, D), 0.02),
        'w_in': nrm(ks[5], (DEPTH, D, IN_PROJ_WIDTH), D ** -0.5),
        'diff_lambda': nrm(ks[6], (DEPTH, 4, DIFF_HEAD_DIM), 0.1),
        'diff_subln_g': 1.0 + nrm(ks[7], (DEPTH, 2 * DIFF_HEAD_DIM), 0.02),
        'w_pool': nrm(ks[8], (DEPTH, N_POOL_GROUPS, POOL_GROUP, POOL_GROUP), POOL_GROUP ** -0.5),
        'pool_scale': 1.0 + nrm(ks[9], (DEPTH, POOL_W), 0.1),
        'w_gate': nrm(ks[10], (DEPTH, N_BRANCHES, D, D), D ** -0.5),
        'b_gate': nrm(ks[11], (DEPTH, N_BRANCHES, D), 0.02),
        'w_branch': nrm(ks[12], (DEPTH, N_BRANCHES, BRANCH_WIDTH, D), BRANCH_WIDTH ** -0.5),
        'w_out': nrm(ks[13], (DEPTH, D, D), D ** -0.5),
        'norm2_g': 1.0 + nrm(ks[14], (DEPTH, D), 0.02),
        'w_ff1': nrm(ks[15], (DEPTH, D, D_FF), D ** -0.5),
        'w_ff2': nrm(ks[16], (DEPTH, D_FF, D), D_FF ** -0.5),
        'final_norm_g': 1.0 + nrm(ks[17], (D,), 0.02),
    }


def reference(x, c, w_ada, b_ada, norm1_g, w_in, diff_lambda, diff_subln_g, w_pool, pool_scale,
              w_gate, b_gate, w_branch, w_out, norm2_g, w_ff1, w_ff2, final_norm_g):
    slopes = alibi_slopes()
    c_act = jax.nn.silu(c)
    for l in range(DEPTH):
        x = hybrid_layer(x, c_act, l, slopes, w_ada[l], b_ada[l], norm1_g[l], w_in[l], diff_lambda[l],
                         diff_subln_g[l], w_pool[l], pool_scale[l], w_gate[l], b_gate[l], w_branch[l],
                         w_out[l], norm2_g[l], w_ff1[l], w_ff2[l])
    return rms_norm(x, final_norm_g)
```

```cpp
#define REPEAT_MASK 0x8
#include <hip/hip_runtime.h>
#include <cstdio>
#include <cstdint>
namespace pg8 {
#define PG8_LAS __attribute__((address_space(3)))
typedef unsigned short bf16_t;
typedef short bf16x8 __attribute__((ext_vector_type(8)));
typedef float f32x4 __attribute__((ext_vector_type(4)));
typedef unsigned u32x4 __attribute__((ext_vector_type(4)));
constexpr int BM = 256, BK = 64, HALF = 128, HTB = HALF * BK * 2  , STAGE_BYTES = 8 * HTB, NXCD = 8, WGM = 8;

__host__ __device__ __forceinline__ int lds_byte(int r, int c) { const int st = (r >> 4) * 2 + (c >> 5), rr = r & 15, cc = c & 31, ob = rr * 64 + cc * 2; return st * 1024 + (ob ^ (((ob >> 9) & 1) << 5)); }
__host__ __device__ __forceinline__ void stage_rc(int b, int& R, int& C) { const int st = b / 1024, sb = b % 1024, swz = sb ^ (((sb >> 9) & 1) << 5); R = (st >> 1) * 16 + swz / 64; C = (st & 1) * 32 + (swz % 64) / 2; }
__host__ __device__ __forceinline__ int perm32(int rho) { const int n = rho >> 4, i = rho & 15; return 8 * (i >> 2) + 4 * n + (i & 3); }

struct Unit { int pm, pn; };
struct Gemm { const bf16_t* A; const bf16_t* Bt; int M, N, K; };

struct StaticOrder {
    int nM, nN, nwg, G, c;
    __host__ __device__ void init(int M, int N, int G_, int c_) { nM = M / BM; nN = N / BM; nwg = nM * nN; G = G_; c = c_; }
    __host__ __device__ bool next(int i, Unit& u) const {
        const long L = (long)i * G + c; if (L >= nwg) return false;
        int wgid = (int)L; { const int q = nwg / NXCD, r = nwg % NXCD, xcd = wgid % NXCD, off = wgid / NXCD; wgid = (xcd < r ? xcd * (q + 1) : r * (q + 1) + (xcd - r) * q) + off; }
        const int nig = WGM * nN, gid = wgid / nig, fm = gid * WGM, gsz = (nM - fm) < WGM ? (nM - fm) : WGM;
        u.pm = fm + ((wgid % nig) % gsz); u.pn = (wgid % nig) / gsz; return true;
    }
    __device__ __forceinline__ void a_ready(const Unit&) const {}
    __device__ __forceinline__ void done(const Unit&) const {}
};

__device__ __forceinline__ unsigned cvt_pk_bf16(float lo, float hi) { unsigned r; asm volatile("v_cvt_pk_bf16_f32 %0, %1, %2" : "=v"(r) : "v"(lo), "v"(hi)); return r; }
typedef unsigned u32x2 __attribute__((ext_vector_type(2)));
constexpr int TT = 32768;
constexpr float QS64 = 0.125f * 1.4426950408889634f;
constexpr float QS32 = 0.17677669529663687f * 1.4426950408889634f;

struct EpiProj {
    static constexpr bool PERM = true, AFTER_DRAIN = false;
    bf16_t* O; size_t tile_stride;
    __device__ __forceinline__ void operator()(const f32x4 (&acc)[2][2][4][2], const Unit& u, int wr, int wc, int fr, int fq) const {
        const int row0 = u.pm * BM + wr * 64 + fr; bf16_t* base = O + (size_t)u.pn * tile_stride;
        float sc = 1.f; if (u.pn == 0 || u.pn == 7) sc = QS64; else if (u.pn == 3) sc = QS32;
        const int col0 = wc * 32 + 8 * fq;
#pragma unroll
        for (int ai = 0; ai < 2; ++ai)
#pragma unroll
            for (int m = 0; m < 4; ++m) { bf16_t* rowp = base + (size_t)(row0 + ai * HALF + m * 16) * 256 + col0;
#pragma unroll
                for (int bj = 0; bj < 2; ++bj) { const f32x4 v0 = acc[ai][bj][m][0] * sc, v1 = acc[ai][bj][m][1] * sc;
                    u32x4 w; w.x = cvt_pk_bf16(v0[0], v0[1]); w.y = cvt_pk_bf16(v0[2], v0[3]); w.z = cvt_pk_bf16(v1[0], v1[1]); w.w = cvt_pk_bf16(v1[2], v1[3]);
                    *(u32x4*)(rowp + bj * HALF) = w; } }
    }
};
struct EpiZ {
    static constexpr bool PERM = true, AFTER_DRAIN = false;
    bf16_t* O;
    __device__ __forceinline__ void operator()(const f32x4 (&acc)[2][2][4][2], const Unit& u, int wr, int wc, int fr, int fq) const {
        const int row0 = u.pm * BM + wr * 64 + fr; const int col0 = (u.pn & 3) * BM + wc * 32 + 8 * fq;
#pragma unroll
        for (int ai = 0; ai < 2; ++ai)
#pragma unroll
            for (int m = 0; m < 4; ++m) { bf16_t* rowp = O + (size_t)(row0 + ai * HALF + m * 16) * 1024 + col0;
#pragma unroll
                for (int bj = 0; bj < 2; ++bj) { const f32x4 v0 = acc[ai][bj][m][0], v1 = acc[ai][bj][m][1];
                    u32x4 w; w.x = cvt_pk_bf16(v0[0], v0[1]); w.y = cvt_pk_bf16(v0[2], v0[3]); w.z = cvt_pk_bf16(v1[0], v1[1]); w.w = cvt_pk_bf16(v1[2], v1[3]);
                    *(u32x4*)(rowp + bj * HALF) = w; } }
    }
};
struct EpiRelu2 {
    static constexpr bool PERM = true, AFTER_DRAIN = false;
    bf16_t* O; int ldc;
    __device__ __forceinline__ void operator()(const f32x4 (&acc)[2][2][4][2], const Unit& u, int wr, int wc, int fr, int fq) const {
        const int row0 = u.pm * BM + wr * 64 + fr; const int col0 = u.pn * BM + wc * 32 + 8 * fq;
#pragma unroll
        for (int ai = 0; ai < 2; ++ai)
#pragma unroll
            for (int m = 0; m < 4; ++m) { bf16_t* rowp = O + (size_t)(row0 + ai * HALF + m * 16) * ldc + col0;
#pragma unroll
                for (int bj = 0; bj < 2; ++bj) { f32x4 v0 = acc[ai][bj][m][0], v1 = acc[ai][bj][m][1];
#pragma unroll
                    for (int j = 0; j < 4; ++j) { const float a = fmaxf(v0[j], 0.f), b = fmaxf(v1[j], 0.f); v0[j] = a * a; v1[j] = b * b; }
                    u32x4 w; w.x = cvt_pk_bf16(v0[0], v0[1]); w.y = cvt_pk_bf16(v0[2], v0[3]); w.z = cvt_pk_bf16(v1[0], v1[1]); w.w = cvt_pk_bf16(v1[2], v1[3]);
                    *(u32x4*)(rowp + bj * HALF) = w; } }
    }
};
struct EpiResid {
    static constexpr bool PERM = false, AFTER_DRAIN = false;
    const float* base; float* out; const float* gate;
    __device__ __forceinline__ void operator()(const f32x4 (&acc)[2][2][4][2], const Unit& u, int wr, int wc, int fr, int fq) const {
        const int row0 = u.pm * BM + wr * 64 + fr; const int col0 = u.pn * BM + wc * 32 + 4 * fq;
        const float* gp = gate + (size_t)(u.pm >> 4) * 6144 + col0;
        f32x4 gv[2][2];
#pragma unroll
        for (int bj = 0; bj < 2; ++bj)
#pragma unroll
            for (int n = 0; n < 2; ++n) gv[bj][n] = *(const f32x4*)(gp + bj * HALF + n * 16);
#pragma unroll
        for (int ai = 0; ai < 2; ++ai)
#pragma unroll
            for (int m = 0; m < 4; ++m) { const size_t off = (size_t)(row0 + ai * HALF + m * 16) * 1024 + col0;
#pragma unroll
                for (int bj = 0; bj < 2; ++bj)
#pragma unroll
                    for (int n = 0; n < 2; ++n) { const f32x4 bs = *(const f32x4*)(base + off + bj * HALF + n * 16);
                        *(f32x4*)(out + off + bj * HALF + n * 16) = bs + gv[bj][n] * acc[ai][bj][m][n]; }
                if (m & 1) asm volatile("" ::: "memory"); }
    }
};
struct EpiGate {
    static constexpr bool PERM = true, AFTER_DRAIN = false;
    const bf16_t* Z; const float* bg; bf16_t* O;
    __device__ __forceinline__ void operator()(const f32x4 (&acc)[2][2][4][2], const Unit& u, int wr, int wc, int fr, int fq) const {
        const int row0 = u.pm * BM + wr * 64 + fr; const int mc0 = u.pn * 64 + wc * 16 + 4 * fq;
        f32x4 bv[2][2];
#pragma unroll
        for (int bj = 0; bj < 2; ++bj)
#pragma unroll
            for (int n = 0; n < 2; ++n) bv[bj][n] = *(const f32x4*)(bg + (2 * bj + n) * 1024 + mc0);
#pragma unroll
        for (int ai = 0; ai < 2; ++ai)
#pragma unroll
            for (int m = 0; m < 4; ++m) { const size_t row = (size_t)(row0 + ai * HALF + m * 16);
                f32x4 sum = (f32x4){0.f, 0.f, 0.f, 0.f};
#pragma unroll
                for (int bj = 0; bj < 2; ++bj)
#pragma unroll
                    for (int n = 0; n < 2; ++n) { const u32x2 zr = *(const u32x2*)(Z + ((size_t)(2 * bj + n) * TT + row) * 1024 + mc0);
                        const f32x4 x = acc[ai][bj][m][n] + bv[bj][n]; f32x4 zz;
                        zz[0] = __uint_as_float(zr.x << 16); zz[1] = __uint_as_float(zr.x & 0xffff0000u); zz[2] = __uint_as_float(zr.y << 16); zz[3] = __uint_as_float(zr.y & 0xffff0000u);
#pragma unroll
                        for (int j = 0; j < 4; ++j) { const float g = __builtin_amdgcn_rcpf(1.f + __builtin_amdgcn_exp2f(-1.4426950408889634f * x[j])); sum[j] += g * zz[j]; } }
                u32x2 w; w.x = cvt_pk_bf16(sum[0], sum[1]); w.y = cvt_pk_bf16(sum[2], sum[3]);
                *(u32x2*)(O + row * 1024 + mc0) = w; }
    }
};
template <class Epi, class Sched, bool ALIGN_EPI = false, bool SP2 = false>
__device__ __forceinline__ void gemm_phase(PG8_LAS unsigned char* lds, const Gemm g, const Sched& S, const Epi& E) {
    int tid_l = threadIdx.x; asm volatile("" : "+v"(tid_l)); const int tid = tid_l, wid = __builtin_amdgcn_readfirstlane(tid >> 6), lane = tid & 63, wr = wid >> 2, wc = wid & 3, fr = lane & 15, fq = lane >> 4;
    const int K = g.K, nt = K / BK;
    unsigned voffA[2], voffB[2];
#pragma unroll
    for (int i = 0; i < 2; ++i) { int R, C; stage_rc(tid * 16 + i * 8192, R, C); const int Rb = Epi::PERM ? ((R & ~31) + perm32(R & 31)) : R;
        voffA[i] = (unsigned)(R * K + C) * 2u; voffB[i] = (unsigned)(Rb * K + C) * 2u; }
    const size_t kstep = (size_t)(BK * 2);
    const size_t hstep = (size_t)HALF * K * 2;
    const size_t tstep = 2 * hstep;
    const unsigned ldsw = (unsigned)wid * 1024u;
    const int aoff = lds_byte(wr * 64 + fr, fq * 8), boff = lds_byte(wc * 32 + fr, fq * 8);
#define PG8_SA(b, h) (((b) * 2 + (h)) * HTB)
#define PG8_SB(b, h) ((4 + (b) * 2 + (h)) * HTB)
#define PG8_STAGE(bufoff, gbase, voff) do { _Pragma("unroll") for (int _i = 0; _i < 2; ++_i) \
        __builtin_amdgcn_global_load_lds((const unsigned*)((const char*)(gbase) + (voff)[_i]), (PG8_LAS unsigned*)(lds + (bufoff) + ldsw + _i * 8192), 16, 0, 0); } while (0)
#define PG8_LDA(dst, b, h) do { _Pragma("unroll") for (int m = 0; m < 4; ++m) _Pragma("unroll") for (int k = 0; k < 2; ++k) dst[m][k] = *(const PG8_LAS bf16x8*)(lds + PG8_SA(b, h) + aoff + m * 2048 + k * 1024); } while (0)
#define PG8_LDB(dst, b, h) do { _Pragma("unroll") for (int n = 0; n < 2; ++n) _Pragma("unroll") for (int k = 0; k < 2; ++k) dst[n][k] = *(const PG8_LAS bf16x8*)(lds + PG8_SB(b, h) + boff + n * 2048 + k * 1024); } while (0)
#define PG8_MMA(ai, bj, At, Bt) do { __builtin_amdgcn_s_setprio(1); _Pragma("unroll") for (int m = 0; m < 4; ++m) _Pragma("unroll") for (int n = 0; n < 2; ++n) _Pragma("unroll") for (int k = 0; k < 2; ++k) \
        acc[ai][bj][m][n] = __builtin_amdgcn_mfma_f32_16x16x32_bf16(Bt[n][k], At[m][k], acc[ai][bj][m][n], 0, 0, 0); __builtin_amdgcn_s_setprio(0); } while (0)
#define PG8_WAIT_V(n) asm volatile("s_waitcnt vmcnt(" #n ")" ::: "memory")
#define PG8_WAIT_L(n) asm volatile("s_waitcnt lgkmcnt(" #n ")" ::: "memory")
#define PG8_BAR __builtin_amdgcn_s_barrier()
#define PG8_SCHED __builtin_amdgcn_sched_barrier(0)
    Unit cur, nxt; int ui = 0;
    if (!S.next(0, cur)) return;
    f32x4 acc[2][2][4][2];
#pragma unroll
    for (int a = 0; a < 2; ++a)
#pragma unroll
        for (int b = 0; b < 2; ++b)
#pragma unroll
            for (int m = 0; m < 4; ++m)
#pragma unroll
                for (int n = 0; n < 2; ++n) acc[a][b][m][n] = (f32x4){0.f, 0.f, 0.f, 0.f};
    bf16x8 At[4][2], B0[2][2], B1[2][2];
    const char* cA = (const char*)g.A + (size_t)cur.pm * tstep; const char* cB = (const char*)g.Bt + (size_t)cur.pn * tstep;
    S.a_ready(cur);
    if constexpr (SP2) {
        PG8_STAGE(PG8_SB(0, 0), cB, voffB); PG8_STAGE(PG8_SB(0, 1), cB + hstep, voffB); PG8_STAGE(PG8_SA(0, 0), cA, voffA); PG8_STAGE(PG8_SA(0, 1), cA + hstep, voffA);
        if (wr == 1) PG8_BAR;
        PG8_WAIT_V(2); PG8_BAR;
        PG8_STAGE(PG8_SB(1, 0), cB + kstep, voffB); PG8_STAGE(PG8_SA(1, 0), cA + kstep, voffA); PG8_STAGE(PG8_SB(1, 1), cB + hstep + kstep, voffB);
        PG8_WAIT_V(6); PG8_BAR;
    } else {
        PG8_STAGE(PG8_SB(0, 0), cB, voffB); PG8_STAGE(PG8_SA(0, 0), cA, voffA); PG8_STAGE(PG8_SB(0, 1), cB + hstep, voffB); PG8_STAGE(PG8_SA(0, 1), cA + hstep, voffA);
        if (wr == 1) PG8_BAR;
        PG8_WAIT_V(4); PG8_BAR;
        PG8_STAGE(PG8_SB(1, 0), cB + kstep, voffB); PG8_STAGE(PG8_SA(1, 0), cA + kstep, voffA); PG8_STAGE(PG8_SB(1, 1), cB + hstep + kstep, voffB);
        PG8_WAIT_V(6); PG8_BAR;
    }
    for (;;) {
        const bool has_next = S.next(ui + 1, nxt);
        const char* nA = has_next ? (const char*)g.A + (size_t)nxt.pm * tstep : cA; const char* nB = has_next ? (const char*)g.Bt + (size_t)nxt.pn * tstep : cB;
        for (int t = 0; t < nt; t += 2) {
            const bool last = (t == nt - 2);
            const char* a1 = cA + (size_t)(t + 1) * kstep;
            const char* a2 = last ? nA : cA + (size_t)(t + 2) * kstep; const char* b2 = last ? nB : cB + (size_t)(t + 2) * kstep;
            const char* a3 = a2 + kstep; const char* b3 = b2 + kstep;
            if (last && has_next) S.a_ready(nxt);
            if constexpr (SP2) {
            PG8_LDB(B0, 0, 0); PG8_LDB(B1, 0, 1); PG8_SCHED; PG8_LDA(At, 0, 0); PG8_STAGE(PG8_SA(1, 1), a1 + hstep, voffA);
            PG8_WAIT_V(8); PG8_WAIT_L(0); PG8_BAR; PG8_MMA(0, 0, At, B0); PG8_MMA(0, 1, At, B1); PG8_BAR; PG8_SCHED;
            PG8_LDA(At, 0, 1); PG8_STAGE(PG8_SB(0, 0), b2, voffB); PG8_STAGE(PG8_SB(0, 1), b2 + hstep, voffB); PG8_STAGE(PG8_SA(0, 0), a2, voffA);
            PG8_WAIT_V(8); PG8_WAIT_L(0); PG8_BAR; PG8_MMA(1, 0, At, B0); PG8_MMA(1, 1, At, B1); PG8_BAR; PG8_SCHED;
            PG8_LDB(B0, 1, 0); PG8_LDB(B1, 1, 1); PG8_SCHED; PG8_LDA(At, 1, 0); PG8_STAGE(PG8_SA(0, 1), a2 + hstep, voffA);
            PG8_WAIT_V(8); PG8_WAIT_L(0); PG8_BAR; PG8_MMA(0, 0, At, B0); PG8_MMA(0, 1, At, B1); PG8_BAR; PG8_SCHED;
            PG8_LDA(At, 1, 1); PG8_STAGE(PG8_SB(1, 0), b3, voffB); PG8_STAGE(PG8_SB(1, 1), b3 + hstep, voffB); PG8_STAGE(PG8_SA(1, 0), a3, voffA);
            PG8_WAIT_V(8); PG8_WAIT_L(0); PG8_BAR; PG8_MMA(1, 0, At, B0); PG8_MMA(1, 1, At, B1); PG8_BAR; PG8_SCHED;
            } else {
            PG8_LDB(B0, 0, 0); PG8_SCHED; PG8_LDA(At, 0, 0); PG8_STAGE(PG8_SA(1, 1), a1 + hstep, voffA);
            PG8_WAIT_L(8); PG8_BAR; PG8_WAIT_L(0); PG8_MMA(0, 0, At, B0); PG8_BAR; PG8_SCHED;
            PG8_LDB(B1, 0, 1); PG8_STAGE(PG8_SB(0, 0), b2, voffB);
            PG8_BAR; PG8_WAIT_L(0); PG8_MMA(0, 1, At, B1); PG8_BAR;
            PG8_LDA(At, 0, 1); PG8_STAGE(PG8_SA(0, 0), a2, voffA);
            PG8_BAR; PG8_WAIT_L(0); PG8_MMA(1, 0, At, B0); PG8_BAR; PG8_SCHED;
            PG8_STAGE(PG8_SB(0, 1), b2 + hstep, voffB);
            PG8_WAIT_V(6); PG8_BAR; PG8_MMA(1, 1, At, B1); PG8_BAR;
            PG8_LDB(B0, 1, 0); PG8_SCHED; PG8_LDA(At, 1, 0); PG8_STAGE(PG8_SA(0, 1), a2 + hstep, voffA);
            PG8_WAIT_L(8); PG8_BAR; PG8_WAIT_L(0); PG8_MMA(0, 0, At, B0); PG8_BAR; PG8_SCHED;
            PG8_LDB(B1, 1, 1); PG8_STAGE(PG8_SB(1, 0), b3, voffB);
            PG8_BAR; PG8_WAIT_L(0); PG8_MMA(0, 1, At, B1); PG8_BAR;
            PG8_LDA(At, 1, 1); PG8_STAGE(PG8_SA(1, 0), a3, voffA);
            PG8_BAR; PG8_WAIT_L(0); PG8_MMA(1, 0, At, B0); PG8_BAR; PG8_SCHED;
            PG8_STAGE(PG8_SB(1, 1), b3 + hstep, voffB);
            PG8_WAIT_V(6); PG8_BAR; PG8_MMA(1, 1, At, B1); PG8_BAR;
            }
        }
        if constexpr (ALIGN_EPI) { if (wr == 0) PG8_BAR; }
        if constexpr (!Epi::AFTER_DRAIN) { E(acc, cur, wr, wc, fr, fq); S.done(cur); }
        if (!has_next) break;
#pragma unroll
        for (int a = 0; a < 2; ++a)
#pragma unroll
            for (int b = 0; b < 2; ++b)
#pragma unroll
                for (int m = 0; m < 4; ++m)
#pragma unroll
                    for (int n = 0; n < 2; ++n) acc[a][b][m][n] = (f32x4){0.f, 0.f, 0.f, 0.f};
        cur = nxt; cA = nA; cB = nB; ++ui;
        if constexpr (ALIGN_EPI) { if (wr == 1) PG8_BAR; }
    }
    PG8_WAIT_V(0);
    if constexpr (!ALIGN_EPI) { if (wr == 0) PG8_BAR; }
    PG8_BAR;
    if constexpr (Epi::AFTER_DRAIN) { E.fused(acc, cur, wr, wc, fr, fq, lds, wid, lane); S.done(cur); }
#undef PG8_SA
#undef PG8_SB
#undef PG8_STAGE
#undef PG8_LDA
#undef PG8_LDB
#undef PG8_MMA
#undef PG8_WAIT_V
#undef PG8_WAIT_L
#undef PG8_BAR
#undef PG8_SCHED
}
}

constexpr int NB = 8, SEQ = 4096, DM = 1024, NL = 2, FF = 4096, NPROJ = 2724, NPROJ_PAD = 2816, NTILE_PROJ = 11;
constexpr int TOK = NB * SEQ;
static_assert(TOK == pg8::TT, "token count");
constexpr float NORM_EPS = 1e-6f;
constexpr float LOG2E = 1.4426950408889634f;
constexpr int NWAVES = 8;

constexpr size_t MiB = 1u << 20;
constexpr size_t WS_CTL = 0, CTL_ZERO_BYTES = 1 * MiB;
constexpr size_t WS_MOD = 1 * MiB;
constexpr size_t WS_KMEAN = WS_MOD + 512 * 1024;
constexpr size_t WS_W = 2 * MiB;
constexpr size_t W_IN = 0, W_GATE = W_IN + (size_t)NPROJ_PAD * DM, W_BR = W_GATE + (size_t)4 * DM * DM, W_OUT = W_BR + (size_t)4 * DM * 256,
                 W_FF1 = W_OUT + (size_t)DM * DM, W_FF2 = W_FF1 + (size_t)FF * DM, W_LAYER = W_FF2 + (size_t)DM * FF;
constexpr size_t WS_MASK = 70 * MiB;
constexpr size_t WS_H = 86 * MiB;
constexpr size_t WS_Y = 150 * MiB;
constexpr size_t WS_R = 214 * MiB;
constexpr size_t WS_END = 470 * MiB;
static_assert(WS_W + 2 * W_LAYER * 2 <= WS_MASK, "weights fit");
constexpr int CW_BAR = 4096;
constexpr int CW_WQ = 131072;
constexpr int CW_NRM = CW_WQ + 2048;
constexpr int NPHASE = 22;

constexpr int RING_BYTES = 135168;
constexpr int LDSCTL_OFF = RING_BYTES;
constexpr int LDS_BYTES = 147456;

#define GAS __attribute__((address_space(1)))
#define LAS __attribute__((address_space(3)))
typedef unsigned short bf16;
typedef unsigned v4u __attribute__((ext_vector_type(4)));
typedef unsigned v2u __attribute__((ext_vector_type(2)));
typedef float f32x4 __attribute__((ext_vector_type(4)));
typedef float f32x16 __attribute__((ext_vector_type(16)));
typedef short bf16x8 __attribute__((ext_vector_type(8)));
typedef short s16x4 __attribute__((ext_vector_type(4)));
typedef GAS unsigned gu32;
#define RLX_AGENT __ATOMIC_RELAXED, __HIP_MEMORY_SCOPE_AGENT
#define LDS_WAIT() asm volatile("s_waitcnt lgkmcnt(0)" ::: "memory")
__device__ __forceinline__ unsigned f2bf(float f) { unsigned u = __builtin_bit_cast(unsigned, f); return (u + 0x7fffu + ((u >> 16) & 1u)) >> 16; }
__device__ __forceinline__ unsigned pk2(float lo, float hi) { return f2bf(lo) | (f2bf(hi) << 16); }
__device__ __forceinline__ float bf2f(unsigned short b) { return __uint_as_float((unsigned)b << 16); }
__device__ __forceinline__ float bflo(unsigned w) { return __uint_as_float(w << 16); }
__device__ __forceinline__ float bfhi(unsigned w) { return __uint_as_float(w & 0xffff0000u); }

#define XB_TMO      128
#define XB_XCNT(j)  (256  + 64 * (j))
#define XB_XSUB(j)  (1280 + 64 * (j))
#define XB_XGEN(j)  (2304 + 64 * (j))
#define XB_TOP      3328
#define XB_TOPGEN   3392
#define XCD_BAR_WORDS 3456
#define XB_SPIN_CAP (1u << 18)

__device__ __forceinline__ unsigned xb_ld(unsigned* p)              { return __hip_atomic_load(p, __ATOMIC_RELAXED, __HIP_MEMORY_SCOPE_AGENT); }
__device__ __forceinline__ unsigned xb_add(unsigned* p, unsigned v) { return __hip_atomic_fetch_add(p, v, __ATOMIC_RELAXED, __HIP_MEMORY_SCOPE_AGENT); }
__device__ __forceinline__ unsigned xb_xcc_id() { return (unsigned)__builtin_amdgcn_s_getreg((3 << 11) | 20) & 0xFu; }
#define XB_SPIN(cond, bar) do { unsigned _sp = 0; while (cond) { __builtin_amdgcn_s_sleep(1); \
    if ((++_sp & 255u) == 0u) { if (xb_ld(&(bar)[XB_TMO])) break; if (_sp > XB_SPIN_CAP) { atomicAdd(&(bar)[XB_TMO], 1u); break; } } } } while (0)

struct XcdBarrier {
    unsigned* bar; unsigned x;
    volatile LAS unsigned* st;
};

__device__ __forceinline__ XcdBarrier xcd_barrier_post(unsigned* bar, volatile LAS unsigned* st) {
    XcdBarrier b; b.bar = bar; b.x = xb_xcc_id(); b.st = st;
    if (threadIdx.x == 0) (void)xb_add(&bar[XB_XCNT(b.x)], 1u);
    return b;
}
__device__ __forceinline__ void xcd_barrier_complete(unsigned* bar, unsigned x, unsigned& nloc, unsigned& nx) {
    const unsigned G = gridDim.x * gridDim.y * gridDim.z;
    unsigned sum, cnt, mine, sp = 0u;
    for (;;) {
        sum = 0u; cnt = 0u; mine = 0u;
#pragma unroll
        for (unsigned j = 0; j < 16; ++j) { const unsigned c = xb_ld(&bar[XB_XCNT(j)]); sum += c; cnt += (c > 0u) ? 1u : 0u; mine = (j == x) ? c : mine; }
        if (sum == G) break;
        __builtin_amdgcn_s_sleep(1);
        if ((++sp & 255u) == 0u) { if (xb_ld(&bar[XB_TMO])) break; if (sp > XB_SPIN_CAP) { atomicAdd(&bar[XB_TMO], 1u); break; } }
    }
    nloc = mine > 0u ? mine : 1u; nx = cnt > 0u ? cnt : 1u;
}

__device__ __forceinline__ void xcd_barrier(const XcdBarrier& b) {
    asm volatile("s_waitcnt vmcnt(0)" ::: "memory");
    __syncthreads();
    if (threadIdx.x == 0) {
        unsigned* bar = b.bar;
        __builtin_amdgcn_s_waitcnt(0);
        unsigned nloc = b.st[0], nx = b.st[1];
        if (nloc == 0u) { xcd_barrier_complete(bar, b.x, nloc, nx); b.st[0] = nloc; b.st[1] = nx; }
        const unsigned old = xb_add(&bar[XB_XSUB(b.x)], 1u);
        const unsigned gen = old / nloc;
        if (old + 1u == (gen + 1u) * nloc) {
            __builtin_amdgcn_fence(__ATOMIC_RELEASE, "agent");
            asm volatile("s_waitcnt vmcnt(0)" ::: "memory");
            const unsigned og = xb_add(&bar[XB_TOP], 1u);
            const unsigned tg = og / nx;
            if (og + 1u == (tg + 1u) * nx) xb_add(&bar[XB_TOPGEN], 1u);
            else XB_SPIN(xb_ld(&bar[XB_TOPGEN]) == tg, bar);
            __builtin_amdgcn_fence(__ATOMIC_ACQUIRE, "agent");
            xb_add(&bar[XB_XGEN(b.x)], 1u);
            asm volatile("s_waitcnt vmcnt(0)" ::: "memory");
        } else {
            XB_SPIN(xb_ld(&bar[XB_XGEN(b.x)]) == gen, bar);
            __builtin_amdgcn_fence(__ATOMIC_ACQUIRE, "agent");
            asm volatile("s_waitcnt vmcnt(0)" ::: "memory");
        }
    }
    __syncthreads();
}

struct Args {
    const float *x, *c, *w_ada, *b_ada, *norm1_g, *w_in, *diff_lambda, *diff_subln_g, *w_pool, *pool_scale, *w_gate, *b_gate, *w_branch, *w_out, *norm2_g, *w_ff1, *w_ff2, *final_g;
    float* out; unsigned char* ws; int ph_lo, ph_hi, li, pad;
};

__device__ __forceinline__ float shx(float v, int mask, int lane) { return __int_as_float(__builtin_amdgcn_ds_bpermute((lane ^ mask) << 2, __float_as_int(v))); }
__device__ __forceinline__ unsigned shxu(unsigned v, int mask, int lane) { return (unsigned)__builtin_amdgcn_ds_bpermute((lane ^ mask) << 2, (int)v); }
__device__ __forceinline__ unsigned shupu(unsigned v, int delta, int lane) { return (unsigned)__builtin_amdgcn_ds_bpermute(((lane - delta) & 63) << 2, (int)v); }
__device__ __forceinline__ float wave_sum(float v, int lane) {
#pragma unroll
    for (int o = 1; o < 64; o <<= 1) v += shx(v, o, lane);
    return v;
}
__device__ __forceinline__ int crow(int r, int hi) { return (r & 3) + 8 * (r >> 2) + 4 * hi; }
__device__ __forceinline__ unsigned cvtpk(float lo, float hi) { unsigned r; asm volatile("v_cvt_pk_bf16_f32 %0, %1, %2" : "=v"(r) : "v"(lo), "v"(hi)); return r; }

__device__ __forceinline__ int gate_row(int br, int c) { const int pn = c >> 6, ml = c & 63; return 256 * pn + 128 * (br >> 1) + 32 * (ml >> 4) + 8 * ((ml >> 2) & 3) + 4 * (br & 1) + (ml & 3); }
__device__ __forceinline__ void p0_transpose_item(const float* W, int K, int Nsrc, int Npad, bf16* WT, int mode, int br, LAS float* scr, int item, int lane) {
    const int nblk = Npad / 32, kb = item / nblk, nb = item % nblk, k0 = 64 * kb, n0 = 32 * nb;
    const int nn = n0 + (lane & 31);
#pragma unroll 8
    for (int i = 0; i < 32; ++i) { const int kk = 2 * i + (lane >> 5); scr[kk * 33 + (lane & 31)] = (nn < Nsrc) ? W[(size_t)(k0 + kk) * Nsrc + nn] : 0.f; }
    LDS_WAIT(); asm volatile("" ::: "memory");
    const int c = lane & 7;
#pragma unroll
    for (int j = 0; j < 4; ++j) { const int n = (lane >> 3) + 8 * j; const LAS float* s = scr + (8 * c) * 33 + n;
        v4u o; o.x = pk2(s[0 * 33], s[1 * 33]); o.y = pk2(s[2 * 33], s[3 * 33]); o.z = pk2(s[4 * 33], s[5 * 33]); o.w = pk2(s[6 * 33], s[7 * 33]);
        const int drow = (mode == 1) ? gate_row(br, n0 + n) : (n0 + n);
        *(v4u*)(WT + (size_t)drow * K + k0 + 8 * c) = o; }
    LDS_WAIT(); asm volatile("" ::: "memory");
}

__device__ __forceinline__ void norm_rows_bf16(const float* X, bf16* O, const float* g, const float* mod  , int sh_idx, int sc_idx, int gw, int ngw, int lane_in) {
    int lane = lane_in; asm volatile("" : "+v"(lane));
    for (int m = gw; m < TOK; m += ngw) {
        const int b = m >> 12;
        const f32x4* xr = (const f32x4*)(X + (size_t)m * DM) + lane;
        f32x4 v[4]; float s = 0.f;
#pragma unroll
        for (int j = 0; j < 4; ++j) { v[j] = xr[64 * j]; s += (v[j].x * v[j].x + v[j].y * v[j].y) + (v[j].z * v[j].z + v[j].w * v[j].w); }
        const float rstd = 1.f / sqrtf(wave_sum(s, lane) * (1.f / DM) + NORM_EPS);
        const f32x4* gp = (const f32x4*)g + lane;
        const f32x4* shp = (const f32x4*)(mod + (size_t)b * 6144 + sh_idx * 1024) + lane;
        const f32x4* scp = (const f32x4*)(mod + (size_t)b * 6144 + sc_idx * 1024) + lane;
        unsigned long long* o8 = (unsigned long long*)(O + (size_t)m * DM) + lane;
#pragma unroll
        for (int j = 0; j < 4; ++j) { const f32x4 gg = gp[64 * j], sh = shp[64 * j], sc = scp[64 * j]; f32x4 y;
#pragma unroll
            for (int e = 0; e < 4; ++e) y[e] = v[j][e] * rstd * gg[e] * (1.f + sc[e]) + sh[e];
            o8[64 * j] = (unsigned long long)pk2(y.x, y.y) | ((unsigned long long)pk2(y.z, y.w) << 32); }
    }
}
__device__ __forceinline__ void final_norm_rows(float* X, const float* g, int gw, int ngw, int lane_in) {
    int lane = lane_in; asm volatile("" : "+v"(lane));
    for (int m = gw; m < TOK; m += ngw) {
        f32x4* xr = (f32x4*)(X + (size_t)m * DM) + lane;
        f32x4 v[4]; float s = 0.f;
#pragma unroll
        for (int j = 0; j < 4; ++j) { v[j] = xr[64 * j]; s += (v[j].x * v[j].x + v[j].y * v[j].y) + (v[j].z * v[j].z + v[j].w * v[j].w); }
        const float rstd = 1.f / sqrtf(wave_sum(s, lane) * (1.f / DM) + NORM_EPS);
        const f32x4* gp = (const f32x4*)g + lane;
#pragma unroll
        for (int j = 0; j < 4; ++j) { const f32x4 gg = gp[64 * j]; xr[64 * j] = v[j] * rstd * gg; }
    }
}

#ifndef ATT_PD
#define ATT_PD 1
#endif
constexpr int AT_K0 = 0, AT_KSLOT = 9216, AT_V0 = 18432, AT_VSLOT = 12288, AT_SEL = 43008, AT_KM = 44032, AT_END = 47872;
__device__ __forceinline__ s16x4 vtr(LAS const unsigned char* p) { return __builtin_bit_cast(s16x4, __builtin_amdgcn_ds_read_tr16_b64_v4i16((LAS s16x4*)p)); }

#define TRRD(dst, addr, off) asm volatile("ds_read_b64_tr_b16 %0, %1 offset:%2" : "=v"(dst) : "v"(addr), "i"(off) : "memory")
__device__ __forceinline__ void softmax_pv(f32x16& s0, f32x16& s1, float& l, f32x16 (&o)[2], LAS const unsigned char* vbase  ) {
    const unsigned va = (unsigned)(uintptr_t)vbase;
    s16x4 vl[2][2][2], vh[2][2][2];
#pragma unroll
    for (int db = 0; db < 2; ++db)
#pragma unroll
        for (int sub = 0; sub < 2; ++sub)
#pragma unroll
            for (int s2 = 0; s2 < 2; ++s2) { TRRD(vl[db][sub][s2], va, (32 * sub + 16 * s2) * 192 + db * 64); TRRD(vh[db][sub][s2], va, (32 * sub + 16 * s2 + 8) * 192 + db * 64); }
#if defined(PROBE_EXP2X)
    { f32x16 d0 = s0, d1 = s1;
#pragma unroll
      for (int r = 0; r < 16; ++r) { d0[r] = __builtin_amdgcn_exp2f(d0[r] * 0.5f); d1[r] = __builtin_amdgcn_exp2f(d1[r] * 0.5f); }
      asm volatile("" :: "v"(d0), "v"(d1)); }
#endif
    float la = 0.f, lb = 0.f;
#pragma unroll
    for (int r = 0; r < 16; ++r) { s0[r] = __builtin_amdgcn_exp2f(s0[r]); s1[r] = __builtin_amdgcn_exp2f(s1[r]); la += s0[r]; lb += s1[r]; }
    l += la + lb;
    bf16x8 pf[2][2];
#pragma unroll
    for (int s2 = 0; s2 < 2; ++s2) {
        v4u a, c;
        a.x = cvtpk(s0[8 * s2 + 0], s0[8 * s2 + 1]); a.y = cvtpk(s0[8 * s2 + 2], s0[8 * s2 + 3]); a.z = cvtpk(s0[8 * s2 + 4], s0[8 * s2 + 5]); a.w = cvtpk(s0[8 * s2 + 6], s0[8 * s2 + 7]);
        c.x = cvtpk(s1[8 * s2 + 0], s1[8 * s2 + 1]); c.y = cvtpk(s1[8 * s2 + 2], s1[8 * s2 + 3]); c.z = cvtpk(s1[8 * s2 + 4], s1[8 * s2 + 5]); c.w = cvtpk(s1[8 * s2 + 6], s1[8 * s2 + 7]);
        pf[0][s2] = __builtin_bit_cast(bf16x8, a); pf[1][s2] = __builtin_bit_cast(bf16x8, c);
    }
    asm volatile("s_waitcnt lgkmcnt(0)" : "+v"(vl[0][0][0]), "+v"(vl[0][0][1]), "+v"(vl[0][1][0]), "+v"(vl[0][1][1]), "+v"(vl[1][0][0]), "+v"(vl[1][0][1]), "+v"(vl[1][1][0]), "+v"(vl[1][1][1]),
                                          "+v"(vh[0][0][0]), "+v"(vh[0][0][1]), "+v"(vh[0][1][0]), "+v"(vh[0][1][1]), "+v"(vh[1][0][0]), "+v"(vh[1][0][1]), "+v"(vh[1][1][0]), "+v"(vh[1][1][1]) :: "memory");
#pragma unroll
    for (int db = 0; db < 2; ++db)
#pragma unroll
        for (int sub = 0; sub < 2; ++sub)
#pragma unroll
            for (int s2 = 0; s2 < 2; ++s2) {
                const s16x4 lo = vl[db][sub][s2], hh = vh[db][sub][s2];
                const bf16x8 vf = (bf16x8){lo[0], lo[1], lo[2], lo[3], hh[0], hh[1], hh[2], hh[3]};
                o[db] = __builtin_amdgcn_mfma_f32_32x32x16_bf16(vf, pf[sub][s2], o[db], 0, 0, 0);
            }
#if defined(PROBE_PV2X)
    { f32x16 dz;
#pragma unroll
      for (int r = 0; r < 16; ++r) dz[r] = 0.f;
#pragma unroll
      for (int db = 0; db < 2; ++db)
#pragma unroll
        for (int sub = 0; sub < 2; ++sub)
#pragma unroll
            for (int s2 = 0; s2 < 2; ++s2) {
                const s16x4 lo = vl[db][sub][s2], hh = vh[db][sub][s2];
                const bf16x8 vf = (bf16x8){lo[0], lo[1], lo[2], lo[3], hh[0], hh[1], hh[2], hh[3]};
                dz = __builtin_amdgcn_mfma_f32_32x32x16_bf16(vf, pf[sub][s2], dz, 0, 0, 0);
            }
      asm volatile("" :: "v"(dz)); }
#endif
}
__device__ __forceinline__ void split3(float x, unsigned& h, unsigned& m, unsigned& l) {
    h = f2bf(x); const float r1 = x - __uint_as_float(h << 16); m = f2bf(r1); const float r2 = r1 - __uint_as_float(m << 16); l = f2bf(r2);
}

template <int MODE>
__device__ __forceinline__ void attn_unit(LAS unsigned char* lds, int b, int h, int qb, const bf16* Qb, const bf16* Kb, const bf16* Vb, bf16* Ob, float slope,
                                          const float* kmean, float lam, float post_scale, const float* subg, const unsigned* maskw, const unsigned* nrm  ) {
    int tid_l = threadIdx.x; asm volatile("" : "+v"(tid_l)); const int tid = tid_l, lane = tid & 63, wid = __builtin_amdgcn_readfirstlane(tid >> 6), r32 = lane & 31, hi = lane >> 5;
    const int q = qb * 256 + wid * 32 + r32;
    const size_t rowg = (size_t)b * SEQ;
    const float c2 = slope * LOG2E;
    unsigned sel = 0u;
    if (MODE == 0) {
        LAS float* KM = (LAS float*)(lds + AT_KM); LAS unsigned* SEL = (LAS unsigned*)(lds + AT_SEL);
        for (int i = tid; i < qb * 64; i += 512) KM[i] = kmean[(size_t)((b * 4 + h) * 16) * 64 + i];
        __syncthreads();
        if (tid < 256) {
            const bf16* qrow = Qb + (rowg + qb * 256 + tid) * 256 + h * 64;
            float qv[64];
#pragma unroll
            for (int c = 0; c < 8; ++c) { const v4u w = *(const v4u*)(qrow + 8 * c);
                qv[8 * c + 0] = bflo(w.x); qv[8 * c + 1] = bfhi(w.x); qv[8 * c + 2] = bflo(w.y); qv[8 * c + 3] = bfhi(w.y);
                qv[8 * c + 4] = bflo(w.z); qv[8 * c + 5] = bfhi(w.z); qv[8 * c + 6] = bflo(w.w); qv[8 * c + 7] = bfhi(w.w); }
            float v1 = -INFINITY, v2 = -INFINITY, v3 = -INFINITY; int i1 = -1, i2 = -1, i3 = -1;
            for (int n = 0; n < qb; ++n) {
                float g = 0.f;
#pragma unroll
                for (int d = 0; d < 64; ++d) g = __builtin_fmaf(qv[d], KM[n * 64 + d], g);
                if (g > v1) { v3 = v2; i3 = i2; v2 = v1; i2 = i1; v1 = g; i1 = n; }
                else if (g > v2) { v3 = v2; i3 = i2; v2 = g; i2 = n; }
                else if (g > v3) { v3 = g; i3 = n; }
            }
            unsigned sm = 0u; if (i1 >= 0) sm |= 1u << i1; if (i2 >= 0) sm |= 1u << i2; if (i3 >= 0) sm |= 1u << i3;
            SEL[tid] = sm;
        }
        __syncthreads();
        sel = SEL[wid * 32 + r32];
    }
    bf16x8 qf[4];
#pragma unroll
    for (int ds = 0; ds < 4; ++ds) qf[ds] = *(const bf16x8*)(Qb + (rowg + q) * 256 + h * 64 + ds * 16 + hi * 8);
    const int skey = tid >> 3, sch = tid & 7;
    const bf16* ksrc = Kb + (rowg + skey) * 256 + h * 64 + sch * 8;
    const bf16* vsrc = Vb + (rowg + skey) * 256 + h * 64 + sch * 8;
    const int kdst = AT_K0 + skey * 144 + sch * 16, vdst = AT_V0 + skey * 192 + sch * 16;
    const int NT = 4 * qb + 4;
    const float Bq = __uint_as_float(nrm[b * 4 + h]), Bk = __uint_as_float(nrm[32 + b * 4 + h]);
#if defined(PROBE_NOSKIP)
    const float Dskip = 1e9f + 0.f * (Bq + Bk);
#else
    const float Dskip = (150.f + 2.f * sqrtf(Bq * Bk)) / c2;
#endif
    const int koff = r32 * 144 + hi * 16;
    const int vtoff = (4 * hi + ((lane & 15) >> 2)) * 192 + (16 * ((lane >> 4) & 1) + 4 * (lane & 3)) * 2;
    float l1 = 0.f, l2 = 0.f;
    f32x16 oA[2], oB[2];
#pragma unroll
    for (int r = 0; r < 16; ++r) { oA[0][r] = 0.f; oA[1][r] = 0.f; oB[0][r] = 0.f; oB[1][r] = 0.f; }
    const int qmin = qb * 256 + wid * 32, qmax = qmin + 31;
    constexpr int PD = ATT_PD;
    v4u kR[PD], vR[PD]; v2u mR[PD];
    int refpos = q;
    int minref = qb * 256;
    if (MODE == 2) {
        const unsigned* mrow = maskw + (rowg + q) * 128; int wi = q >> 5; unsigned wv = mrow[wi];
        while (wv == 0u && wi > 0) { --wi; wv = mrow[wi]; }
        refpos = 32 * wi + 31 - __clz((int)(wv | 1u));
        LAS int* MR = (LAS int*)(lds + AT_SEL);
        if (tid == 0) MR[0] = 0x7fffffff;
        __syncthreads();
        __hip_atomic_fetch_min(MR, refpos, __ATOMIC_RELAXED, __HIP_MEMORY_SCOPE_WORKGROUP);
        __syncthreads();
        minref = MR[0];
    }
    int T0 = (int)floorf(((float)minref - Dskip) * (1.f / 64.f)); T0 = T0 < 0 ? 0 : T0; T0 = __builtin_amdgcn_readfirstlane(T0);
    { const v4u k0r = *(const v4u*)(ksrc + (size_t)T0 * 64 * 256), v0r = *(const v4u*)(vsrc + (size_t)T0 * 64 * 256);
      *(LAS v4u*)(lds + kdst + (T0 & 1) * AT_KSLOT) = k0r; *(LAS v4u*)(lds + vdst + (T0 & 1) * AT_VSLOT) = v0r; }
#pragma unroll
    for (int i = 0; i < PD; ++i) { kR[i] = (v4u){0u, 0u, 0u, 0u}; vR[i] = kR[i]; mR[i] = (v2u){0u, 0u};
        if (T0 + i + 1 < NT) { kR[i] = *(const v4u*)(ksrc + (size_t)(T0 + i + 1) * 64 * 256); vR[i] = *(const v4u*)(vsrc + (size_t)(T0 + i + 1) * 64 * 256);
            if (MODE == 2) mR[i] = *(const v2u*)(maskw + (rowg + q) * 128 + 2 * (T0 + i + 1)); } }
    v2u mw = (v2u){0u, 0u};
    if (MODE == 2) mw = *(const v2u*)(maskw + (rowg + q) * 128 + 2 * T0);
    bf16x8 qaug; v4u ka0, ka1;
    { unsigned a, b2, c; split3(-c2 * (float)refpos, a, b2, c);
      v4u w; if (hi == 0) { w.x = a | (b2 << 16); w.y = c | (0x3f80u << 16); w.z = 0x3f80u | (0x3f80u << 16); w.w = 0u; }
             else { w.x = 0x3f80u | (0x3f80u << 16); w.y = 0x3f80u; w.z = 0u; w.w = 0u; }
      qaug = __builtin_bit_cast(bf16x8, w);
      split3(c2 * (float)r32, a, b2, c); ka0.x = 0x3f80u | (0x3f80u << 16); ka0.y = 0x3f80u | (a << 16); ka0.z = b2 | (c << 16); ka0.w = 0u;
      split3(c2 * (float)(r32 + 32), a, b2, c); ka1.x = ka0.x; ka1.y = 0x3f80u | (a << 16); ka1.z = b2 | (c << 16); ka1.w = 0u; }
    __syncthreads();
#pragma nounroll
    for (int t0 = T0; t0 < NT; t0 += PD) {
#pragma unroll
      for (int u = 0; u < PD; ++u) { const int t = t0 + u; if (t < NT) {
        const int slot = t & 1;
        const int k0 = 64 * t;
        bool active = (k0 <= qmax);
        bool keep = true;
        if (MODE == 0) { const int n = t >> 2; if (n < qb) { keep = ((sel >> n) & 1u) != 0u; active = (__ballot(keep) != 0ull); } }
        if (active) {
            LAS const unsigned char* ks = lds + AT_K0 + slot * AT_KSLOT + koff;
            LAS const unsigned char* vb = lds + AT_V0 + slot * AT_VSLOT + vtoff;
            const int lim = q - k0 - 4 * hi;
            const bool needmask = (k0 + 63 > qmin);
            bf16x8 kaug0, kaug1;
            { unsigned a, b2, c; split3(c2 * (float)k0, a, b2, c);
              v4u w0 = ka0, w1 = ka1; if (hi) { w0.x = a | (b2 << 16); w0.y = c; w0.z = 0u; w1 = w0; }
              kaug0 = __builtin_bit_cast(bf16x8, w0); kaug1 = __builtin_bit_cast(bf16x8, w1); }
#pragma unroll
            for (int mp = 0; mp < (MODE == 1 ? 2 : 1); ++mp) {
                f32x16 s0, s1;
#pragma unroll
                for (int r = 0; r < 16; ++r) { s0[r] = 0.f; s1[r] = 0.f; }
                s0 = __builtin_amdgcn_mfma_f32_32x32x16_bf16(kaug0, qaug, s0, 0, 0, 0);
                s1 = __builtin_amdgcn_mfma_f32_32x32x16_bf16(kaug1, qaug, s1, 0, 0, 0);
#pragma unroll
                for (int dd = 0; dd < (MODE == 1 ? 2 : 4); ++dd) { const int ds = (MODE == 1) ? (2 * mp + dd) : dd;
                    const bf16x8 a0 = *(LAS const bf16x8*)(ks + ds * 32), a1 = *(LAS const bf16x8*)(ks + 32 * 144 + ds * 32);
                    s0 = __builtin_amdgcn_mfma_f32_32x32x16_bf16(a0, qf[ds], s0, 0, 0, 0);
                    s1 = __builtin_amdgcn_mfma_f32_32x32x16_bf16(a1, qf[ds], s1, 0, 0, 0); }
#if defined(PROBE_QK2X)
                { f32x16 d0, d1;
#pragma unroll
                  for (int r = 0; r < 16; ++r) { d0[r] = 0.f; d1[r] = 0.f; }
#pragma unroll
                  for (int dd = 0; dd < (MODE == 1 ? 2 : 4); ++dd) { const int ds = (MODE == 1) ? (2 * mp + dd) : dd;
                    const bf16x8 a0 = *(LAS const bf16x8*)(ks + ds * 32 + 16), a1 = *(LAS const bf16x8*)(ks + 32 * 144 + ds * 32 + 16);
                    d0 = __builtin_amdgcn_mfma_f32_32x32x16_bf16(a0, qf[ds], d0, 0, 0, 0);
                    d1 = __builtin_amdgcn_mfma_f32_32x32x16_bf16(a1, qf[ds], d1, 0, 0, 0); }
                  asm volatile("" :: "v"(d0), "v"(d1)); }
#endif
                if (MODE == 2) {
#pragma unroll
                    for (int r = 0; r < 16; ++r) { const int pos = (r & 3) + 8 * (r >> 2) + 4 * hi;
                        if (!((mw.x >> pos) & 1u)) s0[r] = -INFINITY; if (!((mw.y >> pos) & 1u)) s1[r] = -INFINITY; }
                } else {
                    if (MODE == 0 && !keep) {
#pragma unroll
                        for (int r = 0; r < 16; ++r) { s0[r] = -INFINITY; s1[r] = -INFINITY; }
                    }
                    if (needmask) {
#pragma unroll
                        for (int r = 0; r < 16; ++r) { const int ko = (r & 3) + 8 * (r >> 2);
                            if (ko > lim) s0[r] = -INFINITY; if (ko + 32 > lim) s1[r] = -INFINITY; }
                    }
                }
                if (mp == 0) softmax_pv(s0, s1, l1, oA, vb); else softmax_pv(s0, s1, l2, oB, vb);
            }
        }
        if (t + 1 < NT) { *(LAS v4u*)(lds + kdst + (slot ^ 1) * AT_KSLOT) = kR[u]; *(LAS v4u*)(lds + vdst + (slot ^ 1) * AT_VSLOT) = vR[u];
            if (MODE == 2) mw = mR[u];
            if (t + 1 + PD < NT) { kR[u] = *(const v4u*)(ksrc + (size_t)(t + 1 + PD) * 64 * 256); vR[u] = *(const v4u*)(vsrc + (size_t)(t + 1 + PD) * 64 * 256);
                if (MODE == 2) mR[u] = *(const v2u*)(maskw + (rowg + q) * 128 + 2 * (t + 1 + PD)); } }
        __syncthreads();
#if defined(PROBE_BAR2X)
        __syncthreads();
#endif
      } }
    }
    const float l1t = l1 + shx(l1, 32, lane);
    bf16* orow = Ob + (rowg + q) * 256 + h * 64 + 4 * hi;
    if (MODE == 1) {
        const float l2t = l2 + shx(l2, 32, lane);
        const float i1 = 1.f / l1t, i2 = lam / l2t;
        float ssq = 0.f;
#pragma unroll
        for (int db = 0; db < 2; ++db)
#pragma unroll
            for (int r = 0; r < 16; ++r) { const float v = oA[db][r] * i1 - oB[db][r] * i2; oA[db][r] = v; ssq += v * v; }
        ssq += shx(ssq, 32, lane);
        const float rn = post_scale / sqrtf(ssq * (1.f / 64.f) + NORM_EPS);
#pragma unroll
        for (int db = 0; db < 2; ++db)
#pragma unroll
            for (int g4 = 0; g4 < 4; ++g4) { const f32x4 gg = *(const f32x4*)(subg + 32 * db + 8 * g4 + 4 * hi);
                v2u w; w.x = cvtpk(oA[db][4 * g4 + 0] * rn * gg[0], oA[db][4 * g4 + 1] * rn * gg[1]); w.y = cvtpk(oA[db][4 * g4 + 2] * rn * gg[2], oA[db][4 * g4 + 3] * rn * gg[3]);
                *(v2u*)(orow + 32 * db + 8 * g4) = w; }
    } else {
        const float i1 = 1.f / l1t;
#pragma unroll
        for (int db = 0; db < 2; ++db)
#pragma unroll
            for (int g4 = 0; g4 < 4; ++g4) { v2u w; w.x = cvtpk(oA[db][4 * g4 + 0] * i1, oA[db][4 * g4 + 1] * i1); w.y = cvtpk(oA[db][4 * g4 + 2] * i1, oA[db][4 * g4 + 3] * i1);
                *(v2u*)(orow + 32 * db + 8 * g4) = w; }
    }
    __syncthreads();
}

constexpr int DS_HP = 1025;
constexpr int DS_HIST_BYTES = 32 * DS_HP * 4;
constexpr int DS_BP = 129;
constexpr int DS_G = 0, DS_C = 32 * DS_BP * 4, DS_AUX = DS_HIST_BYTES;
__device__ __forceinline__ float relu_asm(float x) { return __builtin_amdgcn_fmed3f(x, 0.f, __builtin_inff()); }
__device__ __forceinline__ void dsa_scores(const bf16x8 (&iqf)[4][2], const float (&w)[4], const bf16x8 k0, const bf16x8 k1, float (&sc)[16]) {
#pragma unroll
    for (int hh = 0; hh < 4; ++hh) {
        f32x16 x;
#pragma unroll
        for (int r = 0; r < 16; ++r) x[r] = 0.f;
        x = __builtin_amdgcn_mfma_f32_32x32x16_bf16(k0, iqf[hh][0], x, 0, 0, 0);
        x = __builtin_amdgcn_mfma_f32_32x32x16_bf16(k1, iqf[hh][1], x, 0, 0, 0);
#pragma unroll
        for (int r = 0; r < 16; ++r) sc[r] = (hh == 0) ? (w[0] * relu_asm(x[r])) : __builtin_fmaf(w[hh], relu_asm(x[r]), sc[r]);
    }
}
__device__ __forceinline__ unsigned dsa_mono(float s) { const unsigned bits = __float_as_uint(s); return bits ^ ((unsigned)((int)bits >> 31) | 0x80000000u); }
__device__ __forceinline__ unsigned dsa_ckey(float s, unsigned keyidx) { return (dsa_mono(s) & 0xFFFFF000u) | (4095u - keyidx); }
__device__ __forceinline__ unsigned take_low(unsigned w, unsigned n) {
    if (n >= (unsigned)__popc(w)) return w;
    unsigned res = 0u;
    while (n > 0u) { const unsigned low = w & (0u - w); res |= low; w ^= low; --n; }
    return res;
}
template <int PASS>
__device__ __forceinline__ void dsa_hist_pass(LAS unsigned* hist, const bf16x8 (&iqf)[4][2], const float (&w)[4], const bf16* kbase, int qg, int wid, int r32, int hi, int t, unsigned P1) {
    bf16x8 nk0 = *(const bf16x8*)(kbase + (size_t)wid * 32 * 256), nk1 = *(const bf16x8*)(kbase + (size_t)wid * 32 * 256 + 16);
    const unsigned rowb = (unsigned)(r32 * DS_HP * 4);
#pragma nounroll
    for (int j = wid; j <= qg; j += 8) {
        const bf16x8 k0 = nk0, k1 = nk1;
        { const int jn = (j + 8 <= qg) ? j + 8 : j; const bf16* kp = kbase + (size_t)jn * 32 * 256; nk0 = *(const bf16x8*)kp; nk1 = *(const bf16x8*)(kp + 16); }
        float sc[16]; dsa_scores(iqf, w, k0, k1, sc);
        const int lim = t - 32 * j - 4 * hi;
        const bool diag = (j == qg);
#pragma unroll
        for (int r = 0; r < 16; ++r) {
            unsigned bin; bool ok = true;
            if (PASS == 0) { bin = dsa_mono(sc[r]) >> 21; }
            else { const unsigned ck = dsa_ckey(sc[r], 32u * (unsigned)j + (unsigned)((r & 3) + 8 * (r >> 2) + 4 * hi)); ok = (ck >> 21) == P1; bin = (ck >> 10) & 2047u; }
            unsigned addr = rowb + ((bin & 1023u) << 2);
            const unsigned inc = (bin & 1024u) ? 65536u : 1u;
            if (PASS == 0) { if (diag && ((r & 3) + 8 * (r >> 2) > lim)) addr = rowb + 4096u;
                __hip_atomic_fetch_add((LAS unsigned*)((LAS unsigned char*)hist + addr), inc, __ATOMIC_RELAXED, __HIP_MEMORY_SCOPE_WORKGROUP); }
            else { if (ok && !(diag && ((r & 3) + 8 * (r >> 2) > lim)))
                __hip_atomic_fetch_add((LAS unsigned*)((LAS unsigned char*)hist + addr), inc, __ATOMIC_RELAXED, __HIP_MEMORY_SCOPE_WORKGROUP); }
        }
    }
}
__device__ __forceinline__ void dsa_scan(LAS unsigned* hist, LAS unsigned* AUX, int pass, int wid, int lane) {
#pragma nounroll
    for (int qi = 0; qi < 4; ++qi) {
        const int qq = 4 * wid + qi;
        const unsigned K = (pass == 0) ? 256u : AUX[32 + qq];
        LAS const unsigned* hrow = hist + qq * DS_HP;
        const int wb = (2016 - 32 * lane) & 1023; const int sh = (lane < 32) ? 16 : 0;
        unsigned s = 0u;
#pragma unroll
        for (int i = 0; i < 32; ++i) { const unsigned wv = hrow[wb + ((i + lane) & 31)]; s += (wv >> sh) & 0xffffu; }
        unsigned incl = s;
#pragma unroll
        for (int o = 1; o < 64; o <<= 1) { const unsigned v = shupu(incl, o, lane); if (lane >= o) incl += v; }
        const unsigned long long bal = __ballot(incl >= K);
        const int L = __builtin_amdgcn_readfirstlane(bal ? (__ffsll((long long)bal) - 1) : 0);
        const unsigned above = (unsigned)__builtin_amdgcn_readlane((int)(incl - s), L);
        const int bin = 2047 - 32 * L - (lane & 31);
        const unsigned wv2 = hrow[bin & 1023]; const unsigned c = (lane < 32) ? ((bin & 1024) ? (wv2 >> 16) : (wv2 & 0xffffu)) : 0u;
        unsigned inc2 = c;
#pragma unroll
        for (int o = 1; o < 32; o <<= 1) { const unsigned v = shupu(inc2, o, lane); if (lane >= o) inc2 += v; }
        const unsigned long long bal2 = __ballot(lane < 32 && above + inc2 >= K);
        const int I = __builtin_amdgcn_readfirstlane(bal2 ? (__ffsll((long long)bal2) - 1) : 0);
        if (lane == I) { AUX[64 * pass + qq] = (unsigned)bin; AUX[64 * pass + 32 + qq] = K - (above + inc2 - c); }
    }
}
__device__ __forceinline__ void dsa_select_unit(LAS unsigned char* lds, int b, int qg, const bf16* IX, unsigned* MASK) {
    int tid_l = threadIdx.x; asm volatile("" : "+v"(tid_l)); const int tid = tid_l, lane = tid & 63, wid = __builtin_amdgcn_readfirstlane(tid >> 6), r32 = lane & 31, hi = lane >> 5;
    const int t = 32 * qg + r32;
    const size_t rowg = (size_t)b * SEQ;
    const bf16* qrow = IX + (rowg + t) * 256;
    bf16x8 iqf[4][2];
#pragma unroll
    for (int hh = 0; hh < 4; ++hh)
#pragma unroll
        for (int ds = 0; ds < 2; ++ds) iqf[hh][ds] = *(const bf16x8*)(qrow + 32 * hh + 16 * ds + 8 * hi);
    float w[4];
    { const v2u ww = *(const v2u*)(qrow + 160); w[0] = bflo(ww.x); w[1] = bfhi(ww.x); w[2] = bflo(ww.y); w[3] = bfhi(ww.y); }
    LAS unsigned* hist = (LAS unsigned*)lds;
    LAS unsigned* AUX = (LAS unsigned*)(lds + DS_AUX);
    const bf16* kbase = IX + (rowg + r32) * 256 + 128 + 8 * hi;
    unsigned P = 0u;
    const bool all = (qg < 8);
    if (!all) {
        for (int i = tid; i < DS_HIST_BYTES / 16; i += 512) ((LAS v4u*)lds)[i] = (v4u){0u, 0u, 0u, 0u};
        __syncthreads();
        dsa_hist_pass<0>(hist, iqf, w, kbase, qg, wid, r32, hi, t, 0u);
        __syncthreads();
        dsa_scan(hist, AUX, 0, wid, lane);
        __syncthreads();
        const unsigned P1 = AUX[r32];
        for (int i = tid; i < DS_HIST_BYTES / 16; i += 512) ((LAS v4u*)lds)[i] = (v4u){0u, 0u, 0u, 0u};
        __syncthreads();
        dsa_hist_pass<1>(hist, iqf, w, kbase, qg, wid, r32, hi, t, P1);
        __syncthreads();
        dsa_scan(hist, AUX, 1, wid, lane);
        __syncthreads();
        P = (P1 << 11) | AUX[64 + r32];
    }
    if (all) { if (tid < 32) { AUX[64 + 32 + tid] = 0u; } }
    for (int i = tid; i < (2 * 32 * DS_BP * 4) / 16; i += 512) ((LAS v4u*)lds)[i] = (v4u){0u, 0u, 0u, 0u};
    __syncthreads();
    LAS unsigned* G = (LAS unsigned*)(lds + DS_G);
    LAS unsigned* C = (LAS unsigned*)(lds + DS_C);
    bf16x8 nk0, nk1;
    { const int j0 = (wid <= qg) ? wid : 0; nk0 = *(const bf16x8*)(kbase + (size_t)j0 * 32 * 256); nk1 = *(const bf16x8*)(kbase + (size_t)j0 * 32 * 256 + 16); }
#pragma nounroll
    for (int j = wid; j <= qg; j += 8) {
        const bf16x8 k0 = nk0, k1 = nk1;
        { const int jn = (j + 8 <= qg) ? j + 8 : j; const bf16* kp = kbase + (size_t)jn * 32 * 256; nk0 = *(const bf16x8*)kp; nk1 = *(const bf16x8*)(kp + 16); }
        float sc[16]; dsa_scores(iqf, w, k0, k1, sc);
        unsigned bg = 0u, bc = 0u;
        const int lim = t - 32 * j - 4 * hi;
#pragma unroll
        for (int r = 0; r < 16; ++r) {
            const int pos = (r & 3) + 8 * (r >> 2) + 4 * hi;
            const unsigned p22 = dsa_ckey(sc[r], 32u * (unsigned)j + (unsigned)pos) >> 10;
            const bool ok = ((r & 3) + 8 * (r >> 2)) <= lim;
            if (ok && p22 > P) bg |= 1u << pos;
            if (ok && p22 == P) bc |= 1u << pos;
        }
        bg |= shxu(bg, 32, lane); bc |= shxu(bc, 32, lane);
        if (hi == 0) { G[r32 * DS_BP + j] = bg; C[r32 * DS_BP + j] = bc; }
    }
    __syncthreads();
#pragma nounroll
    for (int qi = 0; qi < 4; ++qi) {
        const int qq = 4 * wid + qi;
        const unsigned K2 = AUX[64 + 32 + qq];
        const unsigned w0 = C[qq * DS_BP + 2 * lane], w1 = C[qq * DS_BP + 2 * lane + 1];
        const unsigned pc = (unsigned)__popc(w0) + (unsigned)__popc(w1);
        unsigned incl = pc;
#pragma unroll
        for (int o = 1; o < 64; o <<= 1) { const unsigned v = shupu(incl, o, lane); if (lane >= o) incl += v; }
        const unsigned pre = incl - pc;
        unsigned need = K2 > pre ? K2 - pre : 0u;
        const unsigned t0 = take_low(w0, need); need -= (unsigned)__popc(t0);
        const unsigned t1 = take_low(w1, need);
        G[qq * DS_BP + 2 * lane] |= t0; G[qq * DS_BP + 2 * lane + 1] |= t1;
    }
    __syncthreads();
    { const int qq = tid >> 4, part = tid & 15;
        unsigned* dst = MASK + (rowg + 32 * qg + qq) * 128 + part * 8;
        v4u a, c2;
        a.x = G[qq * DS_BP + part * 8 + 0]; a.y = G[qq * DS_BP + part * 8 + 1]; a.z = G[qq * DS_BP + part * 8 + 2]; a.w = G[qq * DS_BP + part * 8 + 3];
        c2.x = G[qq * DS_BP + part * 8 + 4]; c2.y = G[qq * DS_BP + part * 8 + 5]; c2.z = G[qq * DS_BP + part * 8 + 6]; c2.w = G[qq * DS_BP + part * 8 + 7];
        *(v4u*)dst = a; *(v4u*)(dst + 4) = c2; }
    __syncthreads();
}

constexpr int PL_U = 0, PL_UP = 528, PL_D = 79 * 528 + 16  , PL_DP = 257;
__device__ __forceinline__ void pool_unit(LAS unsigned char* lds, int b, int tile, const bf16* PU, const float* wpool  , const float* pscale  , bf16* YC) {
    int tid_l = threadIdx.x; asm volatile("" : "+v"(tid_l)); const int tid = tid_l, cb = __builtin_amdgcn_readfirstlane(tid >> 6), tt = tid & 63;
    const int t0 = tile * 64; const size_t rowg = (size_t)b * SEQ;
    for (int i = tid; i < 79 * 32; i += 512) { const int rr = i >> 5, ch = i & 31; const int tok = t0 - 15 + rr;
        v4u v = (v4u){0u, 0u, 0u, 0u}; if (tok >= 0) v = *(const v4u*)(PU + (rowg + tok) * 256 + ch * 8);
        *(LAS v4u*)(lds + PL_U + rr * PL_UP + ch * 16) = v; }
    __syncthreads();
    const int g = cb >> 1, wlen = 2 << g, c0 = 32 * cb, t = t0 + tt;
    const float inv = 1.f / (float)((t + 1 < wlen) ? (t + 1) : wlen);
    LAS float* Dm = (LAS float*)(lds + PL_D);
#pragma unroll
    for (int ch = 0; ch < 4; ++ch) {
        float sum[8];
#pragma unroll
        for (int e = 0; e < 8; ++e) sum[e] = 0.f;
        float self[8];
        for (int i = 0; i < wlen; ++i) {
            const v4u v = *(LAS const v4u*)(lds + PL_U + (15 + tt - i) * PL_UP + (c0 + 8 * ch) * 2);
            const float f[8] = {bflo(v.x), bfhi(v.x), bflo(v.y), bfhi(v.y), bflo(v.z), bfhi(v.z), bflo(v.w), bfhi(v.w)};
#pragma unroll
            for (int e = 0; e < 8; ++e) { sum[e] += f[e]; if (i == 0) self[e] = f[e]; }
        }
#pragma unroll
        for (int e = 0; e < 8; ++e) Dm[tt * PL_DP + c0 + 8 * ch + e] = sum[e] * inv - self[e];
    }
    __syncthreads();
    const int e0 = 32 * (cb & 1);
    float acc[32];
#pragma unroll
    for (int e = 0; e < 32; ++e) acc[e] = 0.f;
    const float* wg = wpool + (size_t)g * 4096 + e0;
    for (int c = 0; c < 64; ++c) {
        const float dv = Dm[tt * PL_DP + 64 * g + c];
        const float* wr = wg + c * 64;
#pragma unroll
        for (int e = 0; e < 32; ++e) acc[e] = __builtin_fmaf(dv, wr[e], acc[e]);
    }
    bf16* orow = YC + (rowg + t) * 256 + 64 * g + e0;
    const float* ps = pscale + 64 * g + e0;
#pragma unroll
    for (int k = 0; k < 4; ++k) { v4u o;
        o.x = pk2(acc[8 * k + 0] * ps[8 * k + 0], acc[8 * k + 1] * ps[8 * k + 1]); o.y = pk2(acc[8 * k + 2] * ps[8 * k + 2], acc[8 * k + 3] * ps[8 * k + 3]);
        o.z = pk2(acc[8 * k + 4] * ps[8 * k + 4], acc[8 * k + 5] * ps[8 * k + 5]); o.w = pk2(acc[8 * k + 6] * ps[8 * k + 6], acc[8 * k + 7] * ps[8 * k + 7]);
        *(v4u*)(orow + 8 * k) = o; }
    __syncthreads();
}
__device__ __forceinline__ void kmean_item(int item, const bf16* AK, float* KMEAN, int wid, int lane_in) {
    int lane = lane_in; asm volatile("" : "+v"(lane));
    const int combo = item * 8 + wid; const int b = combo >> 6, h = (combo >> 4) & 3, n = combo & 15;
    const int ks = lane >> 3, ch = lane & 7;
    const bf16* p = AK + ((size_t)b * SEQ + 256 * n + ks) * 256 + 64 * h + 8 * ch;
    float s[8];
#pragma unroll
    for (int e = 0; e < 8; ++e) s[e] = 0.f;
#pragma unroll 8
    for (int j = 0; j < 32; ++j) { const v4u v = *(const v4u*)(p + (size_t)j * 8 * 256);
        s[0] += bflo(v.x); s[1] += bfhi(v.x); s[2] += bflo(v.y); s[3] += bfhi(v.y); s[4] += bflo(v.z); s[5] += bfhi(v.z); s[6] += bflo(v.w); s[7] += bfhi(v.w); }
#pragma unroll
    for (int e = 0; e < 8; ++e) { s[e] += shx(s[e], 8, lane); s[e] += shx(s[e], 16, lane); s[e] += shx(s[e], 32, lane); }
    if (ks == 0) { float* o = KMEAN + (size_t)combo * 64 + 8 * ch;
        *(f32x4*)o = (f32x4){s[0], s[1], s[2], s[3]} * (1.f / 256.f); *(f32x4*)(o + 4) = (f32x4){s[4], s[5], s[6], s[7]} * (1.f / 256.f); }
}

__device__ __forceinline__ void norm_unit(LAS unsigned char* lds, int n, const bf16* PROJ, size_t TS, unsigned* NRM  ) {
    int tid_l = threadIdx.x; asm volatile("" : "+v"(tid_l)); const int tid = tid_l, lane = tid & 63, wid = __builtin_amdgcn_readfirstlane(tid >> 6);
    const int a = n >> 6, rem = n & 63, sq = rem >> 5, b = (rem >> 2) & 7, c = rem & 3;
    const int tile = (a == 0 ? 0 : (a == 1 ? 3 : 7)) + sq;
    const int row = tid >> 1, hp = tid & 1;
    float ss[2] = {0.f, 0.f};
#pragma unroll
    for (int rr = 0; rr < 4; ++rr) {
        const bf16* p = PROJ + (size_t)tile * TS + ((size_t)b * SEQ + 1024 * c + 256 * rr + row) * 256 + 128 * hp;
#pragma unroll
        for (int hh = 0; hh < 2; ++hh) { float acc = 0.f;
#pragma unroll
            for (int i = 0; i < 8; ++i) { const v4u v = *(const v4u*)(p + 64 * hh + 8 * i);
                const float f0 = bflo(v.x), f1 = bfhi(v.x), f2 = bflo(v.y), f3 = bfhi(v.y), f4 = bflo(v.z), f5 = bfhi(v.z), f6 = bflo(v.w), f7 = bfhi(v.w);
                acc += (f0 * f0 + f1 * f1) + (f2 * f2 + f3 * f3) + (f4 * f4 + f5 * f5) + (f6 * f6 + f7 * f7); }
            ss[hh] = fmaxf(ss[hh], acc); }
    }
#pragma unroll
    for (int o = 2; o < 64; o <<= 1) { ss[0] = fmaxf(ss[0], shx(ss[0], o, lane)); ss[1] = fmaxf(ss[1], shx(ss[1], o, lane)); }
    LAS float* R = (LAS float*)lds;
    if (lane < 2) { R[wid * 4 + 2 * hp] = ss[0]; R[wid * 4 + 2 * hp + 1] = ss[1]; }
    __syncthreads();
    if (tid < 4) { float m = R[tid];
#pragma unroll
        for (int w2 = 1; w2 < 8; ++w2) m = fmaxf(m, R[w2 * 4 + tid]);
        __hip_atomic_fetch_max(NRM + ((a * 2 + sq) * 8 + b) * 4 + tid, __float_as_uint(m * 1.0001f), __ATOMIC_RELAXED, __HIP_MEMORY_SCOPE_AGENT); }
    __syncthreads();
}

__device__ __forceinline__ float alibi_slope(int idx  ) { return exp2f(-8.f * (float)idx / 12.f); }

__device__ __forceinline__ void p0_prologue(const Args& A, LAS unsigned char* lds, int vcu, int G) {
    int tid_l = threadIdx.x; asm volatile("" : "+v"(tid_l)); const int tid = tid_l, lane = tid & 63, wid = __builtin_amdgcn_readfirstlane(tid >> 6);
    unsigned char* ws = A.ws;
    LAS float* cact = (LAS float*)lds;
    LAS float* red = (LAS float*)(lds + 32768);
    float* MOD = (float*)(ws + WS_MOD);
    if ((int)blockIdx.x < 192) {
        for (int i = tid; i < 8192; i += 512) { const int bb = i >> 10, k = i & 1023; const float v = A.c[i]; cact[k * 8 + bb] = v / (1.f + __expf(-v)); }
        __syncthreads();
        for (int u = blockIdx.x; u < 192; u += G) {
            const int l = u / 96, n0 = (u % 96) * 64;
            const float* wp = A.w_ada + ((size_t)l * 1024 + 128 * wid) * 6144 + n0 + lane;
            float acc[8];
#pragma unroll
            for (int bb = 0; bb < 8; ++bb) acc[bb] = 0.f;
#pragma unroll 8
            for (int k = 0; k < 128; ++k) {
                const float wv = wp[(size_t)k * 6144];
                const f32x4 c0 = *(LAS const f32x4*)(cact + (128 * wid + k) * 8), c1 = *(LAS const f32x4*)(cact + (128 * wid + k) * 8 + 4);
                acc[0] += c0[0] * wv; acc[1] += c0[1] * wv; acc[2] += c0[2] * wv; acc[3] += c0[3] * wv;
                acc[4] += c1[0] * wv; acc[5] += c1[1] * wv; acc[6] += c1[2] * wv; acc[7] += c1[3] * wv;
            }
#pragma unroll
            for (int bb = 0; bb < 8; ++bb) red[(wid * 8 + bb) * 64 + lane] = acc[bb];
            __syncthreads();
            { const int bb = wid; float s = A.b_ada[(size_t)l * 6144 + n0 + lane];
#pragma unroll
                for (int w2 = 0; w2 < 8; ++w2) s += red[(w2 * 8 + bb) * 64 + lane];
                MOD[((size_t)l * 8 + bb) * 6144 + n0 + lane] = s; }
            __syncthreads();
        }
    }
    __syncthreads();
    LAS float* scr = (LAS float*)(lds + wid * 16384);
    const int gw = vcu * NWAVES + wid, NGW = G * NWAVES;
    constexpr int I_IN = 16 * (NPROJ_PAD / 32), I_G1 = 16 * 32, I_BR1 = 4 * 32, I_OUT = 16 * 32, I_F1 = 16 * 128, I_F2 = 64 * 32;
    constexpr int I_LAYER = I_IN + 4 * I_G1 + 4 * I_BR1 + I_OUT + I_F1 + I_F2;
    for (int it = gw; it < 2 * I_LAYER; it += NGW) {
        const int l = it / I_LAYER; int r = it % I_LAYER;
        bf16* WL = (bf16*)(ws + WS_W) + (size_t)l * W_LAYER;
        if (r < I_IN) { p0_transpose_item(A.w_in + (size_t)l * DM * NPROJ, DM, NPROJ, NPROJ_PAD, WL + W_IN, 0, 0, scr, r, lane); continue; } r -= I_IN;
        if (r < 4 * I_G1) { const int br = r / I_G1; p0_transpose_item(A.w_gate + ((size_t)l * 4 + br) * DM * DM, DM, DM, DM, WL + W_GATE, 1, br, scr, r % I_G1, lane); continue; } r -= 4 * I_G1;
        if (r < 4 * I_BR1) { const int br = r / I_BR1; p0_transpose_item(A.w_branch + ((size_t)l * 4 + br) * 256 * DM, 256, DM, DM, WL + W_BR + (size_t)br * DM * 256, 0, 0, scr, r % I_BR1, lane); continue; } r -= 4 * I_BR1;
        if (r < I_OUT) { p0_transpose_item(A.w_out + (size_t)l * DM * DM, DM, DM, DM, WL + W_OUT, 0, 0, scr, r, lane); continue; } r -= I_OUT;
        if (r < I_F1) { p0_transpose_item(A.w_ff1 + (size_t)l * DM * FF, DM, FF, FF, WL + W_FF1, 0, 0, scr, r, lane); continue; } r -= I_F1;
        p0_transpose_item(A.w_ff2 + (size_t)l * FF * DM, FF, DM, DM, WL + W_FF2, 0, 0, scr, r, lane);
    }
}

__device__ __forceinline__ int wq_next(gu32* ctr, volatile LAS unsigned* slot) {
    if (threadIdx.x == 0) *slot = __hip_atomic_fetch_add(ctr, 1u, RLX_AGENT);
    __syncthreads();
    const int item = (int)*slot;
    __syncthreads();
    return item;
}

struct ZOrder {
    pg8::StaticOrder base;
    __device__ __forceinline__ bool next(int i, pg8::Unit& u) const { if (!base.next(i, u)) return false; u.pn += 4 * (u.pm >> 7); return true; }
    __device__ __forceinline__ void a_ready(const pg8::Unit&) const {}
    __device__ __forceinline__ void done(const pg8::Unit&) const {}
};

__global__ void __launch_bounds__(NWAVES * 64, 2) hybrid_fwd(Args args) {
    extern __shared__ __attribute__((aligned(16))) unsigned char lds_raw[];
    LAS unsigned char* lds = (LAS unsigned char*)lds_raw;
#define PHASE_IDS int tid_p = threadIdx.x; asm volatile("" : "+v"(tid_p)); const int lane = tid_p & 63, wid = __builtin_amdgcn_readfirstlane(tid_p >> 6); const int gw = vcu * NWAVES + wid, ngw = G * NWAVES; (void)lane; (void)gw; (void)ngw;
    const int G = gridDim.x; const int bx = blockIdx.x; const int vcu = (G % 8 == 0) ? (bx % 8) * (G / 8) + bx / 8 : bx;
    unsigned char* ws = args.ws;
    gu32* ctl = (gu32*)(ws + WS_CTL);
    volatile LAS unsigned* MISC = (volatile LAS unsigned*)(lds + LDSCTL_OFF);
    for (int u = threadIdx.x; u < (LDS_BYTES - LDSCTL_OFF) / 4; u += NWAVES * 64) ((LAS unsigned*)(lds + LDSCTL_OFF))[u] = 0u;
    __syncthreads();
    const int lo = args.ph_lo, hi = args.ph_hi;
    XcdBarrier bar; bar.bar = (unsigned*)(ctl + CW_BAR) + args.li * XCD_BAR_WORDS; bar.x = 0; bar.st = nullptr;
    if (hi - lo > 1) bar = xcd_barrier_post((unsigned*)(ctl + CW_BAR) + args.li * XCD_BAR_WORDS, MISC + 8);
#ifndef PHASE_OFF
#define PHASE_OFF 0
#endif
#define IN(k) (lo <= (k) && (k) < hi && !((PHASE_OFF >> ((k) == 0 ? 0 : (k) == 21 ? 11 : (((k) - 1) % 10) + 1)) & 1))
#ifndef REPEAT_MASK
#define REPEAT_MASK 0
#endif
#define NREP(bit) (((REPEAT_MASK >> (bit)) & 1) ? 2 : 1)
#define SEAM(k) do { if (IN(k) && IN((k) + 1)) xcd_barrier(bar); } while (0)
    float* MOD = (float*)(ws + WS_MOD);
    float* KMEAN = (float*)(ws + WS_KMEAN);
    unsigned* MASK = (unsigned*)(ws + WS_MASK);
    bf16* H = (bf16*)(ws + WS_H);
    bf16* Y = (bf16*)(ws + WS_Y);
    bf16* MERGED = (bf16*)(ws + WS_Y);
    bf16* PROJ = (bf16*)(ws + WS_R);
    bf16* Z = (bf16*)(ws + WS_R);
    bf16* U = (bf16*)(ws + WS_R);
    float* XR = args.out;
    constexpr size_t TS = (size_t)TOK * 256;
    volatile LAS unsigned* wqslot = MISC + 16;

    if (IN(0)) { p0_prologue(args, lds, vcu, G); }
    SEAM(0);

#pragma nounroll
    for (int l = 0; l < NL; ++l) {
        const int pb = 1 + 10 * l;
        const float* modl = MOD + (size_t)l * 8 * 6144;
        const bf16* WL = (const bf16*)(ws + WS_W) + (size_t)l * W_LAYER;
        const float* xin = (l == 0) ? args.x : XR;
        if (IN(pb + 0)) for (int rep = 0; rep < NREP(1); ++rep) { PHASE_IDS norm_rows_bf16(xin, H, args.norm1_g + (size_t)l * DM, modl, 0, 1, gw, ngw, lane); }
        SEAM(pb + 0);
        if (IN(pb + 1)) for (int rep = 0; rep < NREP(2); ++rep) {
            pg8::Gemm g{H, WL + W_IN, TOK, NPROJ_PAD, DM}; pg8::StaticOrder S; S.init(TOK, NPROJ_PAD, G, bx);
            pg8::EpiProj E{PROJ, TS};
            pg8::gemm_phase<pg8::EpiProj, pg8::StaticOrder, true, true>(lds, g, S, E);
        }
        SEAM(pb + 1);
        unsigned* NRM = (unsigned*)(ctl + CW_NRM) + l * 192;
        if (IN(pb + 2)) for (int rep = 0; rep < NREP(3); ++rep) {
            gu32* ctr = ctl + CW_WQ + (l * 2 + 0 + 4 * rep) * 64;
            for (;;) {
                const int item = wq_next(ctr, wqslot);
                if (item >= 1024 + 512 + 64 + 192) break;
                if (item < 1024) { const int qg = 127 - (item >> 3), b = item & 7;
                    dsa_select_unit(lds, b, qg, PROJ + 10 * TS, MASK);
                } else if (item < 1536) { const int i2 = item - 1024; const int b = i2 >> 6, tile = i2 & 63;
                    pool_unit(lds, b, tile, PROJ + 6 * TS, args.w_pool + (size_t)l * 4 * 4096, args.pool_scale + (size_t)l * 256, Y + 2 * TS);
                } else if (item < 1600) { PHASE_IDS kmean_item(item - 1536, PROJ + 1 * TS, KMEAN, wid, lane);
                } else { norm_unit(lds, item - 1600, PROJ, TS, NRM); }
            }
        }
        SEAM(pb + 2);
        if (IN(pb + 3)) for (int rep = 0; rep < NREP(4); ++rep) {
            gu32* ctr = ctl + CW_WQ + (l * 2 + 1 + 4 * rep) * 64;
            const float li = 0.8f - 0.6f * __expf(-0.3f * (float)l);
            const float* dl = args.diff_lambda + (size_t)l * 128;
            float d1 = 0.f, d2 = 0.f;
            for (int i = 0; i < 32; ++i) { d1 += dl[i] * dl[32 + i]; d2 += dl[64 + i] * dl[96 + i]; }
            const float lam = __expf(d1) - __expf(d2) + li;
            for (;;) {
                const int item = wq_next(ctr, wqslot);
                if (item >= 1536) break;
                const int ty = item % 3, rest = item / 3; const int qb = 15 - (rest >> 5), bh = rest & 31, b = bh >> 2, h = bh & 3;
                if (ty == 0) attn_unit<1>(lds, b, h, qb, PROJ + 3 * TS, PROJ + 4 * TS, PROJ + 5 * TS, Y + 1 * TS, alibi_slope(3 * h + 2), nullptr, lam, 1.f - li, args.diff_subln_g + (size_t)l * 64, nullptr, NRM + 64);
                else if (ty == 1) attn_unit<0>(lds, b, h, qb, PROJ + 0 * TS, PROJ + 1 * TS, PROJ + 2 * TS, Y + 0 * TS, alibi_slope(3 * h + 1), KMEAN, 0.f, 0.f, nullptr, nullptr, NRM);
                else              attn_unit<2>(lds, b, h, qb, PROJ + 7 * TS, PROJ + 8 * TS, PROJ + 9 * TS, Y + 3 * TS, alibi_slope(3 * h + 3), nullptr, 0.f, 0.f, nullptr, MASK, NRM + 128);
            }
        }
        SEAM(pb + 3);
        if (IN(pb + 4)) for (int rep = 0; rep < NREP(5); ++rep) {
            int kz = 256; asm volatile("" : "+s"(kz)); pg8::Gemm g{Y, WL + W_BR, 4 * TOK, 4096, kz}; ZOrder S; S.base.init(4 * TOK, DM, G, bx);
            pg8::EpiZ E{Z};
            pg8::gemm_phase<pg8::EpiZ, ZOrder, true, true>(lds, g, S, E);
        }
        SEAM(pb + 4);
        if (IN(pb + 5)) for (int rep = 0; rep < NREP(6); ++rep) {
            pg8::Gemm g{H, WL + W_GATE, TOK, 4096, DM}; pg8::StaticOrder S; S.init(TOK, 4096, G, bx);
            pg8::EpiGate E{Z, args.b_gate + (size_t)l * 4 * DM, MERGED};
            pg8::gemm_phase<pg8::EpiGate, pg8::StaticOrder, true, true>(lds, g, S, E);
        }
        SEAM(pb + 5);
        if (IN(pb + 6)) for (int rep = 0; rep < NREP(7); ++rep) {
            pg8::Gemm g{MERGED, WL + W_OUT, TOK, DM, DM}; pg8::StaticOrder S; S.init(TOK, DM, G, bx);
            pg8::EpiResid E{xin, rep ? (float*)(ws + WS_R) : XR, modl + 2 * 1024};
            pg8::gemm_phase<pg8::EpiResid, pg8::StaticOrder, true, true>(lds, g, S, E);
        }
        SEAM(pb + 6);
        if (IN(pb + 7)) for (int rep = 0; rep < NREP(8); ++rep) { PHASE_IDS norm_rows_bf16(XR, H, args.norm2_g + (size_t)l * DM, modl, 3, 4, gw, ngw, lane); }
        SEAM(pb + 7);
        if (IN(pb + 8)) for (int rep = 0; rep < NREP(9); ++rep) {
            pg8::Gemm g{H, WL + W_FF1, TOK, FF, DM}; pg8::StaticOrder S; S.init(TOK, FF, G, bx);
            pg8::EpiRelu2 E{U, FF};
            pg8::gemm_phase<pg8::EpiRelu2, pg8::StaticOrder, true, true>(lds, g, S, E);
        }
        SEAM(pb + 8);
        if (IN(pb + 9)) for (int rep = 0; rep < NREP(10); ++rep) {
            pg8::Gemm g{U, WL + W_FF2, TOK, DM, FF}; pg8::StaticOrder S; S.init(TOK, DM, G, bx);
            pg8::EpiResid E{XR, rep ? (float*)(ws + WS_MASK) : XR, modl + 5 * 1024};
            pg8::gemm_phase<pg8::EpiResid, pg8::StaticOrder, true, true>(lds, g, S, E);
        }
        SEAM(pb + 9);
    }
    if (IN(21)) { PHASE_IDS final_norm_rows(XR, args.final_g, gw, ngw, lane); }
#undef IN
#undef SEAM
}

#ifndef MK_SPLIT
#define MK_SPLIT 0
#endif
extern "C" void kernel_launch(void* const* d_in, const int* in_sizes, int n_in, void* d_out, int out_size, void* d_ws, size_t ws_size, hipStream_t stream) {
    static int grid = 0;
    if (grid == 0) {
        if (n_in != 18 || in_sizes[0] != TOK * DM || out_size != TOK * DM || ws_size < WS_END) { fprintf(stderr, "kernel_launch: unexpected shapes (n_in %d, in0 %d, out %d, ws %zu)\n", n_in, n_in > 0 ? in_sizes[0] : -1, out_size, ws_size); grid = -1; return; }
        int dev = 0, cus = 0, per_cu = 0;
        if (hipGetDevice(&dev) != hipSuccess || hipDeviceGetAttribute(&cus, hipDeviceAttributeMultiprocessorCount, dev) != hipSuccess) { grid = -1; return; }
        if (hipFuncSetAttribute((const void*)hybrid_fwd, hipFuncAttributeMaxDynamicSharedMemorySize, LDS_BYTES) != hipSuccess) { fprintf(stderr, "kernel_launch: hipFuncSetAttribute failed\n"); grid = -1; return; }
        if (hipOccupancyMaxActiveBlocksPerMultiprocessor(&per_cu, (const void*)hybrid_fwd, NWAVES * 64, LDS_BYTES) != hipSuccess || per_cu < 1) fprintf(stderr, "kernel_launch: occupancy query reports %d\n", per_cu);
        (void)hipGetLastError();
        grid = cus;
    }
    if (grid < 0) return;
    if (hipMemsetAsync((char*)d_ws + WS_CTL, 0, CTL_ZERO_BYTES, stream) != hipSuccess) return;
    Args a{};
    const float** ap = (const float**)&a;
    for (int i = 0; i < 18; ++i) ap[i] = (const float*)d_in[i];
    a.out = (float*)d_out; a.ws = (unsigned char*)d_ws; a.pad = 0;
#if MK_SPLIT
    for (int p = 0; p < NPHASE; ++p) { a.ph_lo = p; a.ph_hi = p + 1; a.li = 0;
        hipLaunchKernelGGL(hybrid_fwd, dim3(grid), dim3(NWAVES * 64), LDS_BYTES, stream, a); }
#else
    a.ph_lo = 0; a.ph_hi = NPHASE; a.li = 0;
    hipLaunchKernelGGL(hybrid_fwd, dim3(grid), dim3(NWAVES * 64), LDS_BYTES, stream, a);
#endif
}
```

```cpp
#include <hip/hip_runtime.h>
#include <cstdio>
#include <cstdint>
namespace pg8 {
#define PG8_LAS __attribute__((address_space(3)))
typedef unsigned short bf16_t;
typedef short bf16x8 __attribute__((ext_vector_type(8)));
typedef float f32x4 __attribute__((ext_vector_type(4)));
typedef unsigned u32x4 __attribute__((ext_vector_type(4)));
constexpr int BM = 256, BK = 64, HALF = 128, HTB = HALF * BK * 2  , STAGE_BYTES = 8 * HTB, NXCD = 8, WGM = 8;

__host__ __device__ __forceinline__ int lds_byte(int r, int c) { const int st = (r >> 4) * 2 + (c >> 5), rr = r & 15, cc = c & 31, ob = rr * 64 + cc * 2; return st * 1024 + (ob ^ (((ob >> 9) & 1) << 5)); }
__host__ __device__ __forceinline__ void stage_rc(int b, int& R, int& C) { const int st = b / 1024, sb = b % 1024, swz = sb ^ (((sb >> 9) & 1) << 5); R = (st >> 1) * 16 + swz / 64; C = (st & 1) * 32 + (swz % 64) / 2; }
__host__ __device__ __forceinline__ int perm32(int rho) { const int n = rho >> 4, i = rho & 15; return 8 * (i >> 2) + 4 * n + (i & 3); }

struct Unit { int pm, pn; };
struct Gemm { const bf16_t* A; const bf16_t* Bt; int M, N, K; };

struct StaticOrder {
    int nM, nN, nwg, G, c;
    __host__ __device__ void init(int M, int N, int G_, int c_) { nM = M / BM; nN = N / BM; nwg = nM * nN; G = G_; c = c_; }
    __host__ __device__ bool next(int i, Unit& u) const {
        const long L = (long)i * G + c; if (L >= nwg) return false;
        int wgid = (int)L; { const int q = nwg / NXCD, r = nwg % NXCD, xcd = wgid % NXCD, off = wgid / NXCD; wgid = (xcd < r ? xcd * (q + 1) : r * (q + 1) + (xcd - r) * q) + off; }
        const int nig = WGM * nN, gid = wgid / nig, fm = gid * WGM, gsz = (nM - fm) < WGM ? (nM - fm) : WGM;
        u.pm = fm + ((wgid % nig) % gsz); u.pn = (wgid % nig) / gsz; return true;
    }
    __device__ __forceinline__ void a_ready(const Unit&) const {}
    __device__ __forceinline__ void done(const Unit&) const {}
};

__device__ __forceinline__ unsigned cvt_pk_bf16(float lo, float hi) { unsigned r; asm volatile("v_cvt_pk_bf16_f32 %0, %1, %2" : "=v"(r) : "v"(lo), "v"(hi)); return r; }
typedef unsigned u32x2 __attribute__((ext_vector_type(2)));
constexpr int TT = 32768;
constexpr float QS64 = 0.125f * 1.4426950408889634f;
constexpr float QS32 = 0.17677669529663687f * 1.4426950408889634f;

struct EpiProj {
    static constexpr bool PERM = true, AFTER_DRAIN = false;
    bf16_t* O; size_t tile_stride;
    __device__ __forceinline__ void operator()(const f32x4 (&acc)[2][2][4][2], const Unit& u, int wr, int wc, int fr, int fq) const {
        const int row0 = u.pm * BM + wr * 64 + fr; bf16_t* base = O + (size_t)u.pn * tile_stride;
        float sc = 1.f; if (u.pn == 0 || u.pn == 7) sc = QS64; else if (u.pn == 3) sc = QS32;
        const int col0 = wc * 32 + 8 * fq;
#pragma unroll
        for (int ai = 0; ai < 2; ++ai)
#pragma unroll
            for (int m = 0; m < 4; ++m) { bf16_t* rowp = base + (size_t)(row0 + ai * HALF + m * 16) * 256 + col0;
#pragma unroll
                for (int bj = 0; bj < 2; ++bj) { const f32x4 v0 = acc[ai][bj][m][0] * sc, v1 = acc[ai][bj][m][1] * sc;
                    u32x4 w; w.x = cvt_pk_bf16(v0[0], v0[1]); w.y = cvt_pk_bf16(v0[2], v0[3]); w.z = cvt_pk_bf16(v1[0], v1[1]); w.w = cvt_pk_bf16(v1[2], v1[3]);
                    *(u32x4*)(rowp + bj * HALF) = w; } }
    }
};
struct EpiZ {
    static constexpr bool PERM = true, AFTER_DRAIN = false;
    bf16_t* O;
    __device__ __forceinline__ void operator()(const f32x4 (&acc)[2][2][4][2], const Unit& u, int wr, int wc, int fr, int fq) const {
        const int row0 = u.pm * BM + wr * 64 + fr; const int col0 = (u.pn & 3) * BM + wc * 32 + 8 * fq;
#pragma unroll
        for (int ai = 0; ai < 2; ++ai)
#pragma unroll
            for (int m = 0; m < 4; ++m) { bf16_t* rowp = O + (size_t)(row0 + ai * HALF + m * 16) * 1024 + col0;
#pragma unroll
                for (int bj = 0; bj < 2; ++bj) { const f32x4 v0 = acc[ai][bj][m][0], v1 = acc[ai][bj][m][1];
                    u32x4 w; w.x = cvt_pk_bf16(v0[0], v0[1]); w.y = cvt_pk_bf16(v0[2], v0[3]); w.z = cvt_pk_bf16(v1[0], v1[1]); w.w = cvt_pk_bf16(v1[2], v1[3]);
                    *(u32x4*)(rowp + bj * HALF) = w; } }
    }
};
struct EpiRelu2 {
    static constexpr bool PERM = true, AFTER_DRAIN = false;
    bf16_t* O; int ldc;
    __device__ __forceinline__ void operator()(const f32x4 (&acc)[2][2][4][2], const Unit& u, int wr, int wc, int fr, int fq) const {
        const int row0 = u.pm * BM + wr * 64 + fr; const int col0 = u.pn * BM + wc * 32 + 8 * fq;
#pragma unroll
        for (int ai = 0; ai < 2; ++ai)
#pragma unroll
            for (int m = 0; m < 4; ++m) { bf16_t* rowp = O + (size_t)(row0 + ai * HALF + m * 16) * ldc + col0;
#pragma unroll
                for (int bj = 0; bj < 2; ++bj) { f32x4 v0 = acc[ai][bj][m][0], v1 = acc[ai][bj][m][1];
#pragma unroll
                    for (int j = 0; j < 4; ++j) { const float a = fmaxf(v0[j], 0.f), b = fmaxf(v1[j], 0.f); v0[j] = a * a; v1[j] = b * b; }
                    u32x4 w; w.x = cvt_pk_bf16(v0[0], v0[1]); w.y = cvt_pk_bf16(v0[2], v0[3]); w.z = cvt_pk_bf16(v1[0], v1[1]); w.w = cvt_pk_bf16(v1[2], v1[3]);
                    *(u32x4*)(rowp + bj * HALF) = w; } }
    }
};
struct EpiResid {
    static constexpr bool PERM = false, AFTER_DRAIN = false;
    const float* base; float* out; const float* gate;
    __device__ __forceinline__ void operator()(const f32x4 (&acc)[2][2][4][2], const Unit& u, int wr, int wc, int fr, int fq) const {
        const int row0 = u.pm * BM + wr * 64 + fr; const int col0 = u.pn * BM + wc * 32 + 4 * fq;
        const float* gp = gate + (size_t)(u.pm >> 4) * 6144 + col0;
        f32x4 gv[2][2];
#pragma unroll
        for (int bj = 0; bj < 2; ++bj)
#pragma unroll
            for (int n = 0; n < 2; ++n) gv[bj][n] = *(const f32x4*)(gp + bj * HALF + n * 16);
#pragma unroll
        for (int ai = 0; ai < 2; ++ai)
#pragma unroll
            for (int m = 0; m < 4; ++m) { const size_t off = (size_t)(row0 + ai * HALF + m * 16) * 1024 + col0;
#pragma unroll
                for (int bj = 0; bj < 2; ++bj)
#pragma unroll
                    for (int n = 0; n < 2; ++n) { const f32x4 bs = *(const f32x4*)(base + off + bj * HALF + n * 16);
                        *(f32x4*)(out + off + bj * HALF + n * 16) = bs + gv[bj][n] * acc[ai][bj][m][n]; }
                if (m & 1) asm volatile("" ::: "memory"); }
    }
};
struct EpiGate {
    static constexpr bool PERM = true, AFTER_DRAIN = false;
    const bf16_t* Z; const float* bg; bf16_t* O;
    __device__ __forceinline__ void operator()(const f32x4 (&acc)[2][2][4][2], const Unit& u, int wr, int wc, int fr, int fq) const {
        const int row0 = u.pm * BM + wr * 64 + fr; const int mc0 = u.pn * 64 + wc * 16 + 4 * fq;
        f32x4 bv[2][2];
#pragma unroll
        for (int bj = 0; bj < 2; ++bj)
#pragma unroll
            for (int n = 0; n < 2; ++n) bv[bj][n] = *(const f32x4*)(bg + (2 * bj + n) * 1024 + mc0);
#pragma unroll
        for (int ai = 0; ai < 2; ++ai)
#pragma unroll
            for (int m = 0; m < 4; ++m) { const size_t row = (size_t)(row0 + ai * HALF + m * 16);
                f32x4 sum = (f32x4){0.f, 0.f, 0.f, 0.f};
#pragma unroll
                for (int bj = 0; bj < 2; ++bj)
#pragma unroll
                    for (int n = 0; n < 2; ++n) { const u32x2 zr = *(const u32x2*)(Z + ((size_t)(2 * bj + n) * TT + row) * 1024 + mc0);
                        const f32x4 x = acc[ai][bj][m][n] + bv[bj][n]; f32x4 zz;
                        zz[0] = __uint_as_float(zr.x << 16); zz[1] = __uint_as_float(zr.x & 0xffff0000u); zz[2] = __uint_as_float(zr.y << 16); zz[3] = __uint_as_float(zr.y & 0xffff0000u);
#pragma unroll
                        for (int j = 0; j < 4; ++j) { const float g = __builtin_amdgcn_rcpf(1.f + __builtin_amdgcn_exp2f(-1.4426950408889634f * x[j])); sum[j] += g * zz[j]; } }
                u32x2 w; w.x = cvt_pk_bf16(sum[0], sum[1]); w.y = cvt_pk_bf16(sum[2], sum[3]);
                *(u32x2*)(O + row * 1024 + mc0) = w; }
    }
};
template <class Epi, class Sched, bool ALIGN_EPI = false, bool SP2 = false>
__device__ __forceinline__ void gemm_phase(PG8_LAS unsigned char* lds, const Gemm g, const Sched& S, const Epi& E) {
    int tid_l = threadIdx.x; asm volatile("" : "+v"(tid_l)); const int tid = tid_l, wid = __builtin_amdgcn_readfirstlane(tid >> 6), lane = tid & 63, wr = wid >> 2, wc = wid & 3, fr = lane & 15, fq = lane >> 4;
    const int K = g.K, nt = K / BK;
    unsigned voffA[2], voffB[2];
#pragma unroll
    for (int i = 0; i < 2; ++i) { int R, C; stage_rc(tid * 16 + i * 8192, R, C); const int Rb = Epi::PERM ? ((R & ~31) + perm32(R & 31)) : R;
        voffA[i] = (unsigned)(R * K + C) * 2u; voffB[i] = (unsigned)(Rb * K + C) * 2u; }
    const size_t kstep = (size_t)(BK * 2);
    const size_t hstep = (size_t)HALF * K * 2;
    const size_t tstep = 2 * hstep;
    const unsigned ldsw = (unsigned)wid * 1024u;
    const int aoff = lds_byte(wr * 64 + fr, fq * 8), boff = lds_byte(wc * 32 + fr, fq * 8);
#define PG8_SA(b, h) (((b) * 2 + (h)) * HTB)
#define PG8_SB(b, h) ((4 + (b) * 2 + (h)) * HTB)
#define PG8_STAGE(bufoff, gbase, voff) do { _Pragma("unroll") for (int _i = 0; _i < 2; ++_i) \
        __builtin_amdgcn_global_load_lds((const unsigned*)((const char*)(gbase) + (voff)[_i]), (PG8_LAS unsigned*)(lds + (bufoff) + ldsw + _i * 8192), 16, 0, 0); } while (0)
#define PG8_LDA(dst, b, h) do { _Pragma("unroll") for (int m = 0; m < 4; ++m) _Pragma("unroll") for (int k = 0; k < 2; ++k) dst[m][k] = *(const PG8_LAS bf16x8*)(lds + PG8_SA(b, h) + aoff + m * 2048 + k * 1024); } while (0)
#define PG8_LDB(dst, b, h) do { _Pragma("unroll") for (int n = 0; n < 2; ++n) _Pragma("unroll") for (int k = 0; k < 2; ++k) dst[n][k] = *(const PG8_LAS bf16x8*)(lds + PG8_SB(b, h) + boff + n * 2048 + k * 1024); } while (0)
#define PG8_MMA(ai, bj, At, Bt) do { __builtin_amdgcn_s_setprio(1); _Pragma("unroll") for (int m = 0; m < 4; ++m) _Pragma("unroll") for (int n = 0; n < 2; ++n) _Pragma("unroll") for (int k = 0; k < 2; ++k) \
        acc[ai][bj][m][n] = __builtin_amdgcn_mfma_f32_16x16x32_bf16(Bt[n][k], At[m][k], acc[ai][bj][m][n], 0, 0, 0); __builtin_amdgcn_s_setprio(0); } while (0)
#define PG8_WAIT_V(n) asm volatile("s_waitcnt vmcnt(" #n ")" ::: "memory")
#define PG8_WAIT_L(n) asm volatile("s_waitcnt lgkmcnt(" #n ")" ::: "memory")
#define PG8_BAR __builtin_amdgcn_s_barrier()
#define PG8_SCHED __builtin_amdgcn_sched_barrier(0)
    Unit cur, nxt; int ui = 0;
    if (!S.next(0, cur)) return;
    f32x4 acc[2][2][4][2];
#pragma unroll
    for (int a = 0; a < 2; ++a)
#pragma unroll
        for (int b = 0; b < 2; ++b)
#pragma unroll
            for (int m = 0; m < 4; ++m)
#pragma unroll
                for (int n = 0; n < 2; ++n) acc[a][b][m][n] = (f32x4){0.f, 0.f, 0.f, 0.f};
    bf16x8 At[4][2], B0[2][2], B1[2][2];
    const char* cA = (const char*)g.A + (size_t)cur.pm * tstep; const char* cB = (const char*)g.Bt + (size_t)cur.pn * tstep;
    S.a_ready(cur);
    if constexpr (SP2) {
        PG8_STAGE(PG8_SB(0, 0), cB, voffB); PG8_STAGE(PG8_SB(0, 1), cB + hstep, voffB); PG8_STAGE(PG8_SA(0, 0), cA, voffA); PG8_STAGE(PG8_SA(0, 1), cA + hstep, voffA);
        if (wr == 1) PG8_BAR;
        PG8_WAIT_V(2); PG8_BAR;
        PG8_STAGE(PG8_SB(1, 0), cB + kstep, voffB); PG8_STAGE(PG8_SA(1, 0), cA + kstep, voffA); PG8_STAGE(PG8_SB(1, 1), cB + hstep + kstep, voffB);
        PG8_WAIT_V(6); PG8_BAR;
    } else {
        PG8_STAGE(PG8_SB(0, 0), cB, voffB); PG8_STAGE(PG8_SA(0, 0), cA, voffA); PG8_STAGE(PG8_SB(0, 1), cB + hstep, voffB); PG8_STAGE(PG8_SA(0, 1), cA + hstep, voffA);
        if (wr == 1) PG8_BAR;
        PG8_WAIT_V(4); PG8_BAR;
        PG8_STAGE(PG8_SB(1, 0), cB + kstep, voffB); PG8_STAGE(PG8_SA(1, 0), cA + kstep, voffA); PG8_STAGE(PG8_SB(1, 1), cB + hstep + kstep, voffB);
        PG8_WAIT_V(6); PG8_BAR;
    }
    for (;;) {
        const bool has_next = S.next(ui + 1, nxt);
        const char* nA = has_next ? (const char*)g.A + (size_t)nxt.pm * tstep : cA; const char* nB = has_next ? (const char*)g.Bt + (size_t)nxt.pn * tstep : cB;
        for (int t = 0; t < nt; t += 2) {
            const bool last = (t == nt - 2);
            const char* a1 = cA + (size_t)(t + 1) * kstep;
            const char* a2 = last ? nA : cA + (size_t)(t + 2) * kstep; const char* b2 = last ? nB : cB + (size_t)(t + 2) * kstep;
            const char* a3 = a2 + kstep; const char* b3 = b2 + kstep;
            if (last && has_next) S.a_ready(nxt);
            if constexpr (SP2) {
            PG8_LDB(B0, 0, 0); PG8_LDB(B1, 0, 1); PG8_SCHED; PG8_LDA(At, 0, 0); PG8_STAGE(PG8_SA(1, 1), a1 + hstep, voffA);
            PG8_WAIT_V(8); PG8_WAIT_L(0); PG8_BAR; PG8_MMA(0, 0, At, B0); PG8_MMA(0, 1, At, B1); PG8_BAR; PG8_SCHED;
            PG8_LDA(At, 0, 1); PG8_STAGE(PG8_SB(0, 0), b2, voffB); PG8_STAGE(PG8_SB(0, 1), b2 + hstep, voffB); PG8_STAGE(PG8_SA(0, 0), a2, voffA);
            PG8_WAIT_V(8); PG8_WAIT_L(0); PG8_BAR; PG8_MMA(1, 0, At, B0); PG8_MMA(1, 1, At, B1); PG8_BAR; PG8_SCHED;
            PG8_LDB(B0, 1, 0); PG8_LDB(B1, 1, 1); PG8_SCHED; PG8_LDA(At, 1, 0); PG8_STAGE(PG8_SA(0, 1), a2 + hstep, voffA);
            PG8_WAIT_V(8); PG8_WAIT_L(0); PG8_BAR; PG8_MMA(0, 0, At, B0); PG8_MMA(0, 1, At, B1); PG8_BAR; PG8_SCHED;
            PG8_LDA(At, 1, 1); PG8_STAGE(PG8_SB(1, 0), b3, voffB); PG8_STAGE(PG8_SB(1, 1), b3 + hstep, voffB); PG8_STAGE(PG8_SA(1, 0), a3, voffA);
            PG8_WAIT_V(8); PG8_WAIT_L(0); PG8_BAR; PG8_MMA(1, 0, At, B0); PG8_MMA(1, 1, At, B1); PG8_BAR; PG8_SCHED;
            } else {
            PG8_LDB(B0, 0, 0); PG8_SCHED; PG8_LDA(At, 0, 0); PG8_STAGE(PG8_SA(1, 1), a1 + hstep, voffA);
            PG8_WAIT_L(8); PG8_BAR; PG8_WAIT_L(0); PG8_MMA(0, 0, At, B0); PG8_BAR; PG8_SCHED;
            PG8_LDB(B1, 0, 1); PG8_STAGE(PG8_SB(0, 0), b2, voffB);
            PG8_BAR; PG8_WAIT_L(0); PG8_MMA(0, 1, At, B1); PG8_BAR;
            PG8_LDA(At, 0, 1); PG8_STAGE(PG8_SA(0, 0), a2, voffA);
            PG8_BAR; PG8_WAIT_L(0); PG8_MMA(1, 0, At, B0); PG8_BAR; PG8_SCHED;
            PG8_STAGE(PG8_SB(0, 1), b2 + hstep, voffB);
            PG8_WAIT_V(6); PG8_BAR; PG8_MMA(1, 1, At, B1); PG8_BAR;
            PG8_LDB(B0, 1, 0); PG8_SCHED; PG8_LDA(At, 1, 0); PG8_STAGE(PG8_SA(0, 1), a2 + hstep, voffA);
            PG8_WAIT_L(8); PG8_BAR; PG8_WAIT_L(0); PG8_MMA(0, 0, At, B0); PG8_BAR; PG8_SCHED;
            PG8_LDB(B1, 1, 1); PG8_STAGE(PG8_SB(1, 0), b3, voffB);
            PG8_BAR; PG8_WAIT_L(0); PG8_MMA(0, 1, At, B1); PG8_BAR;
            PG8_LDA(At, 1, 1); PG8_STAGE(PG8_SA(1, 0), a3, voffA);
            PG8_BAR; PG8_WAIT_L(0); PG8_MMA(1, 0, At, B0); PG8_BAR; PG8_SCHED;
            PG8_STAGE(PG8_SB(1, 1), b3 + hstep, voffB);
            PG8_WAIT_V(6); PG8_BAR; PG8_MMA(1, 1, At, B1); PG8_BAR;
            }
        }
        if constexpr (ALIGN_EPI) { if (wr == 0) PG8_BAR; }
        if constexpr (!Epi::AFTER_DRAIN) { E(acc, cur, wr, wc, fr, fq); S.done(cur); }
        if (!has_next) break;
#pragma unroll
        for (int a = 0; a < 2; ++a)
#pragma unroll
            for (int b = 0; b < 2; ++b)
#pragma unroll
                for (int m = 0; m < 4; ++m)
#pragma unroll
                    for (int n = 0; n < 2; ++n) acc[a][b][m][n] = (f32x4){0.f, 0.f, 0.f, 0.f};
        cur = nxt; cA = nA; cB = nB; ++ui;
        if constexpr (ALIGN_EPI) { if (wr == 1) PG8_BAR; }
    }
    PG8_WAIT_V(0);
    if constexpr (!ALIGN_EPI) { if (wr == 0) PG8_BAR; }
    PG8_BAR;
    if constexpr (Epi::AFTER_DRAIN) { E.fused(acc, cur, wr, wc, fr, fq, lds, wid, lane); S.done(cur); }
#undef PG8_SA
#undef PG8_SB
#undef PG8_STAGE
#undef PG8_LDA
#undef PG8_LDB
#undef PG8_MMA
#undef PG8_WAIT_V
#undef PG8_WAIT_L
#undef PG8_BAR
#undef PG8_SCHED
}
}

constexpr int NB = 8, SEQ = 4096, DM = 1024, NL = 2, FF = 4096, NPROJ = 2724, NPROJ_PAD = 2816, NTILE_PROJ = 11;
constexpr int TOK = NB * SEQ;
static_assert(TOK == pg8::TT, "token count");
constexpr float NORM_EPS = 1e-6f;
constexpr float LOG2E = 1.4426950408889634f;
constexpr int NWAVES = 8;

constexpr size_t MiB = 1u << 20;
constexpr size_t WS_CTL = 0, CTL_ZERO_BYTES = 1 * MiB;
constexpr size_t WS_MOD = 1 * MiB;
constexpr size_t WS_KMEAN = WS_MOD + 512 * 1024;
constexpr size_t WS_W = 2 * MiB;
constexpr size_t W_IN = 0, W_GATE = W_IN + (size_t)NPROJ_PAD * DM, W_BR = W_GATE + (size_t)4 * DM * DM, W_OUT = W_BR + (size_t)4 * DM * 256,
                 W_FF1 = W_OUT + (size_t)DM * DM, W_FF2 = W_FF1 + (size_t)FF * DM, W_LAYER = W_FF2 + (size_t)DM * FF;
constexpr size_t WS_MASK = 70 * MiB;
constexpr size_t WS_H = 86 * MiB;
constexpr size_t WS_Y = 150 * MiB;
constexpr size_t WS_R = 214 * MiB;
constexpr size_t WS_END = 470 * MiB;
static_assert(WS_W + 2 * W_LAYER * 2 <= WS_MASK, "weights fit");
constexpr int CW_BAR = 4096;
constexpr int CW_WQ = 131072;
constexpr int CW_NRM = CW_WQ + 4096;
constexpr int NPHASE = 22;

constexpr int RING_BYTES = 135168;
constexpr int LDSCTL_OFF = RING_BYTES;
constexpr int LDS_BYTES = 147456;

#define GAS __attribute__((address_space(1)))
#define LAS __attribute__((address_space(3)))
typedef unsigned short bf16;
typedef unsigned v4u __attribute__((ext_vector_type(4)));
typedef unsigned v2u __attribute__((ext_vector_type(2)));
typedef float f32x4 __attribute__((ext_vector_type(4)));
typedef float f32x16 __attribute__((ext_vector_type(16)));
typedef short bf16x8 __attribute__((ext_vector_type(8)));
typedef short s16x4 __attribute__((ext_vector_type(4)));
typedef GAS unsigned gu32;
#define RLX_AGENT __ATOMIC_RELAXED, __HIP_MEMORY_SCOPE_AGENT
#define LDS_WAIT() asm volatile("s_waitcnt lgkmcnt(0)" ::: "memory")
__device__ __forceinline__ unsigned f2bf(float f) { unsigned u = __builtin_bit_cast(unsigned, f); return (u + 0x7fffu + ((u >> 16) & 1u)) >> 16; }
__device__ __forceinline__ unsigned pk2(float lo, float hi) { return f2bf(lo) | (f2bf(hi) << 16); }
__device__ __forceinline__ float bf2f(unsigned short b) { return __uint_as_float((unsigned)b << 16); }
__device__ __forceinline__ float bflo(unsigned w) { return __uint_as_float(w << 16); }
__device__ __forceinline__ float bfhi(unsigned w) { return __uint_as_float(w & 0xffff0000u); }

#define XB_TMO      128
#define XB_XCNT(j)  (256  + 64 * (j))
#define XB_XSUB(j)  (1280 + 64 * (j))
#define XB_XGEN(j)  (2304 + 64 * (j))
#define XB_TOP      3328
#define XB_TOPGEN   3392
#define XCD_BAR_WORDS 3456
#define XB_SPIN_CAP (1u << 18)

__device__ __forceinline__ unsigned xb_ld(unsigned* p)              { return __hip_atomic_load(p, __ATOMIC_RELAXED, __HIP_MEMORY_SCOPE_AGENT); }
__device__ __forceinline__ unsigned xb_add(unsigned* p, unsigned v) { return __hip_atomic_fetch_add(p, v, __ATOMIC_RELAXED, __HIP_MEMORY_SCOPE_AGENT); }
__device__ __forceinline__ unsigned xb_xcc_id() { return (unsigned)__builtin_amdgcn_s_getreg((3 << 11) | 20) & 0xFu; }
#define XB_SPIN(cond, bar) do { unsigned _sp = 0; while (cond) { __builtin_amdgcn_s_sleep(1); \
    if ((++_sp & 255u) == 0u) { if (xb_ld(&(bar)[XB_TMO])) break; if (_sp > XB_SPIN_CAP) { atomicAdd(&(bar)[XB_TMO], 1u); break; } } } } while (0)

struct XcdBarrier {
    unsigned* bar; unsigned x;
    volatile LAS unsigned* st;
};

__device__ __forceinline__ XcdBarrier xcd_barrier_post(unsigned* bar, volatile LAS unsigned* st) {
    XcdBarrier b; b.bar = bar; b.x = xb_xcc_id(); b.st = st;
    if (threadIdx.x == 0) (void)xb_add(&bar[XB_XCNT(b.x)], 1u);
    return b;
}
__device__ __forceinline__ void xcd_barrier_complete(unsigned* bar, unsigned x, unsigned& nloc, unsigned& nx) {
    const unsigned G = gridDim.x * gridDim.y * gridDim.z;
    unsigned sum, cnt, mine, sp = 0u;
    for (;;) {
        sum = 0u; cnt = 0u; mine = 0u;
#pragma unroll
        for (unsigned j = 0; j < 16; ++j) { const unsigned c = xb_ld(&bar[XB_XCNT(j)]); sum += c; cnt += (c > 0u) ? 1u : 0u; mine = (j == x) ? c : mine; }
        if (sum == G) break;
        __builtin_amdgcn_s_sleep(1);
        if ((++sp & 255u) == 0u) { if (xb_ld(&bar[XB_TMO])) break; if (sp > XB_SPIN_CAP) { atomicAdd(&bar[XB_TMO], 1u); break; } }
    }
    nloc = mine > 0u ? mine : 1u; nx = cnt > 0u ? cnt : 1u;
}

__device__ __forceinline__ void xcd_barrier(const XcdBarrier& b) {
    asm volatile("s_waitcnt vmcnt(0)" ::: "memory");
    __syncthreads();
    if (threadIdx.x == 0) {
        unsigned* bar = b.bar;
        __builtin_amdgcn_s_waitcnt(0);
        unsigned nloc = b.st[0], nx = b.st[1];
        if (nloc == 0u) { xcd_barrier_complete(bar, b.x, nloc, nx); b.st[0] = nloc; b.st[1] = nx; }
        const unsigned old = xb_add(&bar[XB_XSUB(b.x)], 1u);
        const unsigned gen = old / nloc;
        if (old + 1u == (gen + 1u) * nloc) {
            __builtin_amdgcn_fence(__ATOMIC_RELEASE, "agent");
            asm volatile("s_waitcnt vmcnt(0)" ::: "memory");
            const unsigned og = xb_add(&bar[XB_TOP], 1u);
            const unsigned tg = og / nx;
            if (og + 1u == (tg + 1u) * nx) xb_add(&bar[XB_TOPGEN], 1u);
            else XB_SPIN(xb_ld(&bar[XB_TOPGEN]) == tg, bar);
            __builtin_amdgcn_fence(__ATOMIC_ACQUIRE, "agent");
            xb_add(&bar[XB_XGEN(b.x)], 1u);
            asm volatile("s_waitcnt vmcnt(0)" ::: "memory");
        } else {
            XB_SPIN(xb_ld(&bar[XB_XGEN(b.x)]) == gen, bar);
            __builtin_amdgcn_fence(__ATOMIC_ACQUIRE, "agent");
            asm volatile("s_waitcnt vmcnt(0)" ::: "memory");
        }
    }
    __syncthreads();
}

struct Args {
    const float *x, *c, *w_ada, *b_ada, *norm1_g, *w_in, *diff_lambda, *diff_subln_g, *w_pool, *pool_scale, *w_gate, *b_gate, *w_branch, *w_out, *norm2_g, *w_ff1, *w_ff2, *final_g;
    float* out; unsigned char* ws; int ph_lo, ph_hi, li, pad;
};

__device__ __forceinline__ float shx(float v, int mask, int lane) { return __int_as_float(__builtin_amdgcn_ds_bpermute((lane ^ mask) << 2, __float_as_int(v))); }
__device__ __forceinline__ unsigned shxu(unsigned v, int mask, int lane) { return (unsigned)__builtin_amdgcn_ds_bpermute((lane ^ mask) << 2, (int)v); }
__device__ __forceinline__ unsigned shupu(unsigned v, int delta, int lane) { return (unsigned)__builtin_amdgcn_ds_bpermute(((lane - delta) & 63) << 2, (int)v); }
__device__ __forceinline__ float wave_sum(float v, int lane) {
#pragma unroll
    for (int o = 1; o < 64; o <<= 1) v += shx(v, o, lane);
    return v;
}
__device__ __forceinline__ int crow(int r, int hi) { return (r & 3) + 8 * (r >> 2) + 4 * hi; }
__device__ __forceinline__ unsigned cvtpk(float lo, float hi) { unsigned r; asm volatile("v_cvt_pk_bf16_f32 %0, %1, %2" : "=v"(r) : "v"(lo), "v"(hi)); return r; }

__device__ __forceinline__ int gate_row(int br, int c) { const int pn = c >> 6, ml = c & 63; return 256 * pn + 128 * (br >> 1) + 32 * (ml >> 4) + 8 * ((ml >> 2) & 3) + 4 * (br & 1) + (ml & 3); }
__device__ __forceinline__ void p0_transpose_item(const float* W, int K, int Nsrc, int Npad, bf16* WT, int mode, int br, LAS float* scr, int item, int lane) {
    const int nblk = Npad / 32, kb = item / nblk, nb = item % nblk, k0 = 64 * kb, n0 = 32 * nb;
    const int c4 = lane & 7, kr = lane >> 3, nn = n0 + 4 * c4;
    f32x4 v[8];
#pragma unroll
    for (int i = 0; i < 8; ++i) v[i] = (nn < Nsrc) ? *(const f32x4*)(W + (size_t)(k0 + 8 * i + kr) * Nsrc + nn) : (f32x4){0.f, 0.f, 0.f, 0.f};
#pragma unroll
    for (int i = 0; i < 8; ++i) { LAS float* d = scr + (8 * i + kr) * 33 + 4 * c4; d[0] = v[i][0]; d[1] = v[i][1]; d[2] = v[i][2]; d[3] = v[i][3]; }
    LDS_WAIT(); asm volatile("" ::: "memory");
    const int c = lane & 7;
#pragma unroll
    for (int j = 0; j < 4; ++j) { const int n = (lane >> 3) + 8 * j; const LAS float* s = scr + (8 * c) * 33 + n;
        v4u o; o.x = pk2(s[0 * 33], s[1 * 33]); o.y = pk2(s[2 * 33], s[3 * 33]); o.z = pk2(s[4 * 33], s[5 * 33]); o.w = pk2(s[6 * 33], s[7 * 33]);
        const int drow = (mode == 1) ? gate_row(br, n0 + n) : (n0 + n);
        *(v4u*)(WT + (size_t)drow * K + k0 + 8 * c) = o; }
    LDS_WAIT(); asm volatile("" ::: "memory");
}

__device__ __forceinline__ void norm_rows_bf16(const float* X, bf16* O, const float* g, const float* mod  , int sh_idx, int sc_idx, int gw, int ngw, int lane_in) {
    int lane = lane_in; asm volatile("" : "+v"(lane));
    for (int m = gw; m < TOK; m += ngw) {
        const int b = m >> 12;
        const f32x4* xr = (const f32x4*)(X + (size_t)m * DM) + lane;
        f32x4 v[4]; float s = 0.f;
#pragma unroll
        for (int j = 0; j < 4; ++j) { v[j] = xr[64 * j]; s += (v[j].x * v[j].x + v[j].y * v[j].y) + (v[j].z * v[j].z + v[j].w * v[j].w); }
        const float rstd = 1.f / sqrtf(wave_sum(s, lane) * (1.f / DM) + NORM_EPS);
        const f32x4* gp = (const f32x4*)g + lane;
        const f32x4* shp = (const f32x4*)(mod + (size_t)b * 6144 + sh_idx * 1024) + lane;
        const f32x4* scp = (const f32x4*)(mod + (size_t)b * 6144 + sc_idx * 1024) + lane;
        unsigned long long* o8 = (unsigned long long*)(O + (size_t)m * DM) + lane;
#pragma unroll
        for (int j = 0; j < 4; ++j) { const f32x4 gg = gp[64 * j], sh = shp[64 * j], sc = scp[64 * j]; f32x4 y;
#pragma unroll
            for (int e = 0; e < 4; ++e) y[e] = v[j][e] * rstd * gg[e] * (1.f + sc[e]) + sh[e];
            o8[64 * j] = (unsigned long long)pk2(y.x, y.y) | ((unsigned long long)pk2(y.z, y.w) << 32); }
    }
}
__device__ __forceinline__ void final_norm_rows(float* X, const float* g, int gw, int ngw, int lane_in) {
    int lane = lane_in; asm volatile("" : "+v"(lane));
    for (int m = gw; m < TOK; m += ngw) {
        f32x4* xr = (f32x4*)(X + (size_t)m * DM) + lane;
        f32x4 v[4]; float s = 0.f;
#pragma unroll
        for (int j = 0; j < 4; ++j) { v[j] = xr[64 * j]; s += (v[j].x * v[j].x + v[j].y * v[j].y) + (v[j].z * v[j].z + v[j].w * v[j].w); }
        const float rstd = 1.f / sqrtf(wave_sum(s, lane) * (1.f / DM) + NORM_EPS);
        const f32x4* gp = (const f32x4*)g + lane;
#pragma unroll
        for (int j = 0; j < 4; ++j) { const f32x4 gg = gp[64 * j]; xr[64 * j] = v[j] * rstd * gg; }
    }
}

#ifndef ATT_PD
#define ATT_PD 1
#endif
constexpr int AT_K0 = 0, AT_KSLOT = 9216, AT_V0 = 18432, AT_VSLOT = 12288, AT_SEL = 43008, AT_KM = 44032, AT_END = 47872;
__device__ __forceinline__ s16x4 vtr(LAS const unsigned char* p) { return __builtin_bit_cast(s16x4, __builtin_amdgcn_ds_read_tr16_b64_v4i16((LAS s16x4*)p)); }

#define TRRD(dst, addr, off) asm volatile("ds_read_b64_tr_b16 %0, %1 offset:%2" : "=v"(dst) : "v"(addr), "i"(off) : "memory")
__device__ __forceinline__ void softmax_pv(f32x16& s0, f32x16& s1, float& l, f32x16 (&o)[2], LAS const unsigned char* vbase  ) {
    const unsigned va = (unsigned)(uintptr_t)vbase;
    s16x4 vl[2][2][2], vh[2][2][2];
#pragma unroll
    for (int db = 0; db < 2; ++db)
#pragma unroll
        for (int sub = 0; sub < 2; ++sub)
#pragma unroll
            for (int s2 = 0; s2 < 2; ++s2) { TRRD(vl[db][sub][s2], va, (32 * sub + 16 * s2) * 192 + db * 64); TRRD(vh[db][sub][s2], va, (32 * sub + 16 * s2 + 8) * 192 + db * 64); }
#if defined(PROBE_EXP2X)
    { f32x16 d0 = s0, d1 = s1;
#pragma unroll
      for (int r = 0; r < 16; ++r) { d0[r] = __builtin_amdgcn_exp2f(d0[r] * 0.5f); d1[r] = __builtin_amdgcn_exp2f(d1[r] * 0.5f); }
      asm volatile("" :: "v"(d0), "v"(d1)); }
#endif
    float la = 0.f, lb = 0.f;
#pragma unroll
    for (int r = 0; r < 16; ++r) { s0[r] = __builtin_amdgcn_exp2f(s0[r]); s1[r] = __builtin_amdgcn_exp2f(s1[r]); la += s0[r]; lb += s1[r]; }
    l += la + lb;
    bf16x8 pf[2][2];
#pragma unroll
    for (int s2 = 0; s2 < 2; ++s2) {
        v4u a, c;
        a.x = cvtpk(s0[8 * s2 + 0], s0[8 * s2 + 1]); a.y = cvtpk(s0[8 * s2 + 2], s0[8 * s2 + 3]); a.z = cvtpk(s0[8 * s2 + 4], s0[8 * s2 + 5]); a.w = cvtpk(s0[8 * s2 + 6], s0[8 * s2 + 7]);
        c.x = cvtpk(s1[8 * s2 + 0], s1[8 * s2 + 1]); c.y = cvtpk(s1[8 * s2 + 2], s1[8 * s2 + 3]); c.z = cvtpk(s1[8 * s2 + 4], s1[8 * s2 + 5]); c.w = cvtpk(s1[8 * s2 + 6], s1[8 * s2 + 7]);
        pf[0][s2] = __builtin_bit_cast(bf16x8, a); pf[1][s2] = __builtin_bit_cast(bf16x8, c);
    }
    asm volatile("s_waitcnt lgkmcnt(0)" : "+v"(vl[0][0][0]), "+v"(vl[0][0][1]), "+v"(vl[0][1][0]), "+v"(vl[0][1][1]), "+v"(vl[1][0][0]), "+v"(vl[1][0][1]), "+v"(vl[1][1][0]), "+v"(vl[1][1][1]),
                                          "+v"(vh[0][0][0]), "+v"(vh[0][0][1]), "+v"(vh[0][1][0]), "+v"(vh[0][1][1]), "+v"(vh[1][0][0]), "+v"(vh[1][0][1]), "+v"(vh[1][1][0]), "+v"(vh[1][1][1]) :: "memory");
#pragma unroll
    for (int db = 0; db < 2; ++db)
#pragma unroll
        for (int sub = 0; sub < 2; ++sub)
#pragma unroll
            for (int s2 = 0; s2 < 2; ++s2) {
                const s16x4 lo = vl[db][sub][s2], hh = vh[db][sub][s2];
                const bf16x8 vf = (bf16x8){lo[0], lo[1], lo[2], lo[3], hh[0], hh[1], hh[2], hh[3]};
                o[db] = __builtin_amdgcn_mfma_f32_32x32x16_bf16(vf, pf[sub][s2], o[db], 0, 0, 0);
            }
#if defined(PROBE_PV2X)
    { f32x16 dz;
#pragma unroll
      for (int r = 0; r < 16; ++r) dz[r] = 0.f;
#pragma unroll
      for (int db = 0; db < 2; ++db)
#pragma unroll
        for (int sub = 0; sub < 2; ++sub)
#pragma unroll
            for (int s2 = 0; s2 < 2; ++s2) {
                const s16x4 lo = vl[db][sub][s2], hh = vh[db][sub][s2];
                const bf16x8 vf = (bf16x8){lo[0], lo[1], lo[2], lo[3], hh[0], hh[1], hh[2], hh[3]};
                dz = __builtin_amdgcn_mfma_f32_32x32x16_bf16(vf, pf[sub][s2], dz, 0, 0, 0);
            }
      asm volatile("" :: "v"(dz)); }
#endif
}
__device__ __forceinline__ void split3(float x, unsigned& h, unsigned& m, unsigned& l) {
    h = f2bf(x); const float r1 = x - __uint_as_float(h << 16); m = f2bf(r1); const float r2 = r1 - __uint_as_float(m << 16); l = f2bf(r2);
}

template <int MODE>
__device__ __forceinline__ void attn_unit(LAS unsigned char* lds, int b, int h, int qb, const bf16* Qb, const bf16* Kb, const bf16* Vb, bf16* Ob, float slope,
                                          const float* kmean, float lam, float post_scale, const float* subg, const unsigned* maskw, const unsigned* nrm  ) {
    int tid_l = threadIdx.x; asm volatile("" : "+v"(tid_l)); const int tid = tid_l, lane = tid & 63, wid = __builtin_amdgcn_readfirstlane(tid >> 6), r32 = lane & 31, hi = lane >> 5;
    const int q = qb * 256 + wid * 32 + r32;
    const size_t rowg = (size_t)b * SEQ;
    const float c2 = slope * LOG2E;
    unsigned sel = 0u;
    if (MODE == 0) {
        LAS float* KM = (LAS float*)(lds + AT_KM); LAS unsigned* SEL = (LAS unsigned*)(lds + AT_SEL);
        for (int i = tid; i < qb * 64; i += 512) KM[i] = kmean[(size_t)((b * 4 + h) * 16) * 64 + i];
        __syncthreads();
        if (tid < 256) {
            const bf16* qrow = Qb + (rowg + qb * 256 + tid) * 256 + h * 64;
            float qv[64];
#pragma unroll
            for (int c = 0; c < 8; ++c) { const v4u w = *(const v4u*)(qrow + 8 * c);
                qv[8 * c + 0] = bflo(w.x); qv[8 * c + 1] = bfhi(w.x); qv[8 * c + 2] = bflo(w.y); qv[8 * c + 3] = bfhi(w.y);
                qv[8 * c + 4] = bflo(w.z); qv[8 * c + 5] = bfhi(w.z); qv[8 * c + 6] = bflo(w.w); qv[8 * c + 7] = bfhi(w.w); }
            float v1 = -INFINITY, v2 = -INFINITY, v3 = -INFINITY; int i1 = -1, i2 = -1, i3 = -1;
            for (int n = 0; n < qb; ++n) {
                float g = 0.f;
#pragma unroll
                for (int d = 0; d < 64; ++d) g = __builtin_fmaf(qv[d], KM[n * 64 + d], g);
                if (g > v1) { v3 = v2; i3 = i2; v2 = v1; i2 = i1; v1 = g; i1 = n; }
                else if (g > v2) { v3 = v2; i3 = i2; v2 = g; i2 = n; }
                else if (g > v3) { v3 = g; i3 = n; }
            }
            unsigned sm = 0u; if (i1 >= 0) sm |= 1u << i1; if (i2 >= 0) sm |= 1u << i2; if (i3 >= 0) sm |= 1u << i3;
            SEL[tid] = sm;
        }
        __syncthreads();
        sel = SEL[wid * 32 + r32];
    }
    bf16x8 qf[4];
#pragma unroll
    for (int ds = 0; ds < 4; ++ds) qf[ds] = *(const bf16x8*)(Qb + (rowg + q) * 256 + h * 64 + ds * 16 + hi * 8);
    const int skey = tid >> 3, sch = tid & 7;
    const bf16* ksrc = Kb + (rowg + skey) * 256 + h * 64 + sch * 8;
    const bf16* vsrc = Vb + (rowg + skey) * 256 + h * 64 + sch * 8;
    const int kdst = AT_K0 + skey * 144 + sch * 16, vdst = AT_V0 + skey * 192 + sch * 16;
    const int NT = 4 * qb + 4;
    const float Bq = __uint_as_float(nrm[b * 4 + h]), Bk = __uint_as_float(nrm[32 + b * 4 + h]);
#if defined(PROBE_NOSKIP)
    const float Dskip = 1e9f + 0.f * (Bq + Bk);
#else
    const float Dskip = (150.f + 2.f * sqrtf(Bq * Bk)) / c2;
#endif
    const int koff = r32 * 144 + hi * 16;
    const int vtoff = (4 * hi + ((lane & 15) >> 2)) * 192 + (16 * ((lane >> 4) & 1) + 4 * (lane & 3)) * 2;
    float l1 = 0.f, l2 = 0.f;
    f32x16 oA[2], oB[2];
#pragma unroll
    for (int r = 0; r < 16; ++r) { oA[0][r] = 0.f; oA[1][r] = 0.f; oB[0][r] = 0.f; oB[1][r] = 0.f; }
    const int qmin = qb * 256 + wid * 32, qmax = qmin + 31;
    constexpr int PD = ATT_PD;
    v4u kR[PD], vR[PD]; v2u mR[PD];
    int refpos = q;
    int minref = qb * 256;
    if (MODE == 2) {
        const unsigned* mrow = maskw + (rowg + q) * 128; int wi = q >> 5; unsigned wv = mrow[wi];
        while (wv == 0u && wi > 0) { --wi; wv = mrow[wi]; }
        refpos = 32 * wi + 31 - __clz((int)(wv | 1u));
        LAS int* MR = (LAS int*)(lds + AT_SEL);
        if (tid == 0) MR[0] = 0x7fffffff;
        __syncthreads();
        __hip_atomic_fetch_min(MR, refpos, __ATOMIC_RELAXED, __HIP_MEMORY_SCOPE_WORKGROUP);
        __syncthreads();
        minref = MR[0];
    }
    int T0 = (int)floorf(((float)minref - Dskip) * (1.f / 64.f)); T0 = T0 < 0 ? 0 : T0; T0 = __builtin_amdgcn_readfirstlane(T0);
    { const v4u k0r = *(const v4u*)(ksrc + (size_t)T0 * 64 * 256), v0r = *(const v4u*)(vsrc + (size_t)T0 * 64 * 256);
      *(LAS v4u*)(lds + kdst + (T0 & 1) * AT_KSLOT) = k0r; *(LAS v4u*)(lds + vdst + (T0 & 1) * AT_VSLOT) = v0r; }
#pragma unroll
    for (int i = 0; i < PD; ++i) { kR[i] = (v4u){0u, 0u, 0u, 0u}; vR[i] = kR[i]; mR[i] = (v2u){0u, 0u};
        if (T0 + i + 1 < NT) { kR[i] = *(const v4u*)(ksrc + (size_t)(T0 + i + 1) * 64 * 256); vR[i] = *(const v4u*)(vsrc + (size_t)(T0 + i + 1) * 64 * 256);
            if (MODE == 2) mR[i] = *(const v2u*)(maskw + (rowg + q) * 128 + 2 * (T0 + i + 1)); } }
    v2u mw = (v2u){0u, 0u};
    if (MODE == 2) mw = *(const v2u*)(maskw + (rowg + q) * 128 + 2 * T0);
    bf16x8 qaug; v4u ka0, ka1;
    { unsigned a, b2, c; split3(-c2 * (float)refpos, a, b2, c);
      v4u w; if (hi == 0) { w.x = a | (b2 << 16); w.y = c | (0x3f80u << 16); w.z = 0x3f80u | (0x3f80u << 16); w.w = 0u; }
             else { w.x = 0x3f80u | (0x3f80u << 16); w.y = 0x3f80u; w.z = 0u; w.w = 0u; }
      qaug = __builtin_bit_cast(bf16x8, w);
      split3(c2 * (float)r32, a, b2, c); ka0.x = 0x3f80u | (0x3f80u << 16); ka0.y = 0x3f80u | (a << 16); ka0.z = b2 | (c << 16); ka0.w = 0u;
      split3(c2 * (float)(r32 + 32), a, b2, c); ka1.x = ka0.x; ka1.y = 0x3f80u | (a << 16); ka1.z = b2 | (c << 16); ka1.w = 0u; }
    __syncthreads();
#pragma nounroll
    for (int t0 = T0; t0 < NT; t0 += PD) {
#pragma unroll
      for (int u = 0; u < PD; ++u) { const int t = t0 + u; if (t < NT) {
        const int slot = t & 1;
        const int k0 = 64 * t;
        bool active = (k0 <= qmax);
        bool keep = true;
        if (MODE == 0) { const int n = t >> 2; if (n < qb) { keep = ((sel >> n) & 1u) != 0u; active = (__ballot(keep) != 0ull); } }
        if (active) {
            LAS const unsigned char* ks = lds + AT_K0 + slot * AT_KSLOT + koff;
            LAS const unsigned char* vb = lds + AT_V0 + slot * AT_VSLOT + vtoff;
            const int lim = q - k0 - 4 * hi;
            const bool needmask = (k0 + 63 > qmin);
            bf16x8 kaug0, kaug1;
            { unsigned a, b2, c; split3(c2 * (float)k0, a, b2, c);
              v4u w0 = ka0, w1 = ka1; if (hi) { w0.x = a | (b2 << 16); w0.y = c; w0.z = 0u; w1 = w0; }
              kaug0 = __builtin_bit_cast(bf16x8, w0); kaug1 = __builtin_bit_cast(bf16x8, w1); }
#pragma unroll
            for (int mp = 0; mp < (MODE == 1 ? 2 : 1); ++mp) {
                f32x16 s0, s1;
#pragma unroll
                for (int r = 0; r < 16; ++r) { s0[r] = 0.f; s1[r] = 0.f; }
                s0 = __builtin_amdgcn_mfma_f32_32x32x16_bf16(kaug0, qaug, s0, 0, 0, 0);
                s1 = __builtin_amdgcn_mfma_f32_32x32x16_bf16(kaug1, qaug, s1, 0, 0, 0);
#pragma unroll
                for (int dd = 0; dd < (MODE == 1 ? 2 : 4); ++dd) { const int ds = (MODE == 1) ? (2 * mp + dd) : dd;
                    const bf16x8 a0 = *(LAS const bf16x8*)(ks + ds * 32), a1 = *(LAS const bf16x8*)(ks + 32 * 144 + ds * 32);
                    s0 = __builtin_amdgcn_mfma_f32_32x32x16_bf16(a0, qf[ds], s0, 0, 0, 0);
                    s1 = __builtin_amdgcn_mfma_f32_32x32x16_bf16(a1, qf[ds], s1, 0, 0, 0); }
#if defined(PROBE_QK2X)
                { f32x16 d0, d1;
#pragma unroll
                  for (int r = 0; r < 16; ++r) { d0[r] = 0.f; d1[r] = 0.f; }
#pragma unroll
                  for (int dd = 0; dd < (MODE == 1 ? 2 : 4); ++dd) { const int ds = (MODE == 1) ? (2 * mp + dd) : dd;
                    const bf16x8 a0 = *(LAS const bf16x8*)(ks + ds * 32 + 16), a1 = *(LAS const bf16x8*)(ks + 32 * 144 + ds * 32 + 16);
                    d0 = __builtin_amdgcn_mfma_f32_32x32x16_bf16(a0, qf[ds], d0, 0, 0, 0);
                    d1 = __builtin_amdgcn_mfma_f32_32x32x16_bf16(a1, qf[ds], d1, 0, 0, 0); }
                  asm volatile("" :: "v"(d0), "v"(d1)); }
#endif
                if (MODE == 2) {
#pragma unroll
                    for (int r = 0; r < 16; ++r) { const int pos = (r & 3) + 8 * (r >> 2) + 4 * hi;
                        if (!((mw.x >> pos) & 1u)) s0[r] = -INFINITY; if (!((mw.y >> pos) & 1u)) s1[r] = -INFINITY; }
                } else {
                    if (MODE == 0 && !keep) {
#pragma unroll
                        for (int r = 0; r < 16; ++r) { s0[r] = -INFINITY; s1[r] = -INFINITY; }
                    }
                    if (needmask) {
#pragma unroll
                        for (int r = 0; r < 16; ++r) { const int ko = (r & 3) + 8 * (r >> 2);
                            if (ko > lim) s0[r] = -INFINITY; if (ko + 32 > lim) s1[r] = -INFINITY; }
                    }
                }
                if (mp == 0) softmax_pv(s0, s1, l1, oA, vb); else softmax_pv(s0, s1, l2, oB, vb);
            }
        }
        if (t + 1 < NT) { *(LAS v4u*)(lds + kdst + (slot ^ 1) * AT_KSLOT) = kR[u]; *(LAS v4u*)(lds + vdst + (slot ^ 1) * AT_VSLOT) = vR[u];
            if (MODE == 2) mw = mR[u];
            if (t + 1 + PD < NT) { kR[u] = *(const v4u*)(ksrc + (size_t)(t + 1 + PD) * 64 * 256); vR[u] = *(const v4u*)(vsrc + (size_t)(t + 1 + PD) * 64 * 256);
                if (MODE == 2) mR[u] = *(const v2u*)(maskw + (rowg + q) * 128 + 2 * (t + 1 + PD)); } }
        __syncthreads();
#if defined(PROBE_BAR2X)
        __syncthreads();
#endif
      } }
    }
    const float l1t = l1 + shx(l1, 32, lane);
    bf16* orow = Ob + (rowg + q) * 256 + h * 64 + 4 * hi;
    if (MODE == 1) {
        const float l2t = l2 + shx(l2, 32, lane);
        const float i1 = 1.f / l1t, i2 = lam / l2t;
        float ssq = 0.f;
#pragma unroll
        for (int db = 0; db < 2; ++db)
#pragma unroll
            for (int r = 0; r < 16; ++r) { const float v = oA[db][r] * i1 - oB[db][r] * i2; oA[db][r] = v; ssq += v * v; }
        ssq += shx(ssq, 32, lane);
        const float rn = post_scale / sqrtf(ssq * (1.f / 64.f) + NORM_EPS);
#pragma unroll
        for (int db = 0; db < 2; ++db)
#pragma unroll
            for (int g4 = 0; g4 < 4; ++g4) { const f32x4 gg = *(const f32x4*)(subg + 32 * db + 8 * g4 + 4 * hi);
                v2u w; w.x = cvtpk(oA[db][4 * g4 + 0] * rn * gg[0], oA[db][4 * g4 + 1] * rn * gg[1]); w.y = cvtpk(oA[db][4 * g4 + 2] * rn * gg[2], oA[db][4 * g4 + 3] * rn * gg[3]);
                *(v2u*)(orow + 32 * db + 8 * g4) = w; }
    } else {
        const float i1 = 1.f / l1t;
#pragma unroll
        for (int db = 0; db < 2; ++db)
#pragma unroll
            for (int g4 = 0; g4 < 4; ++g4) { v2u w; w.x = cvtpk(oA[db][4 * g4 + 0] * i1, oA[db][4 * g4 + 1] * i1); w.y = cvtpk(oA[db][4 * g4 + 2] * i1, oA[db][4 * g4 + 3] * i1);
                *(v2u*)(orow + 32 * db + 8 * g4) = w; }
    }
    __syncthreads();
}

constexpr int DS_HP = 1025;
constexpr int DS_HIST_BYTES = 32 * DS_HP * 4;
constexpr int DS_BP = 129;
constexpr int DS_G = 0, DS_C = 32 * DS_BP * 4, DS_AUX = DS_HIST_BYTES;
__device__ __forceinline__ float relu_asm(float x) { return __builtin_amdgcn_fmed3f(x, 0.f, __builtin_inff()); }
__device__ __forceinline__ void dsa_scores(const bf16x8 (&iqf)[4][2], const float (&w)[4], const bf16x8 k0, const bf16x8 k1, float (&sc)[16]) {
#pragma unroll
    for (int hh = 0; hh < 4; ++hh) {
        f32x16 x;
#pragma unroll
        for (int r = 0; r < 16; ++r) x[r] = 0.f;
        x = __builtin_amdgcn_mfma_f32_32x32x16_bf16(k0, iqf[hh][0], x, 0, 0, 0);
        x = __builtin_amdgcn_mfma_f32_32x32x16_bf16(k1, iqf[hh][1], x, 0, 0, 0);
#pragma unroll
        for (int r = 0; r < 16; ++r) sc[r] = (hh == 0) ? (w[0] * relu_asm(x[r])) : __builtin_fmaf(w[hh], relu_asm(x[r]), sc[r]);
    }
}
__device__ __forceinline__ unsigned dsa_mono(float s) { const unsigned bits = __float_as_uint(s); return bits ^ ((unsigned)((int)bits >> 31) | 0x80000000u); }
__device__ __forceinline__ unsigned dsa_ckey(float s, unsigned keyidx) { return (dsa_mono(s) & 0xFFFFF000u) | (4095u - keyidx); }
__device__ __forceinline__ unsigned take_low(unsigned w, unsigned n) {
    if (n >= (unsigned)__popc(w)) return w;
    unsigned res = 0u;
    while (n > 0u) { const unsigned low = w & (0u - w); res |= low; w ^= low; --n; }
    return res;
}
template <int PASS>
__device__ __forceinline__ void dsa_hist_pass(LAS unsigned* hist, const bf16x8 (&iqf)[4][2], const float (&w)[4], const bf16* kbase, int qg, int wid, int r32, int hi, int t, unsigned P1) {
    bf16x8 nk0 = *(const bf16x8*)(kbase + (size_t)wid * 32 * 256), nk1 = *(const bf16x8*)(kbase + (size_t)wid * 32 * 256 + 16);
    const unsigned rowb = (unsigned)(r32 * DS_HP * 4);
#pragma nounroll
    for (int j = wid; j <= qg; j += 8) {
        const bf16x8 k0 = nk0, k1 = nk1;
        { const int jn = (j + 8 <= qg) ? j + 8 : j; const bf16* kp = kbase + (size_t)jn * 32 * 256; nk0 = *(const bf16x8*)kp; nk1 = *(const bf16x8*)(kp + 16); }
        float sc[16]; dsa_scores(iqf, w, k0, k1, sc);
        const int lim = t - 32 * j - 4 * hi;
        const bool diag = (j == qg);
#pragma unroll
        for (int r = 0; r < 16; ++r) {
            unsigned bin; bool ok = true;
            if (PASS == 0) { bin = dsa_mono(sc[r]) >> 21; }
            else { const unsigned ck = dsa_ckey(sc[r], 32u * (unsigned)j + (unsigned)((r & 3) + 8 * (r >> 2) + 4 * hi)); ok = (ck >> 21) == P1; bin = (ck >> 10) & 2047u; }
            unsigned addr = rowb + ((bin & 1023u) << 2);
            const unsigned inc = (bin & 1024u) ? 65536u : 1u;
            if (PASS == 0) { if (diag && ((r & 3) + 8 * (r >> 2) > lim)) addr = rowb + 4096u;
                __hip_atomic_fetch_add((LAS unsigned*)((LAS unsigned char*)hist + addr), inc, __ATOMIC_RELAXED, __HIP_MEMORY_SCOPE_WORKGROUP); }
            else { if (ok && !(diag && ((r & 3) + 8 * (r >> 2) > lim)))
                __hip_atomic_fetch_add((LAS unsigned*)((LAS unsigned char*)hist + addr), inc, __ATOMIC_RELAXED, __HIP_MEMORY_SCOPE_WORKGROUP); }
        }
    }
}
__device__ __forceinline__ void dsa_scan(LAS unsigned* hist, LAS unsigned* AUX, int pass, int wid, int lane) {
#pragma nounroll
    for (int qi = 0; qi < 4; ++qi) {
        const int qq = 4 * wid + qi;
        const unsigned K = (pass == 0) ? 256u : AUX[32 + qq];
        LAS const unsigned* hrow = hist + qq * DS_HP;
        const int wb = (2016 - 32 * lane) & 1023; const int sh = (lane < 32) ? 16 : 0;
        unsigned s = 0u;
#pragma unroll
        for (int i = 0; i < 32; ++i) { const unsigned wv = hrow[wb + ((i + lane) & 31)]; s += (wv >> sh) & 0xffffu; }
        unsigned incl = s;
#pragma unroll
        for (int o = 1; o < 64; o <<= 1) { const unsigned v = shupu(incl, o, lane); if (lane >= o) incl += v; }
        const unsigned long long bal = __ballot(incl >= K);
        const int L = __builtin_amdgcn_readfirstlane(bal ? (__ffsll((long long)bal) - 1) : 0);
        const unsigned above = (unsigned)__builtin_amdgcn_readlane((int)(incl - s), L);
        const int bin = 2047 - 32 * L - (lane & 31);
        const unsigned wv2 = hrow[bin & 1023]; const unsigned c = (lane < 32) ? ((bin & 1024) ? (wv2 >> 16) : (wv2 & 0xffffu)) : 0u;
        unsigned inc2 = c;
#pragma unroll
        for (int o = 1; o < 32; o <<= 1) { const unsigned v = shupu(inc2, o, lane); if (lane >= o) inc2 += v; }
        const unsigned long long bal2 = __ballot(lane < 32 && above + inc2 >= K);
        const int I = __builtin_amdgcn_readfirstlane(bal2 ? (__ffsll((long long)bal2) - 1) : 0);
        if (lane == I) { AUX[64 * pass + qq] = (unsigned)bin; AUX[64 * pass + 32 + qq] = K - (above + inc2 - c); }
    }
}
__device__ __forceinline__ void dsa_select_unit(LAS unsigned char* lds, int b, int qg, const bf16* IX, unsigned* MASK) {
    int tid_l = threadIdx.x; asm volatile("" : "+v"(tid_l)); const int tid = tid_l, lane = tid & 63, wid = __builtin_amdgcn_readfirstlane(tid >> 6), r32 = lane & 31, hi = lane >> 5;
    const int t = 32 * qg + r32;
    const size_t rowg = (size_t)b * SEQ;
    const bf16* qrow = IX + (rowg + t) * 256;
    bf16x8 iqf[4][2];
#pragma unroll
    for (int hh = 0; hh < 4; ++hh)
#pragma unroll
        for (int ds = 0; ds < 2; ++ds) iqf[hh][ds] = *(const bf16x8*)(qrow + 32 * hh + 16 * ds + 8 * hi);
    float w[4];
    { const v2u ww = *(const v2u*)(qrow + 160); w[0] = bflo(ww.x); w[1] = bfhi(ww.x); w[2] = bflo(ww.y); w[3] = bfhi(ww.y); }
    LAS unsigned* hist = (LAS unsigned*)lds;
    LAS unsigned* AUX = (LAS unsigned*)(lds + DS_AUX);
    const bf16* kbase = IX + (rowg + r32) * 256 + 128 + 8 * hi;
    unsigned P = 0u;
    const bool all = (qg < 8);
    if (!all) {
        for (int i = tid; i < DS_HIST_BYTES / 16; i += 512) ((LAS v4u*)lds)[i] = (v4u){0u, 0u, 0u, 0u};
        __syncthreads();
        dsa_hist_pass<0>(hist, iqf, w, kbase, qg, wid, r32, hi, t, 0u);
        __syncthreads();
        dsa_scan(hist, AUX, 0, wid, lane);
        __syncthreads();
        const unsigned P1 = AUX[r32];
        for (int i = tid; i < DS_HIST_BYTES / 16; i += 512) ((LAS v4u*)lds)[i] = (v4u){0u, 0u, 0u, 0u};
        __syncthreads();
        dsa_hist_pass<1>(hist, iqf, w, kbase, qg, wid, r32, hi, t, P1);
        __syncthreads();
        dsa_scan(hist, AUX, 1, wid, lane);
        __syncthreads();
        P = (P1 << 11) | AUX[64 + r32];
    }
    if (all) { if (tid < 32) { AUX[64 + 32 + tid] = 0u; } }
    for (int i = tid; i < (2 * 32 * DS_BP * 4) / 16; i += 512) ((LAS v4u*)lds)[i] = (v4u){0u, 0u, 0u, 0u};
    __syncthreads();
    LAS unsigned* G = (LAS unsigned*)(lds + DS_G);
    LAS unsigned* C = (LAS unsigned*)(lds + DS_C);
    bf16x8 nk0, nk1;
    { const int j0 = (wid <= qg) ? wid : 0; nk0 = *(const bf16x8*)(kbase + (size_t)j0 * 32 * 256); nk1 = *(const bf16x8*)(kbase + (size_t)j0 * 32 * 256 + 16); }
#pragma nounroll
    for (int j = wid; j <= qg; j += 8) {
        const bf16x8 k0 = nk0, k1 = nk1;
        { const int jn = (j + 8 <= qg) ? j + 8 : j; const bf16* kp = kbase + (size_t)jn * 32 * 256; nk0 = *(const bf16x8*)kp; nk1 = *(const bf16x8*)(kp + 16); }
        float sc[16]; dsa_scores(iqf, w, k0, k1, sc);
        unsigned bg = 0u, bc = 0u;
        const int lim = t - 32 * j - 4 * hi;
#pragma unroll
        for (int r = 0; r < 16; ++r) {
            const int pos = (r & 3) + 8 * (r >> 2) + 4 * hi;
            const unsigned p22 = dsa_ckey(sc[r], 32u * (unsigned)j + (unsigned)pos) >> 10;
            const bool ok = ((r & 3) + 8 * (r >> 2)) <= lim;
            if (ok && p22 > P) bg |= 1u << pos;
            if (ok && p22 == P) bc |= 1u << pos;
        }
        bg |= shxu(bg, 32, lane); bc |= shxu(bc, 32, lane);
        if (hi == 0) { G[r32 * DS_BP + j] = bg; C[r32 * DS_BP + j] = bc; }
    }
    __syncthreads();
#pragma nounroll
    for (int qi = 0; qi < 4; ++qi) {
        const int qq = 4 * wid + qi;
        const unsigned K2 = AUX[64 + 32 + qq];
        const unsigned w0 = C[qq * DS_BP + 2 * lane], w1 = C[qq * DS_BP + 2 * lane + 1];
        const unsigned pc = (unsigned)__popc(w0) + (unsigned)__popc(w1);
        unsigned incl = pc;
#pragma unroll
        for (int o = 1; o < 64; o <<= 1) { const unsigned v = shupu(incl, o, lane); if (lane >= o) incl += v; }
        const unsigned pre = incl - pc;
        unsigned need = K2 > pre ? K2 - pre : 0u;
        const unsigned t0 = take_low(w0, need); need -= (unsigned)__popc(t0);
        const unsigned t1 = take_low(w1, need);
        G[qq * DS_BP + 2 * lane] |= t0; G[qq * DS_BP + 2 * lane + 1] |= t1;
    }
    __syncthreads();
    { const int qq = tid >> 4, part = tid & 15;
        unsigned* dst = MASK + (rowg + 32 * qg + qq) * 128 + part * 8;
        v4u a, c2;
        a.x = G[qq * DS_BP + part * 8 + 0]; a.y = G[qq * DS_BP + part * 8 + 1]; a.z = G[qq * DS_BP + part * 8 + 2]; a.w = G[qq * DS_BP + part * 8 + 3];
        c2.x = G[qq * DS_BP + part * 8 + 4]; c2.y = G[qq * DS_BP + part * 8 + 5]; c2.z = G[qq * DS_BP + part * 8 + 6]; c2.w = G[qq * DS_BP + part * 8 + 7];
        *(v4u*)dst = a; *(v4u*)(dst + 4) = c2; }
    __syncthreads();
}

constexpr int PL_U = 0, PL_UP = 528, PL_D = 79 * 528 + 16  , PL_DP = 257;
__device__ __forceinline__ void pool_unit(LAS unsigned char* lds, int b, int tile, const bf16* PU, const float* wpool  , const float* pscale  , bf16* YC) {
    int tid_l = threadIdx.x; asm volatile("" : "+v"(tid_l)); const int tid = tid_l, cb = __builtin_amdgcn_readfirstlane(tid >> 6), tt = tid & 63;
    const int t0 = tile * 64; const size_t rowg = (size_t)b * SEQ;
    for (int i = tid; i < 79 * 32; i += 512) { const int rr = i >> 5, ch = i & 31; const int tok = t0 - 15 + rr;
        v4u v = (v4u){0u, 0u, 0u, 0u}; if (tok >= 0) v = *(const v4u*)(PU + (rowg + tok) * 256 + ch * 8);
        *(LAS v4u*)(lds + PL_U + rr * PL_UP + ch * 16) = v; }
    __syncthreads();
    const int g = cb >> 1, wlen = 2 << g, c0 = 32 * cb, t = t0 + tt;
    const float inv = 1.f / (float)((t + 1 < wlen) ? (t + 1) : wlen);
    LAS float* Dm = (LAS float*)(lds + PL_D);
#pragma unroll
    for (int ch = 0; ch < 4; ++ch) {
        float sum[8];
#pragma unroll
        for (int e = 0; e < 8; ++e) sum[e] = 0.f;
        float self[8];
        for (int i = 0; i < wlen; ++i) {
            const v4u v = *(LAS const v4u*)(lds + PL_U + (15 + tt - i) * PL_UP + (c0 + 8 * ch) * 2);
            const float f[8] = {bflo(v.x), bfhi(v.x), bflo(v.y), bfhi(v.y), bflo(v.z), bfhi(v.z), bflo(v.w), bfhi(v.w)};
#pragma unroll
            for (int e = 0; e < 8; ++e) { sum[e] += f[e]; if (i == 0) self[e] = f[e]; }
        }
#pragma unroll
        for (int e = 0; e < 8; ++e) Dm[tt * PL_DP + c0 + 8 * ch + e] = sum[e] * inv - self[e];
    }
    __syncthreads();
    const int e0 = 32 * (cb & 1);
    float acc[32];
#pragma unroll
    for (int e = 0; e < 32; ++e) acc[e] = 0.f;
    const float* wg = wpool + (size_t)g * 4096 + e0;
    for (int c = 0; c < 64; ++c) {
        const float dv = Dm[tt * PL_DP + 64 * g + c];
        const float* wr = wg + c * 64;
#pragma unroll
        for (int e = 0; e < 32; ++e) acc[e] = __builtin_fmaf(dv, wr[e], acc[e]);
    }
    bf16* orow = YC + (rowg + t) * 256 + 64 * g + e0;
    const float* ps = pscale + 64 * g + e0;
#pragma unroll
    for (int k = 0; k < 4; ++k) { v4u o;
        o.x = pk2(acc[8 * k + 0] * ps[8 * k + 0], acc[8 * k + 1] * ps[8 * k + 1]); o.y = pk2(acc[8 * k + 2] * ps[8 * k + 2], acc[8 * k + 3] * ps[8 * k + 3]);
        o.z = pk2(acc[8 * k + 4] * ps[8 * k + 4], acc[8 * k + 5] * ps[8 * k + 5]); o.w = pk2(acc[8 * k + 6] * ps[8 * k + 6], acc[8 * k + 7] * ps[8 * k + 7]);
        *(v4u*)(orow + 8 * k) = o; }
    __syncthreads();
}
__device__ __forceinline__ void kmean_item(int item, const bf16* AK, float* KMEAN, int wid, int lane_in) {
    int lane = lane_in; asm volatile("" : "+v"(lane));
    const int combo = item * 8 + wid; const int b = combo >> 6, h = (combo >> 4) & 3, n = combo & 15;
    const int ks = lane >> 3, ch = lane & 7;
    const bf16* p = AK + ((size_t)b * SEQ + 256 * n + ks) * 256 + 64 * h + 8 * ch;
    float s[8];
#pragma unroll
    for (int e = 0; e < 8; ++e) s[e] = 0.f;
#pragma unroll 8
    for (int j = 0; j < 32; ++j) { const v4u v = *(const v4u*)(p + (size_t)j * 8 * 256);
        s[0] += bflo(v.x); s[1] += bfhi(v.x); s[2] += bflo(v.y); s[3] += bfhi(v.y); s[4] += bflo(v.z); s[5] += bfhi(v.z); s[6] += bflo(v.w); s[7] += bfhi(v.w); }
#pragma unroll
    for (int e = 0; e < 8; ++e) { s[e] += shx(s[e], 8, lane); s[e] += shx(s[e], 16, lane); s[e] += shx(s[e], 32, lane); }
    if (ks == 0) { float* o = KMEAN + (size_t)combo * 64 + 8 * ch;
        *(f32x4*)o = (f32x4){s[0], s[1], s[2], s[3]} * (1.f / 256.f); *(f32x4*)(o + 4) = (f32x4){s[4], s[5], s[6], s[7]} * (1.f / 256.f); }
}

__device__ __forceinline__ void norm_unit(LAS unsigned char* lds, int n, const bf16* PROJ, size_t TS, unsigned* NRM  ) {
    int tid_l = threadIdx.x; asm volatile("" : "+v"(tid_l)); const int tid = tid_l, lane = tid & 63, wid = __builtin_amdgcn_readfirstlane(tid >> 6);
    const int a = n >> 6, rem = n & 63, sq = rem >> 5, b = (rem >> 2) & 7, c = rem & 3;
    const int tile = (a == 0 ? 0 : (a == 1 ? 3 : 7)) + sq;
    const int row = tid >> 1, hp = tid & 1;
    float ss[2] = {0.f, 0.f};
#pragma unroll
    for (int rr = 0; rr < 4; ++rr) {
        const bf16* p = PROJ + (size_t)tile * TS + ((size_t)b * SEQ + 1024 * c + 256 * rr + row) * 256 + 128 * hp;
#pragma unroll
        for (int hh = 0; hh < 2; ++hh) { float acc = 0.f;
#pragma unroll
            for (int i = 0; i < 8; ++i) { const v4u v = *(const v4u*)(p + 64 * hh + 8 * i);
                const float f0 = bflo(v.x), f1 = bfhi(v.x), f2 = bflo(v.y), f3 = bfhi(v.y), f4 = bflo(v.z), f5 = bfhi(v.z), f6 = bflo(v.w), f7 = bfhi(v.w);
                acc += (f0 * f0 + f1 * f1) + (f2 * f2 + f3 * f3) + (f4 * f4 + f5 * f5) + (f6 * f6 + f7 * f7); }
            ss[hh] = fmaxf(ss[hh], acc); }
    }
#pragma unroll
    for (int o = 2; o < 64; o <<= 1) { ss[0] = fmaxf(ss[0], shx(ss[0], o, lane)); ss[1] = fmaxf(ss[1], shx(ss[1], o, lane)); }
    LAS float* R = (LAS float*)lds;
    if (lane < 2) { R[wid * 4 + 2 * hp] = ss[0]; R[wid * 4 + 2 * hp + 1] = ss[1]; }
    __syncthreads();
    if (tid < 4) { float m = R[tid];
#pragma unroll
        for (int w2 = 1; w2 < 8; ++w2) m = fmaxf(m, R[w2 * 4 + tid]);
        __hip_atomic_fetch_max(NRM + ((a * 2 + sq) * 8 + b) * 4 + tid, __float_as_uint(m * 1.0001f), __ATOMIC_RELAXED, __HIP_MEMORY_SCOPE_AGENT); }
    __syncthreads();
}

__device__ __forceinline__ float alibi_slope(int idx  ) { return exp2f(-8.f * (float)idx / 12.f); }

__device__ __forceinline__ void p0_adaln(const Args& A, LAS unsigned char* lds, int G) {
    int tid_l = threadIdx.x; asm volatile("" : "+v"(tid_l)); const int tid = tid_l, lane = tid & 63, wid = __builtin_amdgcn_readfirstlane(tid >> 6);
    LAS float* cact = (LAS float*)lds;
    LAS float* red = (LAS float*)(lds + 32768);
    float* MOD = (float*)(A.ws + WS_MOD);
    if ((int)blockIdx.x < 192) {
        for (int i = tid; i < 8192; i += 512) { const int bb = i >> 10, k = i & 1023; const float v = A.c[i]; cact[k * 8 + bb] = v / (1.f + __expf(-v)); }
        __syncthreads();
        for (int u = blockIdx.x; u < 192; u += G) {
            const int l = u / 96, n0 = (u % 96) * 64;
            const float* wp = A.w_ada + ((size_t)l * 1024 + 128 * wid) * 6144 + n0 + lane;
            float acc[8];
#pragma unroll
            for (int bb = 0; bb < 8; ++bb) acc[bb] = 0.f;
#pragma unroll 16
            for (int k = 0; k < 128; ++k) {
                const float wv = wp[(size_t)k * 6144];
                const f32x4 c0 = *(LAS const f32x4*)(cact + (128 * wid + k) * 8), c1 = *(LAS const f32x4*)(cact + (128 * wid + k) * 8 + 4);
                acc[0] += c0[0] * wv; acc[1] += c0[1] * wv; acc[2] += c0[2] * wv; acc[3] += c0[3] * wv;
                acc[4] += c1[0] * wv; acc[5] += c1[1] * wv; acc[6] += c1[2] * wv; acc[7] += c1[3] * wv;
            }
#pragma unroll
            for (int bb = 0; bb < 8; ++bb) red[(wid * 8 + bb) * 64 + lane] = acc[bb];
            __syncthreads();
            { const int bb = wid; float s = A.b_ada[(size_t)l * 6144 + n0 + lane];
#pragma unroll
                for (int w2 = 0; w2 < 8; ++w2) s += red[(w2 * 8 + bb) * 64 + lane];
                MOD[((size_t)l * 8 + bb) * 6144 + n0 + lane] = s; }
            __syncthreads();
        }
    }
    __syncthreads();
}
__device__ __forceinline__ void p0_weights(const Args& A, LAS unsigned char* lds, int vcu, int G) {
    int tid_l = threadIdx.x; asm volatile("" : "+v"(tid_l)); const int tid = tid_l, lane = tid & 63, wid = __builtin_amdgcn_readfirstlane(tid >> 6);
    unsigned char* ws = A.ws;
    LAS float* scr = (LAS float*)(lds + wid * 16384);
    const int gw = vcu * NWAVES + wid, NGW = G * NWAVES;
    constexpr int I_IN = 16 * (NPROJ_PAD / 32), I_G1 = 16 * 32, I_BR1 = 4 * 32, I_OUT = 16 * 32, I_F1 = 16 * 128, I_F2 = 64 * 32;
    constexpr int I_LAYER = I_IN + 4 * I_G1 + 4 * I_BR1 + I_OUT + I_F1 + I_F2;
    for (int it = gw; it < 2 * I_LAYER; it += NGW) {
        const int l = it / I_LAYER; int r = it % I_LAYER;
        bf16* WL = (bf16*)(ws + WS_W) + (size_t)l * W_LAYER;
        if (r < I_IN) { p0_transpose_item(A.w_in + (size_t)l * DM * NPROJ, DM, NPROJ, NPROJ_PAD, WL + W_IN, 0, 0, scr, r, lane); continue; } r -= I_IN;
        if (r < 4 * I_G1) { const int br = r / I_G1; p0_transpose_item(A.w_gate + ((size_t)l * 4 + br) * DM * DM, DM, DM, DM, WL + W_GATE, 1, br, scr, r % I_G1, lane); continue; } r -= 4 * I_G1;
        if (r < 4 * I_BR1) { const int br = r / I_BR1; p0_transpose_item(A.w_branch + ((size_t)l * 4 + br) * 256 * DM, 256, DM, DM, WL + W_BR + (size_t)br * DM * 256, 0, 0, scr, r % I_BR1, lane); continue; } r -= 4 * I_BR1;
        if (r < I_OUT) { p0_transpose_item(A.w_out + (size_t)l * DM * DM, DM, DM, DM, WL + W_OUT, 0, 0, scr, r, lane); continue; } r -= I_OUT;
        if (r < I_F1) { p0_transpose_item(A.w_ff1 + (size_t)l * DM * FF, DM, FF, FF, WL + W_FF1, 0, 0, scr, r, lane); continue; } r -= I_F1;
        p0_transpose_item(A.w_ff2 + (size_t)l * FF * DM, FF, DM, DM, WL + W_FF2, 0, 0, scr, r, lane);
    }
    __syncthreads();
}

__device__ __forceinline__ int wq_draw(gu32* ctr) { int v = 0; if (threadIdx.x == 0) v = (int)__hip_atomic_fetch_add(ctr, 1u, RLX_AGENT); return v; }
__device__ __forceinline__ int wq_bcast(volatile LAS unsigned* slot, int v) {
    if (threadIdx.x == 0) *slot = (unsigned)v;
    __syncthreads();
    const int item = (int)*slot;
    __syncthreads();
    return item;
}

struct ZOrder {
    pg8::StaticOrder base;
    __device__ __forceinline__ bool next(int i, pg8::Unit& u) const { if (!base.next(i, u)) return false; u.pn += 4 * (u.pm >> 7); return true; }
    __device__ __forceinline__ void a_ready(const pg8::Unit&) const {}
    __device__ __forceinline__ void done(const pg8::Unit&) const {}
};

__global__ void __launch_bounds__(NWAVES * 64, 2) hybrid_fwd(Args args) {
    extern __shared__ __attribute__((aligned(16))) unsigned char lds_raw[];
    LAS unsigned char* lds = (LAS unsigned char*)lds_raw;
#define PHASE_IDS int tid_p = threadIdx.x; asm volatile("" : "+v"(tid_p)); const int lane = tid_p & 63, wid = __builtin_amdgcn_readfirstlane(tid_p >> 6); const int gw = vcu * NWAVES + wid, ngw = G * NWAVES; (void)lane; (void)gw; (void)ngw;
    const int G = gridDim.x; const int bx = blockIdx.x; const int vcu = (G % 8 == 0) ? (bx % 8) * (G / 8) + bx / 8 : bx;
    unsigned char* ws = args.ws;
    gu32* ctl = (gu32*)(ws + WS_CTL);
    volatile LAS unsigned* MISC = (volatile LAS unsigned*)(lds + LDSCTL_OFF);
    for (int u = threadIdx.x; u < (LDS_BYTES - LDSCTL_OFF) / 4; u += NWAVES * 64) ((LAS unsigned*)(lds + LDSCTL_OFF))[u] = 0u;
    __syncthreads();
    const int lo = args.ph_lo, hi = args.ph_hi;
    XcdBarrier bar; bar.bar = (unsigned*)(ctl + CW_BAR) + args.li * XCD_BAR_WORDS; bar.x = 0; bar.st = nullptr;
    if (hi - lo > 1) bar = xcd_barrier_post((unsigned*)(ctl + CW_BAR) + args.li * XCD_BAR_WORDS, MISC + 8);
#ifndef PHASE_OFF
#define PHASE_OFF 0
#endif
#define IN(k) (lo <= (k) && (k) < hi && !((PHASE_OFF >> ((k) == 0 ? 0 : (k) == 21 ? 11 : (((k) - 1) % 10) + 1)) & 1))
#ifndef REPEAT_MASK
#define REPEAT_MASK 0
#endif
#define NREP(bit) (((REPEAT_MASK >> (bit)) & 1) ? 2 : 1)
#define SEAM(k) do { if (IN(k) && IN((k) + 1)) xcd_barrier(bar); } while (0)
    float* MOD = (float*)(ws + WS_MOD);
    float* KMEAN = (float*)(ws + WS_KMEAN);
    unsigned* MASK = (unsigned*)(ws + WS_MASK);
    bf16* H = (bf16*)(ws + WS_H);
    bf16* Y = (bf16*)(ws + WS_Y);
    bf16* MERGED = (bf16*)(ws + WS_Y);
    bf16* PROJ = (bf16*)(ws + WS_R);
    bf16* Z = (bf16*)(ws + WS_R);
    bf16* U = (bf16*)(ws + WS_R);
    float* XR = args.out;
    constexpr size_t TS = (size_t)TOK * 256;
    volatile LAS unsigned* wqslot = MISC + 16;

    if (IN(0)) for (int rep = 0; rep < NREP(0); ++rep) { p0_adaln(args, lds, G); }
    SEAM(0);

#pragma nounroll
    for (int l = 0; l < NL; ++l) {
        const int pb = 1 + 10 * l;
        const float* modl = MOD + (size_t)l * 8 * 6144;
        const bf16* WL = (const bf16*)(ws + WS_W) + (size_t)l * W_LAYER;
        const float* xin = (l == 0) ? args.x : XR;
        if (IN(pb + 0)) for (int rep = 0; rep < NREP(1); ++rep) { PHASE_IDS norm_rows_bf16(xin, H, args.norm1_g + (size_t)l * DM, modl, 0, 1, gw, ngw, lane); if (l == 0) p0_weights(args, lds, vcu, G); }
        SEAM(pb + 0);
        if (IN(pb + 1)) for (int rep = 0; rep < NREP(2); ++rep) {
            pg8::Gemm g{H, WL + W_IN, TOK, NPROJ_PAD, DM}; pg8::StaticOrder S; S.init(TOK, NPROJ_PAD, G, bx);
            pg8::EpiProj E{PROJ, TS};
            pg8::gemm_phase<pg8::EpiProj, pg8::StaticOrder, true, true>(lds, g, S, E);
        }
        SEAM(pb + 1);
        unsigned* NRM = (unsigned*)(ctl + CW_NRM) + l * 192;
        if (IN(pb + 2)) for (int rep = 0; rep < NREP(3); ++rep) {
            gu32* ctr = ctl + CW_WQ + (l * 2 + 0 + 4 * rep) * 64;
            int raw = wq_draw(ctr);
            for (;;) {
                const int item = wq_bcast(wqslot, raw);
                if (item >= 1024 + 512 + 64 + 192) break;
                raw = wq_draw(ctr);
                if (item < 1024) { const int qg = 127 - (item >> 3), b = item & 7;
                    dsa_select_unit(lds, b, qg, PROJ + 10 * TS, MASK);
                } else if (item < 1536) { const int i2 = item - 1024; const int b = i2 >> 6, tile = i2 & 63;
                    pool_unit(lds, b, tile, PROJ + 6 * TS, args.w_pool + (size_t)l * 4 * 4096, args.pool_scale + (size_t)l * 256, Y + 2 * TS);
                } else if (item < 1600) { PHASE_IDS kmean_item(item - 1536, PROJ + 1 * TS, KMEAN, wid, lane);
                } else { norm_unit(lds, item - 1600, PROJ, TS, NRM); }
            }
        }
        SEAM(pb + 2);
        if (IN(pb + 3)) for (int rep = 0; rep < NREP(4); ++rep) {
            gu32* ctr = ctl + CW_WQ + 512 + ((l * 2 + rep) * 8) * 64;
            const float li = 0.8f - 0.6f * __expf(-0.3f * (float)l);
            const float* dl = args.diff_lambda + (size_t)l * 128;
            float d1 = 0.f, d2 = 0.f;
            for (int i = 0; i < 32; ++i) { d1 += dl[i] * dl[32 + i]; d2 += dl[64 + i] * dl[96 + i]; }
            const float lam = __expf(d1) - __expf(d2) + li;
            int raw = wq_draw(ctr);
            for (;;) {
                const int item = wq_bcast(wqslot, raw);
                if (item >= 1536) break;
                raw = wq_draw(ctr);
                const int ty = item % 3, rest = item / 3; const int qb = 15 - (rest >> 5), bh = rest & 31, b = bh >> 2, h = bh & 3;
                if (ty == 0) attn_unit<1>(lds, b, h, qb, PROJ + 3 * TS, PROJ + 4 * TS, PROJ + 5 * TS, Y + 1 * TS, alibi_slope(3 * h + 2), nullptr, lam, 1.f - li, args.diff_subln_g + (size_t)l * 64, nullptr, NRM + 64);
                else if (ty == 1) attn_unit<0>(lds, b, h, qb, PROJ + 0 * TS, PROJ + 1 * TS, PROJ + 2 * TS, Y + 0 * TS, alibi_slope(3 * h + 1), KMEAN, 0.f, 0.f, nullptr, nullptr, NRM);
                else              attn_unit<2>(lds, b, h, qb, PROJ + 7 * TS, PROJ + 8 * TS, PROJ + 9 * TS, Y + 3 * TS, alibi_slope(3 * h + 3), nullptr, 0.f, 0.f, nullptr, MASK, NRM + 128);
            }
        }
        SEAM(pb + 3);
        if (IN(pb + 4)) for (int rep = 0; rep < NREP(5); ++rep) {
            int kz = 256; asm volatile("" : "+s"(kz)); pg8::Gemm g{Y, WL + W_BR, 4 * TOK, 4096, kz}; ZOrder S; S.base.init(4 * TOK, DM, G, bx);
            pg8::EpiZ E{Z};
            pg8::gemm_phase<pg8::EpiZ, ZOrder, true, true>(lds, g, S, E);
        }
        SEAM(pb + 4);
        if (IN(pb + 5)) for (int rep = 0; rep < NREP(6); ++rep) {
            pg8::Gemm g{H, WL + W_GATE, TOK, 4096, DM}; pg8::StaticOrder S; S.init(TOK, 4096, G, bx);
            pg8::EpiGate E{Z, args.b_gate + (size_t)l * 4 * DM, MERGED};
            pg8::gemm_phase<pg8::EpiGate, pg8::StaticOrder, true, true>(lds, g, S, E);
        }
        SEAM(pb + 5);
        if (IN(pb + 6)) for (int rep = 0; rep < NREP(7); ++rep) {
            pg8::Gemm g{MERGED, WL + W_OUT, TOK, DM, DM}; pg8::StaticOrder S; S.init(TOK, DM, G, bx);
            pg8::EpiResid E{xin, rep ? (float*)(ws + WS_R) : XR, modl + 2 * 1024};
            pg8::gemm_phase<pg8::EpiResid, pg8::StaticOrder, true, true>(lds, g, S, E);
        }
        SEAM(pb + 6);
        if (IN(pb + 7)) for (int rep = 0; rep < NREP(8); ++rep) { PHASE_IDS norm_rows_bf16(XR, H, args.norm2_g + (size_t)l * DM, modl, 3, 4, gw, ngw, lane); }
        SEAM(pb + 7);
        if (IN(pb + 8)) for (int rep = 0; rep < NREP(9); ++rep) {
            pg8::Gemm g{H, WL + W_FF1, TOK, FF, DM}; pg8::StaticOrder S; S.init(TOK, FF, G, bx);
            pg8::EpiRelu2 E{U, FF};
            pg8::gemm_phase<pg8::EpiRelu2, pg8::StaticOrder, true, true>(lds, g, S, E);
        }
        SEAM(pb + 8);
        if (IN(pb + 9)) for (int rep = 0; rep < NREP(10); ++rep) {
            pg8::Gemm g{U, WL + W_FF2, TOK, DM, FF}; pg8::StaticOrder S; S.init(TOK, DM, G, bx);
            pg8::EpiResid E{XR, rep ? (float*)(ws + WS_MASK) : XR, modl + 5 * 1024};
            pg8::gemm_phase<pg8::EpiResid, pg8::StaticOrder, true, true>(lds, g, S, E);
        }
        SEAM(pb + 9);
    }
    if (IN(21)) { PHASE_IDS final_norm_rows(XR, args.final_g, gw, ngw, lane); }
#undef IN
#undef SEAM
}

#ifndef MK_SPLIT
#define MK_SPLIT 0
#endif
extern "C" void kernel_launch(void* const* d_in, const int* in_sizes, int n_in, void* d_out, int out_size, void* d_ws, size_t ws_size, hipStream_t stream) {
    static int grid = 0;
    if (grid == 0) {
        if (n_in != 18 || in_sizes[0] != TOK * DM || out_size != TOK * DM || ws_size < WS_END) { fprintf(stderr, "kernel_launch: unexpected shapes (n_in %d, in0 %d, out %d, ws %zu)\n", n_in, n_in > 0 ? in_sizes[0] : -1, out_size, ws_size); grid = -1; return; }
        int dev = 0, cus = 0, per_cu = 0;
        if (hipGetDevice(&dev) != hipSuccess || hipDeviceGetAttribute(&cus, hipDeviceAttributeMultiprocessorCount, dev) != hipSuccess) { grid = -1; return; }
        if (hipFuncSetAttribute((const void*)hybrid_fwd, hipFuncAttributeMaxDynamicSharedMemorySize, LDS_BYTES) != hipSuccess) { fprintf(stderr, "kernel_launch: hipFuncSetAttribute failed\n"); grid = -1; return; }
        if (hipOccupancyMaxActiveBlocksPerMultiprocessor(&per_cu, (const void*)hybrid_fwd, NWAVES * 64, LDS_BYTES) != hipSuccess || per_cu < 1) fprintf(stderr, "kernel_launch: occupancy query reports %d\n", per_cu);
        (void)hipGetLastError();
        grid = cus;
    }
    if (grid < 0) return;
    if (hipMemsetAsync((char*)d_ws + WS_CTL, 0, CTL_ZERO_BYTES, stream) != hipSuccess) return;
    Args a{};
    const float** ap = (const float**)&a;
    for (int i = 0; i < 18; ++i) ap[i] = (const float*)d_in[i];
    a.out = (float*)d_out; a.ws = (unsigned char*)d_ws; a.pad = 0;
#if MK_SPLIT
    for (int p = 0; p < NPHASE; ++p) { a.ph_lo = p; a.ph_hi = p + 1; a.li = 0;
        hipLaunchKernelGGL(hybrid_fwd, dim3(grid), dim3(NWAVES * 64), LDS_BYTES, stream, a); }
#else
    a.ph_lo = 0; a.ph_hi = NPHASE; a.li = 0;
    hipLaunchKernelGGL(hybrid_fwd, dim3(grid), dim3(NWAVES * 64), LDS_BYTES, stream, a);
#endif
}
```

```cpp
#include <hip/hip_runtime.h>
#include <cstdio>
#include <cstdint>
namespace pg8 {
#define PG8_LAS __attribute__((address_space(3)))
typedef unsigned short bf16_t;
typedef short bf16x8 __attribute__((ext_vector_type(8)));
typedef float f32x4 __attribute__((ext_vector_type(4)));
typedef unsigned u32x4 __attribute__((ext_vector_type(4)));
constexpr int BM = 256, BK = 64, HALF = 128, HTB = HALF * BK * 2  , STAGE_BYTES = 8 * HTB, NXCD = 8, WGM = 8;

__host__ __device__ __forceinline__ int lds_byte(int r, int c) { const int st = (r >> 4) * 2 + (c >> 5), rr = r & 15, cc = c & 31, ob = rr * 64 + cc * 2; return st * 1024 + (ob ^ (((ob >> 9) & 1) << 5)); }
__host__ __device__ __forceinline__ void stage_rc(int b, int& R, int& C) { const int st = b / 1024, sb = b % 1024, swz = sb ^ (((sb >> 9) & 1) << 5); R = (st >> 1) * 16 + swz / 64; C = (st & 1) * 32 + (swz % 64) / 2; }
__host__ __device__ __forceinline__ int perm32(int rho) { const int n = rho >> 4, i = rho & 15; return 8 * (i >> 2) + 4 * n + (i & 3); }

struct Unit { int pm, pn; };
struct Gemm { const bf16_t* A; const bf16_t* Bt; int M, N, K; };

struct StaticOrder {
    int nM, nN, nwg, G, c;
    __host__ __device__ void init(int M, int N, int G_, int c_) { nM = M / BM; nN = N / BM; nwg = nM * nN; G = G_; c = c_; }
    __host__ __device__ bool next(int i, Unit& u) const {
        const long L = (long)i * G + c; if (L >= nwg) return false;
        int wgid = (int)L; { const int q = nwg / NXCD, r = nwg % NXCD, xcd = wgid % NXCD, off = wgid / NXCD; wgid = (xcd < r ? xcd * (q + 1) : r * (q + 1) + (xcd - r) * q) + off; }
        const int nig = WGM * nN, gid = wgid / nig, fm = gid * WGM, gsz = (nM - fm) < WGM ? (nM - fm) : WGM;
        u.pm = fm + ((wgid % nig) % gsz); u.pn = (wgid % nig) / gsz; return true;
    }
    __device__ __forceinline__ void a_ready(const Unit&) const {}
    __device__ __forceinline__ void done(const Unit&) const {}
};

__device__ __forceinline__ unsigned cvt_pk_bf16(float lo, float hi) { unsigned r; asm volatile("v_cvt_pk_bf16_f32 %0, %1, %2" : "=v"(r) : "v"(lo), "v"(hi)); return r; }
typedef unsigned u32x2 __attribute__((ext_vector_type(2)));
constexpr int TT = 32768;
constexpr float QS64 = 0.125f * 1.4426950408889634f;
constexpr float QS32 = 0.17677669529663687f * 1.4426950408889634f;

struct EpiProj {
    static constexpr bool PERM = true, AFTER_DRAIN = false;
    bf16_t* O; size_t tile_stride;
    __device__ __forceinline__ void operator()(const f32x4 (&acc)[2][2][4][2], const Unit& u, int wr, int wc, int fr, int fq) const {
        const int row0 = u.pm * BM + wr * 64 + fr; bf16_t* base = O + (size_t)u.pn * tile_stride;
        float sc = 1.f; if (u.pn == 0 || u.pn == 7) sc = QS64; else if (u.pn == 3) sc = QS32;
        const int col0 = wc * 32 + 8 * fq;
#pragma unroll
        for (int ai = 0; ai < 2; ++ai)
#pragma unroll
            for (int m = 0; m < 4; ++m) { bf16_t* rowp = base + (size_t)(row0 + ai * HALF + m * 16) * 256 + col0;
#pragma unroll
                for (int bj = 0; bj < 2; ++bj) { const f32x4 v0 = acc[ai][bj][m][0] * sc, v1 = acc[ai][bj][m][1] * sc;
                    u32x4 w; w.x = cvt_pk_bf16(v0[0], v0[1]); w.y = cvt_pk_bf16(v0[2], v0[3]); w.z = cvt_pk_bf16(v1[0], v1[1]); w.w = cvt_pk_bf16(v1[2], v1[3]);
                    *(u32x4*)(rowp + bj * HALF) = w; } }
    }
};
struct EpiZ {
    static constexpr bool PERM = true, AFTER_DRAIN = false;
    bf16_t* O;
    __device__ __forceinline__ void operator()(const f32x4 (&acc)[2][2][4][2], const Unit& u, int wr, int wc, int fr, int fq) const {
        const int row0 = u.pm * BM + wr * 64 + fr; const int col0 = (u.pn & 3) * BM + wc * 32 + 8 * fq;
#pragma unroll
        for (int ai = 0; ai < 2; ++ai)
#pragma unroll
            for (int m = 0; m < 4; ++m) { bf16_t* rowp = O + (size_t)(row0 + ai * HALF + m * 16) * 1024 + col0;
#pragma unroll
                for (int bj = 0; bj < 2; ++bj) { const f32x4 v0 = acc[ai][bj][m][0], v1 = acc[ai][bj][m][1];
                    u32x4 w; w.x = cvt_pk_bf16(v0[0], v0[1]); w.y = cvt_pk_bf16(v0[2], v0[3]); w.z = cvt_pk_bf16(v1[0], v1[1]); w.w = cvt_pk_bf16(v1[2], v1[3]);
                    *(u32x4*)(rowp + bj * HALF) = w; } }
    }
};
struct EpiRelu2 {
    static constexpr bool PERM = true, AFTER_DRAIN = false;
    bf16_t* O; int ldc;
    __device__ __forceinline__ void operator()(const f32x4 (&acc)[2][2][4][2], const Unit& u, int wr, int wc, int fr, int fq) const {
        const int row0 = u.pm * BM + wr * 64 + fr; const int col0 = u.pn * BM + wc * 32 + 8 * fq;
#pragma unroll
        for (int ai = 0; ai < 2; ++ai)
#pragma unroll
            for (int m = 0; m < 4; ++m) { bf16_t* rowp = O + (size_t)(row0 + ai * HALF + m * 16) * ldc + col0;
#pragma unroll
                for (int bj = 0; bj < 2; ++bj) { f32x4 v0 = acc[ai][bj][m][0], v1 = acc[ai][bj][m][1];
#pragma unroll
                    for (int j = 0; j < 4; ++j) { const float a = fmaxf(v0[j], 0.f), b = fmaxf(v1[j], 0.f); v0[j] = a * a; v1[j] = b * b; }
                    u32x4 w; w.x = cvt_pk_bf16(v0[0], v0[1]); w.y = cvt_pk_bf16(v0[2], v0[3]); w.z = cvt_pk_bf16(v1[0], v1[1]); w.w = cvt_pk_bf16(v1[2], v1[3]);
                    *(u32x4*)(rowp + bj * HALF) = w; } }
    }
};
template <bool BASE_BF16> struct EpiResid {
    static constexpr bool PERM = true, AFTER_DRAIN = false;
    const void* base; bf16_t* out; const float* gate;
    __device__ __forceinline__ void operator()(const f32x4 (&acc)[2][2][4][2], const Unit& u, int wr, int wc, int fr, int fq) const {
        const int row0 = u.pm * BM + wr * 64 + fr; const int col0 = u.pn * BM + wc * 32 + 8 * fq;
        const float* gp = gate + (size_t)(u.pm >> 4) * 6144 + col0;
        f32x4 gv[2][2];
#pragma unroll
        for (int bj = 0; bj < 2; ++bj)
#pragma unroll
            for (int n = 0; n < 2; ++n) gv[bj][n] = *(const f32x4*)(gp + bj * HALF + n * 4);
#pragma unroll
        for (int ai = 0; ai < 2; ++ai)
#pragma unroll
            for (int m = 0; m < 4; ++m) { const size_t off = (size_t)(row0 + ai * HALF + m * 16) * 1024 + col0;
#pragma unroll
                for (int bj = 0; bj < 2; ++bj) { f32x4 b0, b1;
                    if (BASE_BF16) { const u32x4 w = *(const u32x4*)((const bf16_t*)base + off + bj * HALF);
                        b0 = (f32x4){__uint_as_float(w.x << 16), __uint_as_float(w.x & 0xffff0000u), __uint_as_float(w.y << 16), __uint_as_float(w.y & 0xffff0000u)};
                        b1 = (f32x4){__uint_as_float(w.z << 16), __uint_as_float(w.z & 0xffff0000u), __uint_as_float(w.w << 16), __uint_as_float(w.w & 0xffff0000u)}; }
                    else { b0 = *(const f32x4*)((const float*)base + off + bj * HALF); b1 = *(const f32x4*)((const float*)base + off + bj * HALF + 4); }
                    const f32x4 v0 = b0 + gv[bj][0] * acc[ai][bj][m][0], v1 = b1 + gv[bj][1] * acc[ai][bj][m][1];
                    u32x4 o; o.x = cvt_pk_bf16(v0[0], v0[1]); o.y = cvt_pk_bf16(v0[2], v0[3]); o.z = cvt_pk_bf16(v1[0], v1[1]); o.w = cvt_pk_bf16(v1[2], v1[3]);
                    *(u32x4*)(out + off + bj * HALF) = o; }
                if (m & 1) asm volatile("" ::: "memory"); }
    }
};
struct EpiGate {
    static constexpr bool PERM = true, AFTER_DRAIN = false;
    const bf16_t* Z; const float* bg; bf16_t* O;
    __device__ __forceinline__ void operator()(const f32x4 (&acc)[2][2][4][2], const Unit& u, int wr, int wc, int fr, int fq) const {
        const int row0 = u.pm * BM + wr * 64 + fr; const int mc0 = u.pn * 64 + wc * 16 + 4 * fq;
        f32x4 bv[2][2];
#pragma unroll
        for (int bj = 0; bj < 2; ++bj)
#pragma unroll
            for (int n = 0; n < 2; ++n) bv[bj][n] = *(const f32x4*)(bg + (2 * bj + n) * 1024 + mc0);
#pragma unroll
        for (int ai = 0; ai < 2; ++ai)
#pragma unroll
            for (int m = 0; m < 4; ++m) { const size_t row = (size_t)(row0 + ai * HALF + m * 16);
                f32x4 sum = (f32x4){0.f, 0.f, 0.f, 0.f};
#pragma unroll
                for (int bj = 0; bj < 2; ++bj)
#pragma unroll
                    for (int n = 0; n < 2; ++n) { const u32x2 zr = *(const u32x2*)(Z + ((size_t)(2 * bj + n) * TT + row) * 1024 + mc0);
                        const f32x4 x = acc[ai][bj][m][n] + bv[bj][n]; f32x4 zz;
                        zz[0] = __uint_as_float(zr.x << 16); zz[1] = __uint_as_float(zr.x & 0xffff0000u); zz[2] = __uint_as_float(zr.y << 16); zz[3] = __uint_as_float(zr.y & 0xffff0000u);
#pragma unroll
                        for (int j = 0; j < 4; ++j) { const float g = __builtin_amdgcn_rcpf(1.f + __builtin_amdgcn_exp2f(-1.4426950408889634f * x[j])); sum[j] += g * zz[j]; } }
                u32x2 w; w.x = cvt_pk_bf16(sum[0], sum[1]); w.y = cvt_pk_bf16(sum[2], sum[3]);
                *(u32x2*)(O + row * 1024 + mc0) = w; }
    }
};
template <class Epi, class Sched, bool ALIGN_EPI = false, bool SP2 = false>
__device__ __forceinline__ void gemm_phase(PG8_LAS unsigned char* lds, const Gemm g, const Sched& S, const Epi& E) {
    int tid_l = threadIdx.x; asm volatile("" : "+v"(tid_l)); const int tid = tid_l, wid = __builtin_amdgcn_readfirstlane(tid >> 6), lane = tid & 63, wr = wid >> 2, wc = wid & 3, fr = lane & 15, fq = lane >> 4;
    const int K = g.K, nt = K / BK;
    unsigned voffA[2], voffB[2];
#pragma unroll
    for (int i = 0; i < 2; ++i) { int R, C; stage_rc(tid * 16 + i * 8192, R, C); const int Rb = Epi::PERM ? ((R & ~31) + perm32(R & 31)) : R;
        voffA[i] = (unsigned)(R * K + C) * 2u; voffB[i] = (unsigned)(Rb * K + C) * 2u; }
    const size_t kstep = (size_t)(BK * 2);
    const size_t hstep = (size_t)HALF * K * 2;
    const size_t tstep = 2 * hstep;
    const unsigned ldsw = (unsigned)wid * 1024u;
    const int aoff = lds_byte(wr * 64 + fr, fq * 8), boff = lds_byte(wc * 32 + fr, fq * 8);
#define PG8_SA(b, h) (((b) * 2 + (h)) * HTB)
#define PG8_SB(b, h) ((4 + (b) * 2 + (h)) * HTB)
#define PG8_STAGE(bufoff, gbase, voff) do { _Pragma("unroll") for (int _i = 0; _i < 2; ++_i) \
        __builtin_amdgcn_global_load_lds((const unsigned*)((const char*)(gbase) + (voff)[_i]), (PG8_LAS unsigned*)(lds + (bufoff) + ldsw + _i * 8192), 16, 0, 0); } while (0)
#define PG8_LDA(dst, b, h) do { _Pragma("unroll") for (int m = 0; m < 4; ++m) _Pragma("unroll") for (int k = 0; k < 2; ++k) dst[m][k] = *(const PG8_LAS bf16x8*)(lds + PG8_SA(b, h) + aoff + m * 2048 + k * 1024); } while (0)
#define PG8_LDB(dst, b, h) do { _Pragma("unroll") for (int n = 0; n < 2; ++n) _Pragma("unroll") for (int k = 0; k < 2; ++k) dst[n][k] = *(const PG8_LAS bf16x8*)(lds + PG8_SB(b, h) + boff + n * 2048 + k * 1024); } while (0)
#define PG8_MMA(ai, bj, At, Bt) do { __builtin_amdgcn_s_setprio(1); _Pragma("unroll") for (int m = 0; m < 4; ++m) _Pragma("unroll") for (int n = 0; n < 2; ++n) _Pragma("unroll") for (int k = 0; k < 2; ++k) \
        acc[ai][bj][m][n] = __builtin_amdgcn_mfma_f32_16x16x32_bf16(Bt[n][k], At[m][k], acc[ai][bj][m][n], 0, 0, 0); __builtin_amdgcn_s_setprio(0); } while (0)
#define PG8_WAIT_V(n) asm volatile("s_waitcnt vmcnt(" #n ")" ::: "memory")
#define PG8_WAIT_L(n) asm volatile("s_waitcnt lgkmcnt(" #n ")" ::: "memory")
#define PG8_BAR __builtin_amdgcn_s_barrier()
#define PG8_SCHED __builtin_amdgcn_sched_barrier(0)
    Unit cur, nxt; int ui = 0;
    if (!S.next(0, cur)) return;
    f32x4 acc[2][2][4][2];
#pragma unroll
    for (int a = 0; a < 2; ++a)
#pragma unroll
        for (int b = 0; b < 2; ++b)
#pragma unroll
            for (int m = 0; m < 4; ++m)
#pragma unroll
                for (int n = 0; n < 2; ++n) acc[a][b][m][n] = (f32x4){0.f, 0.f, 0.f, 0.f};
    bf16x8 At[4][2], B0[2][2], B1[2][2];
    const char* cA = (const char*)g.A + (size_t)cur.pm * tstep; const char* cB = (const char*)g.Bt + (size_t)cur.pn * tstep;
    S.a_ready(cur);
    if constexpr (SP2) {
        PG8_STAGE(PG8_SB(0, 0), cB, voffB); PG8_STAGE(PG8_SB(0, 1), cB + hstep, voffB); PG8_STAGE(PG8_SA(0, 0), cA, voffA); PG8_STAGE(PG8_SA(0, 1), cA + hstep, voffA);
        if (wr == 1) PG8_BAR;
        PG8_WAIT_V(2); PG8_BAR;
        PG8_STAGE(PG8_SB(1, 0), cB + kstep, voffB); PG8_STAGE(PG8_SA(1, 0), cA + kstep, voffA); PG8_STAGE(PG8_SB(1, 1), cB + hstep + kstep, voffB);
        PG8_WAIT_V(6); PG8_BAR;
    } else {
        PG8_STAGE(PG8_SB(0, 0), cB, voffB); PG8_STAGE(PG8_SA(0, 0), cA, voffA); PG8_STAGE(PG8_SB(0, 1), cB + hstep, voffB); PG8_STAGE(PG8_SA(0, 1), cA + hstep, voffA);
        if (wr == 1) PG8_BAR;
        PG8_WAIT_V(4); PG8_BAR;
        PG8_STAGE(PG8_SB(1, 0), cB + kstep, voffB); PG8_STAGE(PG8_SA(1, 0), cA + kstep, voffA); PG8_STAGE(PG8_SB(1, 1), cB + hstep + kstep, voffB);
        PG8_WAIT_V(6); PG8_BAR;
    }
    for (;;) {
        const bool has_next = S.next(ui + 1, nxt);
        const char* nA = has_next ? (const char*)g.A + (size_t)nxt.pm * tstep : cA; const char* nB = has_next ? (const char*)g.Bt + (size_t)nxt.pn * tstep : cB;
        for (int t = 0; t < nt; t += 2) {
            const bool last = (t == nt - 2);
            const char* a1 = cA + (size_t)(t + 1) * kstep;
            const char* a2 = last ? nA : cA + (size_t)(t + 2) * kstep; const char* b2 = last ? nB : cB + (size_t)(t + 2) * kstep;
            const char* a3 = a2 + kstep; const char* b3 = b2 + kstep;
            if (last && has_next) S.a_ready(nxt);
            if constexpr (SP2) {
            PG8_LDB(B0, 0, 0); PG8_LDB(B1, 0, 1); PG8_SCHED; PG8_LDA(At, 0, 0); PG8_STAGE(PG8_SA(1, 1), a1 + hstep, voffA);
            PG8_WAIT_V(8); PG8_WAIT_L(0); PG8_BAR; PG8_MMA(0, 0, At, B0); PG8_MMA(0, 1, At, B1); PG8_BAR; PG8_SCHED;
            PG8_LDA(At, 0, 1); PG8_STAGE(PG8_SB(0, 0), b2, voffB); PG8_STAGE(PG8_SB(0, 1), b2 + hstep, voffB); PG8_STAGE(PG8_SA(0, 0), a2, voffA);
            PG8_WAIT_V(8); PG8_WAIT_L(0); PG8_BAR; PG8_MMA(1, 0, At, B0); PG8_MMA(1, 1, At, B1); PG8_BAR; PG8_SCHED;
            PG8_LDB(B0, 1, 0); PG8_LDB(B1, 1, 1); PG8_SCHED; PG8_LDA(At, 1, 0); PG8_STAGE(PG8_SA(0, 1), a2 + hstep, voffA);
            PG8_WAIT_V(8); PG8_WAIT_L(0); PG8_BAR; PG8_MMA(0, 0, At, B0); PG8_MMA(0, 1, At, B1); PG8_BAR; PG8_SCHED;
            PG8_LDA(At, 1, 1); PG8_STAGE(PG8_SB(1, 0), b3, voffB); PG8_STAGE(PG8_SB(1, 1), b3 + hstep, voffB); PG8_STAGE(PG8_SA(1, 0), a3, voffA);
            PG8_WAIT_V(8); PG8_WAIT_L(0); PG8_BAR; PG8_MMA(1, 0, At, B0); PG8_MMA(1, 1, At, B1); PG8_BAR; PG8_SCHED;
            } else {
            PG8_LDB(B0, 0, 0); PG8_SCHED; PG8_LDA(At, 0, 0); PG8_STAGE(PG8_SA(1, 1), a1 + hstep, voffA);
            PG8_WAIT_L(8); PG8_BAR; PG8_WAIT_L(0); PG8_MMA(0, 0, At, B0); PG8_BAR; PG8_SCHED;
            PG8_LDB(B1, 0, 1); PG8_STAGE(PG8_SB(0, 0), b2, voffB);
            PG8_BAR; PG8_WAIT_L(0); PG8_MMA(0, 1, At, B1); PG8_BAR;
            PG8_LDA(At, 0, 1); PG8_STAGE(PG8_SA(0, 0), a2, voffA);
            PG8_BAR; PG8_WAIT_L(0); PG8_MMA(1, 0, At, B0); PG8_BAR; PG8_SCHED;
            PG8_STAGE(PG8_SB(0, 1), b2 + hstep, voffB);
            PG8_WAIT_V(6); PG8_BAR; PG8_MMA(1, 1, At, B1); PG8_BAR;
            PG8_LDB(B0, 1, 0); PG8_SCHED; PG8_LDA(At, 1, 0); PG8_STAGE(PG8_SA(0, 1), a2 + hstep, voffA);
            PG8_WAIT_L(8); PG8_BAR; PG8_WAIT_L(0); PG8_MMA(0, 0, At, B0); PG8_BAR; PG8_SCHED;
            PG8_LDB(B1, 1, 1); PG8_STAGE(PG8_SB(1, 0), b3, voffB);
            PG8_BAR; PG8_WAIT_L(0); PG8_MMA(0, 1, At, B1); PG8_BAR;
            PG8_LDA(At, 1, 1); PG8_STAGE(PG8_SA(1, 0), a3, voffA);
            PG8_BAR; PG8_WAIT_L(0); PG8_MMA(1, 0, At, B0); PG8_BAR; PG8_SCHED;
            PG8_STAGE(PG8_SB(1, 1), b3 + hstep, voffB);
            PG8_WAIT_V(6); PG8_BAR; PG8_MMA(1, 1, At, B1); PG8_BAR;
            }
        }
        if constexpr (ALIGN_EPI) { if (wr == 0) PG8_BAR; }
        if constexpr (!Epi::AFTER_DRAIN) { E(acc, cur, wr, wc, fr, fq); S.done(cur); }
        if (!has_next) break;
#pragma unroll
        for (int a = 0; a < 2; ++a)
#pragma unroll
            for (int b = 0; b < 2; ++b)
#pragma unroll
                for (int m = 0; m < 4; ++m)
#pragma unroll
                    for (int n = 0; n < 2; ++n) acc[a][b][m][n] = (f32x4){0.f, 0.f, 0.f, 0.f};
        cur = nxt; cA = nA; cB = nB; ++ui;
        if constexpr (ALIGN_EPI) { if (wr == 1) PG8_BAR; }
    }
    PG8_WAIT_V(0);
    if constexpr (!ALIGN_EPI) { if (wr == 0) PG8_BAR; }
    PG8_BAR;
    if constexpr (Epi::AFTER_DRAIN) { E.fused(acc, cur, wr, wc, fr, fq, lds, wid, lane); S.done(cur); }
#undef PG8_SA
#undef PG8_SB
#undef PG8_STAGE
#undef PG8_LDA
#undef PG8_LDB
#undef PG8_MMA
#undef PG8_WAIT_V
#undef PG8_WAIT_L
#undef PG8_BAR
#undef PG8_SCHED
}
}

constexpr int NB = 8, SEQ = 4096, DM = 1024, NL = 2, FF = 4096, NPROJ = 2724, NPROJ_PAD = 2816, NTILE_PROJ = 11;
constexpr int TOK = NB * SEQ;
static_assert(TOK == pg8::TT, "token count");
constexpr float NORM_EPS = 1e-6f;
constexpr float LOG2E = 1.4426950408889634f;
constexpr int NWAVES = 8;

constexpr size_t MiB = 1u << 20;
constexpr size_t WS_CTL = 0, CTL_ZERO_BYTES = 1 * MiB;
constexpr size_t WS_MOD = 1 * MiB;
constexpr size_t WS_KMEAN = WS_MOD + 512 * 1024;
constexpr size_t WS_W = 2 * MiB;
constexpr size_t W_IN = 0, W_GATE = W_IN + (size_t)NPROJ_PAD * DM, W_BR = W_GATE + (size_t)4 * DM * DM, W_OUT = W_BR + (size_t)4 * DM * 256,
                 W_FF1 = W_OUT + (size_t)DM * DM, W_FF2 = W_FF1 + (size_t)FF * DM, W_LAYER = W_FF2 + (size_t)DM * FF;
constexpr size_t WS_MASK = 70 * MiB;
constexpr size_t WS_H = 86 * MiB;
constexpr size_t WS_Y = 150 * MiB;
constexpr size_t WS_R = 214 * MiB;
constexpr size_t WS_END = 470 * MiB;
static_assert(WS_W + 2 * W_LAYER * 2 <= WS_MASK, "weights fit");
constexpr int CW_BAR = 4096;
constexpr int CW_WQ = 131072;
constexpr int CW_NRM = CW_WQ + 4096;
constexpr int NPHASE = 22;

constexpr int RING_BYTES = 135168;
constexpr int LDSCTL_OFF = RING_BYTES;
constexpr int LDS_BYTES = 147456;

#define GAS __attribute__((address_space(1)))
#define LAS __attribute__((address_space(3)))
typedef unsigned short bf16;
typedef unsigned v4u __attribute__((ext_vector_type(4)));
typedef unsigned v2u __attribute__((ext_vector_type(2)));
typedef float f32x4 __attribute__((ext_vector_type(4)));
typedef float f32x16 __attribute__((ext_vector_type(16)));
typedef short bf16x8 __attribute__((ext_vector_type(8)));
typedef short s16x4 __attribute__((ext_vector_type(4)));
typedef GAS unsigned gu32;
#define RLX_AGENT __ATOMIC_RELAXED, __HIP_MEMORY_SCOPE_AGENT
#define LDS_WAIT() asm volatile("s_waitcnt lgkmcnt(0)" ::: "memory")
__device__ __forceinline__ unsigned f2bf(float f) { unsigned u = __builtin_bit_cast(unsigned, f); return (u + 0x7fffu + ((u >> 16) & 1u)) >> 16; }
__device__ __forceinline__ unsigned pk2(float lo, float hi) { return f2bf(lo) | (f2bf(hi) << 16); }
__device__ __forceinline__ float bf2f(unsigned short b) { return __uint_as_float((unsigned)b << 16); }
__device__ __forceinline__ float bflo(unsigned w) { return __uint_as_float(w << 16); }
__device__ __forceinline__ float bfhi(unsigned w) { return __uint_as_float(w & 0xffff0000u); }

#define XB_TMO      128
#define XB_XCNT(j)  (256  + 64 * (j))
#define XB_XSUB(j)  (1280 + 64 * (j))
#define XB_XGEN(j)  (2304 + 64 * (j))
#define XB_TOP      3328
#define XB_TOPGEN   3392
#define XCD_BAR_WORDS 3456
#define XB_SPIN_CAP (1u << 18)

__device__ __forceinline__ unsigned xb_ld(unsigned* p)              { return __hip_atomic_load(p, __ATOMIC_RELAXED, __HIP_MEMORY_SCOPE_AGENT); }
__device__ __forceinline__ unsigned xb_add(unsigned* p, unsigned v) { return __hip_atomic_fetch_add(p, v, __ATOMIC_RELAXED, __HIP_MEMORY_SCOPE_AGENT); }
__device__ __forceinline__ unsigned xb_xcc_id() { return (unsigned)__builtin_amdgcn_s_getreg((3 << 11) | 20) & 0xFu; }
#define XB_SPIN(cond, bar) do { unsigned _sp = 0; while (cond) { __builtin_amdgcn_s_sleep(1); \
    if ((++_sp & 255u) == 0u) { if (xb_ld(&(bar)[XB_TMO])) break; if (_sp > XB_SPIN_CAP) { atomicAdd(&(bar)[XB_TMO], 1u); break; } } } } while (0)

struct XcdBarrier {
    unsigned* bar; unsigned x;
    volatile LAS unsigned* st;
};

__device__ __forceinline__ XcdBarrier xcd_barrier_post(unsigned* bar, volatile LAS unsigned* st) {
    XcdBarrier b; b.bar = bar; b.x = xb_xcc_id(); b.st = st;
    if (threadIdx.x == 0) (void)xb_add(&bar[XB_XCNT(b.x)], 1u);
    return b;
}
__device__ __forceinline__ void xcd_barrier_complete(unsigned* bar, unsigned x, unsigned& nloc, unsigned& nx) {
    const unsigned G = gridDim.x * gridDim.y * gridDim.z;
    unsigned sum, cnt, mine, sp = 0u;
    for (;;) {
        sum = 0u; cnt = 0u; mine = 0u;
#pragma unroll
        for (unsigned j = 0; j < 16; ++j) { const unsigned c = xb_ld(&bar[XB_XCNT(j)]); sum += c; cnt += (c > 0u) ? 1u : 0u; mine = (j == x) ? c : mine; }
        if (sum == G) break;
        __builtin_amdgcn_s_sleep(1);
        if ((++sp & 255u) == 0u) { if (xb_ld(&bar[XB_TMO])) break; if (sp > XB_SPIN_CAP) { atomicAdd(&bar[XB_TMO], 1u); break; } }
    }
    nloc = mine > 0u ? mine : 1u; nx = cnt > 0u ? cnt : 1u;
}

__device__ __forceinline__ void xcd_barrier(const XcdBarrier& b) {
    asm volatile("s_waitcnt vmcnt(0)" ::: "memory");
    __syncthreads();
    if (threadIdx.x == 0) {
        unsigned* bar = b.bar;
        __builtin_amdgcn_s_waitcnt(0);
        unsigned nloc = b.st[0], nx = b.st[1];
        if (nloc == 0u) { xcd_barrier_complete(bar, b.x, nloc, nx); b.st[0] = nloc; b.st[1] = nx; }
        const unsigned old = xb_add(&bar[XB_XSUB(b.x)], 1u);
        const unsigned gen = old / nloc;
        if (old + 1u == (gen + 1u) * nloc) {
            __builtin_amdgcn_fence(__ATOMIC_RELEASE, "agent");
            asm volatile("s_waitcnt vmcnt(0)" ::: "memory");
            const unsigned og = xb_add(&bar[XB_TOP], 1u);
            const unsigned tg = og / nx;
            if (og + 1u == (tg + 1u) * nx) xb_add(&bar[XB_TOPGEN], 1u);
            else XB_SPIN(xb_ld(&bar[XB_TOPGEN]) == tg, bar);
            __builtin_amdgcn_fence(__ATOMIC_ACQUIRE, "agent");
            xb_add(&bar[XB_XGEN(b.x)], 1u);
            asm volatile("s_waitcnt vmcnt(0)" ::: "memory");
        } else {
            XB_SPIN(xb_ld(&bar[XB_XGEN(b.x)]) == gen, bar);
            __builtin_amdgcn_fence(__ATOMIC_ACQUIRE, "agent");
            asm volatile("s_waitcnt vmcnt(0)" ::: "memory");
        }
    }
    __syncthreads();
}

struct Args {
    const float *x, *c, *w_ada, *b_ada, *norm1_g, *w_in, *diff_lambda, *diff_subln_g, *w_pool, *pool_scale, *w_gate, *b_gate, *w_branch, *w_out, *norm2_g, *w_ff1, *w_ff2, *final_g;
    float* out; unsigned char* ws; int ph_lo, ph_hi, li, pad;
};

__device__ __forceinline__ float shx(float v, int mask, int lane) { return __int_as_float(__builtin_amdgcn_ds_bpermute((lane ^ mask) << 2, __float_as_int(v))); }
__device__ __forceinline__ unsigned shxu(unsigned v, int mask, int lane) { return (unsigned)__builtin_amdgcn_ds_bpermute((lane ^ mask) << 2, (int)v); }
__device__ __forceinline__ unsigned shupu(unsigned v, int delta, int lane) { return (unsigned)__builtin_amdgcn_ds_bpermute(((lane - delta) & 63) << 2, (int)v); }
__device__ __forceinline__ float wave_sum(float v, int lane) {
#pragma unroll
    for (int o = 1; o < 64; o <<= 1) v += shx(v, o, lane);
    return v;
}
__device__ __forceinline__ int crow(int r, int hi) { return (r & 3) + 8 * (r >> 2) + 4 * hi; }
typedef float f32x2_t __attribute__((ext_vector_type(2))); typedef __bf16 bf16x2_t __attribute__((ext_vector_type(2)));
__device__ __forceinline__ unsigned cvtpk(float lo, float hi) { f32x2_t v = {lo, hi}; bf16x2_t b = __builtin_convertvector(v, bf16x2_t); return __builtin_bit_cast(unsigned, b); }

__device__ __forceinline__ int gate_row(int br, int c) { const int pn = c >> 6, ml = c & 63; return 256 * pn + 128 * (br >> 1) + 32 * (ml >> 4) + 8 * ((ml >> 2) & 3) + 4 * (br & 1) + (ml & 3); }
__device__ __forceinline__ void p0_transpose_item(const float* W, int K, int Nsrc, int Npad, bf16* WT, int mode, int br, LAS float* scr, int item, int lane) {
    const int nblk = Npad / 32, kb = item / nblk, nb = item % nblk, k0 = 64 * kb, n0 = 32 * nb;
    const int c4 = lane & 7, kr = lane >> 3, nn = n0 + 4 * c4;
    f32x4 v[8];
#pragma unroll
    for (int i = 0; i < 8; ++i) v[i] = (nn < Nsrc) ? *(const f32x4*)(W + (size_t)(k0 + 8 * i + kr) * Nsrc + nn) : (f32x4){0.f, 0.f, 0.f, 0.f};
#pragma unroll
    for (int i = 0; i < 8; ++i) { LAS float* d = scr + (8 * i + kr) * 33 + 4 * c4; d[0] = v[i][0]; d[1] = v[i][1]; d[2] = v[i][2]; d[3] = v[i][3]; }
    LDS_WAIT(); asm volatile("" ::: "memory");
    const int c = lane & 7;
#pragma unroll
    for (int j = 0; j < 4; ++j) { const int n = (lane >> 3) + 8 * j; const LAS float* s = scr + (8 * c) * 33 + n;
        v4u o; o.x = pk2(s[0 * 33], s[1 * 33]); o.y = pk2(s[2 * 33], s[3 * 33]); o.z = pk2(s[4 * 33], s[5 * 33]); o.w = pk2(s[6 * 33], s[7 * 33]);
        const int drow = (mode == 1) ? gate_row(br, n0 + n) : (n0 + n);
        *(v4u*)(WT + (size_t)drow * K + k0 + 8 * c) = o; }
    LDS_WAIT(); asm volatile("" ::: "memory");
}

template <bool XBF16>
__device__ __forceinline__ void norm_rows_bf16(const void* X, bf16* O, const float* g, const float* mod  , int sh_idx, int sc_idx, int gw, int ngw, int lane_in) {
    int lane = lane_in; asm volatile("" : "+v"(lane));
    for (int m = gw; m < TOK; m += ngw) {
        const int b = m >> 12;
        float v[16]; float s = 0.f;
        if (XBF16) { const v4u* xr = (const v4u*)((const bf16*)X + (size_t)m * DM) + 2 * lane; const v4u a = xr[0], c = xr[1];
            v[0] = bflo(a.x); v[1] = bfhi(a.x); v[2] = bflo(a.y); v[3] = bfhi(a.y); v[4] = bflo(a.z); v[5] = bfhi(a.z); v[6] = bflo(a.w); v[7] = bfhi(a.w);
            v[8] = bflo(c.x); v[9] = bfhi(c.x); v[10] = bflo(c.y); v[11] = bfhi(c.y); v[12] = bflo(c.z); v[13] = bfhi(c.z); v[14] = bflo(c.w); v[15] = bfhi(c.w); }
        else { const f32x4* xr = (const f32x4*)((const float*)X + (size_t)m * DM) + 4 * lane;
#pragma unroll
            for (int j = 0; j < 4; ++j) { const f32x4 t = xr[j]; v[4 * j] = t.x; v[4 * j + 1] = t.y; v[4 * j + 2] = t.z; v[4 * j + 3] = t.w; } }
#pragma unroll
        for (int e = 0; e < 16; ++e) s += v[e] * v[e];
        const float rstd = 1.f / sqrtf(wave_sum(s, lane) * (1.f / DM) + NORM_EPS);
        const f32x4* gp = (const f32x4*)g + 4 * lane;
        const f32x4* shp = (const f32x4*)(mod + (size_t)b * 6144 + sh_idx * 1024) + 4 * lane;
        const f32x4* scp = (const f32x4*)(mod + (size_t)b * 6144 + sc_idx * 1024) + 4 * lane;
        float y[16];
#pragma unroll
        for (int j = 0; j < 4; ++j) { const f32x4 gg = gp[j], sh = shp[j], sc = scp[j];
#pragma unroll
            for (int e = 0; e < 4; ++e) y[4 * j + e] = v[4 * j + e] * rstd * gg[e] * (1.f + sc[e]) + sh[e]; }
        v4u o0, o1;
        o0.x = pk2(y[0], y[1]); o0.y = pk2(y[2], y[3]); o0.z = pk2(y[4], y[5]); o0.w = pk2(y[6], y[7]);
        o1.x = pk2(y[8], y[9]); o1.y = pk2(y[10], y[11]); o1.z = pk2(y[12], y[13]); o1.w = pk2(y[14], y[15]);
        v4u* op = (v4u*)(O + (size_t)m * DM) + 2 * lane; op[0] = o0; op[1] = o1;
    }
}

#ifndef ATT_PD
#define ATT_PD 1
#endif
constexpr int AT_K0 = 0, AT_KSLOT = 9216, AT_V0 = 18432, AT_VSLOT = 12288, AT_SEL = 43008, AT_KM = 44032, AT_END = 47872;
__device__ __forceinline__ s16x4 vtr(LAS const unsigned char* p) { return __builtin_bit_cast(s16x4, __builtin_amdgcn_ds_read_tr16_b64_v4i16((LAS s16x4*)p)); }

#define TRRD(dst, addr, off) asm volatile("ds_read_b64_tr_b16 %0, %1 offset:%2" : "=v"(dst) : "v"(addr), "i"(off) : "memory")
#define SBAR0() __builtin_amdgcn_sched_barrier(0)
__device__ __forceinline__ void softmax_pv(f32x16& s0, f32x16& s1, float& l, f32x16 (&o)[2], LAS const unsigned char* vbase  ) {
    const unsigned va = (unsigned)(uintptr_t)vbase;
    s16x4 vl[2][2][2], vh[2][2][2];
#pragma unroll
    for (int sub = 0; sub < 2; ++sub)
#pragma unroll
        for (int db = 0; db < 2; ++db)
#pragma unroll
            for (int s2 = 0; s2 < 2; ++s2) { TRRD(vl[db][sub][s2], va, (32 * sub + 16 * s2) * 192 + db * 64); TRRD(vh[db][sub][s2], va, (32 * sub + 16 * s2 + 8) * 192 + db * 64); }
    float la = l;
#pragma unroll
    for (int r = 0; r < 16; ++r) { s0[r] = __builtin_amdgcn_exp2f(s0[r]); la += s0[r]; }
    bf16x8 pf[2][2];
#pragma unroll
    for (int s2 = 0; s2 < 2; ++s2) { v4u a;
        a.x = cvtpk(s0[8 * s2 + 0], s0[8 * s2 + 1]); a.y = cvtpk(s0[8 * s2 + 2], s0[8 * s2 + 3]); a.z = cvtpk(s0[8 * s2 + 4], s0[8 * s2 + 5]); a.w = cvtpk(s0[8 * s2 + 6], s0[8 * s2 + 7]);
        pf[0][s2] = __builtin_bit_cast(bf16x8, a); }
    asm volatile("s_waitcnt lgkmcnt(0)" : "+v"(vl[0][0][0]), "+v"(vl[0][0][1]), "+v"(vl[0][1][0]), "+v"(vl[0][1][1]), "+v"(vl[1][0][0]), "+v"(vl[1][0][1]), "+v"(vl[1][1][0]), "+v"(vl[1][1][1]),
                                          "+v"(vh[0][0][0]), "+v"(vh[0][0][1]), "+v"(vh[0][1][0]), "+v"(vh[0][1][1]), "+v"(vh[1][0][0]), "+v"(vh[1][0][1]), "+v"(vh[1][1][0]), "+v"(vh[1][1][1]) :: "memory");
    SBAR0();
#pragma unroll
    for (int g = 0; g < 4; ++g) { const int db = g >> 1, s2 = g & 1;
        const s16x4 lo = vl[db][0][s2], hh = vh[db][0][s2];
        const bf16x8 vf = (bf16x8){lo[0], lo[1], lo[2], lo[3], hh[0], hh[1], hh[2], hh[3]};
        o[db] = __builtin_amdgcn_mfma_f32_32x32x16_bf16(vf, pf[0][s2], o[db], 0, 0, 0);
#pragma unroll
        for (int r = 4 * g; r < 4 * g + 4; ++r) { s1[r] = __builtin_amdgcn_exp2f(s1[r]); la += s1[r]; }
        SBAR0(); }
    l = la;
#pragma unroll
    for (int s2 = 0; s2 < 2; ++s2) { v4u c;
        c.x = cvtpk(s1[8 * s2 + 0], s1[8 * s2 + 1]); c.y = cvtpk(s1[8 * s2 + 2], s1[8 * s2 + 3]); c.z = cvtpk(s1[8 * s2 + 4], s1[8 * s2 + 5]); c.w = cvtpk(s1[8 * s2 + 6], s1[8 * s2 + 7]);
        pf[1][s2] = __builtin_bit_cast(bf16x8, c); }
#pragma unroll
    for (int g = 0; g < 4; ++g) { const int db = g >> 1, s2 = g & 1;
        const s16x4 lo = vl[db][1][s2], hh = vh[db][1][s2];
        const bf16x8 vf = (bf16x8){lo[0], lo[1], lo[2], lo[3], hh[0], hh[1], hh[2], hh[3]};
        o[db] = __builtin_amdgcn_mfma_f32_32x32x16_bf16(vf, pf[1][s2], o[db], 0, 0, 0); }
}
__device__ __forceinline__ void split3(float x, unsigned& h, unsigned& m, unsigned& l) {
    h = f2bf(x); const float r1 = x - __uint_as_float(h << 16); m = f2bf(r1); const float r2 = r1 - __uint_as_float(m << 16); l = f2bf(r2);
}

template <int MODE>
__device__ __forceinline__ void attn_unit(LAS unsigned char* lds, int b, int h, int qb, const bf16* Qb, const bf16* Kb, const bf16* Vb, bf16* Ob, float slope,
                                          const float* kmean, float lam, float post_scale, const float* subg, const unsigned* maskw, const unsigned* nrm  ) {
    int tid_l = threadIdx.x; asm volatile("" : "+v"(tid_l)); const int tid = tid_l, lane = tid & 63, wid = __builtin_amdgcn_readfirstlane(tid >> 6), r32 = lane & 31, hi = lane >> 5;
    const int q = qb * 256 + wid * 32 + r32;
    const size_t rowg = (size_t)b * SEQ;
    const float c2 = slope * LOG2E;
    unsigned sel = 0u;
    if (MODE == 0) {
        LAS float* KM = (LAS float*)(lds + AT_KM); LAS unsigned* SEL = (LAS unsigned*)(lds + AT_SEL);
        for (int i = tid; i < qb * 64; i += 512) KM[i] = kmean[(size_t)((b * 4 + h) * 16) * 64 + i];
        __syncthreads();
        if (tid < 256) {
            const bf16* qrow = Qb + (rowg + qb * 256 + tid) * 256 + h * 64;
            float qv[64];
#pragma unroll
            for (int c = 0; c < 8; ++c) { const v4u w = *(const v4u*)(qrow + 8 * c);
                qv[8 * c + 0] = bflo(w.x); qv[8 * c + 1] = bfhi(w.x); qv[8 * c + 2] = bflo(w.y); qv[8 * c + 3] = bfhi(w.y);
                qv[8 * c + 4] = bflo(w.z); qv[8 * c + 5] = bfhi(w.z); qv[8 * c + 6] = bflo(w.w); qv[8 * c + 7] = bfhi(w.w); }
            float v1 = -INFINITY, v2 = -INFINITY, v3 = -INFINITY; int i1 = -1, i2 = -1, i3 = -1;
            for (int n = 0; n < qb; ++n) {
                float g = 0.f;
#pragma unroll
                for (int d = 0; d < 64; ++d) g = __builtin_fmaf(qv[d], KM[n * 64 + d], g);
                if (g > v1) { v3 = v2; i3 = i2; v2 = v1; i2 = i1; v1 = g; i1 = n; }
                else if (g > v2) { v3 = v2; i3 = i2; v2 = g; i2 = n; }
                else if (g > v3) { v3 = g; i3 = n; }
            }
            unsigned sm = 0u; if (i1 >= 0) sm |= 1u << i1; if (i2 >= 0) sm |= 1u << i2; if (i3 >= 0) sm |= 1u << i3;
            SEL[tid] = sm;
        }
        __syncthreads();
        sel = SEL[wid * 32 + r32];
    }
    bf16x8 qf[4];
#pragma unroll
    for (int ds = 0; ds < 4; ++ds) qf[ds] = *(const bf16x8*)(Qb + (rowg + q) * 256 + h * 64 + ds * 16 + hi * 8);
    const int skey = tid >> 3, sch = tid & 7;
    const bf16* ksrc = Kb + (rowg + skey) * 256 + h * 64 + sch * 8;
    const bf16* vsrc = Vb + (rowg + skey) * 256 + h * 64 + sch * 8;
    const int kdst = AT_K0 + skey * 144 + sch * 16, vdst = AT_V0 + skey * 192 + sch * 16;
    const int NT = 4 * qb + 4;
    const float Bq = __uint_as_float(nrm[b * 4 + h]), Bk = __uint_as_float(nrm[32 + b * 4 + h]);
#if defined(PROBE_NOSKIP)
    const float Dskip = 1e9f + 0.f * (Bq + Bk);
#else
    const float Dskip = (150.f + 2.f * sqrtf(Bq * Bk)) / c2;
#endif
    const int koff = r32 * 144 + hi * 16;
    const int vtoff = (4 * hi + ((lane & 15) >> 2)) * 192 + (16 * ((lane >> 4) & 1) + 4 * (lane & 3)) * 2;
    float l1 = 0.f, l2 = 0.f;
    f32x16 oA[2], oB[2];
#pragma unroll
    for (int r = 0; r < 16; ++r) { oA[0][r] = 0.f; oA[1][r] = 0.f; oB[0][r] = 0.f; oB[1][r] = 0.f; }
    const int qmin = qb * 256 + wid * 32, qmax = qmin + 31;
    constexpr int PD = ATT_PD;
    v4u kR[PD], vR[PD]; v2u mR[PD];
    int refpos = q;
    int minref = qb * 256;
    if (MODE == 2) {
        const unsigned* mrow = maskw + (rowg + q) * 128; int wi = q >> 5; unsigned wv = mrow[wi];
        while (wv == 0u && wi > 0) { --wi; wv = mrow[wi]; }
        refpos = 32 * wi + 31 - __clz((int)(wv | 1u));
        LAS int* MR = (LAS int*)(lds + AT_SEL);
        if (tid == 0) MR[0] = 0x7fffffff;
        __syncthreads();
        __hip_atomic_fetch_min(MR, refpos, __ATOMIC_RELAXED, __HIP_MEMORY_SCOPE_WORKGROUP);
        __syncthreads();
        minref = MR[0];
    }
    int T0 = (int)floorf(((float)minref - Dskip) * (1.f / 64.f)); T0 = T0 < 0 ? 0 : T0; T0 = __builtin_amdgcn_readfirstlane(T0);
    { const v4u k0r = *(const v4u*)(ksrc + (size_t)T0 * 64 * 256), v0r = *(const v4u*)(vsrc + (size_t)T0 * 64 * 256);
      *(LAS v4u*)(lds + kdst + (T0 & 1) * AT_KSLOT) = k0r; *(LAS v4u*)(lds + vdst + (T0 & 1) * AT_VSLOT) = v0r; }
#pragma unroll
    for (int i = 0; i < PD; ++i) { kR[i] = (v4u){0u, 0u, 0u, 0u}; vR[i] = kR[i]; mR[i] = (v2u){0u, 0u};
        if (T0 + i + 1 < NT) { kR[i] = *(const v4u*)(ksrc + (size_t)(T0 + i + 1) * 64 * 256); vR[i] = *(const v4u*)(vsrc + (size_t)(T0 + i + 1) * 64 * 256);
            if (MODE == 2) mR[i] = *(const v2u*)(maskw + (rowg + q) * 128 + 2 * (T0 + i + 1)); } }
    v2u mw = (v2u){0u, 0u};
    if (MODE == 2) mw = *(const v2u*)(maskw + (rowg + q) * 128 + 2 * T0);
    bf16x8 qaug; v4u ka0, ka1;
    { unsigned a, b2, c; split3(-c2 * (float)refpos, a, b2, c);
      v4u w; if (hi == 0) { w.x = a | (b2 << 16); w.y = c | (0x3f80u << 16); w.z = 0x3f80u | (0x3f80u << 16); w.w = 0u; }
             else { w.x = 0x3f80u | (0x3f80u << 16); w.y = 0x3f80u; w.z = 0u; w.w = 0u; }
      qaug = __builtin_bit_cast(bf16x8, w);
      split3(c2 * (float)r32, a, b2, c); ka0.x = 0x3f80u | (0x3f80u << 16); ka0.y = 0x3f80u | (a << 16); ka0.z = b2 | (c << 16); ka0.w = 0u;
      split3(c2 * (float)(r32 + 32), a, b2, c); ka1.x = ka0.x; ka1.y = 0x3f80u | (a << 16); ka1.z = b2 | (c << 16); ka1.w = 0u; }
    __syncthreads();
#pragma nounroll
    for (int t0 = T0; t0 < NT; t0 += PD) {
#pragma unroll
      for (int u = 0; u < PD; ++u) { const int t = t0 + u; if (t < NT) {
        const int slot = t & 1;
        const int k0 = 64 * t;
        bool active = (k0 <= qmax);
        bool keep = true;
        if (MODE == 0) { const int n = t >> 2; if (n < qb) { keep = ((sel >> n) & 1u) != 0u; active = (__ballot(keep) != 0ull); } }
        if (active) {
            LAS const unsigned char* ks = lds + AT_K0 + slot * AT_KSLOT + koff;
            LAS const unsigned char* vb = lds + AT_V0 + slot * AT_VSLOT + vtoff;
            const int lim = q - k0 - 4 * hi;
            const bool needmask = (k0 + 63 > qmin);
            bf16x8 kaug0, kaug1;
            { unsigned a, b2, c; split3(c2 * (float)k0, a, b2, c);
              v4u w0 = ka0, w1 = ka1; if (hi) { w0.x = a | (b2 << 16); w0.y = c; w0.z = 0u; w1 = w0; }
              kaug0 = __builtin_bit_cast(bf16x8, w0); kaug1 = __builtin_bit_cast(bf16x8, w1); }
#pragma unroll
            for (int mp = 0; mp < (MODE == 1 ? 2 : 1); ++mp) {
                f32x16 s0, s1;
#pragma unroll
                for (int r = 0; r < 16; ++r) { s0[r] = 0.f; s1[r] = 0.f; }
                s0 = __builtin_amdgcn_mfma_f32_32x32x16_bf16(kaug0, qaug, s0, 0, 0, 0);
                s1 = __builtin_amdgcn_mfma_f32_32x32x16_bf16(kaug1, qaug, s1, 0, 0, 0);
#pragma unroll
                for (int dd = 0; dd < (MODE == 1 ? 2 : 4); ++dd) { const int ds = (MODE == 1) ? (2 * mp + dd) : dd;
                    const bf16x8 a0 = *(LAS const bf16x8*)(ks + ds * 32), a1 = *(LAS const bf16x8*)(ks + 32 * 144 + ds * 32);
                    s0 = __builtin_amdgcn_mfma_f32_32x32x16_bf16(a0, qf[ds], s0, 0, 0, 0);
                    s1 = __builtin_amdgcn_mfma_f32_32x32x16_bf16(a1, qf[ds], s1, 0, 0, 0); }
#if defined(PROBE_QK2X)
                { f32x16 d0, d1;
#pragma unroll
                  for (int r = 0; r < 16; ++r) { d0[r] = 0.f; d1[r] = 0.f; }
#pragma unroll
                  for (int dd = 0; dd < (MODE == 1 ? 2 : 4); ++dd) { const int ds = (MODE == 1) ? (2 * mp + dd) : dd;
                    const bf16x8 a0 = *(LAS const bf16x8*)(ks + ds * 32 + 16), a1 = *(LAS const bf16x8*)(ks + 32 * 144 + ds * 32 + 16);
                    d0 = __builtin_amdgcn_mfma_f32_32x32x16_bf16(a0, qf[ds], d0, 0, 0, 0);
                    d1 = __builtin_amdgcn_mfma_f32_32x32x16_bf16(a1, qf[ds], d1, 0, 0, 0); }
                  asm volatile("" :: "v"(d0), "v"(d1)); }
#endif
                if (MODE == 2) {
#pragma unroll
                    for (int r = 0; r < 16; ++r) { const int pos = (r & 3) + 8 * (r >> 2) + 4 * hi;
                        if (!((mw.x >> pos) & 1u)) s0[r] = -INFINITY; if (!((mw.y >> pos) & 1u)) s1[r] = -INFINITY; }
                } else {
                    if (MODE == 0 && !keep) {
#pragma unroll
                        for (int r = 0; r < 16; ++r) { s0[r] = -INFINITY; s1[r] = -INFINITY; }
                    }
                    if (needmask) {
#pragma unroll
                        for (int r = 0; r < 16; ++r) { const int ko = (r & 3) + 8 * (r >> 2);
                            if (ko > lim) s0[r] = -INFINITY; if (ko + 32 > lim) s1[r] = -INFINITY; }
                    }
                }
                if (mp == 0) softmax_pv(s0, s1, l1, oA, vb); else softmax_pv(s0, s1, l2, oB, vb);
            }
        }
        if (t + 1 < NT) { *(LAS v4u*)(lds + kdst + (slot ^ 1) * AT_KSLOT) = kR[u]; *(LAS v4u*)(lds + vdst + (slot ^ 1) * AT_VSLOT) = vR[u];
            if (MODE == 2) mw = mR[u];
            if (t + 1 + PD < NT) { kR[u] = *(const v4u*)(ksrc + (size_t)(t + 1 + PD) * 64 * 256); vR[u] = *(const v4u*)(vsrc + (size_t)(t + 1 + PD) * 64 * 256);
                if (MODE == 2) mR[u] = *(const v2u*)(maskw + (rowg + q) * 128 + 2 * (t + 1 + PD)); } }
        __syncthreads();
#if defined(PROBE_BAR2X)
        __syncthreads();
#endif
      } }
    }
    const float l1t = l1 + shx(l1, 32, lane);
    bf16* orow = Ob + (rowg + q) * 256 + h * 64 + 4 * hi;
    if (MODE == 1) {
        const float l2t = l2 + shx(l2, 32, lane);
        const float i1 = 1.f / l1t, i2 = lam / l2t;
        float ssq = 0.f;
#pragma unroll
        for (int db = 0; db < 2; ++db)
#pragma unroll
            for (int r = 0; r < 16; ++r) { const float v = oA[db][r] * i1 - oB[db][r] * i2; oA[db][r] = v; ssq += v * v; }
        ssq += shx(ssq, 32, lane);
        const float rn = post_scale / sqrtf(ssq * (1.f / 64.f) + NORM_EPS);
#pragma unroll
        for (int db = 0; db < 2; ++db)
#pragma unroll
            for (int g4 = 0; g4 < 4; ++g4) { const f32x4 gg = *(const f32x4*)(subg + 32 * db + 8 * g4 + 4 * hi);
                v2u w; w.x = cvtpk(oA[db][4 * g4 + 0] * rn * gg[0], oA[db][4 * g4 + 1] * rn * gg[1]); w.y = cvtpk(oA[db][4 * g4 + 2] * rn * gg[2], oA[db][4 * g4 + 3] * rn * gg[3]);
                *(v2u*)(orow + 32 * db + 8 * g4) = w; }
    } else {
        const float i1 = 1.f / l1t;
#pragma unroll
        for (int db = 0; db < 2; ++db)
#pragma unroll
            for (int g4 = 0; g4 < 4; ++g4) { v2u w; w.x = cvtpk(oA[db][4 * g4 + 0] * i1, oA[db][4 * g4 + 1] * i1); w.y = cvtpk(oA[db][4 * g4 + 2] * i1, oA[db][4 * g4 + 3] * i1);
                *(v2u*)(orow + 32 * db + 8 * g4) = w; }
    }
    __syncthreads();
}

constexpr int DS_HP = 1025;
constexpr int DS_HIST_BYTES = 32 * DS_HP * 4;
constexpr int DS_BP = 129;
constexpr int DS_G = 0, DS_C = 32 * DS_BP * 4, DS_AUX = DS_HIST_BYTES;
__device__ __forceinline__ float relu_asm(float x) { return __builtin_amdgcn_fmed3f(x, 0.f, __builtin_inff()); }
__device__ __forceinline__ void dsa_scores(const bf16x8 (&iqf)[4][2], const float (&w)[4], const bf16x8 k0, const bf16x8 k1, float (&sc)[16]) {
#pragma unroll
    for (int hh = 0; hh < 4; ++hh) {
        f32x16 x;
#pragma unroll
        for (int r = 0; r < 16; ++r) x[r] = 0.f;
        x = __builtin_amdgcn_mfma_f32_32x32x16_bf16(k0, iqf[hh][0], x, 0, 0, 0);
        x = __builtin_amdgcn_mfma_f32_32x32x16_bf16(k1, iqf[hh][1], x, 0, 0, 0);
#pragma unroll
        for (int r = 0; r < 16; ++r) sc[r] = (hh == 0) ? (w[0] * relu_asm(x[r])) : __builtin_fmaf(w[hh], relu_asm(x[r]), sc[r]);
    }
}
__device__ __forceinline__ unsigned dsa_mono(float s) { const unsigned bits = __float_as_uint(s); return bits ^ ((unsigned)((int)bits >> 31) | 0x80000000u); }
__device__ __forceinline__ unsigned dsa_ckey(float s, unsigned keyidx) { return (dsa_mono(s) & 0xFFFFF000u) | (4095u - keyidx); }
__device__ __forceinline__ unsigned take_low(unsigned w, unsigned n) {
    if (n >= (unsigned)__popc(w)) return w;
    unsigned res = 0u;
    while (n > 0u) { const unsigned low = w & (0u - w); res |= low; w ^= low; --n; }
    return res;
}
template <int PASS>
__device__ __forceinline__ void dsa_hist_pass(LAS unsigned* hist, const bf16x8 (&iqf)[4][2], const float (&w)[4], const bf16* kbase, int qg, int wid, int r32, int hi, int t, unsigned P1) {
    bf16x8 nk0 = *(const bf16x8*)(kbase + (size_t)wid * 32 * 256), nk1 = *(const bf16x8*)(kbase + (size_t)wid * 32 * 256 + 16);
    const unsigned rowb = (unsigned)(r32 * DS_HP * 4);
#pragma nounroll
    for (int j = wid; j <= qg; j += 8) {
        const bf16x8 k0 = nk0, k1 = nk1;
        { const int jn = (j + 8 <= qg) ? j + 8 : j; const bf16* kp = kbase + (size_t)jn * 32 * 256; nk0 = *(const bf16x8*)kp; nk1 = *(const bf16x8*)(kp + 16); }
        float sc[16]; dsa_scores(iqf, w, k0, k1, sc);
        const int lim = t - 32 * j - 4 * hi;
        const bool diag = (j == qg);
#pragma unroll
        for (int r = 0; r < 16; ++r) {
            unsigned bin; bool ok = true;
            if (PASS == 0) { bin = dsa_mono(sc[r]) >> 21; }
            else { const unsigned ck = dsa_ckey(sc[r], 32u * (unsigned)j + (unsigned)((r & 3) + 8 * (r >> 2) + 4 * hi)); ok = (ck >> 21) == P1; bin = (ck >> 10) & 2047u; }
            unsigned addr = rowb + ((bin & 1023u) << 2);
            const unsigned inc = (bin & 1024u) ? 65536u : 1u;
            if (PASS == 0) { if (diag && ((r & 3) + 8 * (r >> 2) > lim)) addr = rowb + 4096u;
                __hip_atomic_fetch_add((LAS unsigned*)((LAS unsigned char*)hist + addr), inc, __ATOMIC_RELAXED, __HIP_MEMORY_SCOPE_WORKGROUP); }
            else { if (ok && !(diag && ((r & 3) + 8 * (r >> 2) > lim)))
                __hip_atomic_fetch_add((LAS unsigned*)((LAS unsigned char*)hist + addr), inc, __ATOMIC_RELAXED, __HIP_MEMORY_SCOPE_WORKGROUP); }
        }
    }
}
__device__ __forceinline__ void dsa_scan(LAS unsigned* hist, LAS unsigned* AUX, int pass, int wid, int lane) {
#pragma nounroll
    for (int qi = 0; qi < 4; ++qi) {
        const int qq = 4 * wid + qi;
        const unsigned K = (pass == 0) ? 256u : AUX[32 + qq];
        LAS const unsigned* hrow = hist + qq * DS_HP;
        const int wb = (2016 - 32 * lane) & 1023; const int sh = (lane < 32) ? 16 : 0;
        unsigned s = 0u;
#pragma unroll
        for (int i = 0; i < 32; ++i) { const unsigned wv = hrow[wb + ((i + lane) & 31)]; s += (wv >> sh) & 0xffffu; }
        unsigned incl = s;
#pragma unroll
        for (int o = 1; o < 64; o <<= 1) { const unsigned v = shupu(incl, o, lane); if (lane >= o) incl += v; }
        const unsigned long long bal = __ballot(incl >= K);
        const int L = __builtin_amdgcn_readfirstlane(bal ? (__ffsll((long long)bal) - 1) : 0);
        const unsigned above = (unsigned)__builtin_amdgcn_readlane((int)(incl - s), L);
        const int bin = 2047 - 32 * L - (lane & 31);
        const unsigned wv2 = hrow[bin & 1023]; const unsigned c = (lane < 32) ? ((bin & 1024) ? (wv2 >> 16) : (wv2 & 0xffffu)) : 0u;
        unsigned inc2 = c;
#pragma unroll
        for (int o = 1; o < 32; o <<= 1) { const unsigned v = shupu(inc2, o, lane); if (lane >= o) inc2 += v; }
        const unsigned long long bal2 = __ballot(lane < 32 && above + inc2 >= K);
        const int I = __builtin_amdgcn_readfirstlane(bal2 ? (__ffsll((long long)bal2) - 1) : 0);
        if (lane == I) { AUX[64 * pass + qq] = (unsigned)bin; AUX[64 * pass + 32 + qq] = K - (above + inc2 - c); }
    }
}
__device__ __forceinline__ void dsa_select_unit(LAS unsigned char* lds, int b, int qg, const bf16* IX, unsigned* MASK) {
    int tid_l = threadIdx.x; asm volatile("" : "+v"(tid_l)); const int tid = tid_l, lane = tid & 63, wid = __builtin_amdgcn_readfirstlane(tid >> 6), r32 = lane & 31, hi = lane >> 5;
    const int t = 32 * qg + r32;
    const size_t rowg = (size_t)b * SEQ;
    const bf16* qrow = IX + (rowg + t) * 256;
    bf16x8 iqf[4][2];
#pragma unroll
    for (int hh = 0; hh < 4; ++hh)
#pragma unroll
        for (int ds = 0; ds < 2; ++ds) iqf[hh][ds] = *(const bf16x8*)(qrow + 32 * hh + 16 * ds + 8 * hi);
    float w[4];
    { const v2u ww = *(const v2u*)(qrow + 160); w[0] = bflo(ww.x); w[1] = bfhi(ww.x); w[2] = bflo(ww.y); w[3] = bfhi(ww.y); }
    LAS unsigned* hist = (LAS unsigned*)lds;
    LAS unsigned* AUX = (LAS unsigned*)(lds + DS_AUX);
    const bf16* kbase = IX + (rowg + r32) * 256 + 128 + 8 * hi;
    unsigned P = 0u;
    const bool all = (qg < 8);
    if (!all) {
        for (int i = tid; i < DS_HIST_BYTES / 16; i += 512) ((LAS v4u*)lds)[i] = (v4u){0u, 0u, 0u, 0u};
        __syncthreads();
        dsa_hist_pass<0>(hist, iqf, w, kbase, qg, wid, r32, hi, t, 0u);
        __syncthreads();
        dsa_scan(hist, AUX, 0, wid, lane);
        __syncthreads();
        const unsigned P1 = AUX[r32];
        for (int i = tid; i < DS_HIST_BYTES / 16; i += 512) ((LAS v4u*)lds)[i] = (v4u){0u, 0u, 0u, 0u};
        __syncthreads();
        dsa_hist_pass<1>(hist, iqf, w, kbase, qg, wid, r32, hi, t, P1);
        __syncthreads();
        dsa_scan(hist, AUX, 1, wid, lane);
        __syncthreads();
        P = (P1 << 11) | AUX[64 + r32];
    }
    if (all) { if (tid < 32) { AUX[64 + 32 + tid] = 0u; } }
    for (int i = tid; i < (2 * 32 * DS_BP * 4) / 16; i += 512) ((LAS v4u*)lds)[i] = (v4u){0u, 0u, 0u, 0u};
    __syncthreads();
    LAS unsigned* G = (LAS unsigned*)(lds + DS_G);
    LAS unsigned* C = (LAS unsigned*)(lds + DS_C);
    bf16x8 nk0, nk1;
    { const int j0 = (wid <= qg) ? wid : 0; nk0 = *(const bf16x8*)(kbase + (size_t)j0 * 32 * 256); nk1 = *(const bf16x8*)(kbase + (size_t)j0 * 32 * 256 + 16); }
#pragma nounroll
    for (int j = wid; j <= qg; j += 8) {
        const bf16x8 k0 = nk0, k1 = nk1;
        { const int jn = (j + 8 <= qg) ? j + 8 : j; const bf16* kp = kbase + (size_t)jn * 32 * 256; nk0 = *(const bf16x8*)kp; nk1 = *(const bf16x8*)(kp + 16); }
        float sc[16]; dsa_scores(iqf, w, k0, k1, sc);
        unsigned bg = 0u, bc = 0u;
        const int lim = t - 32 * j - 4 * hi;
#pragma unroll
        for (int r = 0; r < 16; ++r) {
            const int pos = (r & 3) + 8 * (r >> 2) + 4 * hi;
            const unsigned p22 = dsa_ckey(sc[r], 32u * (unsigned)j + (unsigned)pos) >> 10;
            const bool ok = ((r & 3) + 8 * (r >> 2)) <= lim;
            if (ok && p22 > P) bg |= 1u << pos;
            if (ok && p22 == P) bc |= 1u << pos;
        }
        bg |= shxu(bg, 32, lane); bc |= shxu(bc, 32, lane);
        if (hi == 0) { G[r32 * DS_BP + j] = bg; C[r32 * DS_BP + j] = bc; }
    }
    __syncthreads();
#pragma nounroll
    for (int qi = 0; qi < 4; ++qi) {
        const int qq = 4 * wid + qi;
        const unsigned K2 = AUX[64 + 32 + qq];
        const unsigned w0 = C[qq * DS_BP + 2 * lane], w1 = C[qq * DS_BP + 2 * lane + 1];
        const unsigned pc = (unsigned)__popc(w0) + (unsigned)__popc(w1);
        unsigned incl = pc;
#pragma unroll
        for (int o = 1; o < 64; o <<= 1) { const unsigned v = shupu(incl, o, lane); if (lane >= o) incl += v; }
        const unsigned pre = incl - pc;
        unsigned need = K2 > pre ? K2 - pre : 0u;
        const unsigned t0 = take_low(w0, need); need -= (unsigned)__popc(t0);
        const unsigned t1 = take_low(w1, need);
        G[qq * DS_BP + 2 * lane] |= t0; G[qq * DS_BP + 2 * lane + 1] |= t1;
    }
    __syncthreads();
    { const int qq = tid >> 4, part = tid & 15;
        unsigned* dst = MASK + (rowg + 32 * qg + qq) * 128 + part * 8;
        v4u a, c2;
        a.x = G[qq * DS_BP + part * 8 + 0]; a.y = G[qq * DS_BP + part * 8 + 1]; a.z = G[qq * DS_BP + part * 8 + 2]; a.w = G[qq * DS_BP + part * 8 + 3];
        c2.x = G[qq * DS_BP + part * 8 + 4]; c2.y = G[qq * DS_BP + part * 8 + 5]; c2.z = G[qq * DS_BP + part * 8 + 6]; c2.w = G[qq * DS_BP + part * 8 + 7];
        *(v4u*)dst = a; *(v4u*)(dst + 4) = c2; }
    __syncthreads();
}

constexpr int PL_U = 0, PL_UP = 528, PL_D = 79 * 528 + 16  , PL_DP = 257;
__device__ __forceinline__ void pool_unit(LAS unsigned char* lds, int b, int tile, const bf16* PU, const float* wpool  , const float* pscale  , bf16* YC) {
    int tid_l = threadIdx.x; asm volatile("" : "+v"(tid_l)); const int tid = tid_l, cb = __builtin_amdgcn_readfirstlane(tid >> 6), tt = tid & 63;
    const int t0 = tile * 64; const size_t rowg = (size_t)b * SEQ;
    for (int i = tid; i < 79 * 32; i += 512) { const int rr = i >> 5, ch = i & 31; const int tok = t0 - 15 + rr;
        v4u v = (v4u){0u, 0u, 0u, 0u}; if (tok >= 0) v = *(const v4u*)(PU + (rowg + tok) * 256 + ch * 8);
        *(LAS v4u*)(lds + PL_U + rr * PL_UP + ch * 16) = v; }
    __syncthreads();
    const int g = cb >> 1, wlen = 2 << g, c0 = 32 * cb, t = t0 + tt;
    const float inv = 1.f / (float)((t + 1 < wlen) ? (t + 1) : wlen);
    LAS float* Dm = (LAS float*)(lds + PL_D);
#pragma unroll
    for (int ch = 0; ch < 4; ++ch) {
        float sum[8];
#pragma unroll
        for (int e = 0; e < 8; ++e) sum[e] = 0.f;
        float self[8];
        for (int i = 0; i < wlen; ++i) {
            const v4u v = *(LAS const v4u*)(lds + PL_U + (15 + tt - i) * PL_UP + (c0 + 8 * ch) * 2);
            const float f[8] = {bflo(v.x), bfhi(v.x), bflo(v.y), bfhi(v.y), bflo(v.z), bfhi(v.z), bflo(v.w), bfhi(v.w)};
#pragma unroll
            for (int e = 0; e < 8; ++e) { sum[e] += f[e]; if (i == 0) self[e] = f[e]; }
        }
#pragma unroll
        for (int e = 0; e < 8; ++e) Dm[tt * PL_DP + c0 + 8 * ch + e] = sum[e] * inv - self[e];
    }
    __syncthreads();
    const int e0 = 32 * (cb & 1);
    float acc[32];
#pragma unroll
    for (int e = 0; e < 32; ++e) acc[e] = 0.f;
    const float* wg = wpool + (size_t)g * 4096 + e0;
    for (int c = 0; c < 64; ++c) {
        const float dv = Dm[tt * PL_DP + 64 * g + c];
        const float* wr = wg + c * 64;
#pragma unroll
        for (int e = 0; e < 32; ++e) acc[e] = __builtin_fmaf(dv, wr[e], acc[e]);
    }
    bf16* orow = YC + (rowg + t) * 256 + 64 * g + e0;
    const float* ps = pscale + 64 * g + e0;
#pragma unroll
    for (int k = 0; k < 4; ++k) { v4u o;
        o.x = pk2(acc[8 * k + 0] * ps[8 * k + 0], acc[8 * k + 1] * ps[8 * k + 1]); o.y = pk2(acc[8 * k + 2] * ps[8 * k + 2], acc[8 * k + 3] * ps[8 * k + 3]);
        o.z = pk2(acc[8 * k + 4] * ps[8 * k + 4], acc[8 * k + 5] * ps[8 * k + 5]); o.w = pk2(acc[8 * k + 6] * ps[8 * k + 6], acc[8 * k + 7] * ps[8 * k + 7]);
        *(v4u*)(orow + 8 * k) = o; }
    __syncthreads();
}
__device__ __forceinline__ void kmean_item(int item, const bf16* AK, float* KMEAN, int wid, int lane_in) {
    int lane = lane_in; asm volatile("" : "+v"(lane));
    const int combo = item * 8 + wid; const int b = combo >> 6, h = (combo >> 4) & 3, n = combo & 15;
    const int ks = lane >> 3, ch = lane & 7;
    const bf16* p = AK + ((size_t)b * SEQ + 256 * n + ks) * 256 + 64 * h + 8 * ch;
    float s[8];
#pragma unroll
    for (int e = 0; e < 8; ++e) s[e] = 0.f;
#pragma unroll 8
    for (int j = 0; j < 32; ++j) { const v4u v = *(const v4u*)(p + (size_t)j * 8 * 256);
        s[0] += bflo(v.x); s[1] += bfhi(v.x); s[2] += bflo(v.y); s[3] += bfhi(v.y); s[4] += bflo(v.z); s[5] += bfhi(v.z); s[6] += bflo(v.w); s[7] += bfhi(v.w); }
#pragma unroll
    for (int e = 0; e < 8; ++e) { s[e] += shx(s[e], 8, lane); s[e] += shx(s[e], 16, lane); s[e] += shx(s[e], 32, lane); }
    if (ks == 0) { float* o = KMEAN + (size_t)combo * 64 + 8 * ch;
        *(f32x4*)o = (f32x4){s[0], s[1], s[2], s[3]} * (1.f / 256.f); *(f32x4*)(o + 4) = (f32x4){s[4], s[5], s[6], s[7]} * (1.f / 256.f); }
}

__device__ __forceinline__ void norm_unit(LAS unsigned char* lds, int n, const bf16* PROJ, size_t TS, unsigned* NRM  ) {
    int tid_l = threadIdx.x; asm volatile("" : "+v"(tid_l)); const int tid = tid_l, lane = tid & 63, wid = __builtin_amdgcn_readfirstlane(tid >> 6);
    const int a = n >> 6, rem = n & 63, sq = rem >> 5, b = (rem >> 2) & 7, c = rem & 3;
    const int tile = (a == 0 ? 0 : (a == 1 ? 3 : 7)) + sq;
    const int row = tid >> 1, hp = tid & 1;
    float ss[2] = {0.f, 0.f};
#pragma unroll
    for (int rr = 0; rr < 4; ++rr) {
        const bf16* p = PROJ + (size_t)tile * TS + ((size_t)b * SEQ + 1024 * c + 256 * rr + row) * 256 + 128 * hp;
#pragma unroll
        for (int hh = 0; hh < 2; ++hh) { float acc = 0.f;
#pragma unroll
            for (int i = 0; i < 8; ++i) { const v4u v = *(const v4u*)(p + 64 * hh + 8 * i);
                const float f0 = bflo(v.x), f1 = bfhi(v.x), f2 = bflo(v.y), f3 = bfhi(v.y), f4 = bflo(v.z), f5 = bfhi(v.z), f6 = bflo(v.w), f7 = bfhi(v.w);
                acc += (f0 * f0 + f1 * f1) + (f2 * f2 + f3 * f3) + (f4 * f4 + f5 * f5) + (f6 * f6 + f7 * f7); }
            ss[hh] = fmaxf(ss[hh], acc); }
    }
#pragma unroll
    for (int o = 2; o < 64; o <<= 1) { ss[0] = fmaxf(ss[0], shx(ss[0], o, lane)); ss[1] = fmaxf(ss[1], shx(ss[1], o, lane)); }
    LAS float* R = (LAS float*)lds;
    if (lane < 2) { R[wid * 4 + 2 * hp] = ss[0]; R[wid * 4 + 2 * hp + 1] = ss[1]; }
    __syncthreads();
    if (tid < 4) { float m = R[tid];
#pragma unroll
        for (int w2 = 1; w2 < 8; ++w2) m = fmaxf(m, R[w2 * 4 + tid]);
        __hip_atomic_fetch_max(NRM + ((a * 2 + sq) * 8 + b) * 4 + tid, __float_as_uint(m * 1.0001f), __ATOMIC_RELAXED, __HIP_MEMORY_SCOPE_AGENT); }
    __syncthreads();
}

__device__ __forceinline__ float alibi_slope(int idx  ) { return exp2f(-8.f * (float)idx / 12.f); }

__device__ __forceinline__ void p0_adaln(const Args& A, LAS unsigned char* lds, int G) {
    int tid_l = threadIdx.x; asm volatile("" : "+v"(tid_l)); const int tid = tid_l, lane = tid & 63, wid = __builtin_amdgcn_readfirstlane(tid >> 6);
    LAS float* cact = (LAS float*)lds;
    LAS float* red = (LAS float*)(lds + 32768);
    float* MOD = (float*)(A.ws + WS_MOD);
    if ((int)blockIdx.x < 192) {
        for (int i = tid; i < 8192; i += 512) { const int bb = i >> 10, k = i & 1023; const float v = A.c[i]; cact[k * 8 + bb] = v / (1.f + __expf(-v)); }
        __syncthreads();
        for (int u = blockIdx.x; u < 192; u += G) {
            const int l = u / 96, n0 = (u % 96) * 64;
            const float* wp = A.w_ada + ((size_t)l * 1024 + 128 * wid) * 6144 + n0 + lane;
            float acc[8];
#pragma unroll
            for (int bb = 0; bb < 8; ++bb) acc[bb] = 0.f;
#pragma unroll 16
            for (int k = 0; k < 128; ++k) {
                const float wv = wp[(size_t)k * 6144];
                const f32x4 c0 = *(LAS const f32x4*)(cact + (128 * wid + k) * 8), c1 = *(LAS const f32x4*)(cact + (128 * wid + k) * 8 + 4);
                acc[0] += c0[0] * wv; acc[1] += c0[1] * wv; acc[2] += c0[2] * wv; acc[3] += c0[3] * wv;
                acc[4] += c1[0] * wv; acc[5] += c1[1] * wv; acc[6] += c1[2] * wv; acc[7] += c1[3] * wv;
            }
#pragma unroll
            for (int bb = 0; bb < 8; ++bb) red[(wid * 8 + bb) * 64 + lane] = acc[bb];
            __syncthreads();
            { const int bb = wid; float s = A.b_ada[(size_t)l * 6144 + n0 + lane];
#pragma unroll
                for (int w2 = 0; w2 < 8; ++w2) s += red[(w2 * 8 + bb) * 64 + lane];
                MOD[((size_t)l * 8 + bb) * 6144 + n0 + lane] = s; }
            __syncthreads();
        }
    }
    __syncthreads();
}
__device__ __forceinline__ void p0_weights(const Args& A, LAS unsigned char* lds, int vcu, int G) {
    int tid_l = threadIdx.x; asm volatile("" : "+v"(tid_l)); const int tid = tid_l, lane = tid & 63, wid = __builtin_amdgcn_readfirstlane(tid >> 6);
    unsigned char* ws = A.ws;
    LAS float* scr = (LAS float*)(lds + wid * 16384);
    const int gw = vcu * NWAVES + wid, NGW = G * NWAVES;
    constexpr int I_IN = 16 * (NPROJ_PAD / 32), I_G1 = 16 * 32, I_BR1 = 4 * 32, I_OUT = 16 * 32, I_F1 = 16 * 128, I_F2 = 64 * 32;
    constexpr int I_LAYER = I_IN + 4 * I_G1 + 4 * I_BR1 + I_OUT + I_F1 + I_F2;
    for (int it = gw; it < 2 * I_LAYER; it += NGW) {
        const int l = it / I_LAYER; int r = it % I_LAYER;
        bf16* WL = (bf16*)(ws + WS_W) + (size_t)l * W_LAYER;
        if (r < I_IN) { p0_transpose_item(A.w_in + (size_t)l * DM * NPROJ, DM, NPROJ, NPROJ_PAD, WL + W_IN, 0, 0, scr, r, lane); continue; } r -= I_IN;
        if (r < 4 * I_G1) { const int br = r / I_G1; p0_transpose_item(A.w_gate + ((size_t)l * 4 + br) * DM * DM, DM, DM, DM, WL + W_GATE, 1, br, scr, r % I_G1, lane); continue; } r -= 4 * I_G1;
        if (r < 4 * I_BR1) { const int br = r / I_BR1; p0_transpose_item(A.w_branch + ((size_t)l * 4 + br) * 256 * DM, 256, DM, DM, WL + W_BR + (size_t)br * DM * 256, 0, 0, scr, r % I_BR1, lane); continue; } r -= 4 * I_BR1;
        if (r < I_OUT) { p0_transpose_item(A.w_out + (size_t)l * DM * DM, DM, DM, DM, WL + W_OUT, 0, 0, scr, r, lane); continue; } r -= I_OUT;
        if (r < I_F1) { p0_transpose_item(A.w_ff1 + (size_t)l * DM * FF, DM, FF, FF, WL + W_FF1, 0, 0, scr, r, lane); continue; } r -= I_F1;
        p0_transpose_item(A.w_ff2 + (size_t)l * FF * DM, FF, DM, DM, WL + W_FF2, 0, 0, scr, r, lane);
    }
    __syncthreads();
}

__device__ __forceinline__ int wq_draw(gu32* ctr) { int v = 0; if (threadIdx.x == 0) v = (int)__hip_atomic_fetch_add(ctr, 1u, RLX_AGENT); return v; }
__device__ __forceinline__ int wq_bcast(volatile LAS unsigned* slot, int v) {
    if (threadIdx.x == 0) *slot = (unsigned)v;
    __syncthreads();
    const int item = (int)*slot;
    __syncthreads();
    return item;
}

struct ZOrder {
    pg8::StaticOrder base;
    __device__ __forceinline__ bool next(int i, pg8::Unit& u) const { if (!base.next(i, u)) return false; u.pn += 4 * (u.pm >> 7); return true; }
    __device__ __forceinline__ void a_ready(const pg8::Unit&) const {}
    __device__ __forceinline__ void done(const pg8::Unit&) const {}
};

__global__ void __launch_bounds__(NWAVES * 64, 2) hybrid_fwd(Args args) {
    extern __shared__ __attribute__((aligned(16))) unsigned char lds_raw[];
    LAS unsigned char* lds = (LAS unsigned char*)lds_raw;
#define PHASE_IDS int tid_p = threadIdx.x; asm volatile("" : "+v"(tid_p)); const int lane = tid_p & 63, wid = __builtin_amdgcn_readfirstlane(tid_p >> 6); const int gw = vcu * NWAVES + wid, ngw = G * NWAVES; (void)lane; (void)gw; (void)ngw;
    const int G = gridDim.x; const int bx = blockIdx.x; const int vcu = (G % 8 == 0) ? (bx % 8) * (G / 8) + bx / 8 : bx;
    unsigned char* ws = args.ws;
    gu32* ctl = (gu32*)(ws + WS_CTL);
    volatile LAS unsigned* MISC = (volatile LAS unsigned*)(lds + LDSCTL_OFF);
    for (int u = threadIdx.x; u < (LDS_BYTES - LDSCTL_OFF) / 4; u += NWAVES * 64) ((LAS unsigned*)(lds + LDSCTL_OFF))[u] = 0u;
    __syncthreads();
    const int lo = args.ph_lo, hi = args.ph_hi;
    XcdBarrier bar; bar.bar = (unsigned*)(ctl + CW_BAR) + args.li * XCD_BAR_WORDS; bar.x = 0; bar.st = nullptr;
    if (hi - lo > 1) bar = xcd_barrier_post((unsigned*)(ctl + CW_BAR) + args.li * XCD_BAR_WORDS, MISC + 8);
#ifndef PHASE_OFF
#define PHASE_OFF 0
#endif
#define IN(k) (lo <= (k) && (k) < hi && !((PHASE_OFF >> ((k) == 0 ? 0 : (k) == 21 ? 11 : (((k) - 1) % 10) + 1)) & 1))
#ifndef REPEAT_MASK
#define REPEAT_MASK 0
#endif
#define NREP(bit) (((REPEAT_MASK >> (bit)) & 1) ? 2 : 1)
#if defined(PROBE_SEAM2X)
#define SEAM(k) do { if (IN(k) && IN((k) + 1)) { xcd_barrier(bar); xcd_barrier(bar); } } while (0)
#else
#define SEAM(k) do { if (IN(k) && IN((k) + 1)) xcd_barrier(bar); } while (0)
#endif
    float* MOD = (float*)(ws + WS_MOD);
    float* KMEAN = (float*)(ws + WS_KMEAN);
    unsigned* MASK = (unsigned*)(ws + WS_MASK);
    bf16* H = (bf16*)(ws + WS_H);
    bf16* Y = (bf16*)(ws + WS_Y);
    bf16* MERGED = (bf16*)(ws + WS_Y);
    bf16* PROJ = (bf16*)(ws + WS_R);
    bf16* Z = (bf16*)(ws + WS_R);
    bf16* U = (bf16*)(ws + WS_R);
    bf16* XRB = (bf16*)args.out;
    constexpr size_t TS = (size_t)TOK * 256;
    volatile LAS unsigned* wqslot = MISC + 16;

    if (IN(0)) for (int rep = 0; rep < NREP(0); ++rep) { p0_adaln(args, lds, G); }
    SEAM(0);

#pragma nounroll
    for (int l = 0; l < NL; ++l) {
        const int pb = 1 + 10 * l;
        const float* modl = MOD + (size_t)l * 8 * 6144;
        const bf16* WL = (const bf16*)(ws + WS_W) + (size_t)l * W_LAYER;
        if (IN(pb + 0)) for (int rep = 0; rep < NREP(1); ++rep) { PHASE_IDS if (l == 0) norm_rows_bf16<false>(args.x, H, args.norm1_g + (size_t)l * DM, modl, 0, 1, gw, ngw, lane); else norm_rows_bf16<true>(XRB, H, args.norm1_g + (size_t)l * DM, modl, 0, 1, gw, ngw, lane); if (l == 0) p0_weights(args, lds, vcu, G); }
        SEAM(pb + 0);
        if (IN(pb + 1)) for (int rep = 0; rep < NREP(2); ++rep) {
            pg8::Gemm g{H, WL + W_IN, TOK, NPROJ_PAD, DM}; pg8::StaticOrder S; S.init(TOK, NPROJ_PAD, G, bx);
            pg8::EpiProj E{PROJ, TS};
            pg8::gemm_phase<pg8::EpiProj, pg8::StaticOrder, true, true>(lds, g, S, E);
        }
        SEAM(pb + 1);
        unsigned* NRM = (unsigned*)(ctl + CW_NRM) + l * 192;
        if (IN(pb + 2)) for (int rep = 0; rep < NREP(3); ++rep) {
            gu32* ctr = ctl + CW_WQ + (l * 2 + 0 + 4 * rep) * 64;
            int raw = wq_draw(ctr);
            for (;;) {
                const int item = wq_bcast(wqslot, raw);
                if (item >= 1024 + 512 + 64 + 192) break;
                raw = wq_draw(ctr);
                if (item < 1024) { const int qg = 127 - (item >> 3), b = item & 7;
                    dsa_select_unit(lds, b, qg, PROJ + 10 * TS, MASK);
                } else if (item < 1536) { const int i2 = item - 1024; const int b = i2 >> 6, tile = i2 & 63;
                    pool_unit(lds, b, tile, PROJ + 6 * TS, args.w_pool + (size_t)l * 4 * 4096, args.pool_scale + (size_t)l * 256, Y + 2 * TS);
                } else if (item < 1600) { PHASE_IDS kmean_item(item - 1536, PROJ + 1 * TS, KMEAN, wid, lane);
                } else { norm_unit(lds, item - 1600, PROJ, TS, NRM); }
            }
        }
        SEAM(pb + 2);
        if (IN(pb + 3)) for (int rep = 0; rep < NREP(4); ++rep) {
            gu32* ctr = ctl + CW_WQ + 512 + ((l * 2 + rep) * 8) * 64;
            const float li = 0.8f - 0.6f * __expf(-0.3f * (float)l);
            const float* dl = args.diff_lambda + (size_t)l * 128;
            float d1 = 0.f, d2 = 0.f;
            for (int i = 0; i < 32; ++i) { d1 += dl[i] * dl[32 + i]; d2 += dl[64 + i] * dl[96 + i]; }
            const float lam = __expf(d1) - __expf(d2) + li;
            int raw = wq_draw(ctr);
            for (;;) {
                const int item = wq_bcast(wqslot, raw);
                if (item >= 1536) break;
                raw = wq_draw(ctr);
                const int ty = item % 3, rest = item / 3; const int qb = 15 - (rest >> 5), bh = rest & 31, b = bh >> 2, h = bh & 3;
                if (ty == 0) attn_unit<1>(lds, b, h, qb, PROJ + 3 * TS, PROJ + 4 * TS, PROJ + 5 * TS, Y + 1 * TS, alibi_slope(3 * h + 2), nullptr, lam, 1.f - li, args.diff_subln_g + (size_t)l * 64, nullptr, NRM + 64);
                else if (ty == 1) attn_unit<0>(lds, b, h, qb, PROJ + 0 * TS, PROJ + 1 * TS, PROJ + 2 * TS, Y + 0 * TS, alibi_slope(3 * h + 1), KMEAN, 0.f, 0.f, nullptr, nullptr, NRM);
                else              attn_unit<2>(lds, b, h, qb, PROJ + 7 * TS, PROJ + 8 * TS, PROJ + 9 * TS, Y + 3 * TS, alibi_slope(3 * h + 3), nullptr, 0.f, 0.f, nullptr, MASK, NRM + 128);
            }
        }
        SEAM(pb + 3);
        if (IN(pb + 4)) for (int rep = 0; rep < NREP(5); ++rep) {
            int kz = 256; asm volatile("" : "+s"(kz)); pg8::Gemm g{Y, WL + W_BR, 4 * TOK, 4096, kz}; ZOrder S; S.base.init(4 * TOK, DM, G, bx);
            pg8::EpiZ E{Z};
            pg8::gemm_phase<pg8::EpiZ, ZOrder, true, true>(lds, g, S, E);
        }
        SEAM(pb + 4);
        if (IN(pb + 5)) for (int rep = 0; rep < NREP(6); ++rep) {
            pg8::Gemm g{H, WL + W_GATE, TOK, 4096, DM}; pg8::StaticOrder S; S.init(TOK, 4096, G, bx);
            pg8::EpiGate E{Z, args.b_gate + (size_t)l * 4 * DM, MERGED};
            pg8::gemm_phase<pg8::EpiGate, pg8::StaticOrder, true, true>(lds, g, S, E);
        }
        SEAM(pb + 5);
        if (IN(pb + 6)) for (int rep = 0; rep < NREP(7); ++rep) {
            pg8::Gemm g{MERGED, WL + W_OUT, TOK, DM, DM}; pg8::StaticOrder S; S.init(TOK, DM, G, bx);
            if (l == 0) { pg8::EpiResid<false> E{args.x, rep ? (bf16*)(ws + WS_R) : XRB, modl + 2 * 1024};
                pg8::gemm_phase<pg8::EpiResid<false>, pg8::StaticOrder, true, true>(lds, g, S, E); }
            else { pg8::EpiResid<true> E{XRB, rep ? (bf16*)(ws + WS_R) : XRB, modl + 2 * 1024};
                pg8::gemm_phase<pg8::EpiResid<true>, pg8::StaticOrder, true, true>(lds, g, S, E); }
        }
        SEAM(pb + 6);
        if (IN(pb + 7)) for (int rep = 0; rep < NREP(8); ++rep) { PHASE_IDS norm_rows_bf16<true>(XRB, H, args.norm2_g + (size_t)l * DM, modl, 3, 4, gw, ngw, lane); }
        SEAM(pb + 7);
        if (IN(pb + 8)) for (int rep = 0; rep < NREP(9); ++rep) {
            pg8::Gemm g{H, WL + W_FF1, TOK, FF, DM}; pg8::StaticOrder S; S.init(TOK, FF, G, bx);
            pg8::EpiRelu2 E{U, FF};
            pg8::gemm_phase<pg8::EpiRelu2, pg8::StaticOrder, true, true>(lds, g, S, E);
        }
        SEAM(pb + 8);
        if (IN(pb + 9)) for (int rep = 0; rep < NREP(10); ++rep) {
            pg8::Gemm g{U, WL + W_FF2, TOK, DM, FF}; pg8::StaticOrder S; S.init(TOK, DM, G, bx);
            pg8::EpiResid<true> E{XRB, rep ? (bf16*)(ws + WS_MASK) : XRB, modl + 5 * 1024};
            pg8::gemm_phase<pg8::EpiResid<true>, pg8::StaticOrder, true, true>(lds, g, S, E);
        }
        SEAM(pb + 9);
    }
    if (IN(21)) {
        PHASE_IDS
        v4u xa[16], xb[16]; float rs[16];
        const v4u* xp = (const v4u*)(XRB + (size_t)gw * DM) + 2 * lane;
#pragma unroll
        for (int i = 0; i < 16; ++i) { xa[i] = xp[(size_t)i * ngw * (DM / 8)]; xb[i] = xp[(size_t)i * ngw * (DM / 8) + 1]; }
#pragma unroll
        for (int i = 0; i < 16; ++i) { const v4u a = xa[i], c = xb[i];
            float s = bflo(a.x) * bflo(a.x); s += bfhi(a.x) * bfhi(a.x); s += bflo(a.y) * bflo(a.y); s += bfhi(a.y) * bfhi(a.y); s += bflo(a.z) * bflo(a.z); s += bfhi(a.z) * bfhi(a.z); s += bflo(a.w) * bflo(a.w); s += bfhi(a.w) * bfhi(a.w);
            s += bflo(c.x) * bflo(c.x); s += bfhi(c.x) * bfhi(c.x); s += bflo(c.y) * bflo(c.y); s += bfhi(c.y) * bfhi(c.y); s += bflo(c.z) * bflo(c.z); s += bfhi(c.z) * bfhi(c.z); s += bflo(c.w) * bflo(c.w); s += bfhi(c.w) * bfhi(c.w);
            rs[i] = 1.f / sqrtf(wave_sum(s, lane) * (1.f / DM) + NORM_EPS); }
        xcd_barrier(bar);
#pragma unroll
        for (int i = 0; i < 16; ++i) asm volatile("" : "+v"(xa[i]), "+v"(xb[i]));
        const f32x4* gp = (const f32x4*)args.final_g + 4 * lane;
        f32x4* op = (f32x4*)(args.out + (size_t)gw * DM) + 4 * lane;
#pragma unroll
        for (int i = 0; i < 16; ++i) { const v4u a = xa[i], c = xb[i]; const float r = rs[i]; f32x4* o = op + (size_t)i * ngw * (DM / 4);
            o[0] = (f32x4){bflo(a.x), bfhi(a.x), bflo(a.y), bfhi(a.y)} * r * gp[0]; o[1] = (f32x4){bflo(a.z), bfhi(a.z), bflo(a.w), bfhi(a.w)} * r * gp[1];
            o[2] = (f32x4){bflo(c.x), bfhi(c.x), bflo(c.y), bfhi(c.y)} * r * gp[2]; o[3] = (f32x4){bflo(c.z), bfhi(c.z), bflo(c.w), bfhi(c.w)} * r * gp[3]; }
    }
#undef IN
#undef SEAM
}

#ifndef MK_SPLIT
#define MK_SPLIT 0
#endif
extern "C" void kernel_launch(void* const* d_in, const int* in_sizes, int n_in, void* d_out, int out_size, void* d_ws, size_t ws_size, hipStream_t stream) {
    static int grid = 0;
    if (grid == 0) {
        if (n_in != 18 || in_sizes[0] != TOK * DM || out_size != TOK * DM || ws_size < WS_END) { fprintf(stderr, "kernel_launch: unexpected shapes (n_in %d, in0 %d, out %d, ws %zu)\n", n_in, n_in > 0 ? in_sizes[0] : -1, out_size, ws_size); grid = -1; return; }
        int dev = 0, cus = 0, per_cu = 0;
        if (hipGetDevice(&dev) != hipSuccess || hipDeviceGetAttribute(&cus, hipDeviceAttributeMultiprocessorCount, dev) != hipSuccess) { grid = -1; return; }
        if (hipFuncSetAttribute((const void*)hybrid_fwd, hipFuncAttributeMaxDynamicSharedMemorySize, LDS_BYTES) != hipSuccess) { fprintf(stderr, "kernel_launch: hipFuncSetAttribute failed\n"); grid = -1; return; }
        if (hipOccupancyMaxActiveBlocksPerMultiprocessor(&per_cu, (const void*)hybrid_fwd, NWAVES * 64, LDS_BYTES) != hipSuccess || per_cu < 1) fprintf(stderr, "kernel_launch: occupancy query reports %d\n", per_cu);
        (void)hipGetLastError();
        grid = cus;
        if (cus != 256) { fprintf(stderr, "kernel_launch: built for 256 CUs (the final norm stages 16 rows per wave), found %d\n", cus); grid = -1; return; }
    }
    if (grid < 0) return;
    if (hipMemsetAsync((char*)d_ws + WS_CTL, 0, CTL_ZERO_BYTES, stream) != hipSuccess) return;
    Args a{};
    const float** ap = (const float**)&a;
    for (int i = 0; i < 18; ++i) ap[i] = (const float*)d_in[i];
    a.out = (float*)d_out; a.ws = (unsigned char*)d_ws; a.pad = 0;
#if MK_SPLIT
    for (int p = 0; p < NPHASE; ++p) { a.ph_lo = p; a.ph_hi = p + 1; a.li = 0;
        hipLaunchKernelGGL(hybrid_fwd, dim3(grid), dim3(NWAVES * 64), LDS_BYTES, stream, a); }
#else
    a.ph_lo = 0; a.ph_hi = NPHASE; a.li = 0;
    hipLaunchKernelGGL(hybrid_fwd, dim3(grid), dim3(NWAVES * 64), LDS_BYTES, stream, a);
#endif
}
```

```cpp
#include <hip/hip_runtime.h>
#include <cstdio>
#include <cstdint>
namespace pg8 {
#define PG8_LAS __attribute__((address_space(3)))
typedef unsigned short bf16_t;
typedef short bf16x8 __attribute__((ext_vector_type(8)));
typedef float f32x4 __attribute__((ext_vector_type(4)));
typedef unsigned u32x4 __attribute__((ext_vector_type(4)));
constexpr int BM = 256, BK = 64, HALF = 128, HTB = HALF * BK * 2  , STAGE_BYTES = 8 * HTB, NXCD = 8, WGM = 8;

__host__ __device__ __forceinline__ int lds_byte(int r, int c) { const int st = (r >> 4) * 2 + (c >> 5), rr = r & 15, cc = c & 31, ob = rr * 64 + cc * 2; return st * 1024 + (ob ^ (((ob >> 9) & 1) << 5)); }
__host__ __device__ __forceinline__ void stage_rc(int b, int& R, int& C) { const int st = b / 1024, sb = b % 1024, swz = sb ^ (((sb >> 9) & 1) << 5); R = (st >> 1) * 16 + swz / 64; C = (st & 1) * 32 + (swz % 64) / 2; }
__host__ __device__ __forceinline__ int perm32(int rho) { const int n = rho >> 4, i = rho & 15; return 8 * (i >> 2) + 4 * n + (i & 3); }

struct Unit { int pm, pn; };
struct Gemm { const bf16_t* A; const bf16_t* Bt; int M, N, K; };

struct StaticOrder {
    int nM, nN, nwg, G, c;
    __host__ __device__ void init(int M, int N, int G_, int c_) { nM = M / BM; nN = N / BM; nwg = nM * nN; G = G_; c = c_; }
    __host__ __device__ bool next(int i, Unit& u) const {
        const long L = (long)i * G + c; if (L >= nwg) return false;
        int wgid = (int)L; { const int q = nwg / NXCD, r = nwg % NXCD, xcd = wgid % NXCD, off = wgid / NXCD; wgid = (xcd < r ? xcd * (q + 1) : r * (q + 1) + (xcd - r) * q) + off; }
        const int nig = WGM * nN, gid = wgid / nig, fm = gid * WGM, gsz = (nM - fm) < WGM ? (nM - fm) : WGM;
        u.pm = fm + ((wgid % nig) % gsz); u.pn = (wgid % nig) / gsz; return true;
    }
    __device__ __forceinline__ void a_ready(const Unit&) const {}
    __device__ __forceinline__ void done(const Unit&) const {}
};

__device__ __forceinline__ unsigned cvt_pk_bf16(float lo, float hi) { unsigned r; asm volatile("v_cvt_pk_bf16_f32 %0, %1, %2" : "=v"(r) : "v"(lo), "v"(hi)); return r; }
typedef unsigned u32x2 __attribute__((ext_vector_type(2)));
constexpr int TT = 32768;
constexpr float QS64 = 0.125f * 1.4426950408889634f;
constexpr float QS32 = 0.17677669529663687f * 1.4426950408889634f;

struct EpiProj {
    static constexpr bool PERM = true, AFTER_DRAIN = false;
    bf16_t* O; size_t tile_stride;
    __device__ __forceinline__ void operator()(const f32x4 (&acc)[2][2][4][2], const Unit& u, int wr, int wc, int fr, int fq) const {
        const int row0 = u.pm * BM + wr * 64 + fr; bf16_t* base = O + (size_t)u.pn * tile_stride;
        float sc = 1.f; if (u.pn == 0 || u.pn == 7) sc = QS64; else if (u.pn == 3) sc = QS32;
        const int col0 = wc * 32 + 8 * fq;
#pragma unroll
        for (int ai = 0; ai < 2; ++ai)
#pragma unroll
            for (int m = 0; m < 4; ++m) { bf16_t* rowp = base + (size_t)(row0 + ai * HALF + m * 16) * 256 + col0;
#pragma unroll
                for (int bj = 0; bj < 2; ++bj) { const f32x4 v0 = acc[ai][bj][m][0] * sc, v1 = acc[ai][bj][m][1] * sc;
                    u32x4 w; w.x = cvt_pk_bf16(v0[0], v0[1]); w.y = cvt_pk_bf16(v0[2], v0[3]); w.z = cvt_pk_bf16(v1[0], v1[1]); w.w = cvt_pk_bf16(v1[2], v1[3]);
                    *(u32x4*)(rowp + bj * HALF) = w; } }
    }
};
struct EpiZ {
    static constexpr bool PERM = true, AFTER_DRAIN = false;
    bf16_t* O;
    __device__ __forceinline__ void operator()(const f32x4 (&acc)[2][2][4][2], const Unit& u, int wr, int wc, int fr, int fq) const {
        const int row0 = u.pm * BM + wr * 64 + fr; const int col0 = (u.pn & 3) * BM + wc * 32 + 8 * fq;
#pragma unroll
        for (int ai = 0; ai < 2; ++ai)
#pragma unroll
            for (int m = 0; m < 4; ++m) { bf16_t* rowp = O + (size_t)(row0 + ai * HALF + m * 16) * 1024 + col0;
#pragma unroll
                for (int bj = 0; bj < 2; ++bj) { const f32x4 v0 = acc[ai][bj][m][0], v1 = acc[ai][bj][m][1];
                    u32x4 w; w.x = cvt_pk_bf16(v0[0], v0[1]); w.y = cvt_pk_bf16(v0[2], v0[3]); w.z = cvt_pk_bf16(v1[0], v1[1]); w.w = cvt_pk_bf16(v1[2], v1[3]);
                    *(u32x4*)(rowp + bj * HALF) = w; } }
    }
};
struct EpiRelu2 {
    static constexpr bool PERM = true, AFTER_DRAIN = false;
    bf16_t* O; int ldc;
    __device__ __forceinline__ void operator()(const f32x4 (&acc)[2][2][4][2], const Unit& u, int wr, int wc, int fr, int fq) const {
        const int row0 = u.pm * BM + wr * 64 + fr; const int col0 = u.pn * BM + wc * 32 + 8 * fq;
#pragma unroll
        for (int ai = 0; ai < 2; ++ai)
#pragma unroll
            for (int m = 0; m < 4; ++m) { bf16_t* rowp = O + (size_t)(row0 + ai * HALF + m * 16) * ldc + col0;
#pragma unroll
                for (int bj = 0; bj < 2; ++bj) { f32x4 v0 = acc[ai][bj][m][0], v1 = acc[ai][bj][m][1];
#pragma unroll
                    for (int j = 0; j < 4; ++j) { const float a = fmaxf(v0[j], 0.f), b = fmaxf(v1[j], 0.f); v0[j] = a * a; v1[j] = b * b; }
                    u32x4 w; w.x = cvt_pk_bf16(v0[0], v0[1]); w.y = cvt_pk_bf16(v0[2], v0[3]); w.z = cvt_pk_bf16(v1[0], v1[1]); w.w = cvt_pk_bf16(v1[2], v1[3]);
                    *(u32x4*)(rowp + bj * HALF) = w; } }
    }
};
template <bool BASE_BF16> struct EpiResid {
    static constexpr bool PERM = true, AFTER_DRAIN = false;
    const void* base; bf16_t* out; const float* gate;
    __device__ __forceinline__ void operator()(const f32x4 (&acc)[2][2][4][2], const Unit& u, int wr, int wc, int fr, int fq) const {
        const int row0 = u.pm * BM + wr * 64 + fr; const int col0 = u.pn * BM + wc * 32 + 8 * fq;
        const float* gp = gate + (size_t)(u.pm >> 4) * 6144 + col0;
        f32x4 gv[2][2];
#pragma unroll
        for (int bj = 0; bj < 2; ++bj)
#pragma unroll
            for (int n = 0; n < 2; ++n) gv[bj][n] = *(const f32x4*)(gp + bj * HALF + n * 4);
#pragma unroll
        for (int ai = 0; ai < 2; ++ai)
#pragma unroll
            for (int m = 0; m < 4; ++m) { const size_t off = (size_t)(row0 + ai * HALF + m * 16) * 1024 + col0;
#pragma unroll
                for (int bj = 0; bj < 2; ++bj) { f32x4 b0, b1;
                    if (BASE_BF16) { const u32x4 w = *(const u32x4*)((const bf16_t*)base + off + bj * HALF);
                        b0 = (f32x4){__uint_as_float(w.x << 16), __uint_as_float(w.x & 0xffff0000u), __uint_as_float(w.y << 16), __uint_as_float(w.y & 0xffff0000u)};
                        b1 = (f32x4){__uint_as_float(w.z << 16), __uint_as_float(w.z & 0xffff0000u), __uint_as_float(w.w << 16), __uint_as_float(w.w & 0xffff0000u)}; }
                    else { b0 = *(const f32x4*)((const float*)base + off + bj * HALF); b1 = *(const f32x4*)((const float*)base + off + bj * HALF + 4); }
                    const f32x4 v0 = b0 + gv[bj][0] * acc[ai][bj][m][0], v1 = b1 + gv[bj][1] * acc[ai][bj][m][1];
                    u32x4 o; o.x = cvt_pk_bf16(v0[0], v0[1]); o.y = cvt_pk_bf16(v0[2], v0[3]); o.z = cvt_pk_bf16(v1[0], v1[1]); o.w = cvt_pk_bf16(v1[2], v1[3]);
                    *(u32x4*)(out + off + bj * HALF) = o; }
                if (m & 1) asm volatile("" ::: "memory"); }
    }
};
struct EpiGate {
    static constexpr bool PERM = true, AFTER_DRAIN = false;
    const bf16_t* Z; const float* bg; bf16_t* O;
    __device__ __forceinline__ void operator()(const f32x4 (&acc)[2][2][4][2], const Unit& u, int wr, int wc, int fr, int fq) const {
        const int row0 = u.pm * BM + wr * 64 + fr; const int mc0 = u.pn * 64 + wc * 16 + 4 * fq;
        f32x4 bv[2][2];
#pragma unroll
        for (int bj = 0; bj < 2; ++bj)
#pragma unroll
            for (int n = 0; n < 2; ++n) bv[bj][n] = *(const f32x4*)(bg + (2 * bj + n) * 1024 + mc0);
#pragma unroll
        for (int ai = 0; ai < 2; ++ai)
#pragma unroll
            for (int m = 0; m < 4; ++m) { const size_t row = (size_t)(row0 + ai * HALF + m * 16);
                f32x4 sum = (f32x4){0.f, 0.f, 0.f, 0.f};
#pragma unroll
                for (int bj = 0; bj < 2; ++bj)
#pragma unroll
                    for (int n = 0; n < 2; ++n) { const u32x2 zr = *(const u32x2*)(Z + ((size_t)(2 * bj + n) * TT + row) * 1024 + mc0);
                        const f32x4 x = acc[ai][bj][m][n] + bv[bj][n]; f32x4 zz;
                        zz[0] = __uint_as_float(zr.x << 16); zz[1] = __uint_as_float(zr.x & 0xffff0000u); zz[2] = __uint_as_float(zr.y << 16); zz[3] = __uint_as_float(zr.y & 0xffff0000u);
#pragma unroll
                        for (int j = 0; j < 4; ++j) { const float g = __builtin_amdgcn_rcpf(1.f + __builtin_amdgcn_exp2f(-1.4426950408889634f * x[j])); sum[j] += g * zz[j]; } }
                u32x2 w; w.x = cvt_pk_bf16(sum[0], sum[1]); w.y = cvt_pk_bf16(sum[2], sum[3]);
                *(u32x2*)(O + row * 1024 + mc0) = w; }
    }
};
template <class Epi, class Sched, bool ALIGN_EPI = false, bool SP2 = false>
__device__ __forceinline__ void gemm_phase(PG8_LAS unsigned char* lds, const Gemm g, const Sched& S, const Epi& E) {
    int tid_l = threadIdx.x; asm volatile("" : "+v"(tid_l)); const int tid = tid_l, wid = __builtin_amdgcn_readfirstlane(tid >> 6), lane = tid & 63, wr = wid >> 2, wc = wid & 3, fr = lane & 15, fq = lane >> 4;
    const int K = g.K, nt = K / BK;
    unsigned voffA[2], voffB[2];
#pragma unroll
    for (int i = 0; i < 2; ++i) { int R, C; stage_rc(tid * 16 + i * 8192, R, C); const int Rb = Epi::PERM ? ((R & ~31) + perm32(R & 31)) : R;
        voffA[i] = (unsigned)(R * K + C) * 2u; voffB[i] = (unsigned)(Rb * K + C) * 2u; }
    const size_t kstep = (size_t)(BK * 2);
    const size_t hstep = (size_t)HALF * K * 2;
    const size_t tstep = 2 * hstep;
    const unsigned ldsw = (unsigned)wid * 1024u;
    const int aoff = lds_byte(wr * 64 + fr, fq * 8), boff = lds_byte(wc * 32 + fr, fq * 8);
#define PG8_SA(b, h) (((b) * 2 + (h)) * HTB)
#define PG8_SB(b, h) ((4 + (b) * 2 + (h)) * HTB)
#define PG8_STAGE(bufoff, gbase, voff) do { _Pragma("unroll") for (int _i = 0; _i < 2; ++_i) \
        __builtin_amdgcn_global_load_lds((const unsigned*)((const char*)(gbase) + (voff)[_i]), (PG8_LAS unsigned*)(lds + (bufoff) + ldsw + _i * 8192), 16, 0, 0); } while (0)
#define PG8_LDA(dst, b, h) do { _Pragma("unroll") for (int m = 0; m < 4; ++m) _Pragma("unroll") for (int k = 0; k < 2; ++k) dst[m][k] = *(const PG8_LAS bf16x8*)(lds + PG8_SA(b, h) + aoff + m * 2048 + k * 1024); } while (0)
#define PG8_LDB(dst, b, h) do { _Pragma("unroll") for (int n = 0; n < 2; ++n) _Pragma("unroll") for (int k = 0; k < 2; ++k) dst[n][k] = *(const PG8_LAS bf16x8*)(lds + PG8_SB(b, h) + boff + n * 2048 + k * 1024); } while (0)
#define PG8_MMA(ai, bj, At, Bt) do { __builtin_amdgcn_s_setprio(1); _Pragma("unroll") for (int m = 0; m < 4; ++m) _Pragma("unroll") for (int n = 0; n < 2; ++n) _Pragma("unroll") for (int k = 0; k < 2; ++k) \
        acc[ai][bj][m][n] = __builtin_amdgcn_mfma_f32_16x16x32_bf16(Bt[n][k], At[m][k], acc[ai][bj][m][n], 0, 0, 0); __builtin_amdgcn_s_setprio(0); } while (0)
#define PG8_WAIT_V(n) asm volatile("s_waitcnt vmcnt(" #n ")" ::: "memory")
#define PG8_WAIT_L(n) asm volatile("s_waitcnt lgkmcnt(" #n ")" ::: "memory")
#define PG8_BAR __builtin_amdgcn_s_barrier()
#define PG8_SCHED __builtin_amdgcn_sched_barrier(0)
    Unit cur, nxt; int ui = 0;
    if (!S.next(0, cur)) return;
    f32x4 acc[2][2][4][2];
#pragma unroll
    for (int a = 0; a < 2; ++a)
#pragma unroll
        for (int b = 0; b < 2; ++b)
#pragma unroll
            for (int m = 0; m < 4; ++m)
#pragma unroll
                for (int n = 0; n < 2; ++n) acc[a][b][m][n] = (f32x4){0.f, 0.f, 0.f, 0.f};
    bf16x8 At[4][2], B0[2][2], B1[2][2];
    const char* cA = (const char*)g.A + (size_t)cur.pm * tstep; const char* cB = (const char*)g.Bt + (size_t)cur.pn * tstep;
    S.a_ready(cur);
    if constexpr (SP2) {
        PG8_STAGE(PG8_SB(0, 0), cB, voffB); PG8_STAGE(PG8_SB(0, 1), cB + hstep, voffB); PG8_STAGE(PG8_SA(0, 0), cA, voffA); PG8_STAGE(PG8_SA(0, 1), cA + hstep, voffA);
        if (wr == 1) PG8_BAR;
        PG8_WAIT_V(2); PG8_BAR;
        PG8_STAGE(PG8_SB(1, 0), cB + kstep, voffB); PG8_STAGE(PG8_SA(1, 0), cA + kstep, voffA); PG8_STAGE(PG8_SB(1, 1), cB + hstep + kstep, voffB);
        PG8_WAIT_V(6); PG8_BAR;
    } else {
        PG8_STAGE(PG8_SB(0, 0), cB, voffB); PG8_STAGE(PG8_SA(0, 0), cA, voffA); PG8_STAGE(PG8_SB(0, 1), cB + hstep, voffB); PG8_STAGE(PG8_SA(0, 1), cA + hstep, voffA);
        if (wr == 1) PG8_BAR;
        PG8_WAIT_V(4); PG8_BAR;
        PG8_STAGE(PG8_SB(1, 0), cB + kstep, voffB); PG8_STAGE(PG8_SA(1, 0), cA + kstep, voffA); PG8_STAGE(PG8_SB(1, 1), cB + hstep + kstep, voffB);
        PG8_WAIT_V(6); PG8_BAR;
    }
    for (;;) {
        const bool has_next = S.next(ui + 1, nxt);
        const char* nA = has_next ? (const char*)g.A + (size_t)nxt.pm * tstep : cA; const char* nB = has_next ? (const char*)g.Bt + (size_t)nxt.pn * tstep : cB;
        for (int t = 0; t < nt; t += 2) {
            const bool last = (t == nt - 2);
            const char* a1 = cA + (size_t)(t + 1) * kstep;
            const char* a2 = last ? nA : cA + (size_t)(t + 2) * kstep; const char* b2 = last ? nB : cB + (size_t)(t + 2) * kstep;
            const char* a3 = a2 + kstep; const char* b3 = b2 + kstep;
            if (last && has_next) S.a_ready(nxt);
            if constexpr (SP2) {
            PG8_LDB(B0, 0, 0); PG8_LDB(B1, 0, 1); PG8_SCHED; PG8_LDA(At, 0, 0); PG8_STAGE(PG8_SA(1, 1), a1 + hstep, voffA);
            PG8_WAIT_V(8); PG8_WAIT_L(0); PG8_BAR; PG8_MMA(0, 0, At, B0); PG8_MMA(0, 1, At, B1); PG8_BAR; PG8_SCHED;
            PG8_LDA(At, 0, 1); PG8_STAGE(PG8_SB(0, 0), b2, voffB); PG8_STAGE(PG8_SB(0, 1), b2 + hstep, voffB); PG8_STAGE(PG8_SA(0, 0), a2, voffA);
            PG8_WAIT_V(8); PG8_WAIT_L(0); PG8_BAR; PG8_MMA(1, 0, At, B0); PG8_MMA(1, 1, At, B1); PG8_BAR; PG8_SCHED;
            PG8_LDB(B0, 1, 0); PG8_LDB(B1, 1, 1); PG8_SCHED; PG8_LDA(At, 1, 0); PG8_STAGE(PG8_SA(0, 1), a2 + hstep, voffA);
            PG8_WAIT_V(8); PG8_WAIT_L(0); PG8_BAR; PG8_MMA(0, 0, At, B0); PG8_MMA(0, 1, At, B1); PG8_BAR; PG8_SCHED;
            PG8_LDA(At, 1, 1); PG8_STAGE(PG8_SB(1, 0), b3, voffB); PG8_STAGE(PG8_SB(1, 1), b3 + hstep, voffB); PG8_STAGE(PG8_SA(1, 0), a3, voffA);
            PG8_WAIT_V(8); PG8_WAIT_L(0); PG8_BAR; PG8_MMA(1, 0, At, B0); PG8_MMA(1, 1, At, B1); PG8_BAR; PG8_SCHED;
            } else {
            PG8_LDB(B0, 0, 0); PG8_SCHED; PG8_LDA(At, 0, 0); PG8_STAGE(PG8_SA(1, 1), a1 + hstep, voffA);
            PG8_WAIT_L(8); PG8_BAR; PG8_WAIT_L(0); PG8_MMA(0, 0, At, B0); PG8_BAR; PG8_SCHED;
            PG8_LDB(B1, 0, 1); PG8_STAGE(PG8_SB(0, 0), b2, voffB);
            PG8_BAR; PG8_WAIT_L(0); PG8_MMA(0, 1, At, B1); PG8_BAR;
            PG8_LDA(At, 0, 1); PG8_STAGE(PG8_SA(0, 0), a2, voffA);
            PG8_BAR; PG8_WAIT_L(0); PG8_MMA(1, 0, At, B0); PG8_BAR; PG8_SCHED;
            PG8_STAGE(PG8_SB(0, 1), b2 + hstep, voffB);
            PG8_WAIT_V(6); PG8_BAR; PG8_MMA(1, 1, At, B1); PG8_BAR;
            PG8_LDB(B0, 1, 0); PG8_SCHED; PG8_LDA(At, 1, 0); PG8_STAGE(PG8_SA(0, 1), a2 + hstep, voffA);
            PG8_WAIT_L(8); PG8_BAR; PG8_WAIT_L(0); PG8_MMA(0, 0, At, B0); PG8_BAR; PG8_SCHED;
            PG8_LDB(B1, 1, 1); PG8_STAGE(PG8_SB(1, 0), b3, voffB);
            PG8_BAR; PG8_WAIT_L(0); PG8_MMA(0, 1, At, B1); PG8_BAR;
            PG8_LDA(At, 1, 1); PG8_STAGE(PG8_SA(1, 0), a3, voffA);
            PG8_BAR; PG8_WAIT_L(0); PG8_MMA(1, 0, At, B0); PG8_BAR; PG8_SCHED;
            PG8_STAGE(PG8_SB(1, 1), b3 + hstep, voffB);
            PG8_WAIT_V(6); PG8_BAR; PG8_MMA(1, 1, At, B1); PG8_BAR;
            }
        }
        if constexpr (ALIGN_EPI) { if (wr == 0) PG8_BAR; }
        if constexpr (!Epi::AFTER_DRAIN) { E(acc, cur, wr, wc, fr, fq); S.done(cur); }
        if (!has_next) break;
#pragma unroll
        for (int a = 0; a < 2; ++a)
#pragma unroll
            for (int b = 0; b < 2; ++b)
#pragma unroll
                for (int m = 0; m < 4; ++m)
#pragma unroll
                    for (int n = 0; n < 2; ++n) acc[a][b][m][n] = (f32x4){0.f, 0.f, 0.f, 0.f};
        cur = nxt; cA = nA; cB = nB; ++ui;
        if constexpr (ALIGN_EPI) { if (wr == 1) PG8_BAR; }
    }
    PG8_WAIT_V(0);
    if constexpr (!ALIGN_EPI) { if (wr == 0) PG8_BAR; }
    PG8_BAR;
    if constexpr (Epi::AFTER_DRAIN) { E.fused(acc, cur, wr, wc, fr, fq, lds, wid, lane); S.done(cur); }
#undef PG8_SA
#undef PG8_SB
#undef PG8_STAGE
#undef PG8_LDA
#undef PG8_LDB
#undef PG8_MMA
#undef PG8_WAIT_V
#undef PG8_WAIT_L
#undef PG8_BAR
#undef PG8_SCHED
}
}

constexpr int NB = 8, SEQ = 4096, DM = 1024, NL = 2, FF = 4096, NPROJ = 2724, NPROJ_PAD = 2816, NTILE_PROJ = 11;
constexpr int TOK = NB * SEQ;
static_assert(TOK == pg8::TT, "token count");
constexpr float NORM_EPS = 1e-6f;
constexpr float LOG2E = 1.4426950408889634f;
constexpr int NWAVES = 8;

constexpr size_t MiB = 1u << 20;
constexpr size_t WS_CTL = 0, CTL_ZERO_BYTES = 1 * MiB;
constexpr size_t WS_MOD = 1 * MiB;
constexpr size_t WS_KMEAN = WS_MOD + 512 * 1024;
constexpr size_t WS_W = 2 * MiB;
constexpr size_t W_IN = 0, W_GATE = W_IN + (size_t)NPROJ_PAD * DM, W_BR = W_GATE + (size_t)4 * DM * DM, W_OUT = W_BR + (size_t)4 * DM * 256,
                 W_FF1 = W_OUT + (size_t)DM * DM, W_FF2 = W_FF1 + (size_t)FF * DM, W_LAYER = W_FF2 + (size_t)DM * FF;
constexpr size_t WS_MASK = 70 * MiB;
constexpr size_t WS_H = 86 * MiB;
constexpr size_t WS_Y = 150 * MiB;
constexpr size_t WS_R = 214 * MiB;
constexpr size_t WS_END = 470 * MiB;
static_assert(WS_W + 2 * W_LAYER * 2 <= WS_MASK, "weights fit");
constexpr int CW_BAR = 4096;
constexpr int CW_WQ = 131072;
constexpr int CW_NRM = CW_WQ + 4096;
constexpr int NPHASE = 22;

constexpr int RING_BYTES = 135168;
constexpr int LDSCTL_OFF = RING_BYTES;
constexpr int LDS_BYTES = 147456;

#define GAS __attribute__((address_space(1)))
#define LAS __attribute__((address_space(3)))
typedef unsigned short bf16;
typedef unsigned v4u __attribute__((ext_vector_type(4)));
typedef unsigned v2u __attribute__((ext_vector_type(2)));
typedef float f32x4 __attribute__((ext_vector_type(4)));
typedef float f32x16 __attribute__((ext_vector_type(16)));
typedef short bf16x8 __attribute__((ext_vector_type(8)));
typedef short s16x4 __attribute__((ext_vector_type(4)));
typedef GAS unsigned gu32;
#define RLX_AGENT __ATOMIC_RELAXED, __HIP_MEMORY_SCOPE_AGENT
#define LDS_WAIT() asm volatile("s_waitcnt lgkmcnt(0)" ::: "memory")
__device__ __forceinline__ unsigned f2bf(float f) { unsigned u = __builtin_bit_cast(unsigned, f); return (u + 0x7fffu + ((u >> 16) & 1u)) >> 16; }
__device__ __forceinline__ unsigned pk2(float lo, float hi) { return f2bf(lo) | (f2bf(hi) << 16); }
__device__ __forceinline__ float bf2f(unsigned short b) { return __uint_as_float((unsigned)b << 16); }
__device__ __forceinline__ float bflo(unsigned w) { return __uint_as_float(w << 16); }
__device__ __forceinline__ float bfhi(unsigned w) { return __uint_as_float(w & 0xffff0000u); }

#define XB_TMO      128
#define XB_XCNT(j)  (256  + 64 * (j))
#define XB_XSUB(j)  (1280 + 64 * (j))
#define XB_XGEN(j)  (2304 + 64 * (j))
#define XB_TOP      3328
#define XB_TOPGEN   3392
#define XCD_BAR_WORDS 3456
#define XB_SPIN_CAP (1u << 18)

__device__ __forceinline__ unsigned xb_ld(unsigned* p)              { return __hip_atomic_load(p, __ATOMIC_RELAXED, __HIP_MEMORY_SCOPE_AGENT); }
__device__ __forceinline__ unsigned xb_add(unsigned* p, unsigned v) { return __hip_atomic_fetch_add(p, v, __ATOMIC_RELAXED, __HIP_MEMORY_SCOPE_AGENT); }
__device__ __forceinline__ unsigned xb_xcc_id() { return (unsigned)__builtin_amdgcn_s_getreg((3 << 11) | 20) & 0xFu; }
#define XB_SPIN(cond, bar) do { unsigned _sp = 0; while (cond) { __builtin_amdgcn_s_sleep(1); \
    if ((++_sp & 255u) == 0u) { if (xb_ld(&(bar)[XB_TMO])) break; if (_sp > XB_SPIN_CAP) { atomicAdd(&(bar)[XB_TMO], 1u); break; } } } } while (0)

struct XcdBarrier {
    unsigned* bar; unsigned x;
    volatile LAS unsigned* st;
};

__device__ __forceinline__ XcdBarrier xcd_barrier_post(unsigned* bar, volatile LAS unsigned* st) {
    XcdBarrier b; b.bar = bar; b.x = xb_xcc_id(); b.st = st;
    if (threadIdx.x == 0) (void)xb_add(&bar[XB_XCNT(b.x)], 1u);
    return b;
}
__device__ __forceinline__ void xcd_barrier_complete(unsigned* bar, unsigned x, unsigned& nloc, unsigned& nx) {
    const unsigned G = gridDim.x * gridDim.y * gridDim.z;
    unsigned sum, cnt, mine, sp = 0u;
    for (;;) {
        sum = 0u; cnt = 0u; mine = 0u;
#pragma unroll
        for (unsigned j = 0; j < 16; ++j) { const unsigned c = xb_ld(&bar[XB_XCNT(j)]); sum += c; cnt += (c > 0u) ? 1u : 0u; mine = (j == x) ? c : mine; }
        if (sum == G) break;
        __builtin_amdgcn_s_sleep(1);
        if ((++sp & 255u) == 0u) { if (xb_ld(&bar[XB_TMO])) break; if (sp > XB_SPIN_CAP) { atomicAdd(&bar[XB_TMO], 1u); break; } }
    }
    nloc = mine > 0u ? mine : 1u; nx = cnt > 0u ? cnt : 1u;
}

__device__ __forceinline__ void xcd_barrier(const XcdBarrier& b) {
    asm volatile("s_waitcnt vmcnt(0)" ::: "memory");
    __syncthreads();
    if (threadIdx.x == 0) {
        unsigned* bar = b.bar;
        __builtin_amdgcn_s_waitcnt(0);
        unsigned nloc = b.st[0], nx = b.st[1];
        if (nloc == 0u) { xcd_barrier_complete(bar, b.x, nloc, nx); b.st[0] = nloc; b.st[1] = nx; }
        const unsigned old = xb_add(&bar[XB_XSUB(b.x)], 1u);
        const unsigned gen = old / nloc;
        if (old + 1u == (gen + 1u) * nloc) {
            __builtin_amdgcn_fence(__ATOMIC_RELEASE, "agent");
            asm volatile("s_waitcnt vmcnt(0)" ::: "memory");
            const unsigned og = xb_add(&bar[XB_TOP], 1u);
            const unsigned tg = og / nx;
            if (og + 1u == (tg + 1u) * nx) xb_add(&bar[XB_TOPGEN], 1u);
            else XB_SPIN(xb_ld(&bar[XB_TOPGEN]) == tg, bar);
            __builtin_amdgcn_fence(__ATOMIC_ACQUIRE, "agent");
            xb_add(&bar[XB_XGEN(b.x)], 1u);
            asm volatile("s_waitcnt vmcnt(0)" ::: "memory");
        } else {
            XB_SPIN(xb_ld(&bar[XB_XGEN(b.x)]) == gen, bar);
            __builtin_amdgcn_fence(__ATOMIC_ACQUIRE, "agent");
            asm volatile("s_waitcnt vmcnt(0)" ::: "memory");
        }
    }
    __syncthreads();
}

struct Args {
    const float *x, *c, *w_ada, *b_ada, *norm1_g, *w_in, *diff_lambda, *diff_subln_g, *w_pool, *pool_scale, *w_gate, *b_gate, *w_branch, *w_out, *norm2_g, *w_ff1, *w_ff2, *final_g;
    float* out; unsigned char* ws; int ph_lo, ph_hi, li, pad;
};

__device__ __forceinline__ float shx(float v, int mask, int lane) { return __int_as_float(__builtin_amdgcn_ds_bpermute((lane ^ mask) << 2, __float_as_int(v))); }
__device__ __forceinline__ unsigned shxu(unsigned v, int mask, int lane) { return (unsigned)__builtin_amdgcn_ds_bpermute((lane ^ mask) << 2, (int)v); }
__device__ __forceinline__ unsigned shupu(unsigned v, int delta, int lane) { return (unsigned)__builtin_amdgcn_ds_bpermute(((lane - delta) & 63) << 2, (int)v); }
__device__ __forceinline__ float wave_sum(float v, int lane) {
#pragma unroll
    for (int o = 1; o < 64; o <<= 1) v += shx(v, o, lane);
    return v;
}
__device__ __forceinline__ int crow(int r, int hi) { return (r & 3) + 8 * (r >> 2) + 4 * hi; }
typedef float f32x2_t __attribute__((ext_vector_type(2))); typedef __bf16 bf16x2_t __attribute__((ext_vector_type(2)));
__device__ __forceinline__ unsigned cvtpk(float lo, float hi) { f32x2_t v = {lo, hi}; bf16x2_t b = __builtin_convertvector(v, bf16x2_t); return __builtin_bit_cast(unsigned, b); }

__device__ __forceinline__ int gate_row(int br, int c) { const int pn = c >> 6, ml = c & 63; return 256 * pn + 128 * (br >> 1) + 32 * (ml >> 4) + 8 * ((ml >> 2) & 3) + 4 * (br & 1) + (ml & 3); }
__device__ __forceinline__ void p0_transpose_item(const float* W, int K, int Nsrc, int Npad, bf16* WT, int mode, int br, LAS float* scr, int item, int lane) {
    const int nblk = Npad / 32, kb = item / nblk, nb = item % nblk, k0 = 64 * kb, n0 = 32 * nb;
    const int c4 = lane & 7, kr = lane >> 3, nn = n0 + 4 * c4;
    f32x4 v[8];
#pragma unroll
    for (int i = 0; i < 8; ++i) v[i] = (nn < Nsrc) ? *(const f32x4*)(W + (size_t)(k0 + 8 * i + kr) * Nsrc + nn) : (f32x4){0.f, 0.f, 0.f, 0.f};
#pragma unroll
    for (int i = 0; i < 8; ++i) { LAS float* d = scr + (8 * i + kr) * 33 + 4 * c4; d[0] = v[i][0]; d[1] = v[i][1]; d[2] = v[i][2]; d[3] = v[i][3]; }
    LDS_WAIT(); asm volatile("" ::: "memory");
    const int c = lane & 7;
#pragma unroll
    for (int j = 0; j < 4; ++j) { const int n = (lane >> 3) + 8 * j; const LAS float* s = scr + (8 * c) * 33 + n;
        v4u o; o.x = pk2(s[0 * 33], s[1 * 33]); o.y = pk2(s[2 * 33], s[3 * 33]); o.z = pk2(s[4 * 33], s[5 * 33]); o.w = pk2(s[6 * 33], s[7 * 33]);
        const int drow = (mode == 1) ? gate_row(br, n0 + n) : (n0 + n);
        *(v4u*)(WT + (size_t)drow * K + k0 + 8 * c) = o; }
    LDS_WAIT(); asm volatile("" ::: "memory");
}

template <bool XBF16>
__device__ __forceinline__ void norm_rows_bf16(const void* X, bf16* O, const float* g, const float* mod  , int sh_idx, int sc_idx, int gw, int ngw, int lane_in) {
    int lane = lane_in; asm volatile("" : "+v"(lane));
    for (int m = gw; m < TOK; m += ngw) {
        const int b = m >> 12;
        float v[16]; float s = 0.f;
        if (XBF16) { const v4u* xr = (const v4u*)((const bf16*)X + (size_t)m * DM) + 2 * lane; const v4u a = xr[0], c = xr[1];
            v[0] = bflo(a.x); v[1] = bfhi(a.x); v[2] = bflo(a.y); v[3] = bfhi(a.y); v[4] = bflo(a.z); v[5] = bfhi(a.z); v[6] = bflo(a.w); v[7] = bfhi(a.w);
            v[8] = bflo(c.x); v[9] = bfhi(c.x); v[10] = bflo(c.y); v[11] = bfhi(c.y); v[12] = bflo(c.z); v[13] = bfhi(c.z); v[14] = bflo(c.w); v[15] = bfhi(c.w); }
        else { const f32x4* xr = (const f32x4*)((const float*)X + (size_t)m * DM) + 4 * lane;
#pragma unroll
            for (int j = 0; j < 4; ++j) { const f32x4 t = xr[j]; v[4 * j] = t.x; v[4 * j + 1] = t.y; v[4 * j + 2] = t.z; v[4 * j + 3] = t.w; } }
#pragma unroll
        for (int e = 0; e < 16; ++e) s += v[e] * v[e];
        const float rstd = 1.f / sqrtf(wave_sum(s, lane) * (1.f / DM) + NORM_EPS);
        const f32x4* gp = (const f32x4*)g + 4 * lane;
        const f32x4* shp = (const f32x4*)(mod + (size_t)b * 6144 + sh_idx * 1024) + 4 * lane;
        const f32x4* scp = (const f32x4*)(mod + (size_t)b * 6144 + sc_idx * 1024) + 4 * lane;
        float y[16];
#pragma unroll
        for (int j = 0; j < 4; ++j) { const f32x4 gg = gp[j], sh = shp[j], sc = scp[j];
#pragma unroll
            for (int e = 0; e < 4; ++e) y[4 * j + e] = v[4 * j + e] * rstd * gg[e] * (1.f + sc[e]) + sh[e]; }
        v4u o0, o1;
        o0.x = pk2(y[0], y[1]); o0.y = pk2(y[2], y[3]); o0.z = pk2(y[4], y[5]); o0.w = pk2(y[6], y[7]);
        o1.x = pk2(y[8], y[9]); o1.y = pk2(y[10], y[11]); o1.z = pk2(y[12], y[13]); o1.w = pk2(y[14], y[15]);
        v4u* op = (v4u*)(O + (size_t)m * DM) + 2 * lane; op[0] = o0; op[1] = o1;
    }
}

#ifndef ATT_PD
#define ATT_PD 2
#endif
constexpr int AT_K0 = 0, AT_KSLOT = 9216, AT_V0 = 18432, AT_VSLOT = 12288, AT_SEL = 43008, AT_KM = 44032, AT_END = 47872;
__device__ __forceinline__ s16x4 vtr(LAS const unsigned char* p) { return __builtin_bit_cast(s16x4, __builtin_amdgcn_ds_read_tr16_b64_v4i16((LAS s16x4*)p)); }

#define TRRD(dst, addr, off) asm volatile("ds_read_b64_tr_b16 %0, %1 offset:%2" : "=v"(dst) : "v"(addr), "i"(off) : "memory")
#define SBAR0() __builtin_amdgcn_sched_barrier(0)
__device__ __forceinline__ void softmax_pv(f32x16& s0, f32x16& s1, float& l, f32x16 (&o)[2], LAS const unsigned char* vbase  ) {
    const unsigned va = (unsigned)(uintptr_t)vbase;
    s16x4 vl[2][2][2], vh[2][2][2];
#pragma unroll
    for (int sub = 0; sub < 2; ++sub)
#pragma unroll
        for (int db = 0; db < 2; ++db)
#pragma unroll
            for (int s2 = 0; s2 < 2; ++s2) { TRRD(vl[db][sub][s2], va, (32 * sub + 16 * s2) * 192 + db * 64); TRRD(vh[db][sub][s2], va, (32 * sub + 16 * s2 + 8) * 192 + db * 64); }
    float la = l;
#pragma unroll
    for (int r = 0; r < 16; ++r) { s0[r] = __builtin_amdgcn_exp2f(s0[r]); la += s0[r]; }
    bf16x8 pf[2][2];
#pragma unroll
    for (int s2 = 0; s2 < 2; ++s2) { v4u a;
        a.x = cvtpk(s0[8 * s2 + 0], s0[8 * s2 + 1]); a.y = cvtpk(s0[8 * s2 + 2], s0[8 * s2 + 3]); a.z = cvtpk(s0[8 * s2 + 4], s0[8 * s2 + 5]); a.w = cvtpk(s0[8 * s2 + 6], s0[8 * s2 + 7]);
        pf[0][s2] = __builtin_bit_cast(bf16x8, a); }
    asm volatile("s_waitcnt lgkmcnt(0)" : "+v"(vl[0][0][0]), "+v"(vl[0][0][1]), "+v"(vl[0][1][0]), "+v"(vl[0][1][1]), "+v"(vl[1][0][0]), "+v"(vl[1][0][1]), "+v"(vl[1][1][0]), "+v"(vl[1][1][1]),
                                          "+v"(vh[0][0][0]), "+v"(vh[0][0][1]), "+v"(vh[0][1][0]), "+v"(vh[0][1][1]), "+v"(vh[1][0][0]), "+v"(vh[1][0][1]), "+v"(vh[1][1][0]), "+v"(vh[1][1][1]) :: "memory");
    SBAR0();
#pragma unroll
    for (int g = 0; g < 4; ++g) { const int db = g >> 1, s2 = g & 1;
        const s16x4 lo = vl[db][0][s2], hh = vh[db][0][s2];
        const bf16x8 vf = (bf16x8){lo[0], lo[1], lo[2], lo[3], hh[0], hh[1], hh[2], hh[3]};
        o[db] = __builtin_amdgcn_mfma_f32_32x32x16_bf16(vf, pf[0][s2], o[db], 0, 0, 0);
#pragma unroll
        for (int r = 4 * g; r < 4 * g + 4; ++r) { s1[r] = __builtin_amdgcn_exp2f(s1[r]); la += s1[r]; }
        SBAR0(); }
    l = la;
#pragma unroll
    for (int s2 = 0; s2 < 2; ++s2) { v4u c;
        c.x = cvtpk(s1[8 * s2 + 0], s1[8 * s2 + 1]); c.y = cvtpk(s1[8 * s2 + 2], s1[8 * s2 + 3]); c.z = cvtpk(s1[8 * s2 + 4], s1[8 * s2 + 5]); c.w = cvtpk(s1[8 * s2 + 6], s1[8 * s2 + 7]);
        pf[1][s2] = __builtin_bit_cast(bf16x8, c); }
#pragma unroll
    for (int g = 0; g < 4; ++g) { const int db = g >> 1, s2 = g & 1;
        const s16x4 lo = vl[db][1][s2], hh = vh[db][1][s2];
        const bf16x8 vf = (bf16x8){lo[0], lo[1], lo[2], lo[3], hh[0], hh[1], hh[2], hh[3]};
        o[db] = __builtin_amdgcn_mfma_f32_32x32x16_bf16(vf, pf[1][s2], o[db], 0, 0, 0); }
}
__device__ __forceinline__ void split3(float x, unsigned& h, unsigned& m, unsigned& l) {
    h = f2bf(x); const float r1 = x - __uint_as_float(h << 16); m = f2bf(r1); const float r2 = r1 - __uint_as_float(m << 16); l = f2bf(r2);
}

template <int MODE>
__device__ __forceinline__ void attn_unit(LAS unsigned char* lds, int b, int h, int qb, const bf16* Qb, const bf16* Kb, const bf16* Vb, bf16* Ob, float slope,
                                          const float* kmean, float lam, float post_scale, const float* subg, const unsigned* maskw, const unsigned* nrm  ,
                                          const int* refposg, const int* refming) {
    int tid_l = threadIdx.x; asm volatile("" : "+v"(tid_l)); const int tid = tid_l, lane = tid & 63, wid = __builtin_amdgcn_readfirstlane(tid >> 6), r32 = lane & 31, hi = lane >> 5;
    const int q = qb * 256 + wid * 32 + r32;
    const size_t rowg = (size_t)b * SEQ;
    const float c2 = slope * LOG2E;
    unsigned sel = 0u;
    bf16x8 qf[4];
#pragma unroll
    for (int ds = 0; ds < 4; ++ds) qf[ds] = *(const bf16x8*)(Qb + (rowg + q) * 256 + h * 64 + ds * 16 + hi * 8);
    const int skey = tid >> 3, sch = tid & 7;
    const bf16* ksrc = Kb + (rowg + skey) * 256 + h * 64 + sch * 8;
    const bf16* vsrc = Vb + (rowg + skey) * 256 + h * 64 + sch * 8;
    const int kdst = AT_K0 + skey * 144 + sch * 16, vdst = AT_V0 + skey * 192 + sch * 16;
    const int NT = 4 * qb + 4;
    const float Bq = __uint_as_float(nrm[b * 4 + h]), Bk = __uint_as_float(nrm[32 + b * 4 + h]);
#if defined(PROBE_NOSKIP)
    const float Dskip = 1e9f + 0.f * (Bq + Bk);
#else
    const float Dskip = (150.f + 2.f * sqrtf(Bq * Bk)) / c2;
#endif
    const int koff = r32 * 144 + hi * 16;
    const int vtoff = (4 * hi + ((lane & 15) >> 2)) * 192 + (16 * ((lane >> 4) & 1) + 4 * (lane & 3)) * 2;
    float l1 = 0.f, l2 = 0.f;
    f32x16 oA[2], oB[2];
#pragma unroll
    for (int r = 0; r < 16; ++r) { oA[0][r] = 0.f; oA[1][r] = 0.f; oB[0][r] = 0.f; oB[1][r] = 0.f; }
    const int qmin = qb * 256 + wid * 32, qmax = qmin + 31;
    constexpr int PD = ATT_PD;
    v4u kR[PD], vR[PD]; v2u mR[PD];
    int refpos = q;
    int minref = qb * 256;
    if (MODE == 2) { refpos = refposg[rowg + q]; minref = refming[b * 128 + 8 * qb];
#pragma unroll
        for (int i = 1; i < 8; ++i) { const int v = refming[b * 128 + 8 * qb + i]; minref = v < minref ? v : minref; } }
    int T0 = (int)floorf(((float)minref - Dskip) * (1.f / 64.f)); T0 = T0 < 0 ? 0 : T0; T0 = __builtin_amdgcn_readfirstlane(T0);
    const v4u k0r = *(const v4u*)(ksrc + (size_t)T0 * 64 * 256), v0r = *(const v4u*)(vsrc + (size_t)T0 * 64 * 256);
#pragma unroll
    for (int i = 0; i < PD; ++i) { kR[i] = (v4u){0u, 0u, 0u, 0u}; vR[i] = kR[i]; mR[i] = (v2u){0u, 0u};
        if (T0 + i + 1 < NT) { kR[i] = *(const v4u*)(ksrc + (size_t)(T0 + i + 1) * 64 * 256); vR[i] = *(const v4u*)(vsrc + (size_t)(T0 + i + 1) * 64 * 256);
            if (MODE == 2) mR[i] = *(const v2u*)(maskw + (rowg + q) * 128 + 2 * (T0 + i + 1)); } }
    v2u mw = (v2u){0u, 0u};
    if (MODE == 2) mw = *(const v2u*)(maskw + (rowg + q) * 128 + 2 * T0);
    if (MODE == 0) {
        LAS float* KM = (LAS float*)(lds + AT_KM); LAS unsigned* SEL = (LAS unsigned*)(lds + AT_SEL);
        for (int i = tid; i < qb * 64; i += 512) KM[i] = kmean[(size_t)((b * 4 + h) * 16) * 64 + i];
        __syncthreads();
        if (tid < 256) {
            const bf16* qrow = Qb + (rowg + qb * 256 + tid) * 256 + h * 64;
            float qv[64];
#pragma unroll
            for (int c = 0; c < 8; ++c) { const v4u w = *(const v4u*)(qrow + 8 * c);
                qv[8 * c + 0] = bflo(w.x); qv[8 * c + 1] = bfhi(w.x); qv[8 * c + 2] = bflo(w.y); qv[8 * c + 3] = bfhi(w.y);
                qv[8 * c + 4] = bflo(w.z); qv[8 * c + 5] = bfhi(w.z); qv[8 * c + 6] = bflo(w.w); qv[8 * c + 7] = bfhi(w.w); }
            float v1 = -INFINITY, v2 = -INFINITY, v3 = -INFINITY; int i1 = -1, i2 = -1, i3 = -1;
            for (int n = 0; n < qb; ++n) {
                float g = 0.f;
#pragma unroll
                for (int d = 0; d < 64; ++d) g = __builtin_fmaf(qv[d], KM[n * 64 + d], g);
                if (g > v1) { v3 = v2; i3 = i2; v2 = v1; i2 = i1; v1 = g; i1 = n; }
                else if (g > v2) { v3 = v2; i3 = i2; v2 = g; i2 = n; }
                else if (g > v3) { v3 = g; i3 = n; }
            }
            unsigned sm = 0u; if (i1 >= 0) sm |= 1u << i1; if (i2 >= 0) sm |= 1u << i2; if (i3 >= 0) sm |= 1u << i3;
            SEL[tid] = sm;
        }
        __syncthreads();
        sel = SEL[wid * 32 + r32];
    }
    *(LAS v4u*)(lds + kdst + (T0 & 1) * AT_KSLOT) = k0r; *(LAS v4u*)(lds + vdst + (T0 & 1) * AT_VSLOT) = v0r;
    bf16x8 qaug; v4u ka0, ka1;
    { unsigned a, b2, c; split3(-c2 * (float)refpos, a, b2, c);
      v4u w; if (hi == 0) { w.x = a | (b2 << 16); w.y = c | (0x3f80u << 16); w.z = 0x3f80u | (0x3f80u << 16); w.w = 0u; }
             else { w.x = 0x3f80u | (0x3f80u << 16); w.y = 0x3f80u; w.z = 0u; w.w = 0u; }
      qaug = __builtin_bit_cast(bf16x8, w);
      split3(c2 * (float)r32, a, b2, c); ka0.x = 0x3f80u | (0x3f80u << 16); ka0.y = 0x3f80u | (a << 16); ka0.z = b2 | (c << 16); ka0.w = 0u;
      split3(c2 * (float)(r32 + 32), a, b2, c); ka1.x = ka0.x; ka1.y = 0x3f80u | (a << 16); ka1.z = b2 | (c << 16); ka1.w = 0u; }
    __syncthreads();
#pragma nounroll
    for (int t0 = T0; t0 < NT; t0 += PD) {
#pragma unroll
      for (int u = 0; u < PD; ++u) { const int t = t0 + u; if (t < NT) {
        const int slot = t & 1;
        const int k0 = 64 * t;
        bool active = (k0 <= qmax);
        bool keep = true;
        if (MODE == 0) { const int n = t >> 2; if (n < qb) { keep = ((sel >> n) & 1u) != 0u; active = (__ballot(keep) != 0ull); } }
        if (active) {
            LAS const unsigned char* ks = lds + AT_K0 + slot * AT_KSLOT + koff;
            LAS const unsigned char* vb = lds + AT_V0 + slot * AT_VSLOT + vtoff;
            const int lim = q - k0 - 4 * hi;
            const bool needmask = (k0 + 63 > qmin);
            bf16x8 kaug0, kaug1;
            { unsigned a, b2, c; split3(c2 * (float)k0, a, b2, c);
              v4u w0 = ka0, w1 = ka1; if (hi) { w0.x = a | (b2 << 16); w0.y = c; w0.z = 0u; w1 = w0; }
              kaug0 = __builtin_bit_cast(bf16x8, w0); kaug1 = __builtin_bit_cast(bf16x8, w1); }
#pragma unroll
            for (int mp = 0; mp < (MODE == 1 ? 2 : 1); ++mp) {
                f32x16 s0, s1;
#pragma unroll
                for (int r = 0; r < 16; ++r) { s0[r] = 0.f; s1[r] = 0.f; }
                s0 = __builtin_amdgcn_mfma_f32_32x32x16_bf16(kaug0, qaug, s0, 0, 0, 0);
                s1 = __builtin_amdgcn_mfma_f32_32x32x16_bf16(kaug1, qaug, s1, 0, 0, 0);
#pragma unroll
                for (int dd = 0; dd < (MODE == 1 ? 2 : 4); ++dd) { const int ds = (MODE == 1) ? (2 * mp + dd) : dd;
                    const bf16x8 a0 = *(LAS const bf16x8*)(ks + ds * 32), a1 = *(LAS const bf16x8*)(ks + 32 * 144 + ds * 32);
                    s0 = __builtin_amdgcn_mfma_f32_32x32x16_bf16(a0, qf[ds], s0, 0, 0, 0);
                    s1 = __builtin_amdgcn_mfma_f32_32x32x16_bf16(a1, qf[ds], s1, 0, 0, 0); }
#if defined(PROBE_QK2X)
                { f32x16 d0, d1;
#pragma unroll
                  for (int r = 0; r < 16; ++r) { d0[r] = 0.f; d1[r] = 0.f; }
#pragma unroll
                  for (int dd = 0; dd < (MODE == 1 ? 2 : 4); ++dd) { const int ds = (MODE == 1) ? (2 * mp + dd) : dd;
                    const bf16x8 a0 = *(LAS const bf16x8*)(ks + ds * 32 + 16), a1 = *(LAS const bf16x8*)(ks + 32 * 144 + ds * 32 + 16);
                    d0 = __builtin_amdgcn_mfma_f32_32x32x16_bf16(a0, qf[ds], d0, 0, 0, 0);
                    d1 = __builtin_amdgcn_mfma_f32_32x32x16_bf16(a1, qf[ds], d1, 0, 0, 0); }
                  asm volatile("" :: "v"(d0), "v"(d1)); }
#endif
                if (MODE == 2) {
#pragma unroll
                    for (int r = 0; r < 16; ++r) { const int pos = (r & 3) + 8 * (r >> 2) + 4 * hi;
                        if (!((mw.x >> pos) & 1u)) s0[r] = -INFINITY; if (!((mw.y >> pos) & 1u)) s1[r] = -INFINITY; }
                } else {
                    if (MODE == 0 && !keep) {
#pragma unroll
                        for (int r = 0; r < 16; ++r) { s0[r] = -INFINITY; s1[r] = -INFINITY; }
                    }
                    if (needmask) {
#pragma unroll
                        for (int r = 0; r < 16; ++r) { const int ko = (r & 3) + 8 * (r >> 2);
                            if (ko > lim) s0[r] = -INFINITY; if (ko + 32 > lim) s1[r] = -INFINITY; }
                    }
                }
                if (mp == 0) softmax_pv(s0, s1, l1, oA, vb); else softmax_pv(s0, s1, l2, oB, vb);
            }
        }
        if (t + 1 < NT) { *(LAS v4u*)(lds + kdst + (slot ^ 1) * AT_KSLOT) = kR[u]; *(LAS v4u*)(lds + vdst + (slot ^ 1) * AT_VSLOT) = vR[u];
            if (MODE == 2) mw = mR[u];
            if (t + 1 + PD < NT) { kR[u] = *(const v4u*)(ksrc + (size_t)(t + 1 + PD) * 64 * 256); vR[u] = *(const v4u*)(vsrc + (size_t)(t + 1 + PD) * 64 * 256);
                if (MODE == 2) mR[u] = *(const v2u*)(maskw + (rowg + q) * 128 + 2 * (t + 1 + PD)); } }
        __syncthreads();
#if defined(PROBE_BAR2X)
        __syncthreads();
#endif
      } }
    }
    const float l1t = l1 + shx(l1, 32, lane);
    bf16* orow = Ob + (rowg + q) * 256 + h * 64 + 4 * hi;
    if (MODE == 1) {
        const float l2t = l2 + shx(l2, 32, lane);
        const float i1 = 1.f / l1t, i2 = lam / l2t;
        float ssq = 0.f;
#pragma unroll
        for (int db = 0; db < 2; ++db)
#pragma unroll
            for (int r = 0; r < 16; ++r) { const float v = oA[db][r] * i1 - oB[db][r] * i2; oA[db][r] = v; ssq += v * v; }
        ssq += shx(ssq, 32, lane);
        const float rn = post_scale / sqrtf(ssq * (1.f / 64.f) + NORM_EPS);
#pragma unroll
        for (int db = 0; db < 2; ++db)
#pragma unroll
            for (int g4 = 0; g4 < 4; ++g4) { const f32x4 gg = *(const f32x4*)(subg + 32 * db + 8 * g4 + 4 * hi);
                v2u w; w.x = cvtpk(oA[db][4 * g4 + 0] * rn * gg[0], oA[db][4 * g4 + 1] * rn * gg[1]); w.y = cvtpk(oA[db][4 * g4 + 2] * rn * gg[2], oA[db][4 * g4 + 3] * rn * gg[3]);
                *(v2u*)(orow + 32 * db + 8 * g4) = w; }
    } else {
        const float i1 = 1.f / l1t;
#pragma unroll
        for (int db = 0; db < 2; ++db)
#pragma unroll
            for (int g4 = 0; g4 < 4; ++g4) { v2u w; w.x = cvtpk(oA[db][4 * g4 + 0] * i1, oA[db][4 * g4 + 1] * i1); w.y = cvtpk(oA[db][4 * g4 + 2] * i1, oA[db][4 * g4 + 3] * i1);
                *(v2u*)(orow + 32 * db + 8 * g4) = w; }
    }
    __syncthreads();
}

constexpr int DS_HP = 1025;
constexpr int DS_HIST_BYTES = 32 * DS_HP * 4;
constexpr int DS_BP = 129;
constexpr int DS_G = 0, DS_C = 32 * DS_BP * 4, DS_AUX = DS_HIST_BYTES;
__device__ __forceinline__ float relu_asm(float x) { return __builtin_amdgcn_fmed3f(x, 0.f, __builtin_inff()); }
__device__ __forceinline__ void dsa_scores(const bf16x8 (&iqf)[4][2], const float (&w)[4], const bf16x8 k0, const bf16x8 k1, float (&sc)[16]) {
#pragma unroll
    for (int hh = 0; hh < 4; ++hh) {
        f32x16 x;
#pragma unroll
        for (int r = 0; r < 16; ++r) x[r] = 0.f;
        x = __builtin_amdgcn_mfma_f32_32x32x16_bf16(k0, iqf[hh][0], x, 0, 0, 0);
        x = __builtin_amdgcn_mfma_f32_32x32x16_bf16(k1, iqf[hh][1], x, 0, 0, 0);
#pragma unroll
        for (int r = 0; r < 16; ++r) sc[r] = (hh == 0) ? (w[0] * relu_asm(x[r])) : __builtin_fmaf(w[hh], relu_asm(x[r]), sc[r]);
    }
}
__device__ __forceinline__ unsigned dsa_mono(float s) { const unsigned bits = __float_as_uint(s); return bits ^ ((unsigned)((int)bits >> 31) | 0x80000000u); }
__device__ __forceinline__ unsigned dsa_ckey(float s, unsigned keyidx) { return (dsa_mono(s) & 0xFFFFF000u) | (4095u - keyidx); }
__device__ __forceinline__ unsigned take_low(unsigned w, unsigned n) {
    if (n >= (unsigned)__popc(w)) return w;
    unsigned res = 0u;
    while (n > 0u) { const unsigned low = w & (0u - w); res |= low; w ^= low; --n; }
    return res;
}
template <int PASS>
__device__ __forceinline__ void dsa_hist_pass(LAS unsigned* hist, const bf16x8 (&iqf)[4][2], const float (&w)[4], const bf16* kbase, int qg, int wid, int r32, int hi, int t, unsigned P1) {
    bf16x8 nk0 = *(const bf16x8*)(kbase + (size_t)wid * 32 * 256), nk1 = *(const bf16x8*)(kbase + (size_t)wid * 32 * 256 + 16);
    const unsigned rowb = (unsigned)(r32 * DS_HP * 4);
#if defined(D1_UNROLL2)
#pragma unroll 2
#else
#pragma nounroll
#endif
    for (int j = wid; j <= qg; j += 8) {
        const bf16x8 k0 = nk0, k1 = nk1;
        { const int jn = (j + 8 <= qg) ? j + 8 : j; const bf16* kp = kbase + (size_t)jn * 32 * 256; nk0 = *(const bf16x8*)kp; nk1 = *(const bf16x8*)(kp + 16); }
        float sc[16]; dsa_scores(iqf, w, k0, k1, sc);
        const int lim = t - 32 * j - 4 * hi;
        const bool diag = (j == qg);
#pragma unroll
        for (int r = 0; r < 16; ++r) {
            unsigned bin; bool ok = true;
            if (PASS == 0) { bin = dsa_mono(sc[r]) >> 21; }
            else { const unsigned ck = dsa_ckey(sc[r], 32u * (unsigned)j + (unsigned)((r & 3) + 8 * (r >> 2) + 4 * hi)); ok = (ck >> 21) == P1; bin = (ck >> 10) & 2047u; }
            unsigned addr = rowb + ((bin & 1023u) << 2);
            const unsigned inc = (bin & 1024u) ? 65536u : 1u;
            if (PASS == 0) { if (diag && ((r & 3) + 8 * (r >> 2) > lim)) addr = rowb + 4096u;
                __hip_atomic_fetch_add((LAS unsigned*)((LAS unsigned char*)hist + addr), inc, __ATOMIC_RELAXED, __HIP_MEMORY_SCOPE_WORKGROUP); }
            else { if (ok && !(diag && ((r & 3) + 8 * (r >> 2) > lim)))
                __hip_atomic_fetch_add((LAS unsigned*)((LAS unsigned char*)hist + addr), inc, __ATOMIC_RELAXED, __HIP_MEMORY_SCOPE_WORKGROUP); }
        }
    }
}
__device__ __forceinline__ void dsa_scan(LAS unsigned* hist, LAS unsigned* AUX, int pass, int wid, int lane) {
#pragma nounroll
    for (int qi = 0; qi < 4; ++qi) {
        const int qq = 4 * wid + qi;
        const unsigned K = (pass == 0) ? 256u : AUX[32 + qq];
        LAS const unsigned* hrow = hist + qq * DS_HP;
        const int wb = (2016 - 32 * lane) & 1023; const int sh = (lane < 32) ? 16 : 0;
        unsigned s = 0u;
#pragma unroll
        for (int i = 0; i < 32; ++i) { const unsigned wv = hrow[wb + ((i + lane) & 31)]; s += (wv >> sh) & 0xffffu; }
        unsigned incl = s;
#pragma unroll
        for (int o = 1; o < 64; o <<= 1) { const unsigned v = shupu(incl, o, lane); if (lane >= o) incl += v; }
        const unsigned long long bal = __ballot(incl >= K);
        const int L = __builtin_amdgcn_readfirstlane(bal ? (__ffsll((long long)bal) - 1) : 0);
        const unsigned above = (unsigned)__builtin_amdgcn_readlane((int)(incl - s), L);
        const int bin = 2047 - 32 * L - (lane & 31);
        const unsigned wv2 = hrow[bin & 1023]; const unsigned c = (lane < 32) ? ((bin & 1024) ? (wv2 >> 16) : (wv2 & 0xffffu)) : 0u;
        unsigned inc2 = c;
#pragma unroll
        for (int o = 1; o < 32; o <<= 1) { const unsigned v = shupu(inc2, o, lane); if (lane >= o) inc2 += v; }
        const unsigned long long bal2 = __ballot(lane < 32 && above + inc2 >= K);
        const int I = __builtin_amdgcn_readfirstlane(bal2 ? (__ffsll((long long)bal2) - 1) : 0);
        if (lane == I) { AUX[64 * pass + qq] = (unsigned)bin; AUX[64 * pass + 32 + qq] = K - (above + inc2 - c); }
    }
}
__device__ __forceinline__ void dsa_select_unit(LAS unsigned char* lds, int b, int qg, const bf16* IX, unsigned* MASK, int* REFPOS  , int* REFMIN  ) {
    int tid_l = threadIdx.x; asm volatile("" : "+v"(tid_l)); const int tid = tid_l, lane = tid & 63, wid = __builtin_amdgcn_readfirstlane(tid >> 6), r32 = lane & 31, hi = lane >> 5;
    const int t = 32 * qg + r32;
    const size_t rowg = (size_t)b * SEQ;
    const bf16* qrow = IX + (rowg + t) * 256;
    bf16x8 iqf[4][2];
#pragma unroll
    for (int hh = 0; hh < 4; ++hh)
#pragma unroll
        for (int ds = 0; ds < 2; ++ds) iqf[hh][ds] = *(const bf16x8*)(qrow + 32 * hh + 16 * ds + 8 * hi);
    float w[4];
    { const v2u ww = *(const v2u*)(qrow + 160); w[0] = bflo(ww.x); w[1] = bfhi(ww.x); w[2] = bflo(ww.y); w[3] = bfhi(ww.y); }
    LAS unsigned* hist = (LAS unsigned*)lds;
    LAS unsigned* AUX = (LAS unsigned*)(lds + DS_AUX);
    const bf16* kbase = IX + (rowg + r32) * 256 + 128 + 8 * hi;
    unsigned P = 0u;
    const bool all = (qg < 8);
    if (!all) {
        for (int i = tid; i < DS_HIST_BYTES / 16; i += 512) ((LAS v4u*)lds)[i] = (v4u){0u, 0u, 0u, 0u};
        __syncthreads();
        dsa_hist_pass<0>(hist, iqf, w, kbase, qg, wid, r32, hi, t, 0u);
        __syncthreads();
        dsa_scan(hist, AUX, 0, wid, lane);
        __syncthreads();
        const unsigned P1 = AUX[r32];
        for (int i = tid; i < DS_HIST_BYTES / 16; i += 512) ((LAS v4u*)lds)[i] = (v4u){0u, 0u, 0u, 0u};
        __syncthreads();
        dsa_hist_pass<1>(hist, iqf, w, kbase, qg, wid, r32, hi, t, P1);
        __syncthreads();
        dsa_scan(hist, AUX, 1, wid, lane);
        __syncthreads();
        P = (P1 << 11) | AUX[64 + r32];
    }
    if (all) { if (tid < 32) { AUX[64 + 32 + tid] = 0u; } }
    for (int i = tid; i < (2 * 32 * DS_BP * 4) / 16; i += 512) ((LAS v4u*)lds)[i] = (v4u){0u, 0u, 0u, 0u};
    __syncthreads();
    LAS unsigned* G = (LAS unsigned*)(lds + DS_G);
    LAS unsigned* C = (LAS unsigned*)(lds + DS_C);
    bf16x8 nk0, nk1;
    { const int j0 = (wid <= qg) ? wid : 0; nk0 = *(const bf16x8*)(kbase + (size_t)j0 * 32 * 256); nk1 = *(const bf16x8*)(kbase + (size_t)j0 * 32 * 256 + 16); }
#pragma nounroll
    for (int j = wid; j <= qg; j += 8) {
        const bf16x8 k0 = nk0, k1 = nk1;
        { const int jn = (j + 8 <= qg) ? j + 8 : j; const bf16* kp = kbase + (size_t)jn * 32 * 256; nk0 = *(const bf16x8*)kp; nk1 = *(const bf16x8*)(kp + 16); }
        float sc[16]; dsa_scores(iqf, w, k0, k1, sc);
        unsigned bg = 0u, bc = 0u;
        const int lim = t - 32 * j - 4 * hi;
#pragma unroll
        for (int r = 0; r < 16; ++r) {
            const int pos = (r & 3) + 8 * (r >> 2) + 4 * hi;
            const unsigned p22 = dsa_ckey(sc[r], 32u * (unsigned)j + (unsigned)pos) >> 10;
            const bool ok = ((r & 3) + 8 * (r >> 2)) <= lim;
            if (ok && p22 > P) bg |= 1u << pos;
            if (ok && p22 == P) bc |= 1u << pos;
        }
        bg |= shxu(bg, 32, lane); bc |= shxu(bc, 32, lane);
        if (hi == 0) { G[r32 * DS_BP + j] = bg; C[r32 * DS_BP + j] = bc; }
    }
    __syncthreads();
#pragma nounroll
    for (int qi = 0; qi < 4; ++qi) {
        const int qq = 4 * wid + qi;
        const unsigned K2 = AUX[64 + 32 + qq];
        const unsigned w0 = C[qq * DS_BP + 2 * lane], w1 = C[qq * DS_BP + 2 * lane + 1];
        const unsigned pc = (unsigned)__popc(w0) + (unsigned)__popc(w1);
        unsigned incl = pc;
#pragma unroll
        for (int o = 1; o < 64; o <<= 1) { const unsigned v = shupu(incl, o, lane); if (lane >= o) incl += v; }
        const unsigned pre = incl - pc;
        unsigned need = K2 > pre ? K2 - pre : 0u;
        const unsigned t0 = take_low(w0, need); need -= (unsigned)__popc(t0);
        const unsigned t1 = take_low(w1, need);
        const unsigned g0 = G[qq * DS_BP + 2 * lane] | t0, g1 = G[qq * DS_BP + 2 * lane + 1] | t1;
        G[qq * DS_BP + 2 * lane] = g0; G[qq * DS_BP + 2 * lane + 1] = g1;
        int hp = g1 ? (64 * lane + 63 - __clz((int)g1)) : (g0 ? (64 * lane + 31 - __clz((int)g0)) : -1);
#pragma unroll
        for (int o = 1; o < 64; o <<= 1) { const int v = (int)shxu((unsigned)hp, o, lane); hp = v > hp ? v : hp; }
        if (lane == 0) { REFPOS[rowg + 32 * qg + qq] = hp; AUX[128 + qq] = (unsigned)hp; }
    }
    __syncthreads();
    if (tid == 0) { int mn = 0x7fffffff; for (int i = 0; i < 32; ++i) { const int v = (int)AUX[128 + i]; mn = v < mn ? v : mn; } REFMIN[b * 128 + qg] = mn; }
    { const int qq = tid >> 4, part = tid & 15;
        unsigned* dst = MASK + (rowg + 32 * qg + qq) * 128 + part * 8;
        v4u a, c2;
        a.x = G[qq * DS_BP + part * 8 + 0]; a.y = G[qq * DS_BP + part * 8 + 1]; a.z = G[qq * DS_BP + part * 8 + 2]; a.w = G[qq * DS_BP + part * 8 + 3];
        c2.x = G[qq * DS_BP + part * 8 + 4]; c2.y = G[qq * DS_BP + part * 8 + 5]; c2.z = G[qq * DS_BP + part * 8 + 6]; c2.w = G[qq * DS_BP + part * 8 + 7];
        *(v4u*)dst = a; *(v4u*)(dst + 4) = c2; }
    __syncthreads();
}

constexpr int PL_U = 0, PL_UP = 528, PL_D = 79 * 528 + 16  , PL_DP = 257;
__device__ __forceinline__ void pool_unit(LAS unsigned char* lds, int b, int tile, const bf16* PU, const float* wpool  , const float* pscale  , bf16* YC) {
    int tid_l = threadIdx.x; asm volatile("" : "+v"(tid_l)); const int tid = tid_l, cb = __builtin_amdgcn_readfirstlane(tid >> 6), tt = tid & 63;
    const int t0 = tile * 64; const size_t rowg = (size_t)b * SEQ;
    for (int i = tid; i < 79 * 32; i += 512) { const int rr = i >> 5, ch = i & 31; const int tok = t0 - 15 + rr;
        v4u v = (v4u){0u, 0u, 0u, 0u}; if (tok >= 0) v = *(const v4u*)(PU + (rowg + tok) * 256 + ch * 8);
        *(LAS v4u*)(lds + PL_U + rr * PL_UP + ch * 16) = v; }
    __syncthreads();
    const int g = cb >> 1, wlen = 2 << g, c0 = 32 * cb, t = t0 + tt;
    const float inv = 1.f / (float)((t + 1 < wlen) ? (t + 1) : wlen);
    LAS float* Dm = (LAS float*)(lds + PL_D);
#pragma unroll
    for (int ch = 0; ch < 4; ++ch) {
        float sum[8];
#pragma unroll
        for (int e = 0; e < 8; ++e) sum[e] = 0.f;
        float self[8];
        for (int i = 0; i < wlen; ++i) {
            const v4u v = *(LAS const v4u*)(lds + PL_U + (15 + tt - i) * PL_UP + (c0 + 8 * ch) * 2);
            const float f[8] = {bflo(v.x), bfhi(v.x), bflo(v.y), bfhi(v.y), bflo(v.z), bfhi(v.z), bflo(v.w), bfhi(v.w)};
#pragma unroll
            for (int e = 0; e < 8; ++e) { sum[e] += f[e]; if (i == 0) self[e] = f[e]; }
        }
#pragma unroll
        for (int e = 0; e < 8; ++e) Dm[tt * PL_DP + c0 + 8 * ch + e] = sum[e] * inv - self[e];
    }
    __syncthreads();
    const int e0 = 32 * (cb & 1);
    float acc[32];
#pragma unroll
    for (int e = 0; e < 32; ++e) acc[e] = 0.f;
    const float* wg = wpool + (size_t)g * 4096 + e0;
    for (int c = 0; c < 64; ++c) {
        const float dv = Dm[tt * PL_DP + 64 * g + c];
        const float* wr = wg + c * 64;
#pragma unroll
        for (int e = 0; e < 32; ++e) acc[e] = __builtin_fmaf(dv, wr[e], acc[e]);
    }
    bf16* orow = YC + (rowg + t) * 256 + 64 * g + e0;
    const float* ps = pscale + 64 * g + e0;
#pragma unroll
    for (int k = 0; k < 4; ++k) { v4u o;
        o.x = pk2(acc[8 * k + 0] * ps[8 * k + 0], acc[8 * k + 1] * ps[8 * k + 1]); o.y = pk2(acc[8 * k + 2] * ps[8 * k + 2], acc[8 * k + 3] * ps[8 * k + 3]);
        o.z = pk2(acc[8 * k + 4] * ps[8 * k + 4], acc[8 * k + 5] * ps[8 * k + 5]); o.w = pk2(acc[8 * k + 6] * ps[8 * k + 6], acc[8 * k + 7] * ps[8 * k + 7]);
        *(v4u*)(orow + 8 * k) = o; }
    __syncthreads();
}
__device__ __forceinline__ void kmean_item(int item, const bf16* AK, float* KMEAN, int wid, int lane_in) {
    int lane = lane_in; asm volatile("" : "+v"(lane));
    const int combo = item * 8 + wid; const int b = combo >> 6, h = (combo >> 4) & 3, n = combo & 15;
    const int ks = lane >> 3, ch = lane & 7;
    const bf16* p = AK + ((size_t)b * SEQ + 256 * n + ks) * 256 + 64 * h + 8 * ch;
    float s[8];
#pragma unroll
    for (int e = 0; e < 8; ++e) s[e] = 0.f;
#pragma unroll 8
    for (int j = 0; j < 32; ++j) { const v4u v = *(const v4u*)(p + (size_t)j * 8 * 256);
        s[0] += bflo(v.x); s[1] += bfhi(v.x); s[2] += bflo(v.y); s[3] += bfhi(v.y); s[4] += bflo(v.z); s[5] += bfhi(v.z); s[6] += bflo(v.w); s[7] += bfhi(v.w); }
#pragma unroll
    for (int e = 0; e < 8; ++e) { s[e] += shx(s[e], 8, lane); s[e] += shx(s[e], 16, lane); s[e] += shx(s[e], 32, lane); }
    if (ks == 0) { float* o = KMEAN + (size_t)combo * 64 + 8 * ch;
        *(f32x4*)o = (f32x4){s[0], s[1], s[2], s[3]} * (1.f / 256.f); *(f32x4*)(o + 4) = (f32x4){s[4], s[5], s[6], s[7]} * (1.f / 256.f); }
}

__device__ __forceinline__ void norm_unit(LAS unsigned char* lds, int n, const bf16* PROJ, size_t TS, unsigned* NRM  ) {
    int tid_l = threadIdx.x; asm volatile("" : "+v"(tid_l)); const int tid = tid_l, lane = tid & 63, wid = __builtin_amdgcn_readfirstlane(tid >> 6);
    const int a = n >> 8, rem = n & 255, sq = rem >> 7, b = (rem >> 4) & 7, c = rem & 15;
    const int tile = (a == 0 ? 0 : (a == 1 ? 3 : 7)) + sq;
    const int row = tid >> 1, hp = tid & 1;
    float ss[2] = {0.f, 0.f};
#pragma unroll
    for (int rr = 0; rr < 1; ++rr) {
        const bf16* p = PROJ + (size_t)tile * TS + ((size_t)b * SEQ + 256 * c + row) * 256 + 128 * hp;
#pragma unroll
        for (int hh = 0; hh < 2; ++hh) { float acc = 0.f;
#pragma unroll
            for (int i = 0; i < 8; ++i) { const v4u v = *(const v4u*)(p + 64 * hh + 8 * i);
                const float f0 = bflo(v.x), f1 = bfhi(v.x), f2 = bflo(v.y), f3 = bfhi(v.y), f4 = bflo(v.z), f5 = bfhi(v.z), f6 = bflo(v.w), f7 = bfhi(v.w);
                acc += (f0 * f0 + f1 * f1) + (f2 * f2 + f3 * f3) + (f4 * f4 + f5 * f5) + (f6 * f6 + f7 * f7); }
            ss[hh] = fmaxf(ss[hh], acc); }
    }
#pragma unroll
    for (int o = 2; o < 64; o <<= 1) { ss[0] = fmaxf(ss[0], shx(ss[0], o, lane)); ss[1] = fmaxf(ss[1], shx(ss[1], o, lane)); }
    LAS float* R = (LAS float*)lds;
    if (lane < 2) { R[wid * 4 + 2 * hp] = ss[0]; R[wid * 4 + 2 * hp + 1] = ss[1]; }
    __syncthreads();
    if (tid < 4) { float m = R[tid];
#pragma unroll
        for (int w2 = 1; w2 < 8; ++w2) m = fmaxf(m, R[w2 * 4 + tid]);
        __hip_atomic_fetch_max(NRM + ((a * 2 + sq) * 8 + b) * 4 + tid, __float_as_uint(m * 1.0001f), __ATOMIC_RELAXED, __HIP_MEMORY_SCOPE_AGENT); }
    __syncthreads();
}

__device__ __forceinline__ float alibi_slope(int idx  ) { return exp2f(-8.f * (float)idx / 12.f); }

__device__ __forceinline__ void p0_adaln(const Args& A, LAS unsigned char* lds, int G) {
    int tid_l = threadIdx.x; asm volatile("" : "+v"(tid_l)); const int tid = tid_l, lane = tid & 63, wid = __builtin_amdgcn_readfirstlane(tid >> 6);
    LAS float* cact = (LAS float*)lds;
    LAS float* red = (LAS float*)(lds + 32768);
    float* MOD = (float*)(A.ws + WS_MOD);
    if ((int)blockIdx.x < 192) {
        for (int i = tid; i < 8192; i += 512) { const int bb = i >> 10, k = i & 1023; const float v = A.c[i]; cact[k * 8 + bb] = v / (1.f + __expf(-v)); }
        __syncthreads();
        for (int u = blockIdx.x; u < 192; u += G) {
            const int l = u / 96, n0 = (u % 96) * 64;
            const float* wp = A.w_ada + ((size_t)l * 1024 + 128 * wid) * 6144 + n0 + lane;
            float acc[8];
#pragma unroll
            for (int bb = 0; bb < 8; ++bb) acc[bb] = 0.f;
#pragma unroll 16
            for (int k = 0; k < 128; ++k) {
                const float wv = wp[(size_t)k * 6144];
                const f32x4 c0 = *(LAS const f32x4*)(cact + (128 * wid + k) * 8), c1 = *(LAS const f32x4*)(cact + (128 * wid + k) * 8 + 4);
                acc[0] += c0[0] * wv; acc[1] += c0[1] * wv; acc[2] += c0[2] * wv; acc[3] += c0[3] * wv;
                acc[4] += c1[0] * wv; acc[5] += c1[1] * wv; acc[6] += c1[2] * wv; acc[7] += c1[3] * wv;
            }
#pragma unroll
            for (int bb = 0; bb < 8; ++bb) red[(wid * 8 + bb) * 64 + lane] = acc[bb];
            __syncthreads();
            { const int bb = wid; float s = A.b_ada[(size_t)l * 6144 + n0 + lane];
#pragma unroll
                for (int w2 = 0; w2 < 8; ++w2) s += red[(w2 * 8 + bb) * 64 + lane];
                MOD[((size_t)l * 8 + bb) * 6144 + n0 + lane] = s; }
            __syncthreads();
        }
    }
    __syncthreads();
}
__device__ __forceinline__ void p0_weights(const Args& A, LAS unsigned char* lds, int vcu, int G) {
    int tid_l = threadIdx.x; asm volatile("" : "+v"(tid_l)); const int tid = tid_l, lane = tid & 63, wid = __builtin_amdgcn_readfirstlane(tid >> 6);
    unsigned char* ws = A.ws;
    LAS float* scr = (LAS float*)(lds + wid * 16384);
    const int gw = vcu * NWAVES + wid, NGW = G * NWAVES;
    constexpr int I_IN = 16 * (NPROJ_PAD / 32), I_G1 = 16 * 32, I_BR1 = 4 * 32, I_OUT = 16 * 32, I_F1 = 16 * 128, I_F2 = 64 * 32;
    constexpr int I_LAYER = I_IN + 4 * I_G1 + 4 * I_BR1 + I_OUT + I_F1 + I_F2;
    for (int it = gw; it < 2 * I_LAYER; it += NGW) {
        const int l = it / I_LAYER; int r = it % I_LAYER;
        bf16* WL = (bf16*)(ws + WS_W) + (size_t)l * W_LAYER;
        if (r < I_IN) { p0_transpose_item(A.w_in + (size_t)l * DM * NPROJ, DM, NPROJ, NPROJ_PAD, WL + W_IN, 0, 0, scr, r, lane); continue; } r -= I_IN;
        if (r < 4 * I_G1) { const int br = r / I_G1; p0_transpose_item(A.w_gate + ((size_t)l * 4 + br) * DM * DM, DM, DM, DM, WL + W_GATE, 1, br, scr, r % I_G1, lane); continue; } r -= 4 * I_G1;
        if (r < 4 * I_BR1) { const int br = r / I_BR1; p0_transpose_item(A.w_branch + ((size_t)l * 4 + br) * 256 * DM, 256, DM, DM, WL + W_BR + (size_t)br * DM * 256, 0, 0, scr, r % I_BR1, lane); continue; } r -= 4 * I_BR1;
        if (r < I_OUT) { p0_transpose_item(A.w_out + (size_t)l * DM * DM, DM, DM, DM, WL + W_OUT, 0, 0, scr, r, lane); continue; } r -= I_OUT;
        if (r < I_F1) { p0_transpose_item(A.w_ff1 + (size_t)l * DM * FF, DM, FF, FF, WL + W_FF1, 0, 0, scr, r, lane); continue; } r -= I_F1;
        p0_transpose_item(A.w_ff2 + (size_t)l * FF * DM, FF, DM, DM, WL + W_FF2, 0, 0, scr, r, lane);
    }
    __syncthreads();
}

__device__ __forceinline__ int wq_draw(gu32* ctr) { int v = 0; if (threadIdx.x == 0) v = (int)__hip_atomic_fetch_add(ctr, 1u, RLX_AGENT); return v; }
__device__ __forceinline__ int wq_bcast(volatile LAS unsigned* slot, int v) {
    if (threadIdx.x == 0) *slot = (unsigned)v;
    __syncthreads();
    const int item = (int)*slot;
    __syncthreads();
    return item;
}

#ifndef ZG_ALIGN
#define ZG_ALIGN true
#define ZG_SP2 false
#endif
#ifndef IN_ALIGN
#define IN_ALIGN true
#define IN_SP2 true
#endif
#ifndef GT_ALIGN
#define GT_ALIGN true
#define GT_SP2 true
#endif
#ifndef WO_ALIGN
#define WO_ALIGN true
#define WO_SP2 true
#endif
#ifndef F1_ALIGN
#define F1_ALIGN true
#define F1_SP2 true
#endif
#ifndef F2_ALIGN
#define F2_ALIGN true
#define F2_SP2 true
#endif
struct ZOrder {
    pg8::StaticOrder base;
    __device__ __forceinline__ bool next(int i, pg8::Unit& u) const { if (!base.next(i, u)) return false; u.pn += 4 * (u.pm >> 7); return true; }
    __device__ __forceinline__ void a_ready(const pg8::Unit&) const {}
    __device__ __forceinline__ void done(const pg8::Unit&) const {}
};

__global__ void __launch_bounds__(NWAVES * 64, 2) hybrid_fwd(Args args) {
    extern __shared__ __attribute__((aligned(16))) unsigned char lds_raw[];
    LAS unsigned char* lds = (LAS unsigned char*)lds_raw;
#define PHASE_IDS int tid_p = threadIdx.x; asm volatile("" : "+v"(tid_p)); const int lane = tid_p & 63, wid = __builtin_amdgcn_readfirstlane(tid_p >> 6); const int gw = vcu * NWAVES + wid, ngw = G * NWAVES; (void)lane; (void)gw; (void)ngw;
    const int G = gridDim.x; const int bx = blockIdx.x; const int vcu = (G % 8 == 0) ? (bx % 8) * (G / 8) + bx / 8 : bx;
    unsigned char* ws = args.ws;
    gu32* ctl = (gu32*)(ws + WS_CTL);
    volatile LAS unsigned* MISC = (volatile LAS unsigned*)(lds + LDSCTL_OFF);
    for (int u = threadIdx.x; u < (LDS_BYTES - LDSCTL_OFF) / 4; u += NWAVES * 64) ((LAS unsigned*)(lds + LDSCTL_OFF))[u] = 0u;
    __syncthreads();
    const int lo = args.ph_lo, hi = args.ph_hi;
    XcdBarrier bar; bar.bar = (unsigned*)(ctl + CW_BAR) + args.li * XCD_BAR_WORDS; bar.x = 0; bar.st = nullptr;
    if (hi - lo > 1) bar = xcd_barrier_post((unsigned*)(ctl + CW_BAR) + args.li * XCD_BAR_WORDS, MISC + 8);
#ifndef PHASE_OFF
#define PHASE_OFF 0
#endif
#define IN(k) (lo <= (k) && (k) < hi && !((PHASE_OFF >> ((k) == 0 ? 0 : (k) == 21 ? 11 : (((k) - 1) % 10) + 1)) & 1))
#ifndef REPEAT_MASK
#define REPEAT_MASK 0
#endif
#define NREP(bit) (((REPEAT_MASK >> (bit)) & 1) ? 2 : 1)
#if defined(PROBE_SEAM2X)
#define SEAM(k) do { if (IN(k) && IN((k) + 1)) { xcd_barrier(bar); xcd_barrier(bar); } } while (0)
#else
#define SEAM(k) do { if (IN(k) && IN((k) + 1)) xcd_barrier(bar); } while (0)
#endif
    float* MOD = (float*)(ws + WS_MOD);
    float* KMEAN = (float*)(ws + WS_KMEAN);
    int* REFPOS = (int*)(ws + WS_KMEAN + 128 * 1024);
    int* REFMIN = (int*)(ws + WS_KMEAN + 256 * 1024);
    unsigned* MASK = (unsigned*)(ws + WS_MASK);
    bf16* H = (bf16*)(ws + WS_H);
    bf16* Y = (bf16*)(ws + WS_Y);
    bf16* MERGED = (bf16*)(ws + WS_Y);
    bf16* PROJ = (bf16*)(ws + WS_R);
    bf16* Z = (bf16*)(ws + WS_R);
    bf16* U = (bf16*)(ws + WS_R);
    bf16* XRB = (bf16*)args.out;
    constexpr size_t TS = (size_t)TOK * 256;
    volatile LAS unsigned* wqslot = MISC + 16;

    if (IN(0)) for (int rep = 0; rep < NREP(0); ++rep) { p0_adaln(args, lds, G); }
    SEAM(0);

#pragma nounroll
    for (int l = 0; l < NL; ++l) {
        const int pb = 1 + 10 * l;
        const float* modl = MOD + (size_t)l * 8 * 6144;
        const bf16* WL = (const bf16*)(ws + WS_W) + (size_t)l * W_LAYER;
        if (IN(pb + 0)) for (int rep = 0; rep < NREP(1); ++rep) { PHASE_IDS if (l == 0) norm_rows_bf16<false>(args.x, H, args.norm1_g + (size_t)l * DM, modl, 0, 1, gw, ngw, lane); else norm_rows_bf16<true>(XRB, H, args.norm1_g + (size_t)l * DM, modl, 0, 1, gw, ngw, lane); if (l == 0) p0_weights(args, lds, vcu, G); }
        SEAM(pb + 0);
        if (IN(pb + 1)) for (int rep = 0; rep < NREP(2); ++rep) {
            pg8::Gemm g{H, WL + W_IN, TOK, NPROJ_PAD, DM}; pg8::StaticOrder S; S.init(TOK, NPROJ_PAD, G, bx);
            pg8::EpiProj E{PROJ, TS};
            pg8::gemm_phase<pg8::EpiProj, pg8::StaticOrder, IN_ALIGN, IN_SP2>(lds, g, S, E);
        }
        SEAM(pb + 1);
        unsigned* NRM = (unsigned*)(ctl + CW_NRM) + l * 192;
        if (IN(pb + 2)) for (int rep = 0; rep < NREP(3); ++rep) {
            gu32* ctr = ctl + CW_WQ + (l * 2 + 0 + 4 * rep) * 64;
            int raw = wq_draw(ctr);
            for (;;) {
#ifndef REPA_LO
#define REPA_LO 0
#define REPA_HI 2368
#endif
                const int item = wq_bcast(wqslot, raw) + (rep ? REPA_LO : 0);
                if (item >= (rep ? REPA_HI : 2368)) break;
                raw = wq_draw(ctr);
                if (item < 1024) { const int qg = 127 - (item >> 3), b = item & 7;
                    dsa_select_unit(lds, b, qg, PROJ + 10 * TS, MASK, REFPOS, REFMIN);
                } else if (item < 1536) { const int i2 = item - 1024; const int b = i2 >> 6, tile = i2 & 63;
                    pool_unit(lds, b, tile, PROJ + 6 * TS, args.w_pool + (size_t)l * 4 * 4096, args.pool_scale + (size_t)l * 256, Y + 2 * TS);
                } else if (item < 1600) { PHASE_IDS kmean_item(item - 1536, PROJ + 1 * TS, KMEAN, wid, lane);
                } else { norm_unit(lds, item - 1600, PROJ, TS, NRM); }
            }
        }
        SEAM(pb + 2);
        if (IN(pb + 3)) for (int rep = 0; rep < NREP(4); ++rep) {
            gu32* ctr = ctl + CW_WQ + 512 + ((l * 2 + rep) * 8) * 64;
            const float li = 0.8f - 0.6f * __expf(-0.3f * (float)l);
            const float* dl = args.diff_lambda + (size_t)l * 128;
            float d1 = 0.f, d2 = 0.f;
            for (int i = 0; i < 32; ++i) { d1 += dl[i] * dl[32 + i]; d2 += dl[64 + i] * dl[96 + i]; }
            const float lam = __expf(d1) - __expf(d2) + li;
            int raw = wq_draw(ctr);
            for (;;) {
                const int item = wq_bcast(wqslot, raw);
                if (item >= 1536) break;
                raw = wq_draw(ctr);
                const int ty = item % 3, rest = item / 3; const int qb = 15 - (rest >> 5), bh = rest & 31, b = bh >> 2, h = bh & 3;
                if (ty == 0) attn_unit<1>(lds, b, h, qb, PROJ + 3 * TS, PROJ + 4 * TS, PROJ + 5 * TS, Y + 1 * TS, alibi_slope(3 * h + 2), nullptr, lam, 1.f - li, args.diff_subln_g + (size_t)l * 64, nullptr, NRM + 64, nullptr, nullptr);
                else if (ty == 1) attn_unit<0>(lds, b, h, qb, PROJ + 0 * TS, PROJ + 1 * TS, PROJ + 2 * TS, Y + 0 * TS, alibi_slope(3 * h + 1), KMEAN, 0.f, 0.f, nullptr, nullptr, NRM, nullptr, nullptr);
                else              attn_unit<2>(lds, b, h, qb, PROJ + 7 * TS, PROJ + 8 * TS, PROJ + 9 * TS, Y + 3 * TS, alibi_slope(3 * h + 3), nullptr, 0.f, 0.f, nullptr, MASK, NRM + 128, REFPOS, REFMIN);
            }
        }
        SEAM(pb + 3);
        if (IN(pb + 4)) for (int rep = 0; rep < NREP(5); ++rep) {
            int kz = 256; asm volatile("" : "+s"(kz)); pg8::Gemm g{Y, WL + W_BR, 4 * TOK, 4096, kz}; ZOrder S; S.base.init(4 * TOK, DM, G, bx);
            pg8::EpiZ E{Z};
            pg8::gemm_phase<pg8::EpiZ, ZOrder, ZG_ALIGN, ZG_SP2>(lds, g, S, E);
        }
        SEAM(pb + 4);
        if (IN(pb + 5)) for (int rep = 0; rep < NREP(6); ++rep) {
            pg8::Gemm g{H, WL + W_GATE, TOK, 4096, DM}; pg8::StaticOrder S; S.init(TOK, 4096, G, bx);
            pg8::EpiGate E{Z, args.b_gate + (size_t)l * 4 * DM, MERGED};
            pg8::gemm_phase<pg8::EpiGate, pg8::StaticOrder, GT_ALIGN, GT_SP2>(lds, g, S, E);
        }
        SEAM(pb + 5);
        if (IN(pb + 6)) for (int rep = 0; rep < NREP(7); ++rep) {
            pg8::Gemm g{MERGED, WL + W_OUT, TOK, DM, DM}; pg8::StaticOrder S; S.init(TOK, DM, G, bx);
            if (l == 0) { pg8::EpiResid<false> E{args.x, rep ? (bf16*)(ws + WS_R) : XRB, modl + 2 * 1024};
                pg8::gemm_phase<pg8::EpiResid<false>, pg8::StaticOrder, WO_ALIGN, WO_SP2>(lds, g, S, E); }
            else { pg8::EpiResid<true> E{XRB, rep ? (bf16*)(ws + WS_R) : XRB, modl + 2 * 1024};
                pg8::gemm_phase<pg8::EpiResid<true>, pg8::StaticOrder, WO_ALIGN, WO_SP2>(lds, g, S, E); }
        }
        SEAM(pb + 6);
        if (IN(pb + 7)) for (int rep = 0; rep < NREP(8); ++rep) { PHASE_IDS norm_rows_bf16<true>(XRB, H, args.norm2_g + (size_t)l * DM, modl, 3, 4, gw, ngw, lane); }
        SEAM(pb + 7);
        if (IN(pb + 8)) for (int rep = 0; rep < NREP(9); ++rep) {
            pg8::Gemm g{H, WL + W_FF1, TOK, FF, DM}; pg8::StaticOrder S; S.init(TOK, FF, G, bx);
            pg8::EpiRelu2 E{U, FF};
            pg8::gemm_phase<pg8::EpiRelu2, pg8::StaticOrder, F1_ALIGN, F1_SP2>(lds, g, S, E);
        }
        SEAM(pb + 8);
        if (IN(pb + 9)) for (int rep = 0; rep < NREP(10); ++rep) {
            pg8::Gemm g{U, WL + W_FF2, TOK, DM, FF}; pg8::StaticOrder S; S.init(TOK, DM, G, bx);
            pg8::EpiResid<true> E{XRB, rep ? (bf16*)(ws + WS_MASK) : XRB, modl + 5 * 1024};
            pg8::gemm_phase<pg8::EpiResid<true>, pg8::StaticOrder, F2_ALIGN, F2_SP2>(lds, g, S, E);
        }
        SEAM(pb + 9);
    }
    if (IN(21)) {
        PHASE_IDS
        v4u xa[16], xb[16]; float rs[16];
        const v4u* xp = (const v4u*)(XRB + (size_t)gw * DM) + 2 * lane;
#pragma unroll
        for (int i = 0; i < 16; ++i) { xa[i] = xp[(size_t)i * ngw * (DM / 8)]; xb[i] = xp[(size_t)i * ngw * (DM / 8) + 1]; }
#pragma unroll
        for (int i = 0; i < 16; ++i) { const v4u a = xa[i], c = xb[i];
            float s = bflo(a.x) * bflo(a.x); s += bfhi(a.x) * bfhi(a.x); s += bflo(a.y) * bflo(a.y); s += bfhi(a.y) * bfhi(a.y); s += bflo(a.z) * bflo(a.z); s += bfhi(a.z) * bfhi(a.z); s += bflo(a.w) * bflo(a.w); s += bfhi(a.w) * bfhi(a.w);
            s += bflo(c.x) * bflo(c.x); s += bfhi(c.x) * bfhi(c.x); s += bflo(c.y) * bflo(c.y); s += bfhi(c.y) * bfhi(c.y); s += bflo(c.z) * bflo(c.z); s += bfhi(c.z) * bfhi(c.z); s += bflo(c.w) * bflo(c.w); s += bfhi(c.w) * bfhi(c.w);
            rs[i] = 1.f / sqrtf(wave_sum(s, lane) * (1.f / DM) + NORM_EPS); }
        xcd_barrier(bar);
#pragma unroll
        for (int i = 0; i < 16; ++i) asm volatile("" : "+v"(xa[i]), "+v"(xb[i]));
        const f32x4* gp = (const f32x4*)args.final_g + 4 * lane;
        f32x4* op = (f32x4*)(args.out + (size_t)gw * DM) + 4 * lane;
#pragma unroll
        for (int i = 0; i < 16; ++i) { const v4u a = xa[i], c = xb[i]; const float r = rs[i]; f32x4* o = op + (size_t)i * ngw * (DM / 4);
            o[0] = (f32x4){bflo(a.x), bfhi(a.x), bflo(a.y), bfhi(a.y)} * r * gp[0]; o[1] = (f32x4){bflo(a.z), bfhi(a.z), bflo(a.w), bfhi(a.w)} * r * gp[1];
            o[2] = (f32x4){bflo(c.x), bfhi(c.x), bflo(c.y), bfhi(c.y)} * r * gp[2]; o[3] = (f32x4){bflo(c.z), bfhi(c.z), bflo(c.w), bfhi(c.w)} * r * gp[3]; }
    }
#undef IN
#undef SEAM
}

#ifndef MK_SPLIT
#define MK_SPLIT 0
#endif
extern "C" void kernel_launch(void* const* d_in, const int* in_sizes, int n_in, void* d_out, int out_size, void* d_ws, size_t ws_size, hipStream_t stream) {
    static int grid = 0;
    if (grid == 0) {
        if (n_in != 18 || in_sizes[0] != TOK * DM || out_size != TOK * DM || ws_size < WS_END) { fprintf(stderr, "kernel_launch: unexpected shapes (n_in %d, in0 %d, out %d, ws %zu)\n", n_in, n_in > 0 ? in_sizes[0] : -1, out_size, ws_size); grid = -1; return; }
        int dev = 0, cus = 0, per_cu = 0;
        if (hipGetDevice(&dev) != hipSuccess || hipDeviceGetAttribute(&cus, hipDeviceAttributeMultiprocessorCount, dev) != hipSuccess) { grid = -1; return; }
        if (hipFuncSetAttribute((const void*)hybrid_fwd, hipFuncAttributeMaxDynamicSharedMemorySize, LDS_BYTES) != hipSuccess) { fprintf(stderr, "kernel_launch: hipFuncSetAttribute failed\n"); grid = -1; return; }
        if (hipOccupancyMaxActiveBlocksPerMultiprocessor(&per_cu, (const void*)hybrid_fwd, NWAVES * 64, LDS_BYTES) != hipSuccess || per_cu < 1) fprintf(stderr, "kernel_launch: occupancy query reports %d\n", per_cu);
        (void)hipGetLastError();
        grid = cus;
        if (cus != 256) { fprintf(stderr, "kernel_launch: built for 256 CUs (the final norm stages 16 rows per wave), found %d\n", cus); grid = -1; return; }
    }
    if (grid < 0) return;
    if (hipMemsetAsync((char*)d_ws + WS_CTL, 0, CTL_ZERO_BYTES, stream) != hipSuccess) return;
    Args a{};
    const float** ap = (const float**)&a;
    for (int i = 0; i < 18; ++i) ap[i] = (const float*)d_in[i];
    a.out = (float*)d_out; a.ws = (unsigned char*)d_ws; a.pad = 0;
#if MK_SPLIT
    for (int p = 0; p < NPHASE; ++p) { a.ph_lo = p; a.ph_hi = p + 1; a.li = 0;
        hipLaunchKernelGGL(hybrid_fwd, dim3(grid), dim3(NWAVES * 64), LDS_BYTES, stream, a); }
#else
    a.ph_lo = 0; a.ph_hi = NPHASE; a.li = 0;
    hipLaunchKernelGGL(hybrid_fwd, dim3(grid), dim3(NWAVES * 64), LDS_BYTES, stream, a);
#endif
}
```

```cpp
#include <hip/hip_runtime.h>
#include <cstdio>
#include <cstdint>
namespace pg8 {
#define PG8_LAS __attribute__((address_space(3)))
typedef unsigned short bf16_t;
typedef short bf16x8 __attribute__((ext_vector_type(8)));
typedef float f32x4 __attribute__((ext_vector_type(4)));
typedef unsigned u32x4 __attribute__((ext_vector_type(4)));
constexpr int BM = 256, BK = 64, HALF = 128, HTB = HALF * BK * 2  , STAGE_BYTES = 8 * HTB, NXCD = 8, WGM = 8;

__host__ __device__ __forceinline__ int lds_byte(int r, int c) { const int st = (r >> 4) * 2 + (c >> 5), rr = r & 15, cc = c & 31, ob = rr * 64 + cc * 2; return st * 1024 + (ob ^ (((ob >> 9) & 1) << 5)); }
__host__ __device__ __forceinline__ void stage_rc(int b, int& R, int& C) { const int st = b / 1024, sb = b % 1024, swz = sb ^ (((sb >> 9) & 1) << 5); R = (st >> 1) * 16 + swz / 64; C = (st & 1) * 32 + (swz % 64) / 2; }
__host__ __device__ __forceinline__ int perm32(int rho) { const int n = rho >> 4, i = rho & 15; return 8 * (i >> 2) + 4 * n + (i & 3); }

struct Unit { int pm, pn; };
struct Gemm { const bf16_t* A; const bf16_t* Bt; int M, N, K; };

struct StaticOrder {
    int nM, nN, nwg, G, c;
    __host__ __device__ void init(int M, int N, int G_, int c_) { nM = M / BM; nN = N / BM; nwg = nM * nN; G = G_; c = c_; }
    __host__ __device__ bool next(int i, Unit& u) const {
        const long L = (long)i * G + c; if (L >= nwg) return false;
        int wgid = (int)L; { const int q = nwg / NXCD, r = nwg % NXCD, xcd = wgid % NXCD, off = wgid / NXCD; wgid = (xcd < r ? xcd * (q + 1) : r * (q + 1) + (xcd - r) * q) + off; }
        const int nig = WGM * nN, gid = wgid / nig, fm = gid * WGM, gsz = (nM - fm) < WGM ? (nM - fm) : WGM;
        u.pm = fm + ((wgid % nig) % gsz); u.pn = (wgid % nig) / gsz; return true;
    }
    __device__ __forceinline__ void a_ready(const Unit&) const {}
    __device__ __forceinline__ void done(const Unit&) const {}
};

__device__ __forceinline__ unsigned cvt_pk_bf16(float lo, float hi) { unsigned r; asm volatile("v_cvt_pk_bf16_f32 %0, %1, %2" : "=v"(r) : "v"(lo), "v"(hi)); return r; }
typedef unsigned u32x2 __attribute__((ext_vector_type(2)));
constexpr int TT = 32768;
constexpr float QS64 = 0.125f * 1.4426950408889634f;
constexpr float QS32 = 0.17677669529663687f * 1.4426950408889634f;

struct EpiProj {
    static constexpr bool PERM = true, AFTER_DRAIN = false;
    bf16_t* O; size_t tile_stride;
    __device__ __forceinline__ void operator()(const f32x4 (&acc)[2][2][4][2], const Unit& u, int wr, int wc, int fr, int fq) const {
        const int row0 = u.pm * BM + wr * 64 + fr; bf16_t* base = O + (size_t)u.pn * tile_stride;
        float sc = 1.f; if (u.pn == 0 || u.pn == 7) sc = QS64; else if (u.pn == 3) sc = QS32;
        const int col0 = wc * 32 + 8 * fq;
#pragma unroll
        for (int ai = 0; ai < 2; ++ai)
#pragma unroll
            for (int m = 0; m < 4; ++m) { bf16_t* rowp = base + (size_t)(row0 + ai * HALF + m * 16) * 256 + col0;
#pragma unroll
                for (int bj = 0; bj < 2; ++bj) { const f32x4 v0 = acc[ai][bj][m][0] * sc, v1 = acc[ai][bj][m][1] * sc;
                    u32x4 w; w.x = cvt_pk_bf16(v0[0], v0[1]); w.y = cvt_pk_bf16(v0[2], v0[3]); w.z = cvt_pk_bf16(v1[0], v1[1]); w.w = cvt_pk_bf16(v1[2], v1[3]);
                    *(u32x4*)(rowp + bj * HALF) = w; } }
    }
};
struct EpiZ {
    static constexpr bool PERM = true, AFTER_DRAIN = false;
    bf16_t* O;
    __device__ __forceinline__ void operator()(const f32x4 (&acc)[2][2][4][2], const Unit& u, int wr, int wc, int fr, int fq) const {
        const int row0 = u.pm * BM + wr * 64 + fr; const int col0 = (u.pn & 3) * BM + wc * 32 + 8 * fq;
#pragma unroll
        for (int ai = 0; ai < 2; ++ai)
#pragma unroll
            for (int m = 0; m < 4; ++m) { bf16_t* rowp = O + (size_t)(row0 + ai * HALF + m * 16) * 1024 + col0;
#pragma unroll
                for (int bj = 0; bj < 2; ++bj) { const f32x4 v0 = acc[ai][bj][m][0], v1 = acc[ai][bj][m][1];
                    u32x4 w; w.x = cvt_pk_bf16(v0[0], v0[1]); w.y = cvt_pk_bf16(v0[2], v0[3]); w.z = cvt_pk_bf16(v1[0], v1[1]); w.w = cvt_pk_bf16(v1[2], v1[3]);
                    *(u32x4*)(rowp + bj * HALF) = w; } }
    }
};
struct EpiRelu2 {
    static constexpr bool PERM = true, AFTER_DRAIN = false;
    bf16_t* O; int ldc;
    __device__ __forceinline__ void operator()(const f32x4 (&acc)[2][2][4][2], const Unit& u, int wr, int wc, int fr, int fq) const {
        const int row0 = u.pm * BM + wr * 64 + fr; const int col0 = u.pn * BM + wc * 32 + 8 * fq;
#pragma unroll
        for (int ai = 0; ai < 2; ++ai)
#pragma unroll
            for (int m = 0; m < 4; ++m) { bf16_t* rowp = O + (size_t)(row0 + ai * HALF + m * 16) * ldc + col0;
#pragma unroll
                for (int bj = 0; bj < 2; ++bj) { f32x4 v0 = acc[ai][bj][m][0], v1 = acc[ai][bj][m][1];
#pragma unroll
                    for (int j = 0; j < 4; ++j) { const float a = fmaxf(v0[j], 0.f), b = fmaxf(v1[j], 0.f); v0[j] = a * a; v1[j] = b * b; }
                    u32x4 w; w.x = cvt_pk_bf16(v0[0], v0[1]); w.y = cvt_pk_bf16(v0[2], v0[3]); w.z = cvt_pk_bf16(v1[0], v1[1]); w.w = cvt_pk_bf16(v1[2], v1[3]);
                    *(u32x4*)(rowp + bj * HALF) = w; } }
    }
};
template <bool BASE_BF16> struct EpiResid {
    static constexpr bool PERM = true, AFTER_DRAIN = false;
    const void* base; bf16_t* out; const float* gate;
    __device__ __forceinline__ void operator()(const f32x4 (&acc)[2][2][4][2], const Unit& u, int wr, int wc, int fr, int fq) const {
        const int row0 = u.pm * BM + wr * 64 + fr; const int col0 = u.pn * BM + wc * 32 + 8 * fq;
        const float* gp = gate + (size_t)(u.pm >> 4) * 6144 + col0;
        f32x4 gv[2][2];
#pragma unroll
        for (int bj = 0; bj < 2; ++bj)
#pragma unroll
            for (int n = 0; n < 2; ++n) gv[bj][n] = *(const f32x4*)(gp + bj * HALF + n * 4);
#pragma unroll
        for (int ai = 0; ai < 2; ++ai)
#pragma unroll
            for (int m = 0; m < 4; ++m) { const size_t off = (size_t)(row0 + ai * HALF + m * 16) * 1024 + col0;
#pragma unroll
                for (int bj = 0; bj < 2; ++bj) { f32x4 b0, b1;
                    if (BASE_BF16) { const u32x4 w = *(const u32x4*)((const bf16_t*)base + off + bj * HALF);
                        b0 = (f32x4){__uint_as_float(w.x << 16), __uint_as_float(w.x & 0xffff0000u), __uint_as_float(w.y << 16), __uint_as_float(w.y & 0xffff0000u)};
                        b1 = (f32x4){__uint_as_float(w.z << 16), __uint_as_float(w.z & 0xffff0000u), __uint_as_float(w.w << 16), __uint_as_float(w.w & 0xffff0000u)}; }
                    else { b0 = *(const f32x4*)((const float*)base + off + bj * HALF); b1 = *(const f32x4*)((const float*)base + off + bj * HALF + 4); }
                    const f32x4 v0 = b0 + gv[bj][0] * acc[ai][bj][m][0], v1 = b1 + gv[bj][1] * acc[ai][bj][m][1];
                    u32x4 o; o.x = cvt_pk_bf16(v0[0], v0[1]); o.y = cvt_pk_bf16(v0[2], v0[3]); o.z = cvt_pk_bf16(v1[0], v1[1]); o.w = cvt_pk_bf16(v1[2], v1[3]);
                    *(u32x4*)(out + off + bj * HALF) = o; }
                if (m & 1) asm volatile("" ::: "memory"); }
    }
};
struct EpiGate {
    static constexpr bool PERM = true, AFTER_DRAIN = false;
    const bf16_t* Z; const float* bg; bf16_t* O;
    __device__ __forceinline__ void operator()(const f32x4 (&acc)[2][2][4][2], const Unit& u, int wr, int wc, int fr, int fq) const {
        const int row0 = u.pm * BM + wr * 64 + fr; const int mc0 = u.pn * 64 + wc * 16 + 4 * fq;
        f32x4 bv[2][2];
#pragma unroll
        for (int bj = 0; bj < 2; ++bj)
#pragma unroll
            for (int n = 0; n < 2; ++n) bv[bj][n] = *(const f32x4*)(bg + (2 * bj + n) * 1024 + mc0);
#pragma unroll
        for (int ai = 0; ai < 2; ++ai)
#pragma unroll
            for (int m = 0; m < 4; ++m) { const size_t row = (size_t)(row0 + ai * HALF + m * 16);
                f32x4 sum = (f32x4){0.f, 0.f, 0.f, 0.f};
#pragma unroll
                for (int bj = 0; bj < 2; ++bj)
#pragma unroll
                    for (int n = 0; n < 2; ++n) { const u32x2 zr = *(const u32x2*)(Z + ((size_t)(2 * bj + n) * TT + row) * 1024 + mc0);
                        const f32x4 x = acc[ai][bj][m][n] + bv[bj][n]; f32x4 zz;
                        zz[0] = __uint_as_float(zr.x << 16); zz[1] = __uint_as_float(zr.x & 0xffff0000u); zz[2] = __uint_as_float(zr.y << 16); zz[3] = __uint_as_float(zr.y & 0xffff0000u);
#pragma unroll
                        for (int j = 0; j < 4; ++j) { const float g = __builtin_amdgcn_rcpf(1.f + __builtin_amdgcn_exp2f(-1.4426950408889634f * x[j])); sum[j] += g * zz[j]; } }
                u32x2 w; w.x = cvt_pk_bf16(sum[0], sum[1]); w.y = cvt_pk_bf16(sum[2], sum[3]);
                *(u32x2*)(O + row * 1024 + mc0) = w; }
    }
};
template <class Epi, class Sched, bool ALIGN_EPI = false, bool SP2 = false>
__device__ __forceinline__ void gemm_phase(PG8_LAS unsigned char* lds, const Gemm g, const Sched& S, const Epi& E) {
    int tid_l = threadIdx.x; asm volatile("" : "+v"(tid_l)); const int tid = tid_l, wid = __builtin_amdgcn_readfirstlane(tid >> 6), lane = tid & 63, wr = wid >> 2, wc = wid & 3, fr = lane & 15, fq = lane >> 4;
    const int K = g.K, nt = K / BK;
    unsigned voffA[2], voffB[2];
#pragma unroll
    for (int i = 0; i < 2; ++i) { int R, C; stage_rc(tid * 16 + i * 8192, R, C); const int Rb = Epi::PERM ? ((R & ~31) + perm32(R & 31)) : R;
        voffA[i] = (unsigned)(R * K + C) * 2u; voffB[i] = (unsigned)(Rb * K + C) * 2u; }
    const size_t kstep = (size_t)(BK * 2);
    const size_t hstep = (size_t)HALF * K * 2;
    const size_t tstep = 2 * hstep;
    const unsigned ldsw = (unsigned)wid * 1024u;
    const int aoff = lds_byte(wr * 64 + fr, fq * 8), boff = lds_byte(wc * 32 + fr, fq * 8);
#define PG8_SA(b, h) (((b) * 2 + (h)) * HTB)
#define PG8_SB(b, h) ((4 + (b) * 2 + (h)) * HTB)
#define PG8_STAGE(bufoff, gbase, voff) do { _Pragma("unroll") for (int _i = 0; _i < 2; ++_i) \
        __builtin_amdgcn_global_load_lds((const unsigned*)((const char*)(gbase) + (voff)[_i]), (PG8_LAS unsigned*)(lds + (bufoff) + ldsw + _i * 8192), 16, 0, 0); } while (0)
#define PG8_LDA(dst, b, h) do { _Pragma("unroll") for (int m = 0; m < 4; ++m) _Pragma("unroll") for (int k = 0; k < 2; ++k) dst[m][k] = *(const PG8_LAS bf16x8*)(lds + PG8_SA(b, h) + aoff + m * 2048 + k * 1024); } while (0)
#define PG8_LDB(dst, b, h) do { _Pragma("unroll") for (int n = 0; n < 2; ++n) _Pragma("unroll") for (int k = 0; k < 2; ++k) dst[n][k] = *(const PG8_LAS bf16x8*)(lds + PG8_SB(b, h) + boff + n * 2048 + k * 1024); } while (0)
#define PG8_MMA(ai, bj, At, Bt) do { __builtin_amdgcn_s_setprio(1); _Pragma("unroll") for (int m = 0; m < 4; ++m) _Pragma("unroll") for (int n = 0; n < 2; ++n) _Pragma("unroll") for (int k = 0; k < 2; ++k) \
        acc[ai][bj][m][n] = __builtin_amdgcn_mfma_f32_16x16x32_bf16(Bt[n][k], At[m][k], acc[ai][bj][m][n], 0, 0, 0); __builtin_amdgcn_s_setprio(0); } while (0)
#define PG8_WAIT_V(n) asm volatile("s_waitcnt vmcnt(" #n ")" ::: "memory")
#define PG8_WAIT_L(n) asm volatile("s_waitcnt lgkmcnt(" #n ")" ::: "memory")
#define PG8_BAR __builtin_amdgcn_s_barrier()
#define PG8_SCHED __builtin_amdgcn_sched_barrier(0)
    Unit cur, nxt; int ui = 0;
    if (!S.next(0, cur)) return;
    f32x4 acc[2][2][4][2];
#pragma unroll
    for (int a = 0; a < 2; ++a)
#pragma unroll
        for (int b = 0; b < 2; ++b)
#pragma unroll
            for (int m = 0; m < 4; ++m)
#pragma unroll
                for (int n = 0; n < 2; ++n) acc[a][b][m][n] = (f32x4){0.f, 0.f, 0.f, 0.f};
    bf16x8 At[4][2], B0[2][2], B1[2][2];
    const char* cA = (const char*)g.A + (size_t)cur.pm * tstep; const char* cB = (const char*)g.Bt + (size_t)cur.pn * tstep;
    S.a_ready(cur);
    if constexpr (SP2) {
        PG8_STAGE(PG8_SB(0, 0), cB, voffB); PG8_STAGE(PG8_SB(0, 1), cB + hstep, voffB); PG8_STAGE(PG8_SA(0, 0), cA, voffA); PG8_STAGE(PG8_SA(0, 1), cA + hstep, voffA);
        if (wr == 1) PG8_BAR;
        PG8_WAIT_V(2); PG8_BAR;
        PG8_STAGE(PG8_SB(1, 0), cB + kstep, voffB); PG8_STAGE(PG8_SA(1, 0), cA + kstep, voffA); PG8_STAGE(PG8_SB(1, 1), cB + hstep + kstep, voffB);
        PG8_WAIT_V(6); PG8_BAR;
    } else {
        PG8_STAGE(PG8_SB(0, 0), cB, voffB); PG8_STAGE(PG8_SA(0, 0), cA, voffA); PG8_STAGE(PG8_SB(0, 1), cB + hstep, voffB); PG8_STAGE(PG8_SA(0, 1), cA + hstep, voffA);
        if (wr == 1) PG8_BAR;
        PG8_WAIT_V(4); PG8_BAR;
        PG8_STAGE(PG8_SB(1, 0), cB + kstep, voffB); PG8_STAGE(PG8_SA(1, 0), cA + kstep, voffA); PG8_STAGE(PG8_SB(1, 1), cB + hstep + kstep, voffB);
        PG8_WAIT_V(6); PG8_BAR;
    }
    for (;;) {
        const bool has_next = S.next(ui + 1, nxt);
        const char* nA = has_next ? (const char*)g.A + (size_t)nxt.pm * tstep : cA; const char* nB = has_next ? (const char*)g.Bt + (size_t)nxt.pn * tstep : cB;
        for (int t = 0; t < nt; t += 2) {
            const bool last = (t == nt - 2);
            const char* a1 = cA + (size_t)(t + 1) * kstep;
            const char* a2 = last ? nA : cA + (size_t)(t + 2) * kstep; const char* b2 = last ? nB : cB + (size_t)(t + 2) * kstep;
            const char* a3 = a2 + kstep; const char* b3 = b2 + kstep;
            if (last && has_next) S.a_ready(nxt);
            if constexpr (SP2) {
            PG8_LDB(B0, 0, 0); PG8_LDB(B1, 0, 1); PG8_SCHED; PG8_LDA(At, 0, 0); PG8_STAGE(PG8_SA(1, 1), a1 + hstep, voffA);
            PG8_WAIT_V(8); PG8_WAIT_L(0); PG8_BAR; PG8_MMA(0, 0, At, B0); PG8_MMA(0, 1, At, B1); PG8_BAR; PG8_SCHED;
            PG8_LDA(At, 0, 1); PG8_STAGE(PG8_SB(0, 0), b2, voffB); PG8_STAGE(PG8_SB(0, 1), b2 + hstep, voffB); PG8_STAGE(PG8_SA(0, 0), a2, voffA);
            PG8_WAIT_V(8); PG8_WAIT_L(0); PG8_BAR; PG8_MMA(1, 0, At, B0); PG8_MMA(1, 1, At, B1); PG8_BAR; PG8_SCHED;
            PG8_LDB(B0, 1, 0); PG8_LDB(B1, 1, 1); PG8_SCHED; PG8_LDA(At, 1, 0); PG8_STAGE(PG8_SA(0, 1), a2 + hstep, voffA);
            PG8_WAIT_V(8); PG8_WAIT_L(0); PG8_BAR; PG8_MMA(0, 0, At, B0); PG8_MMA(0, 1, At, B1); PG8_BAR; PG8_SCHED;
            PG8_LDA(At, 1, 1); PG8_STAGE(PG8_SB(1, 0), b3, voffB); PG8_STAGE(PG8_SB(1, 1), b3 + hstep, voffB); PG8_STAGE(PG8_SA(1, 0), a3, voffA);
            PG8_WAIT_V(8); PG8_WAIT_L(0); PG8_BAR; PG8_MMA(1, 0, At, B0); PG8_MMA(1, 1, At, B1); PG8_BAR; PG8_SCHED;
            } else {
            PG8_LDB(B0, 0, 0); PG8_SCHED; PG8_LDA(At, 0, 0); PG8_STAGE(PG8_SA(1, 1), a1 + hstep, voffA);
            PG8_WAIT_L(8); PG8_BAR; PG8_WAIT_L(0); PG8_MMA(0, 0, At, B0); PG8_BAR; PG8_SCHED;
            PG8_LDB(B1, 0, 1); PG8_STAGE(PG8_SB(0, 0), b2, voffB);
            PG8_BAR; PG8_WAIT_L(0); PG8_MMA(0, 1, At, B1); PG8_BAR;
            PG8_LDA(At, 0, 1); PG8_STAGE(PG8_SA(0, 0), a2, voffA);
            PG8_BAR; PG8_WAIT_L(0); PG8_MMA(1, 0, At, B0); PG8_BAR; PG8_SCHED;
            PG8_STAGE(PG8_SB(0, 1), b2 + hstep, voffB);
            PG8_WAIT_V(6); PG8_BAR; PG8_MMA(1, 1, At, B1); PG8_BAR;
            PG8_LDB(B0, 1, 0); PG8_SCHED; PG8_LDA(At, 1, 0); PG8_STAGE(PG8_SA(0, 1), a2 + hstep, voffA);
            PG8_WAIT_L(8); PG8_BAR; PG8_WAIT_L(0); PG8_MMA(0, 0, At, B0); PG8_BAR; PG8_SCHED;
            PG8_LDB(B1, 1, 1); PG8_STAGE(PG8_SB(1, 0), b3, voffB);
            PG8_BAR; PG8_WAIT_L(0); PG8_MMA(0, 1, At, B1); PG8_BAR;
            PG8_LDA(At, 1, 1); PG8_STAGE(PG8_SA(1, 0), a3, voffA);
            PG8_BAR; PG8_WAIT_L(0); PG8_MMA(1, 0, At, B0); PG8_BAR; PG8_SCHED;
            PG8_STAGE(PG8_SB(1, 1), b3 + hstep, voffB);
            PG8_WAIT_V(6); PG8_BAR; PG8_MMA(1, 1, At, B1); PG8_BAR;
            }
        }
        if constexpr (ALIGN_EPI) { if (wr == 0) PG8_BAR; }
        if constexpr (!Epi::AFTER_DRAIN) { E(acc, cur, wr, wc, fr, fq); S.done(cur); }
        if (!has_next) break;
#pragma unroll
        for (int a = 0; a < 2; ++a)
#pragma unroll
            for (int b = 0; b < 2; ++b)
#pragma unroll
                for (int m = 0; m < 4; ++m)
#pragma unroll
                    for (int n = 0; n < 2; ++n) acc[a][b][m][n] = (f32x4){0.f, 0.f, 0.f, 0.f};
        cur = nxt; cA = nA; cB = nB; ++ui;
        if constexpr (ALIGN_EPI) { if (wr == 1) PG8_BAR; }
    }
    PG8_WAIT_V(0);
    if constexpr (!ALIGN_EPI) { if (wr == 0) PG8_BAR; }
    PG8_BAR;
    if constexpr (Epi::AFTER_DRAIN) { E.fused(acc, cur, wr, wc, fr, fq, lds, wid, lane); S.done(cur); }
#undef PG8_SA
#undef PG8_SB
#undef PG8_STAGE
#undef PG8_LDA
#undef PG8_LDB
#undef PG8_MMA
#undef PG8_WAIT_V
#undef PG8_WAIT_L
#undef PG8_BAR
#undef PG8_SCHED
}
}

constexpr int NB = 8, SEQ = 4096, DM = 1024, NL = 2, FF = 4096, NPROJ = 2724, NPROJ_PAD = 2816, NTILE_PROJ = 11;
constexpr int TOK = NB * SEQ;
static_assert(TOK == pg8::TT, "token count");
constexpr float NORM_EPS = 1e-6f;
constexpr float LOG2E = 1.4426950408889634f;
constexpr int NWAVES = 8;

constexpr size_t MiB = 1u << 20;
constexpr size_t WS_CTL = 0, CTL_ZERO_BYTES = 1 * MiB;
constexpr size_t WS_MOD = 1 * MiB;
constexpr size_t WS_KMEAN = WS_MOD + 512 * 1024;
constexpr size_t WS_W = 2 * MiB;
constexpr size_t W_IN = 0, W_GATE = W_IN + (size_t)NPROJ_PAD * DM, W_BR = W_GATE + (size_t)4 * DM * DM, W_OUT = W_BR + (size_t)4 * DM * 256,
                 W_FF1 = W_OUT + (size_t)DM * DM, W_FF2 = W_FF1 + (size_t)FF * DM, W_LAYER = W_FF2 + (size_t)DM * FF;
constexpr size_t WS_MASK = 70 * MiB;
constexpr size_t WS_H = 86 * MiB;
constexpr size_t WS_Y = 150 * MiB;
constexpr size_t WS_R = 214 * MiB;
constexpr size_t WS_END = 470 * MiB;
static_assert(WS_W + 2 * W_LAYER * 2 <= WS_MASK, "weights fit");
constexpr int CW_BAR = 4096;
constexpr int CW_WQ = 131072;
constexpr int CW_NRM = CW_WQ + 4096;
constexpr int NPHASE = 22;

constexpr int RING_BYTES = 135168;
constexpr int LDSCTL_OFF = RING_BYTES;
constexpr int LDS_BYTES = 147456;

#define GAS __attribute__((address_space(1)))
#define LAS __attribute__((address_space(3)))
typedef unsigned short bf16;
typedef unsigned v4u __attribute__((ext_vector_type(4)));
typedef unsigned v2u __attribute__((ext_vector_type(2)));
typedef float f32x4 __attribute__((ext_vector_type(4)));
typedef float f32x16 __attribute__((ext_vector_type(16)));
typedef short bf16x8 __attribute__((ext_vector_type(8)));
typedef short s16x4 __attribute__((ext_vector_type(4)));
typedef GAS unsigned gu32;
#define RLX_AGENT __ATOMIC_RELAXED, __HIP_MEMORY_SCOPE_AGENT
#define LDS_WAIT() asm volatile("s_waitcnt lgkmcnt(0)" ::: "memory")
__device__ __forceinline__ unsigned f2bf(float f) { unsigned u = __builtin_bit_cast(unsigned, f); return (u + 0x7fffu + ((u >> 16) & 1u)) >> 16; }
__device__ __forceinline__ unsigned pk2(float lo, float hi) { return f2bf(lo) | (f2bf(hi) << 16); }
__device__ __forceinline__ float bf2f(unsigned short b) { return __uint_as_float((unsigned)b << 16); }
__device__ __forceinline__ float bflo(unsigned w) { return __uint_as_float(w << 16); }
__device__ __forceinline__ float bfhi(unsigned w) { return __uint_as_float(w & 0xffff0000u); }

#define XB_TMO      128
#define XB_XCNT(j)  (256  + 64 * (j))
#define XB_XSUB(j)  (1280 + 64 * (j))
#define XB_XGEN(j)  (2304 + 64 * (j))
#define XB_TOP      3328
#define XB_TOPGEN   3392
#define XCD_BAR_WORDS 3456
#define XB_SPIN_CAP (1u << 18)

__device__ __forceinline__ unsigned xb_ld(unsigned* p)              { return __hip_atomic_load(p, __ATOMIC_RELAXED, __HIP_MEMORY_SCOPE_AGENT); }
__device__ __forceinline__ unsigned xb_add(unsigned* p, unsigned v) { return __hip_atomic_fetch_add(p, v, __ATOMIC_RELAXED, __HIP_MEMORY_SCOPE_AGENT); }
__device__ __forceinline__ unsigned xb_xcc_id() { return (unsigned)__builtin_amdgcn_s_getreg((3 << 11) | 20) & 0xFu; }
#define XB_SPIN(cond, bar) do { unsigned _sp = 0; while (cond) { __builtin_amdgcn_s_sleep(1); \
    if ((++_sp & 255u) == 0u) { if (xb_ld(&(bar)[XB_TMO])) break; if (_sp > XB_SPIN_CAP) { atomicAdd(&(bar)[XB_TMO], 1u); break; } } } } while (0)

struct XcdBarrier {
    unsigned* bar; unsigned x;
    volatile LAS unsigned* st;
};

__device__ __forceinline__ XcdBarrier xcd_barrier_post(unsigned* bar, volatile LAS unsigned* st) {
    XcdBarrier b; b.bar = bar; b.x = xb_xcc_id(); b.st = st;
    if (threadIdx.x == 0) (void)xb_add(&bar[XB_XCNT(b.x)], 1u);
    return b;
}
__device__ __forceinline__ void xcd_barrier_complete(unsigned* bar, unsigned x, unsigned& nloc, unsigned& nx) {
    const unsigned G = gridDim.x * gridDim.y * gridDim.z;
    unsigned sum, cnt, mine, sp = 0u;
    for (;;) {
        sum = 0u; cnt = 0u; mine = 0u;
#pragma unroll
        for (unsigned j = 0; j < 16; ++j) { const unsigned c = xb_ld(&bar[XB_XCNT(j)]); sum += c; cnt += (c > 0u) ? 1u : 0u; mine = (j == x) ? c : mine; }
        if (sum == G) break;
        __builtin_amdgcn_s_sleep(1);
        if ((++sp & 255u) == 0u) { if (xb_ld(&bar[XB_TMO])) break; if (sp > XB_SPIN_CAP) { atomicAdd(&bar[XB_TMO], 1u); break; } }
    }
    nloc = mine > 0u ? mine : 1u; nx = cnt > 0u ? cnt : 1u;
}

__device__ __forceinline__ void xcd_barrier(const XcdBarrier& b) {
    asm volatile("s_waitcnt vmcnt(0)" ::: "memory");
    __syncthreads();
    if (threadIdx.x == 0) {
        unsigned* bar = b.bar;
        __builtin_amdgcn_s_waitcnt(0);
        unsigned nloc = b.st[0], nx = b.st[1];
        if (nloc == 0u) { xcd_barrier_complete(bar, b.x, nloc, nx); b.st[0] = nloc; b.st[1] = nx; }
        const unsigned old = xb_add(&bar[XB_XSUB(b.x)], 1u);
        const unsigned gen = old / nloc;
        if (old + 1u == (gen + 1u) * nloc) {
            __builtin_amdgcn_fence(__ATOMIC_RELEASE, "agent");
            asm volatile("s_waitcnt vmcnt(0)" ::: "memory");
            const unsigned og = xb_add(&bar[XB_TOP], 1u);
            const unsigned tg = og / nx;
            if (og + 1u == (tg + 1u) * nx) xb_add(&bar[XB_TOPGEN], 1u);
            else XB_SPIN(xb_ld(&bar[XB_TOPGEN]) == tg, bar);
            __builtin_amdgcn_fence(__ATOMIC_ACQUIRE, "agent");
            xb_add(&bar[XB_XGEN(b.x)], 1u);
            asm volatile("s_waitcnt vmcnt(0)" ::: "memory");
        } else {
            XB_SPIN(xb_ld(&bar[XB_XGEN(b.x)]) == gen, bar);
            __builtin_amdgcn_fence(__ATOMIC_ACQUIRE, "agent");
            asm volatile("s_waitcnt vmcnt(0)" ::: "memory");
        }
    }
    __syncthreads();
}

struct Args {
    const float *x, *c, *w_ada, *b_ada, *norm1_g, *w_in, *diff_lambda, *diff_subln_g, *w_pool, *pool_scale, *w_gate, *b_gate, *w_branch, *w_out, *norm2_g, *w_ff1, *w_ff2, *final_g;
    float* out; unsigned char* ws; int ph_lo, ph_hi, li, pad;
};

__device__ __forceinline__ float shx(float v, int mask, int lane) { return __int_as_float(__builtin_amdgcn_ds_bpermute((lane ^ mask) << 2, __float_as_int(v))); }
__device__ __forceinline__ unsigned shxu(unsigned v, int mask, int lane) { return (unsigned)__builtin_amdgcn_ds_bpermute((lane ^ mask) << 2, (int)v); }
__device__ __forceinline__ unsigned shupu(unsigned v, int delta, int lane) { return (unsigned)__builtin_amdgcn_ds_bpermute(((lane - delta) & 63) << 2, (int)v); }
__device__ __forceinline__ float wave_sum(float v, int lane) {
#pragma unroll
    for (int o = 1; o < 64; o <<= 1) v += shx(v, o, lane);
    return v;
}
__device__ __forceinline__ int crow(int r, int hi) { return (r & 3) + 8 * (r >> 2) + 4 * hi; }
typedef float f32x2_t __attribute__((ext_vector_type(2))); typedef __bf16 bf16x2_t __attribute__((ext_vector_type(2)));
__device__ __forceinline__ unsigned cvtpk(float lo, float hi) { f32x2_t v = {lo, hi}; bf16x2_t b = __builtin_convertvector(v, bf16x2_t); return __builtin_bit_cast(unsigned, b); }

__device__ __forceinline__ int gate_row(int br, int c) { const int pn = c >> 6, ml = c & 63; return 256 * pn + 128 * (br >> 1) + 32 * (ml >> 4) + 8 * ((ml >> 2) & 3) + 4 * (br & 1) + (ml & 3); }
__device__ __forceinline__ void p0_transpose_item(const float* W, int K, int Nsrc, int Npad, bf16* WT, int mode, int br, LAS float* scr, int item, int lane) {
    const int nblk = Npad / 32, kb = item / nblk, nb = item % nblk, k0 = 64 * kb, n0 = 32 * nb;
    const int c4 = lane & 7, kr = lane >> 3, nn = n0 + 4 * c4;
    f32x4 v[8];
#pragma unroll
    for (int i = 0; i < 8; ++i) v[i] = (nn < Nsrc) ? *(const f32x4*)(W + (size_t)(k0 + 8 * i + kr) * Nsrc + nn) : (f32x4){0.f, 0.f, 0.f, 0.f};
#pragma unroll
    for (int i = 0; i < 8; ++i) { LAS float* d = scr + (8 * i + kr) * 33 + 4 * c4; d[0] = v[i][0]; d[1] = v[i][1]; d[2] = v[i][2]; d[3] = v[i][3]; }
    LDS_WAIT(); asm volatile("" ::: "memory");
    const int c = lane & 7;
#pragma unroll
    for (int j = 0; j < 4; ++j) { const int n = (lane >> 3) + 8 * j; const LAS float* s = scr + (8 * c) * 33 + n;
        v4u o; o.x = pk2(s[0 * 33], s[1 * 33]); o.y = pk2(s[2 * 33], s[3 * 33]); o.z = pk2(s[4 * 33], s[5 * 33]); o.w = pk2(s[6 * 33], s[7 * 33]);
        const int drow = (mode == 1) ? gate_row(br, n0 + n) : (n0 + n);
        *(v4u*)(WT + (size_t)drow * K + k0 + 8 * c) = o; }
    LDS_WAIT(); asm volatile("" ::: "memory");
}

template <bool XBF16>
__device__ __forceinline__ void norm_rows_bf16(const void* X, bf16* O, const float* g, const float* mod  , int sh_idx, int sc_idx, int gw, int ngw, int lane_in) {
    int lane = lane_in; asm volatile("" : "+v"(lane));
    for (int m = gw; m < TOK; m += ngw) {
        const int b = m >> 12;
        float v[16]; float s = 0.f;
        if (XBF16) { const v4u* xr = (const v4u*)((const bf16*)X + (size_t)m * DM) + 2 * lane; const v4u a = xr[0], c = xr[1];
            v[0] = bflo(a.x); v[1] = bfhi(a.x); v[2] = bflo(a.y); v[3] = bfhi(a.y); v[4] = bflo(a.z); v[5] = bfhi(a.z); v[6] = bflo(a.w); v[7] = bfhi(a.w);
            v[8] = bflo(c.x); v[9] = bfhi(c.x); v[10] = bflo(c.y); v[11] = bfhi(c.y); v[12] = bflo(c.z); v[13] = bfhi(c.z); v[14] = bflo(c.w); v[15] = bfhi(c.w); }
        else { const f32x4* xr = (const f32x4*)((const float*)X + (size_t)m * DM) + 4 * lane;
#pragma unroll
            for (int j = 0; j < 4; ++j) { const f32x4 t = xr[j]; v[4 * j] = t.x; v[4 * j + 1] = t.y; v[4 * j + 2] = t.z; v[4 * j + 3] = t.w; } }
#pragma unroll
        for (int e = 0; e < 16; ++e) s += v[e] * v[e];
        const float rstd = 1.f / sqrtf(wave_sum(s, lane) * (1.f / DM) + NORM_EPS);
        const f32x4* gp = (const f32x4*)g + 4 * lane;
        const f32x4* shp = (const f32x4*)(mod + (size_t)b * 6144 + sh_idx * 1024) + 4 * lane;
        const f32x4* scp = (const f32x4*)(mod + (size_t)b * 6144 + sc_idx * 1024) + 4 * lane;
        float y[16];
#pragma unroll
        for (int j = 0; j < 4; ++j) { const f32x4 gg = gp[j], sh = shp[j], sc = scp[j];
#pragma unroll
            for (int e = 0; e < 4; ++e) y[4 * j + e] = v[4 * j + e] * rstd * gg[e] * (1.f + sc[e]) + sh[e]; }
        v4u o0, o1;
        o0.x = pk2(y[0], y[1]); o0.y = pk2(y[2], y[3]); o0.z = pk2(y[4], y[5]); o0.w = pk2(y[6], y[7]);
        o1.x = pk2(y[8], y[9]); o1.y = pk2(y[10], y[11]); o1.z = pk2(y[12], y[13]); o1.w = pk2(y[14], y[15]);
        v4u* op = (v4u*)(O + (size_t)m * DM) + 2 * lane; op[0] = o0; op[1] = o1;
    }
}

#ifndef ATT_PD
#define ATT_PD 2
#endif
constexpr int AT_K0 = 0, AT_KSLOT = 9216, AT_V0 = 18432, AT_VSLOT = 12288, AT_SEL = 43008, AT_KM = 44032, AT_END = 47872;
__device__ __forceinline__ s16x4 vtr(LAS const unsigned char* p) { return __builtin_bit_cast(s16x4, __builtin_amdgcn_ds_read_tr16_b64_v4i16((LAS s16x4*)p)); }

#define TRRD(dst, addr, off) asm volatile("ds_read_b64_tr_b16 %0, %1 offset:%2" : "=v"(dst) : "v"(addr), "i"(off) : "memory")
#define SBAR0() __builtin_amdgcn_sched_barrier(0)
__device__ __forceinline__ void softmax_pv(f32x16& s0, f32x16& s1, float& l, f32x16 (&o)[2], LAS const unsigned char* vbase  ) {
    const unsigned va = (unsigned)(uintptr_t)vbase;
    s16x4 vl[2][2][2], vh[2][2][2];
#pragma unroll
    for (int sub = 0; sub < 2; ++sub)
#pragma unroll
        for (int db = 0; db < 2; ++db)
#pragma unroll
            for (int s2 = 0; s2 < 2; ++s2) { TRRD(vl[db][sub][s2], va, (32 * sub + 16 * s2) * 192 + db * 64); TRRD(vh[db][sub][s2], va, (32 * sub + 16 * s2 + 8) * 192 + db * 64); }
    float la = l;
#pragma unroll
    for (int r = 0; r < 16; ++r) { s0[r] = __builtin_amdgcn_exp2f(s0[r]); la += s0[r]; }
    bf16x8 pf[2][2];
#pragma unroll
    for (int s2 = 0; s2 < 2; ++s2) { v4u a;
        a.x = cvtpk(s0[8 * s2 + 0], s0[8 * s2 + 1]); a.y = cvtpk(s0[8 * s2 + 2], s0[8 * s2 + 3]); a.z = cvtpk(s0[8 * s2 + 4], s0[8 * s2 + 5]); a.w = cvtpk(s0[8 * s2 + 6], s0[8 * s2 + 7]);
        pf[0][s2] = __builtin_bit_cast(bf16x8, a); }
    asm volatile("s_waitcnt lgkmcnt(0)" : "+v"(vl[0][0][0]), "+v"(vl[0][0][1]), "+v"(vl[0][1][0]), "+v"(vl[0][1][1]), "+v"(vl[1][0][0]), "+v"(vl[1][0][1]), "+v"(vl[1][1][0]), "+v"(vl[1][1][1]),
                                          "+v"(vh[0][0][0]), "+v"(vh[0][0][1]), "+v"(vh[0][1][0]), "+v"(vh[0][1][1]), "+v"(vh[1][0][0]), "+v"(vh[1][0][1]), "+v"(vh[1][1][0]), "+v"(vh[1][1][1]) :: "memory");
    SBAR0();
#pragma unroll
    for (int g = 0; g < 4; ++g) { const int db = g >> 1, s2 = g & 1;
        const s16x4 lo = vl[db][0][s2], hh = vh[db][0][s2];
        const bf16x8 vf = (bf16x8){lo[0], lo[1], lo[2], lo[3], hh[0], hh[1], hh[2], hh[3]};
        o[db] = __builtin_amdgcn_mfma_f32_32x32x16_bf16(vf, pf[0][s2], o[db], 0, 0, 0);
#pragma unroll
        for (int r = 4 * g; r < 4 * g + 4; ++r) { s1[r] = __builtin_amdgcn_exp2f(s1[r]); la += s1[r]; }
        SBAR0(); }
    l = la;
#pragma unroll
    for (int s2 = 0; s2 < 2; ++s2) { v4u c;
        c.x = cvtpk(s1[8 * s2 + 0], s1[8 * s2 + 1]); c.y = cvtpk(s1[8 * s2 + 2], s1[8 * s2 + 3]); c.z = cvtpk(s1[8 * s2 + 4], s1[8 * s2 + 5]); c.w = cvtpk(s1[8 * s2 + 6], s1[8 * s2 + 7]);
        pf[1][s2] = __builtin_bit_cast(bf16x8, c); }
#pragma unroll
    for (int g = 0; g < 4; ++g) { const int db = g >> 1, s2 = g & 1;
        const s16x4 lo = vl[db][1][s2], hh = vh[db][1][s2];
        const bf16x8 vf = (bf16x8){lo[0], lo[1], lo[2], lo[3], hh[0], hh[1], hh[2], hh[3]};
        o[db] = __builtin_amdgcn_mfma_f32_32x32x16_bf16(vf, pf[1][s2], o[db], 0, 0, 0); }
}
__device__ __forceinline__ void split3(float x, unsigned& h, unsigned& m, unsigned& l) {
    h = f2bf(x); const float r1 = x - __uint_as_float(h << 16); m = f2bf(r1); const float r2 = r1 - __uint_as_float(m << 16); l = f2bf(r2);
}

template <int MODE>
__device__ __forceinline__ void attn_unit(LAS unsigned char* lds, int b, int h, int qb, const bf16* Qb, const bf16* Kb, const bf16* Vb, bf16* Ob, float slope,
                                          const float* kmean, float lam, float post_scale, const float* subg, const unsigned* maskw, const unsigned* nrm  ,
                                          const int* refposg, const int* refming) {
    int tid_l = threadIdx.x; asm volatile("" : "+v"(tid_l)); const int tid = tid_l, lane = tid & 63, wid = __builtin_amdgcn_readfirstlane(tid >> 6), r32 = lane & 31, hi = lane >> 5;
    const int q = qb * 256 + wid * 32 + r32;
    const size_t rowg = (size_t)b * SEQ;
    const float c2 = slope * LOG2E;
    unsigned sel = 0u;
    bf16x8 qf[4];
#pragma unroll
    for (int ds = 0; ds < 4; ++ds) qf[ds] = *(const bf16x8*)(Qb + (rowg + q) * 256 + h * 64 + ds * 16 + hi * 8);
    const int skey = tid >> 3, sch = tid & 7;
    const bf16* ksrc = Kb + (rowg + skey) * 256 + h * 64 + sch * 8;
    const bf16* vsrc = Vb + (rowg + skey) * 256 + h * 64 + sch * 8;
    const int kdst = AT_K0 + skey * 144 + sch * 16, vdst = AT_V0 + skey * 192 + sch * 16;
    const int NT = 4 * qb + 4;
    const float Bq = __uint_as_float(nrm[b * 4 + h]), Bk = __uint_as_float(nrm[32 + b * 4 + h]);
#if defined(PROBE_NOSKIP)
    const float Dskip = 1e9f + 0.f * (Bq + Bk);
#else
    const float Dskip = (150.f + 2.f * sqrtf(Bq * Bk)) / c2;
#endif
    const int koff = r32 * 144 + hi * 16;
    const int vtoff = (4 * hi + ((lane & 15) >> 2)) * 192 + (16 * ((lane >> 4) & 1) + 4 * (lane & 3)) * 2;
    float l1 = 0.f, l2 = 0.f;
    f32x16 oA[2], oB[2];
#pragma unroll
    for (int r = 0; r < 16; ++r) { oA[0][r] = 0.f; oA[1][r] = 0.f; oB[0][r] = 0.f; oB[1][r] = 0.f; }
    const int qmin = qb * 256 + wid * 32, qmax = qmin + 31;
    constexpr int PD = ATT_PD;
    v4u kR[PD], vR[PD]; v2u mR[PD];
    int refpos = q;
    int minref = qb * 256;
    if (MODE == 2) { refpos = refposg[rowg + q]; minref = refming[b * 128 + 8 * qb];
#pragma unroll
        for (int i = 1; i < 8; ++i) { const int v = refming[b * 128 + 8 * qb + i]; minref = v < minref ? v : minref; } }
    int T0 = (int)floorf(((float)minref - Dskip) * (1.f / 64.f)); T0 = T0 < 0 ? 0 : T0; T0 = __builtin_amdgcn_readfirstlane(T0);
    const v4u k0r = *(const v4u*)(ksrc + (size_t)T0 * 64 * 256), v0r = *(const v4u*)(vsrc + (size_t)T0 * 64 * 256);
#pragma unroll
    for (int i = 0; i < PD; ++i) { kR[i] = (v4u){0u, 0u, 0u, 0u}; vR[i] = kR[i]; mR[i] = (v2u){0u, 0u};
        if (T0 + i + 1 < NT) { kR[i] = *(const v4u*)(ksrc + (size_t)(T0 + i + 1) * 64 * 256); vR[i] = *(const v4u*)(vsrc + (size_t)(T0 + i + 1) * 64 * 256);
            if (MODE == 2) mR[i] = *(const v2u*)(maskw + (rowg + q) * 128 + 2 * (T0 + i + 1)); } }
    v2u mw = (v2u){0u, 0u};
    if (MODE == 2) mw = *(const v2u*)(maskw + (rowg + q) * 128 + 2 * T0);
    if (MODE == 0) {
        LAS float* KM = (LAS float*)(lds + AT_KM); LAS unsigned* SEL = (LAS unsigned*)(lds + AT_SEL);
        for (int i = tid; i < qb * 64; i += 512) KM[i] = kmean[(size_t)((b * 4 + h) * 16) * 64 + i];
        __syncthreads();
        if (tid < 256) {
            const bf16* qrow = Qb + (rowg + qb * 256 + tid) * 256 + h * 64;
            float qv[64];
#pragma unroll
            for (int c = 0; c < 8; ++c) { const v4u w = *(const v4u*)(qrow + 8 * c);
                qv[8 * c + 0] = bflo(w.x); qv[8 * c + 1] = bfhi(w.x); qv[8 * c + 2] = bflo(w.y); qv[8 * c + 3] = bfhi(w.y);
                qv[8 * c + 4] = bflo(w.z); qv[8 * c + 5] = bfhi(w.z); qv[8 * c + 6] = bflo(w.w); qv[8 * c + 7] = bfhi(w.w); }
            float v1 = -INFINITY, v2 = -INFINITY, v3 = -INFINITY; int i1 = -1, i2 = -1, i3 = -1;
            for (int n = 0; n < qb; ++n) {
                float g = 0.f;
#pragma unroll
                for (int d = 0; d < 64; ++d) g = __builtin_fmaf(qv[d], KM[n * 64 + d], g);
                if (g > v1) { v3 = v2; i3 = i2; v2 = v1; i2 = i1; v1 = g; i1 = n; }
                else if (g > v2) { v3 = v2; i3 = i2; v2 = g; i2 = n; }
                else if (g > v3) { v3 = g; i3 = n; }
            }
            unsigned sm = 0u; if (i1 >= 0) sm |= 1u << i1; if (i2 >= 0) sm |= 1u << i2; if (i3 >= 0) sm |= 1u << i3;
            SEL[tid] = sm;
        }
        __syncthreads();
        sel = SEL[wid * 32 + r32];
    }
    *(LAS v4u*)(lds + kdst + (T0 & 1) * AT_KSLOT) = k0r; *(LAS v4u*)(lds + vdst + (T0 & 1) * AT_VSLOT) = v0r;
    bf16x8 qaug; v4u ka0, ka1;
    { unsigned a, b2, c; split3(-c2 * (float)refpos, a, b2, c);
      v4u w; if (hi == 0) { w.x = a | (b2 << 16); w.y = c | (0x3f80u << 16); w.z = 0x3f80u | (0x3f80u << 16); w.w = 0u; }
             else { w.x = 0x3f80u | (0x3f80u << 16); w.y = 0x3f80u; w.z = 0u; w.w = 0u; }
      qaug = __builtin_bit_cast(bf16x8, w);
      split3(c2 * (float)r32, a, b2, c); ka0.x = 0x3f80u | (0x3f80u << 16); ka0.y = 0x3f80u | (a << 16); ka0.z = b2 | (c << 16); ka0.w = 0u;
      split3(c2 * (float)(r32 + 32), a, b2, c); ka1.x = ka0.x; ka1.y = 0x3f80u | (a << 16); ka1.z = b2 | (c << 16); ka1.w = 0u; }
    __syncthreads();
#pragma nounroll
    for (int t0 = T0; t0 < NT; t0 += PD) {
#pragma unroll
      for (int u = 0; u < PD; ++u) { const int t = t0 + u; if (t < NT) {
        const int slot = t & 1;
        const int k0 = 64 * t;
        bool active = (k0 <= qmax);
        bool keep = true;
        if (MODE == 0) { const int n = t >> 2; if (n < qb) { keep = ((sel >> n) & 1u) != 0u; active = (__ballot(keep) != 0ull); } }
        if (active) {
            LAS const unsigned char* ks = lds + AT_K0 + slot * AT_KSLOT + koff;
            LAS const unsigned char* vb = lds + AT_V0 + slot * AT_VSLOT + vtoff;
            const int lim = q - k0 - 4 * hi;
            const bool needmask = (k0 + 63 > qmin);
            bf16x8 kaug0, kaug1;
            { unsigned a, b2, c; split3(c2 * (float)k0, a, b2, c);
              v4u w0 = ka0, w1 = ka1; if (hi) { w0.x = a | (b2 << 16); w0.y = c; w0.z = 0u; w1 = w0; }
              kaug0 = __builtin_bit_cast(bf16x8, w0); kaug1 = __builtin_bit_cast(bf16x8, w1); }
#pragma unroll
            for (int mp = 0; mp < (MODE == 1 ? 2 : 1); ++mp) {
                f32x16 s0, s1;
#pragma unroll
                for (int r = 0; r < 16; ++r) { s0[r] = 0.f; s1[r] = 0.f; }
                s0 = __builtin_amdgcn_mfma_f32_32x32x16_bf16(kaug0, qaug, s0, 0, 0, 0);
                s1 = __builtin_amdgcn_mfma_f32_32x32x16_bf16(kaug1, qaug, s1, 0, 0, 0);
#pragma unroll
                for (int dd = 0; dd < (MODE == 1 ? 2 : 4); ++dd) { const int ds = (MODE == 1) ? (2 * mp + dd) : dd;
                    const bf16x8 a0 = *(LAS const bf16x8*)(ks + ds * 32), a1 = *(LAS const bf16x8*)(ks + 32 * 144 + ds * 32);
                    s0 = __builtin_amdgcn_mfma_f32_32x32x16_bf16(a0, qf[ds], s0, 0, 0, 0);
                    s1 = __builtin_amdgcn_mfma_f32_32x32x16_bf16(a1, qf[ds], s1, 0, 0, 0); }
#if defined(PROBE_QK2X)
                { f32x16 d0, d1;
#pragma unroll
                  for (int r = 0; r < 16; ++r) { d0[r] = 0.f; d1[r] = 0.f; }
#pragma unroll
                  for (int dd = 0; dd < (MODE == 1 ? 2 : 4); ++dd) { const int ds = (MODE == 1) ? (2 * mp + dd) : dd;
                    const bf16x8 a0 = *(LAS const bf16x8*)(ks + ds * 32 + 16), a1 = *(LAS const bf16x8*)(ks + 32 * 144 + ds * 32 + 16);
                    d0 = __builtin_amdgcn_mfma_f32_32x32x16_bf16(a0, qf[ds], d0, 0, 0, 0);
                    d1 = __builtin_amdgcn_mfma_f32_32x32x16_bf16(a1, qf[ds], d1, 0, 0, 0); }
                  asm volatile("" :: "v"(d0), "v"(d1)); }
#endif
                if (MODE == 2) {
#pragma unroll
                    for (int r = 0; r < 16; ++r) { const int pos = (r & 3) + 8 * (r >> 2) + 4 * hi;
                        if (!((mw.x >> pos) & 1u)) s0[r] = -INFINITY; if (!((mw.y >> pos) & 1u)) s1[r] = -INFINITY; }
                } else {
                    if (MODE == 0 && !keep) {
#pragma unroll
                        for (int r = 0; r < 16; ++r) { s0[r] = -INFINITY; s1[r] = -INFINITY; }
                    }
                    if (needmask) {
#pragma unroll
                        for (int r = 0; r < 16; ++r) { const int ko = (r & 3) + 8 * (r >> 2);
                            if (ko > lim) s0[r] = -INFINITY; if (ko + 32 > lim) s1[r] = -INFINITY; }
                    }
                }
                if (mp == 0) softmax_pv(s0, s1, l1, oA, vb); else softmax_pv(s0, s1, l2, oB, vb);
            }
        }
        if (t + 1 < NT) { *(LAS v4u*)(lds + kdst + (slot ^ 1) * AT_KSLOT) = kR[u]; *(LAS v4u*)(lds + vdst + (slot ^ 1) * AT_VSLOT) = vR[u];
            if (MODE == 2) mw = mR[u];
            if (t + 1 + PD < NT) { kR[u] = *(const v4u*)(ksrc + (size_t)(t + 1 + PD) * 64 * 256); vR[u] = *(const v4u*)(vsrc + (size_t)(t + 1 + PD) * 64 * 256);
                if (MODE == 2) mR[u] = *(const v2u*)(maskw + (rowg + q) * 128 + 2 * (t + 1 + PD)); } }
        __syncthreads();
#if defined(PROBE_BAR2X)
        __syncthreads();
#endif
      } }
    }
    const float l1t = l1 + shx(l1, 32, lane);
    bf16* orow = Ob + (rowg + q) * 256 + h * 64 + 4 * hi;
    if (MODE == 1) {
        const float l2t = l2 + shx(l2, 32, lane);
        const float i1 = 1.f / l1t, i2 = lam / l2t;
        float ssq = 0.f;
#pragma unroll
        for (int db = 0; db < 2; ++db)
#pragma unroll
            for (int r = 0; r < 16; ++r) { const float v = oA[db][r] * i1 - oB[db][r] * i2; oA[db][r] = v; ssq += v * v; }
        ssq += shx(ssq, 32, lane);
        const float rn = post_scale / sqrtf(ssq * (1.f / 64.f) + NORM_EPS);
#pragma unroll
        for (int db = 0; db < 2; ++db)
#pragma unroll
            for (int g4 = 0; g4 < 4; ++g4) { const f32x4 gg = *(const f32x4*)(subg + 32 * db + 8 * g4 + 4 * hi);
                v2u w; w.x = cvtpk(oA[db][4 * g4 + 0] * rn * gg[0], oA[db][4 * g4 + 1] * rn * gg[1]); w.y = cvtpk(oA[db][4 * g4 + 2] * rn * gg[2], oA[db][4 * g4 + 3] * rn * gg[3]);
                *(v2u*)(orow + 32 * db + 8 * g4) = w; }
    } else {
        const float i1 = 1.f / l1t;
#pragma unroll
        for (int db = 0; db < 2; ++db)
#pragma unroll
            for (int g4 = 0; g4 < 4; ++g4) { v2u w; w.x = cvtpk(oA[db][4 * g4 + 0] * i1, oA[db][4 * g4 + 1] * i1); w.y = cvtpk(oA[db][4 * g4 + 2] * i1, oA[db][4 * g4 + 3] * i1);
                *(v2u*)(orow + 32 * db + 8 * g4) = w; }
    }
    __syncthreads();
}

constexpr int DS_HP = 1025;
constexpr int DS_HIST_BYTES = 32 * DS_HP * 4;
constexpr int DS_BP = 129;
constexpr int DS_G = 0, DS_C = 32 * DS_BP * 4, DS_AUX = DS_HIST_BYTES;
__device__ __forceinline__ float relu_asm(float x) { return __builtin_amdgcn_fmed3f(x, 0.f, __builtin_inff()); }
__device__ __forceinline__ void dsa_scores(const bf16x8 (&iqf)[4][2], const float (&w)[4], const bf16x8 k0, const bf16x8 k1, float (&sc)[16]) {
#pragma unroll
    for (int hh = 0; hh < 4; ++hh) {
        f32x16 x;
#pragma unroll
        for (int r = 0; r < 16; ++r) x[r] = 0.f;
        x = __builtin_amdgcn_mfma_f32_32x32x16_bf16(k0, iqf[hh][0], x, 0, 0, 0);
        x = __builtin_amdgcn_mfma_f32_32x32x16_bf16(k1, iqf[hh][1], x, 0, 0, 0);
#pragma unroll
        for (int r = 0; r < 16; ++r) sc[r] = (hh == 0) ? (w[0] * relu_asm(x[r])) : __builtin_fmaf(w[hh], relu_asm(x[r]), sc[r]);
    }
}
__device__ __forceinline__ unsigned dsa_mono(float s) { const unsigned bits = __float_as_uint(s); return bits ^ ((unsigned)((int)bits >> 31) | 0x80000000u); }
__device__ __forceinline__ unsigned dsa_ckey(float s, unsigned keyidx) { return (dsa_mono(s) & 0xFFFFF000u) | (4095u - keyidx); }
__device__ __forceinline__ unsigned take_low(unsigned w, unsigned n) {
    if (n >= (unsigned)__popc(w)) return w;
    unsigned res = 0u;
    while (n > 0u) { const unsigned low = w & (0u - w); res |= low; w ^= low; --n; }
    return res;
}
template <int PASS>
__device__ __forceinline__ void dsa_hist_pass(LAS unsigned* hist, const bf16x8 (&iqf)[4][2], const float (&w)[4], const bf16* kbase, int qg, int wid, int r32, int hi, int t, unsigned P1) {
    bf16x8 nk0 = *(const bf16x8*)(kbase + (size_t)wid * 32 * 256), nk1 = *(const bf16x8*)(kbase + (size_t)wid * 32 * 256 + 16);
    const unsigned rowb = (unsigned)(r32 * DS_HP * 4);
#pragma nounroll
    for (int j = wid; j <= qg; j += 8) {
        const bf16x8 k0 = nk0, k1 = nk1;
        { const int jn = (j + 8 <= qg) ? j + 8 : j; const bf16* kp = kbase + (size_t)jn * 32 * 256; nk0 = *(const bf16x8*)kp; nk1 = *(const bf16x8*)(kp + 16); }
        float sc[16]; dsa_scores(iqf, w, k0, k1, sc);
#if defined(PROBE_D1_SCORE2X)
        { float sd[16]; dsa_scores(iqf, w, k1, k0, sd);
#pragma unroll
          for (int r = 0; r < 16; ++r) asm volatile("" :: "v"(sd[r])); }
#endif
        const int lim = t - 32 * j - 4 * hi;
        const bool diag = (j == qg);
#pragma unroll
        for (int r = 0; r < 16; ++r) {
            const unsigned mono = dsa_mono(sc[r]);
            unsigned addr;
            if (PASS == 0) { addr = rowb + ((mono >> 22) << 2); if (diag && ((r & 3) + 8 * (r >> 2) > lim)) addr = rowb + 4096u; }
            else { addr = rowb + (((mono >> 12) & 1023u) << 2); if ((mono >> 22) != P1 || (diag && ((r & 3) + 8 * (r >> 2) > lim))) addr = rowb + 4096u; }
            __hip_atomic_fetch_add((LAS unsigned*)((LAS unsigned char*)hist + addr), 1u, __ATOMIC_RELAXED, __HIP_MEMORY_SCOPE_WORKGROUP);
#if defined(PROBE_D1_ATOM2X)
            __hip_atomic_fetch_add((LAS unsigned*)((LAS unsigned char*)hist + rowb + 4096u), 1u, __ATOMIC_RELAXED, __HIP_MEMORY_SCOPE_WORKGROUP);
#endif
        }
    }
}
__device__ __forceinline__ void dsa_scan(LAS unsigned* hist, LAS unsigned* AUX, int pass, int wid, int lane) {
#pragma unroll
    for (int qi = 0; qi < 4; ++qi) {
        const int qq = 4 * wid + qi;
        const unsigned K = (pass == 0) ? 256u : AUX[32 + qq];
        LAS const unsigned* hrow = hist + qq * DS_HP;
        const int wb = 1008 - 16 * lane;
        unsigned s = 0u;
#pragma unroll
        for (int i = 0; i < 16; ++i) s += hrow[wb + ((i + lane) & 15)];
        unsigned incl = s;
#pragma unroll
        for (int o = 1; o < 64; o <<= 1) { const unsigned v = shupu(incl, o, lane); if (lane >= o) incl += v; }
        const unsigned long long bal = __ballot(incl >= K);
        const int L = __builtin_amdgcn_readfirstlane(bal ? (__ffsll((long long)bal) - 1) : 0);
        const unsigned above = (unsigned)__builtin_amdgcn_readlane((int)(incl - s), L);
        const int bin = 1023 - 16 * L - (lane & 15);
        const unsigned c = (lane < 16) ? hrow[bin] : 0u;
        unsigned inc2 = c;
#pragma unroll
        for (int o = 1; o < 16; o <<= 1) { const unsigned v = shupu(inc2, o, lane); if (lane >= o) inc2 += v; }
        const unsigned long long bal2 = __ballot(lane < 16 && above + inc2 >= K);
        const int I = __builtin_amdgcn_readfirstlane(bal2 ? (__ffsll((long long)bal2) - 1) : 0);
        if (lane == I) { AUX[64 * pass + qq] = (unsigned)bin; AUX[64 * pass + 32 + qq] = K - (above + inc2 - c); }
    }
}
__device__ __forceinline__ void dsa_select_unit(LAS unsigned char* lds, int b, int qg, const bf16* IX, unsigned* MASK, int* REFPOS  , int* REFMIN  ) {
    int tid_l = threadIdx.x; asm volatile("" : "+v"(tid_l)); const int tid = tid_l, lane = tid & 63, wid = __builtin_amdgcn_readfirstlane(tid >> 6), r32 = lane & 31, hi = lane >> 5;
    const int t = 32 * qg + r32;
    const size_t rowg = (size_t)b * SEQ;
    const bf16* qrow = IX + (rowg + t) * 256;
    bf16x8 iqf[4][2];
#pragma unroll
    for (int hh = 0; hh < 4; ++hh)
#pragma unroll
        for (int ds = 0; ds < 2; ++ds) iqf[hh][ds] = *(const bf16x8*)(qrow + 32 * hh + 16 * ds + 8 * hi);
    float w[4];
    { const v2u ww = *(const v2u*)(qrow + 160); w[0] = bflo(ww.x); w[1] = bfhi(ww.x); w[2] = bflo(ww.y); w[3] = bfhi(ww.y); }
    LAS unsigned* hist = (LAS unsigned*)lds;
    LAS unsigned* AUX = (LAS unsigned*)(lds + DS_AUX);
    const bf16* kbase = IX + (rowg + r32) * 256 + 128 + 8 * hi;
    unsigned P = 0u;
    const bool all = (qg < 8);
    if (!all) {
        for (int i = tid; i < DS_HIST_BYTES / 16; i += 512) ((LAS v4u*)lds)[i] = (v4u){0u, 0u, 0u, 0u};
#if defined(PROBE_D1_ZERO2X)
        __syncthreads(); for (int i = tid; i < DS_HIST_BYTES / 16; i += 512) ((LAS v4u*)lds)[i] = (v4u){0u, 0u, 0u, 0u}; __syncthreads(); for (int i = tid; i < DS_HIST_BYTES / 16; i += 512) ((LAS v4u*)lds)[i] = (v4u){0u, 0u, 0u, 0u};
#endif
        __syncthreads();
        dsa_hist_pass<0>(hist, iqf, w, kbase, qg, wid, r32, hi, t, 0u);
        __syncthreads();
        dsa_scan(hist, AUX, 0, wid, lane);
#if defined(PROBE_D1_SCAN2X)
        __syncthreads(); dsa_scan(hist, AUX, 0, wid, lane);
#endif
        __syncthreads();
        const unsigned P1 = AUX[r32];
        for (int i = tid; i < DS_HIST_BYTES / 16; i += 512) ((LAS v4u*)lds)[i] = (v4u){0u, 0u, 0u, 0u};
        __syncthreads();
        dsa_hist_pass<1>(hist, iqf, w, kbase, qg, wid, r32, hi, t, P1);
        __syncthreads();
        dsa_scan(hist, AUX, 1, wid, lane);
#if defined(PROBE_D1_SCAN2X)
        __syncthreads(); dsa_scan(hist, AUX, 1, wid, lane);
#endif
        __syncthreads();
        P = (P1 << 10) | AUX[64 + r32];
    }
    if (all) { if (tid < 32) { AUX[64 + 32 + tid] = 0u; } }
    for (int i = tid; i < (2 * 32 * DS_BP * 4) / 16; i += 512) ((LAS v4u*)lds)[i] = (v4u){0u, 0u, 0u, 0u};
    __syncthreads();
    LAS unsigned* G = (LAS unsigned*)(lds + DS_G);
    LAS unsigned* C = (LAS unsigned*)(lds + DS_C);
    bf16x8 nk0, nk1;
    { const int j0 = (wid <= qg) ? wid : 0; nk0 = *(const bf16x8*)(kbase + (size_t)j0 * 32 * 256); nk1 = *(const bf16x8*)(kbase + (size_t)j0 * 32 * 256 + 16); }
#pragma nounroll
    for (int j = wid; j <= qg; j += 8) {
        const bf16x8 k0 = nk0, k1 = nk1;
        { const int jn = (j + 8 <= qg) ? j + 8 : j; const bf16* kp = kbase + (size_t)jn * 32 * 256; nk0 = *(const bf16x8*)kp; nk1 = *(const bf16x8*)(kp + 16); }
        float sc[16]; dsa_scores(iqf, w, k0, k1, sc);
        unsigned bg = 0u, bc = 0u;
        const int lim = t - 32 * j - 4 * hi;
#pragma unroll
        for (int r = 0; r < 16; ++r) {
            const int pos = (r & 3) + 8 * (r >> 2) + 4 * hi;
            const unsigned p22 = dsa_mono(sc[r]) >> 12;
            const bool ok = ((r & 3) + 8 * (r >> 2)) <= lim;
            if (ok && p22 > P) bg |= 1u << pos;
            if (ok && p22 == P) bc |= 1u << pos;
        }
        bg |= shxu(bg, 32, lane); bc |= shxu(bc, 32, lane);
        if (hi == 0) { G[r32 * DS_BP + j] = bg; C[r32 * DS_BP + j] = bc; }
    }
    __syncthreads();
#pragma unroll
    for (int qi = 0; qi < 4; ++qi) {
        const int qq = 4 * wid + qi;
        const unsigned K2 = AUX[64 + 32 + qq];
        const unsigned w0 = C[qq * DS_BP + 2 * lane], w1 = C[qq * DS_BP + 2 * lane + 1];
        const unsigned pc = (unsigned)__popc(w0) + (unsigned)__popc(w1);
        unsigned incl = pc;
#pragma unroll
        for (int o = 1; o < 64; o <<= 1) { const unsigned v = shupu(incl, o, lane); if (lane >= o) incl += v; }
        const unsigned pre = incl - pc;
        unsigned need = K2 > pre ? K2 - pre : 0u;
        const unsigned t0 = take_low(w0, need); need -= (unsigned)__popc(t0);
        const unsigned t1 = take_low(w1, need);
        const unsigned g0 = G[qq * DS_BP + 2 * lane] | t0, g1 = G[qq * DS_BP + 2 * lane + 1] | t1;
        G[qq * DS_BP + 2 * lane] = g0; G[qq * DS_BP + 2 * lane + 1] = g1;
        int hp = g1 ? (64 * lane + 63 - __clz((int)g1)) : (g0 ? (64 * lane + 31 - __clz((int)g0)) : -1);
#pragma unroll
        for (int o = 1; o < 64; o <<= 1) { const int v = (int)shxu((unsigned)hp, o, lane); hp = v > hp ? v : hp; }
        if (lane == 0) { REFPOS[rowg + 32 * qg + qq] = hp; AUX[128 + qq] = (unsigned)hp; }
    }
    __syncthreads();
    if (tid == 0) { int mn = 0x7fffffff; for (int i = 0; i < 32; ++i) { const int v = (int)AUX[128 + i]; mn = v < mn ? v : mn; } REFMIN[b * 128 + qg] = mn; }
    { const int qq = tid >> 4, part = tid & 15;
        unsigned* dst = MASK + (rowg + 32 * qg + qq) * 128 + part * 8;
        v4u a, c2;
        a.x = G[qq * DS_BP + part * 8 + 0]; a.y = G[qq * DS_BP + part * 8 + 1]; a.z = G[qq * DS_BP + part * 8 + 2]; a.w = G[qq * DS_BP + part * 8 + 3];
        c2.x = G[qq * DS_BP + part * 8 + 4]; c2.y = G[qq * DS_BP + part * 8 + 5]; c2.z = G[qq * DS_BP + part * 8 + 6]; c2.w = G[qq * DS_BP + part * 8 + 7];
        *(v4u*)dst = a; *(v4u*)(dst + 4) = c2; }
    __syncthreads();
}

constexpr int PL_U = 0, PL_UP = 528, PL_D = 79 * 528 + 16  , PL_DP = 257;
__device__ __forceinline__ void pool_unit(LAS unsigned char* lds, int b, int tile, const bf16* PU, const float* wpool  , const float* pscale  , bf16* YC) {
    int tid_l = threadIdx.x; asm volatile("" : "+v"(tid_l)); const int tid = tid_l, cb = __builtin_amdgcn_readfirstlane(tid >> 6), tt = tid & 63;
    const int t0 = tile * 64; const size_t rowg = (size_t)b * SEQ;
    for (int i = tid; i < 79 * 32; i += 512) { const int rr = i >> 5, ch = i & 31; const int tok = t0 - 15 + rr;
        v4u v = (v4u){0u, 0u, 0u, 0u}; if (tok >= 0) v = *(const v4u*)(PU + (rowg + tok) * 256 + ch * 8);
        *(LAS v4u*)(lds + PL_U + rr * PL_UP + ch * 16) = v; }
    __syncthreads();
    const int g = cb >> 1, wlen = 2 << g, c0 = 32 * cb, t = t0 + tt;
    const float inv = 1.f / (float)((t + 1 < wlen) ? (t + 1) : wlen);
    LAS float* Dm = (LAS float*)(lds + PL_D);
#pragma unroll
    for (int ch = 0; ch < 4; ++ch) {
        float sum[8];
#pragma unroll
        for (int e = 0; e < 8; ++e) sum[e] = 0.f;
        float self[8];
        for (int i = 0; i < wlen; ++i) {
            const v4u v = *(LAS const v4u*)(lds + PL_U + (15 + tt - i) * PL_UP + (c0 + 8 * ch) * 2);
            const float f[8] = {bflo(v.x), bfhi(v.x), bflo(v.y), bfhi(v.y), bflo(v.z), bfhi(v.z), bflo(v.w), bfhi(v.w)};
#pragma unroll
            for (int e = 0; e < 8; ++e) { sum[e] += f[e]; if (i == 0) self[e] = f[e]; }
        }
#pragma unroll
        for (int e = 0; e < 8; ++e) Dm[tt * PL_DP + c0 + 8 * ch + e] = sum[e] * inv - self[e];
    }
    __syncthreads();
    const int e0 = 32 * (cb & 1);
    float acc[32];
#pragma unroll
    for (int e = 0; e < 32; ++e) acc[e] = 0.f;
    const float* wg = wpool + (size_t)g * 4096 + e0;
    for (int c = 0; c < 64; ++c) {
        const float dv = Dm[tt * PL_DP + 64 * g + c];
        const float* wr = wg + c * 64;
#pragma unroll
        for (int e = 0; e < 32; ++e) acc[e] = __builtin_fmaf(dv, wr[e], acc[e]);
    }
    bf16* orow = YC + (rowg + t) * 256 + 64 * g + e0;
    const float* ps = pscale + 64 * g + e0;
#pragma unroll
    for (int k = 0; k < 4; ++k) { v4u o;
        o.x = pk2(acc[8 * k + 0] * ps[8 * k + 0], acc[8 * k + 1] * ps[8 * k + 1]); o.y = pk2(acc[8 * k + 2] * ps[8 * k + 2], acc[8 * k + 3] * ps[8 * k + 3]);
        o.z = pk2(acc[8 * k + 4] * ps[8 * k + 4], acc[8 * k + 5] * ps[8 * k + 5]); o.w = pk2(acc[8 * k + 6] * ps[8 * k + 6], acc[8 * k + 7] * ps[8 * k + 7]);
        *(v4u*)(orow + 8 * k) = o; }
    __syncthreads();
}
__device__ __forceinline__ void kmean_item(int item, const bf16* AK, float* KMEAN, int wid, int lane_in) {
    int lane = lane_in; asm volatile("" : "+v"(lane));
    const int combo = item * 8 + wid; const int b = combo >> 6, h = (combo >> 4) & 3, n = combo & 15;
    const int ks = lane >> 3, ch = lane & 7;
    const bf16* p = AK + ((size_t)b * SEQ + 256 * n + ks) * 256 + 64 * h + 8 * ch;
    float s[8];
#pragma unroll
    for (int e = 0; e < 8; ++e) s[e] = 0.f;
#pragma unroll 8
    for (int j = 0; j < 32; ++j) { const v4u v = *(const v4u*)(p + (size_t)j * 8 * 256);
        s[0] += bflo(v.x); s[1] += bfhi(v.x); s[2] += bflo(v.y); s[3] += bfhi(v.y); s[4] += bflo(v.z); s[5] += bfhi(v.z); s[6] += bflo(v.w); s[7] += bfhi(v.w); }
#pragma unroll
    for (int e = 0; e < 8; ++e) { s[e] += shx(s[e], 8, lane); s[e] += shx(s[e], 16, lane); s[e] += shx(s[e], 32, lane); }
    if (ks == 0) { float* o = KMEAN + (size_t)combo * 64 + 8 * ch;
        *(f32x4*)o = (f32x4){s[0], s[1], s[2], s[3]} * (1.f / 256.f); *(f32x4*)(o + 4) = (f32x4){s[4], s[5], s[6], s[7]} * (1.f / 256.f); }
}

__device__ __forceinline__ void norm_unit(LAS unsigned char* lds, int n, const bf16* PROJ, size_t TS, unsigned* NRM  ) {
    int tid_l = threadIdx.x; asm volatile("" : "+v"(tid_l)); const int tid = tid_l, lane = tid & 63, wid = __builtin_amdgcn_readfirstlane(tid >> 6);
    const int a = n >> 8, rem = n & 255, sq = rem >> 7, b = (rem >> 4) & 7, c = rem & 15;
    const int tile = (a == 0 ? 0 : (a == 1 ? 3 : 7)) + sq;
    const int row = tid >> 1, hp = tid & 1;
    float ss[2] = {0.f, 0.f};
#pragma unroll
    for (int rr = 0; rr < 1; ++rr) {
        const bf16* p = PROJ + (size_t)tile * TS + ((size_t)b * SEQ + 256 * c + row) * 256 + 128 * hp;
#pragma unroll
        for (int hh = 0; hh < 2; ++hh) { float acc = 0.f;
#pragma unroll
            for (int i = 0; i < 8; ++i) { const v4u v = *(const v4u*)(p + 64 * hh + 8 * i);
                const float f0 = bflo(v.x), f1 = bfhi(v.x), f2 = bflo(v.y), f3 = bfhi(v.y), f4 = bflo(v.z), f5 = bfhi(v.z), f6 = bflo(v.w), f7 = bfhi(v.w);
                acc += (f0 * f0 + f1 * f1) + (f2 * f2 + f3 * f3) + (f4 * f4 + f5 * f5) + (f6 * f6 + f7 * f7); }
            ss[hh] = fmaxf(ss[hh], acc); }
    }
#pragma unroll
    for (int o = 2; o < 64; o <<= 1) { ss[0] = fmaxf(ss[0], shx(ss[0], o, lane)); ss[1] = fmaxf(ss[1], shx(ss[1], o, lane)); }
    LAS float* R = (LAS float*)lds;
    if (lane < 2) { R[wid * 4 + 2 * hp] = ss[0]; R[wid * 4 + 2 * hp + 1] = ss[1]; }
    __syncthreads();
    if (tid < 4) { float m = R[tid];
#pragma unroll
        for (int w2 = 1; w2 < 8; ++w2) m = fmaxf(m, R[w2 * 4 + tid]);
        __hip_atomic_fetch_max(NRM + ((a * 2 + sq) * 8 + b) * 4 + tid, __float_as_uint(m * 1.0001f), __ATOMIC_RELAXED, __HIP_MEMORY_SCOPE_AGENT); }
    __syncthreads();
}

__device__ __forceinline__ float alibi_slope(int idx  ) { return exp2f(-8.f * (float)idx / 12.f); }

__device__ __forceinline__ void p0_adaln(const Args& A, LAS unsigned char* lds, int G) {
    int tid_l = threadIdx.x; asm volatile("" : "+v"(tid_l)); const int tid = tid_l, lane = tid & 63, wid = __builtin_amdgcn_readfirstlane(tid >> 6);
    LAS float* cact = (LAS float*)lds;
    LAS float* red = (LAS float*)(lds + 32768);
    float* MOD = (float*)(A.ws + WS_MOD);
    if ((int)blockIdx.x < 192) {
        for (int i = tid; i < 8192; i += 512) { const int bb = i >> 10, k = i & 1023; const float v = A.c[i]; cact[k * 8 + bb] = v / (1.f + __expf(-v)); }
        __syncthreads();
        for (int u = blockIdx.x; u < 192; u += G) {
            const int l = u / 96, n0 = (u % 96) * 64;
            const float* wp = A.w_ada + ((size_t)l * 1024 + 128 * wid) * 6144 + n0 + lane;
            float acc[8];
#pragma unroll
            for (int bb = 0; bb < 8; ++bb) acc[bb] = 0.f;
#pragma unroll 16
            for (int k = 0; k < 128; ++k) {
                const float wv = wp[(size_t)k * 6144];
                const f32x4 c0 = *(LAS const f32x4*)(cact + (128 * wid + k) * 8), c1 = *(LAS const f32x4*)(cact + (128 * wid + k) * 8 + 4);
                acc[0] += c0[0] * wv; acc[1] += c0[1] * wv; acc[2] += c0[2] * wv; acc[3] += c0[3] * wv;
                acc[4] += c1[0] * wv; acc[5] += c1[1] * wv; acc[6] += c1[2] * wv; acc[7] += c1[3] * wv;
            }
#pragma unroll
            for (int bb = 0; bb < 8; ++bb) red[(wid * 8 + bb) * 64 + lane] = acc[bb];
            __syncthreads();
            { const int bb = wid; float s = A.b_ada[(size_t)l * 6144 + n0 + lane];
#pragma unroll
                for (int w2 = 0; w2 < 8; ++w2) s += red[(w2 * 8 + bb) * 64 + lane];
                MOD[((size_t)l * 8 + bb) * 6144 + n0 + lane] = s; }
            __syncthreads();
        }
    }
    __syncthreads();
}
__device__ __forceinline__ void p0_weights(const Args& A, LAS unsigned char* lds, int vcu, int G, int l0, int l1) {
    int tid_l = threadIdx.x; asm volatile("" : "+v"(tid_l)); const int tid = tid_l, lane = tid & 63, wid = __builtin_amdgcn_readfirstlane(tid >> 6);
    unsigned char* ws = A.ws;
    LAS float* scr = (LAS float*)(lds + wid * 16384);
    const int gw = vcu * NWAVES + wid, NGW = G * NWAVES;
    constexpr int I_IN = 16 * (NPROJ_PAD / 32), I_G1 = 16 * 32, I_BR1 = 4 * 32, I_OUT = 16 * 32, I_F1 = 16 * 128, I_F2 = 64 * 32;
    constexpr int I_LAYER = I_IN + 4 * I_G1 + 4 * I_BR1 + I_OUT + I_F1 + I_F2;
    for (int it = l0 * I_LAYER + gw; it < l1 * I_LAYER; it += NGW) {
        const int l = it / I_LAYER; int r = it % I_LAYER;
        bf16* WL = (bf16*)(ws + WS_W) + (size_t)l * W_LAYER;
        if (r < I_IN) { p0_transpose_item(A.w_in + (size_t)l * DM * NPROJ, DM, NPROJ, NPROJ_PAD, WL + W_IN, 0, 0, scr, r, lane); continue; } r -= I_IN;
        if (r < 4 * I_G1) { const int br = r / I_G1; p0_transpose_item(A.w_gate + ((size_t)l * 4 + br) * DM * DM, DM, DM, DM, WL + W_GATE, 1, br, scr, r % I_G1, lane); continue; } r -= 4 * I_G1;
        if (r < 4 * I_BR1) { const int br = r / I_BR1; p0_transpose_item(A.w_branch + ((size_t)l * 4 + br) * 256 * DM, 256, DM, DM, WL + W_BR + (size_t)br * DM * 256, 0, 0, scr, r % I_BR1, lane); continue; } r -= 4 * I_BR1;
        if (r < I_OUT) { p0_transpose_item(A.w_out + (size_t)l * DM * DM, DM, DM, DM, WL + W_OUT, 0, 0, scr, r, lane); continue; } r -= I_OUT;
        if (r < I_F1) { p0_transpose_item(A.w_ff1 + (size_t)l * DM * FF, DM, FF, FF, WL + W_FF1, 0, 0, scr, r, lane); continue; } r -= I_F1;
        p0_transpose_item(A.w_ff2 + (size_t)l * FF * DM, FF, DM, DM, WL + W_FF2, 0, 0, scr, r, lane);
    }
    __syncthreads();
}

__device__ __forceinline__ int wq_draw(gu32* ctr) { int v = 0; if (threadIdx.x == 0) v = (int)__hip_atomic_fetch_add(ctr, 1u, RLX_AGENT); return v; }
__device__ __forceinline__ int wq_bcast(volatile LAS unsigned* slot, int v) {
    if (threadIdx.x == 0) *slot = (unsigned)v;
    __syncthreads();
    const int item = (int)*slot;
    __syncthreads();
    return item;
}

#ifndef ZG_ALIGN
#define ZG_ALIGN true
#define ZG_SP2 false
#endif
#ifndef IN_ALIGN
#define IN_ALIGN true
#define IN_SP2 true
#endif
#ifndef GT_ALIGN
#define GT_ALIGN true
#define GT_SP2 true
#endif
#ifndef WO_ALIGN
#define WO_ALIGN true
#define WO_SP2 true
#endif
#ifndef F1_ALIGN
#define F1_ALIGN true
#define F1_SP2 true
#endif
#ifndef F2_ALIGN
#define F2_ALIGN true
#define F2_SP2 true
#endif
struct ZOrder {
    pg8::StaticOrder base;
    __device__ __forceinline__ bool next(int i, pg8::Unit& u) const { if (!base.next(i, u)) return false; u.pn += 4 * (u.pm >> 7); return true; }
    __device__ __forceinline__ void a_ready(const pg8::Unit&) const {}
    __device__ __forceinline__ void done(const pg8::Unit&) const {}
};

__global__ void __launch_bounds__(NWAVES * 64, 2) hybrid_fwd(Args args) {
    extern __shared__ __attribute__((aligned(16))) unsigned char lds_raw[];
    LAS unsigned char* lds = (LAS unsigned char*)lds_raw;
#define PHASE_IDS int tid_p = threadIdx.x; asm volatile("" : "+v"(tid_p)); const int lane = tid_p & 63, wid = __builtin_amdgcn_readfirstlane(tid_p >> 6); const int gw = vcu * NWAVES + wid, ngw = G * NWAVES; (void)lane; (void)gw; (void)ngw;
    const int G = gridDim.x; const int bx = blockIdx.x; const int vcu = (G % 8 == 0) ? (bx % 8) * (G / 8) + bx / 8 : bx;
    unsigned char* ws = args.ws;
    gu32* ctl = (gu32*)(ws + WS_CTL);
    volatile LAS unsigned* MISC = (volatile LAS unsigned*)(lds + LDSCTL_OFF);
    for (int u = threadIdx.x; u < (LDS_BYTES - LDSCTL_OFF) / 4; u += NWAVES * 64) ((LAS unsigned*)(lds + LDSCTL_OFF))[u] = 0u;
    __syncthreads();
    const int lo = args.ph_lo, hi = args.ph_hi;
    XcdBarrier bar; bar.bar = (unsigned*)(ctl + CW_BAR) + args.li * XCD_BAR_WORDS; bar.x = 0; bar.st = nullptr;
    if (hi - lo > 1) bar = xcd_barrier_post((unsigned*)(ctl + CW_BAR) + args.li * XCD_BAR_WORDS, MISC + 8);
#ifndef PHASE_OFF
#define PHASE_OFF 0
#endif
#define IN(k) (lo <= (k) && (k) < hi && !((PHASE_OFF >> ((k) == 0 ? 0 : (k) == 21 ? 11 : (((k) - 1) % 10) + 1)) & 1))
#ifndef REPEAT_MASK
#define REPEAT_MASK 0
#endif
#define NREP(bit) (((REPEAT_MASK >> (bit)) & 1) ? 2 : 1)
#if defined(PROBE_SEAM2X)
#define SEAM(k) do { if (IN(k) && IN((k) + 1)) { xcd_barrier(bar); xcd_barrier(bar); } } while (0)
#else
#define SEAM(k) do { if (IN(k) && IN((k) + 1)) xcd_barrier(bar); } while (0)
#endif
    float* MOD = (float*)(ws + WS_MOD);
    float* KMEAN = (float*)(ws + WS_KMEAN);
    int* REFPOS = (int*)(ws + WS_KMEAN + 128 * 1024);
    int* REFMIN = (int*)(ws + WS_KMEAN + 256 * 1024);
    unsigned* MASK = (unsigned*)(ws + WS_MASK);
    bf16* H = (bf16*)(ws + WS_H);
    bf16* Y = (bf16*)(ws + WS_Y);
    bf16* MERGED = (bf16*)(ws + WS_Y);
    bf16* PROJ = (bf16*)(ws + WS_R);
    bf16* Z = (bf16*)(ws + WS_R);
    bf16* U = (bf16*)(ws + WS_R);
    bf16* XRB = (bf16*)args.out;
    constexpr size_t TS = (size_t)TOK * 256;
    volatile LAS unsigned* wqslot = MISC + 16;

    if (IN(0)) for (int rep = 0; rep < NREP(0); ++rep) { p0_adaln(args, lds, G); }
    SEAM(0);

#pragma nounroll
    for (int l = 0; l < NL; ++l) {
        const int pb = 1 + 10 * l;
        const float* modl = MOD + (size_t)l * 8 * 6144;
        const bf16* WL = (const bf16*)(ws + WS_W) + (size_t)l * W_LAYER;
        if (IN(pb + 0)) for (int rep = 0; rep < NREP(1); ++rep) { PHASE_IDS if (l == 0) norm_rows_bf16<false>(args.x, H, args.norm1_g + (size_t)l * DM, modl, 0, 1, gw, ngw, lane); else norm_rows_bf16<true>(XRB, H, args.norm1_g + (size_t)l * DM, modl, 0, 1, gw, ngw, lane); if (l == 0) p0_weights(args, lds, vcu, G, 0, 1); }
        SEAM(pb + 0);
        if (IN(pb + 1)) for (int rep = 0; rep < NREP(2); ++rep) {
            pg8::Gemm g{H, WL + W_IN, TOK, NPROJ_PAD, DM}; pg8::StaticOrder S; S.init(TOK, NPROJ_PAD, G, bx);
            pg8::EpiProj E{PROJ, TS};
            pg8::gemm_phase<pg8::EpiProj, pg8::StaticOrder, IN_ALIGN, IN_SP2>(lds, g, S, E);
            if (l == 0 && rep == 0 && bx >= 128) p0_weights(args, lds, bx - 128, G - 128, 1, 2);
        }
        SEAM(pb + 1);
        unsigned* NRM = (unsigned*)(ctl + CW_NRM) + l * 192;
        if (IN(pb + 2)) for (int rep = 0; rep < NREP(3); ++rep) {
            gu32* ctr = ctl + CW_WQ + (l * 2 + 0 + 4 * rep) * 64;
            int raw = wq_draw(ctr);
            for (;;) {
#ifndef REPA_LO
#define REPA_LO 0
#define REPA_HI 2368
#endif
                const int item = wq_bcast(wqslot, raw) + (rep ? REPA_LO : 0);
                if (item >= (rep ? REPA_HI : 2368)) break;
                raw = wq_draw(ctr);
                if (item < 1024) { const int qg = 127 - (item >> 3), b = item & 7;
                    dsa_select_unit(lds, b, qg, PROJ + 10 * TS, MASK, REFPOS, REFMIN);
                } else if (item < 1536) { const int i2 = item - 1024; const int b = i2 >> 6, tile = i2 & 63;
                    pool_unit(lds, b, tile, PROJ + 6 * TS, args.w_pool + (size_t)l * 4 * 4096, args.pool_scale + (size_t)l * 256, Y + 2 * TS);
                } else if (item < 1600) { PHASE_IDS kmean_item(item - 1536, PROJ + 1 * TS, KMEAN, wid, lane);
                } else { norm_unit(lds, item - 1600, PROJ, TS, NRM); }
            }
        }
        SEAM(pb + 2);
        if (IN(pb + 3)) for (int rep = 0; rep < NREP(4); ++rep) {
            gu32* ctr = ctl + CW_WQ + 512 + ((l * 2 + rep) * 8) * 64;
            const float li = 0.8f - 0.6f * __expf(-0.3f * (float)l);
            const float* dl = args.diff_lambda + (size_t)l * 128;
            float d1 = 0.f, d2 = 0.f;
            for (int i = 0; i < 32; ++i) { d1 += dl[i] * dl[32 + i]; d2 += dl[64 + i] * dl[96 + i]; }
            const float lam = __expf(d1) - __expf(d2) + li;
            int raw = wq_draw(ctr);
            for (;;) {
                const int item = wq_bcast(wqslot, raw);
                if (item >= 1536) break;
                raw = wq_draw(ctr);
                const int ty = item % 3, rest = item / 3; const int qb = 15 - (rest >> 5), bh = rest & 31, b = bh >> 2, h = bh & 3;
                if (ty == 0) attn_unit<1>(lds, b, h, qb, PROJ + 3 * TS, PROJ + 4 * TS, PROJ + 5 * TS, Y + 1 * TS, alibi_slope(3 * h + 2), nullptr, lam, 1.f - li, args.diff_subln_g + (size_t)l * 64, nullptr, NRM + 64, nullptr, nullptr);
                else if (ty == 1) attn_unit<0>(lds, b, h, qb, PROJ + 0 * TS, PROJ + 1 * TS, PROJ + 2 * TS, Y + 0 * TS, alibi_slope(3 * h + 1), KMEAN, 0.f, 0.f, nullptr, nullptr, NRM, nullptr, nullptr);
                else              attn_unit<2>(lds, b, h, qb, PROJ + 7 * TS, PROJ + 8 * TS, PROJ + 9 * TS, Y + 3 * TS, alibi_slope(3 * h + 3), nullptr, 0.f, 0.f, nullptr, MASK, NRM + 128, REFPOS, REFMIN);
            }
        }
        SEAM(pb + 3);
        if (IN(pb + 4)) for (int rep = 0; rep < NREP(5); ++rep) {
            int kz = 256; asm volatile("" : "+s"(kz)); pg8::Gemm g{Y, WL + W_BR, 4 * TOK, 4096, kz}; ZOrder S; S.base.init(4 * TOK, DM, G, bx);
            pg8::EpiZ E{Z};
            pg8::gemm_phase<pg8::EpiZ, ZOrder, ZG_ALIGN, ZG_SP2>(lds, g, S, E);
        }
        SEAM(pb + 4);
        if (IN(pb + 5)) for (int rep = 0; rep < NREP(6); ++rep) {
            pg8::Gemm g{H, WL + W_GATE, TOK, 4096, DM}; pg8::StaticOrder S; S.init(TOK, 4096, G, bx);
            pg8::EpiGate E{Z, args.b_gate + (size_t)l * 4 * DM, MERGED};
            pg8::gemm_phase<pg8::EpiGate, pg8::StaticOrder, GT_ALIGN, GT_SP2>(lds, g, S, E);
        }
        SEAM(pb + 5);
        if (IN(pb + 6)) for (int rep = 0; rep < NREP(7); ++rep) {
            pg8::Gemm g{MERGED, WL + W_OUT, TOK, DM, DM}; pg8::StaticOrder S; S.init(TOK, DM, G, bx);
            if (l == 0) { pg8::EpiResid<false> E{args.x, rep ? (bf16*)(ws + WS_R) : XRB, modl + 2 * 1024};
                pg8::gemm_phase<pg8::EpiResid<false>, pg8::StaticOrder, WO_ALIGN, WO_SP2>(lds, g, S, E); }
            else { pg8::EpiResid<true> E{XRB, rep ? (bf16*)(ws + WS_R) : XRB, modl + 2 * 1024};
                pg8::gemm_phase<pg8::EpiResid<true>, pg8::StaticOrder, WO_ALIGN, WO_SP2>(lds, g, S, E); }
        }
        SEAM(pb + 6);
        if (IN(pb + 7)) for (int rep = 0; rep < NREP(8); ++rep) { PHASE_IDS norm_rows_bf16<true>(XRB, H, args.norm2_g + (size_t)l * DM, modl, 3, 4, gw, ngw, lane); }
        SEAM(pb + 7);
        if (IN(pb + 8)) for (int rep = 0; rep < NREP(9); ++rep) {
            pg8::Gemm g{H, WL + W_FF1, TOK, FF, DM}; pg8::StaticOrder S; S.init(TOK, FF, G, bx);
            pg8::EpiRelu2 E{U, FF};
            pg8::gemm_phase<pg8::EpiRelu2, pg8::StaticOrder, F1_ALIGN, F1_SP2>(lds, g, S, E);
        }
        SEAM(pb + 8);
        if (IN(pb + 9)) for (int rep = 0; rep < NREP(10); ++rep) {
            pg8::Gemm g{U, WL + W_FF2, TOK, DM, FF}; pg8::StaticOrder S; S.init(TOK, DM, G, bx);
            pg8::EpiResid<true> E{XRB, rep ? (bf16*)(ws + WS_MASK) : XRB, modl + 5 * 1024};
            pg8::gemm_phase<pg8::EpiResid<true>, pg8::StaticOrder, F2_ALIGN, F2_SP2>(lds, g, S, E);
        }
        SEAM(pb + 9);
    }
    if (IN(21)) {
        PHASE_IDS
        v4u xa[16], xb[16]; float rs[16];
        const v4u* xp = (const v4u*)(XRB + (size_t)gw * DM) + 2 * lane;
#pragma unroll
        for (int i = 0; i < 16; ++i) { xa[i] = xp[(size_t)i * ngw * (DM / 8)]; xb[i] = xp[(size_t)i * ngw * (DM / 8) + 1]; }
#pragma unroll
        for (int i = 0; i < 16; ++i) { const v4u a = xa[i], c = xb[i];
            float s = bflo(a.x) * bflo(a.x); s += bfhi(a.x) * bfhi(a.x); s += bflo(a.y) * bflo(a.y); s += bfhi(a.y) * bfhi(a.y); s += bflo(a.z) * bflo(a.z); s += bfhi(a.z) * bfhi(a.z); s += bflo(a.w) * bflo(a.w); s += bfhi(a.w) * bfhi(a.w);
            s += bflo(c.x) * bflo(c.x); s += bfhi(c.x) * bfhi(c.x); s += bflo(c.y) * bflo(c.y); s += bfhi(c.y) * bfhi(c.y); s += bflo(c.z) * bflo(c.z); s += bfhi(c.z) * bfhi(c.z); s += bflo(c.w) * bflo(c.w); s += bfhi(c.w) * bfhi(c.w);
            rs[i] = 1.f / sqrtf(wave_sum(s, lane) * (1.f / DM) + NORM_EPS); }
        xcd_barrier(bar);
#pragma unroll
        for (int i = 0; i < 16; ++i) asm volatile("" : "+v"(xa[i]), "+v"(xb[i]));
        const f32x4* gp = (const f32x4*)args.final_g + 4 * lane;
        f32x4* op = (f32x4*)(args.out + (size_t)gw * DM) + 4 * lane;
#pragma unroll
        for (int i = 0; i < 16; ++i) { const v4u a = xa[i], c = xb[i]; const float r = rs[i]; f32x4* o = op + (size_t)i * ngw * (DM / 4);
            o[0] = (f32x4){bflo(a.x), bfhi(a.x), bflo(a.y), bfhi(a.y)} * r * gp[0]; o[1] = (f32x4){bflo(a.z), bfhi(a.z), bflo(a.w), bfhi(a.w)} * r * gp[1];
            o[2] = (f32x4){bflo(c.x), bfhi(c.x), bflo(c.y), bfhi(c.y)} * r * gp[2]; o[3] = (f32x4){bflo(c.z), bfhi(c.z), bflo(c.w), bfhi(c.w)} * r * gp[3]; }
    }
#undef IN
#undef SEAM
}

#ifndef MK_SPLIT
#define MK_SPLIT 0
#endif
extern "C" void kernel_launch(void* const* d_in, const int* in_sizes, int n_in, void* d_out, int out_size, void* d_ws, size_t ws_size, hipStream_t stream) {
    static int grid = 0;
    if (grid == 0) {
        if (n_in != 18 || in_sizes[0] != TOK * DM || out_size != TOK * DM || ws_size < WS_END) { fprintf(stderr, "kernel_launch: unexpected shapes (n_in %d, in0 %d, out %d, ws %zu)\n", n_in, n_in > 0 ? in_sizes[0] : -1, out_size, ws_size); grid = -1; return; }
        int dev = 0, cus = 0, per_cu = 0;
        if (hipGetDevice(&dev) != hipSuccess || hipDeviceGetAttribute(&cus, hipDeviceAttributeMultiprocessorCount, dev) != hipSuccess) { grid = -1; return; }
        if (hipFuncSetAttribute((const void*)hybrid_fwd, hipFuncAttributeMaxDynamicSharedMemorySize, LDS_BYTES) != hipSuccess) { fprintf(stderr, "kernel_launch: hipFuncSetAttribute failed\n"); grid = -1; return; }
        if (hipOccupancyMaxActiveBlocksPerMultiprocessor(&per_cu, (const void*)hybrid_fwd, NWAVES * 64, LDS_BYTES) != hipSuccess || per_cu < 1) fprintf(stderr, "kernel_launch: occupancy query reports %d\n", per_cu);
        (void)hipGetLastError();
        grid = cus;
        if (cus != 256) { fprintf(stderr, "kernel_launch: built for 256 CUs (the final norm stages 16 rows per wave), found %d\n", cus); grid = -1; return; }
    }
    if (grid < 0) return;
    if (hipMemsetAsync((char*)d_ws + WS_CTL, 0, CTL_ZERO_BYTES, stream) != hipSuccess) return;
    Args a{};
    const float** ap = (const float**)&a;
    for (int i = 0; i < 18; ++i) ap[i] = (const float*)d_in[i];
    a.out = (float*)d_out; a.ws = (unsigned char*)d_ws; a.pad = 0;
#if MK_SPLIT
    for (int p = 0; p < NPHASE; ++p) { a.ph_lo = p; a.ph_hi = p + 1; a.li = 0;
        hipLaunchKernelGGL(hybrid_fwd, dim3(grid), dim3(NWAVES * 64), LDS_BYTES, stream, a); }
#else
    a.ph_lo = 0; a.ph_hi = NPHASE; a.li = 0;
    hipLaunchKernelGGL(hybrid_fwd, dim3(grid), dim3(NWAVES * 64), LDS_BYTES, stream, a);
#endif
}
```

```cpp
#include <hip/hip_runtime.h>
#include <cstdio>
#include <cstdint>
namespace pg8 {
#define PG8_LAS __attribute__((address_space(3)))
typedef unsigned short bf16_t;
typedef short bf16x8 __attribute__((ext_vector_type(8)));
typedef float f32x4 __attribute__((ext_vector_type(4)));
typedef unsigned u32x4 __attribute__((ext_vector_type(4)));
constexpr int BM = 256, BK = 64, HALF = 128, HTB = HALF * BK * 2  , STAGE_BYTES = 8 * HTB, NXCD = 8, WGM = 8;

__host__ __device__ __forceinline__ int lds_byte(int r, int c) { const int st = (r >> 4) * 2 + (c >> 5), rr = r & 15, cc = c & 31, ob = rr * 64 + cc * 2; return st * 1024 + (ob ^ (((ob >> 9) & 1) << 5)); }
__host__ __device__ __forceinline__ void stage_rc(int b, int& R, int& C) { const int st = b / 1024, sb = b % 1024, swz = sb ^ (((sb >> 9) & 1) << 5); R = (st >> 1) * 16 + swz / 64; C = (st & 1) * 32 + (swz % 64) / 2; }
__host__ __device__ __forceinline__ int perm32(int rho) { const int n = rho >> 4, i = rho & 15; return 8 * (i >> 2) + 4 * n + (i & 3); }

struct Unit { int pm, pn; };
struct Gemm { const bf16_t* A; const bf16_t* Bt; int M, N, K; };

struct StaticOrder {
    int nM, nN, nwg, G, c;
    __host__ __device__ void init(int M, int N, int G_, int c_) { nM = M / BM; nN = N / BM; nwg = nM * nN; G = G_; c = c_; }
    __host__ __device__ bool next(int i, Unit& u) const {
        const long L = (long)i * G + c; if (L >= nwg) return false;
        int wgid = (int)L; { const int q = nwg / NXCD, r = nwg % NXCD, xcd = wgid % NXCD, off = wgid / NXCD; wgid = (xcd < r ? xcd * (q + 1) : r * (q + 1) + (xcd - r) * q) + off; }
        const int nig = WGM * nN, gid = wgid / nig, fm = gid * WGM, gsz = (nM - fm) < WGM ? (nM - fm) : WGM;
        u.pm = fm + ((wgid % nig) % gsz); u.pn = (wgid % nig) / gsz; return true;
    }
    __device__ __forceinline__ void a_ready(const Unit&) const {}
    __device__ __forceinline__ void done(const Unit&) const {}
};

__device__ __forceinline__ unsigned cvt_pk_bf16(float lo, float hi) { unsigned r; asm volatile("v_cvt_pk_bf16_f32 %0, %1, %2" : "=v"(r) : "v"(lo), "v"(hi)); return r; }
typedef unsigned u32x2 __attribute__((ext_vector_type(2)));
constexpr int TT = 32768;
constexpr float QS64 = 0.125f * 1.4426950408889634f;
constexpr float QS32 = 0.17677669529663687f * 1.4426950408889634f;

struct EpiProj {
    static constexpr bool PERM = true, AFTER_DRAIN = false;
    bf16_t* O; size_t tile_stride;
    __device__ __forceinline__ void operator()(const f32x4 (&acc)[2][2][4][2], const Unit& u, int wr, int wc, int fr, int fq) const {
        const int row0 = u.pm * BM + wr * 64 + fr; bf16_t* base = O + (size_t)u.pn * tile_stride;
        float sc = 1.f; if (u.pn == 0 || u.pn == 7) sc = QS64; else if (u.pn == 3) sc = QS32;
        const int col0 = wc * 32 + 8 * fq;
#pragma unroll
        for (int ai = 0; ai < 2; ++ai)
#pragma unroll
            for (int m = 0; m < 4; ++m) { bf16_t* rowp = base + (size_t)(row0 + ai * HALF + m * 16) * 256 + col0;
#pragma unroll
                for (int bj = 0; bj < 2; ++bj) { const f32x4 v0 = acc[ai][bj][m][0] * sc, v1 = acc[ai][bj][m][1] * sc;
                    u32x4 w; w.x = cvt_pk_bf16(v0[0], v0[1]); w.y = cvt_pk_bf16(v0[2], v0[3]); w.z = cvt_pk_bf16(v1[0], v1[1]); w.w = cvt_pk_bf16(v1[2], v1[3]);
                    *(u32x4*)(rowp + bj * HALF) = w; } }
    }
};
struct EpiZ {
    static constexpr bool PERM = true, AFTER_DRAIN = false;
    unsigned char* O;
    __device__ __forceinline__ void operator()(const f32x4 (&acc)[2][2][4][2], const Unit& u, int wr, int wc, int fr, int fq) const {
        const int row0 = u.pm * BM + wr * 64 + fr; const int col0 = (u.pn & 3) * BM + wc * 32 + 8 * fq;
#pragma unroll
        for (int ai = 0; ai < 2; ++ai)
#pragma unroll
            for (int m = 0; m < 4; ++m) { unsigned char* rowp = O + (size_t)(row0 + ai * HALF + m * 16) * 1024 + col0;
#pragma unroll
                for (int bj = 0; bj < 2; ++bj) { const f32x4 v0 = acc[ai][bj][m][0], v1 = acc[ai][bj][m][1];
                    int w0 = __builtin_amdgcn_cvt_pk_fp8_f32(v0[0], v0[1], 0, false); w0 = __builtin_amdgcn_cvt_pk_fp8_f32(v0[2], v0[3], w0, true);
                    int w1 = __builtin_amdgcn_cvt_pk_fp8_f32(v1[0], v1[1], 0, false); w1 = __builtin_amdgcn_cvt_pk_fp8_f32(v1[2], v1[3], w1, true);
                    u32x2 w; w.x = (unsigned)w0; w.y = (unsigned)w1;
                    *(u32x2*)(rowp + bj * HALF) = w; } }
    }
};
struct EpiRelu2 {
    static constexpr bool PERM = true, AFTER_DRAIN = false;
    bf16_t* O; int ldc;
    __device__ __forceinline__ void operator()(const f32x4 (&acc)[2][2][4][2], const Unit& u, int wr, int wc, int fr, int fq) const {
        const int row0 = u.pm * BM + wr * 64 + fr; const int col0 = u.pn * BM + wc * 32 + 8 * fq;
#pragma unroll
        for (int ai = 0; ai < 2; ++ai)
#pragma unroll
            for (int m = 0; m < 4; ++m) { bf16_t* rowp = O + (size_t)(row0 + ai * HALF + m * 16) * ldc + col0;
#pragma unroll
                for (int bj = 0; bj < 2; ++bj) { f32x4 v0 = acc[ai][bj][m][0], v1 = acc[ai][bj][m][1];
#pragma unroll
                    for (int j = 0; j < 4; ++j) { const float a = fmaxf(v0[j], 0.f), b = fmaxf(v1[j], 0.f); v0[j] = a * a; v1[j] = b * b; }
                    u32x4 w; w.x = cvt_pk_bf16(v0[0], v0[1]); w.y = cvt_pk_bf16(v0[2], v0[3]); w.z = cvt_pk_bf16(v1[0], v1[1]); w.w = cvt_pk_bf16(v1[2], v1[3]);
                    *(u32x4*)(rowp + bj * HALF) = w; } }
    }
};
template <bool BASE_BF16> struct EpiResid {
    static constexpr bool PERM = true, AFTER_DRAIN = false;
    const void* base; bf16_t* out; const float* gate;
    __device__ __forceinline__ void operator()(const f32x4 (&acc)[2][2][4][2], const Unit& u, int wr, int wc, int fr, int fq) const {
        const int row0 = u.pm * BM + wr * 64 + fr; const int col0 = u.pn * BM + wc * 32 + 8 * fq;
        const float* gp = gate + (size_t)(u.pm >> 4) * 6144 + col0;
        f32x4 gv[2][2];
#pragma unroll
        for (int bj = 0; bj < 2; ++bj)
#pragma unroll
            for (int n = 0; n < 2; ++n) gv[bj][n] = *(const f32x4*)(gp + bj * HALF + n * 4);
#pragma unroll
        for (int ai = 0; ai < 2; ++ai)
#pragma unroll
            for (int m = 0; m < 4; ++m) { const size_t off = (size_t)(row0 + ai * HALF + m * 16) * 1024 + col0;
#pragma unroll
                for (int bj = 0; bj < 2; ++bj) { f32x4 b0, b1;
                    if (BASE_BF16) { const u32x4 w = *(const u32x4*)((const bf16_t*)base + off + bj * HALF);
                        b0 = (f32x4){__uint_as_float(w.x << 16), __uint_as_float(w.x & 0xffff0000u), __uint_as_float(w.y << 16), __uint_as_float(w.y & 0xffff0000u)};
                        b1 = (f32x4){__uint_as_float(w.z << 16), __uint_as_float(w.z & 0xffff0000u), __uint_as_float(w.w << 16), __uint_as_float(w.w & 0xffff0000u)}; }
                    else { b0 = *(const f32x4*)((const float*)base + off + bj * HALF); b1 = *(const f32x4*)((const float*)base + off + bj * HALF + 4); }
                    const f32x4 v0 = b0 + gv[bj][0] * acc[ai][bj][m][0], v1 = b1 + gv[bj][1] * acc[ai][bj][m][1];
                    u32x4 o; o.x = cvt_pk_bf16(v0[0], v0[1]); o.y = cvt_pk_bf16(v0[2], v0[3]); o.z = cvt_pk_bf16(v1[0], v1[1]); o.w = cvt_pk_bf16(v1[2], v1[3]);
                    *(u32x4*)(out + off + bj * HALF) = o; }
                if (m & 1) asm volatile("" ::: "memory"); }
    }
};
struct EpiGate {
    static constexpr bool PERM = true, AFTER_DRAIN = false;
    const unsigned char* Z; const float* bg; bf16_t* O;
    __device__ __forceinline__ void operator()(const f32x4 (&acc)[2][2][4][2], const Unit& u, int wr, int wc, int fr, int fq) const {
        const int row0 = u.pm * BM + wr * 64 + fr; const int mc0 = u.pn * 64 + wc * 16 + 4 * fq;
        f32x4 bv[2][2];
#pragma unroll
        for (int bj = 0; bj < 2; ++bj)
#pragma unroll
            for (int n = 0; n < 2; ++n) bv[bj][n] = *(const f32x4*)(bg + (2 * bj + n) * 1024 + mc0);
#pragma unroll
        for (int ai = 0; ai < 2; ++ai)
#pragma unroll
            for (int m = 0; m < 4; ++m) { const size_t row = (size_t)(row0 + ai * HALF + m * 16);
                f32x4 sum = (f32x4){0.f, 0.f, 0.f, 0.f};
#pragma unroll
                for (int bj = 0; bj < 2; ++bj)
#pragma unroll
                    for (int n = 0; n < 2; ++n) { const int zr = *(const int*)(Z + ((size_t)(2 * bj + n) * TT + row) * 1024 + mc0);
                        const f32x4 x = acc[ai][bj][m][n] + bv[bj][n]; f32x4 zz;
                        zz[0] = __builtin_amdgcn_cvt_f32_fp8(zr, 0); zz[1] = __builtin_amdgcn_cvt_f32_fp8(zr, 1); zz[2] = __builtin_amdgcn_cvt_f32_fp8(zr, 2); zz[3] = __builtin_amdgcn_cvt_f32_fp8(zr, 3);
#pragma unroll
                        for (int j = 0; j < 4; ++j) { const float g = __builtin_amdgcn_rcpf(1.f + __builtin_amdgcn_exp2f(-1.4426950408889634f * x[j])); sum[j] += g * zz[j]; } }
                u32x2 w; w.x = cvt_pk_bf16(sum[0], sum[1]); w.y = cvt_pk_bf16(sum[2], sum[3]);
                *(u32x2*)(O + row * 1024 + mc0) = w; }
    }
};
template <class Epi, class Sched, bool ALIGN_EPI = false, bool SP2 = false>
__device__ __forceinline__ void gemm_phase(PG8_LAS unsigned char* lds, const Gemm g, const Sched& S, const Epi& E) {
    int tid_l = threadIdx.x; asm volatile("" : "+v"(tid_l)); const int tid = tid_l, wid = __builtin_amdgcn_readfirstlane(tid >> 6), lane = tid & 63, wr = wid >> 2, wc = wid & 3, fr = lane & 15, fq = lane >> 4;
    const int K = g.K, nt = K / BK;
    unsigned voffA[2], voffB[2];
#pragma unroll
    for (int i = 0; i < 2; ++i) { int R, C; stage_rc(tid * 16 + i * 8192, R, C); const int Rb = Epi::PERM ? ((R & ~31) + perm32(R & 31)) : R;
        voffA[i] = (unsigned)(R * K + C) * 2u; voffB[i] = (unsigned)(Rb * K + C) * 2u; }
    const size_t kstep = (size_t)(BK * 2);
    const size_t hstep = (size_t)HALF * K * 2;
    const size_t tstep = 2 * hstep;
    const unsigned ldsw = (unsigned)wid * 1024u;
    const int aoff = lds_byte(wr * 64 + fr, fq * 8), boff = lds_byte(wc * 32 + fr, fq * 8);
#define PG8_SA(b, h) (((b) * 2 + (h)) * HTB)
#define PG8_SB(b, h) ((4 + (b) * 2 + (h)) * HTB)
#define PG8_STAGE(bufoff, gbase, voff) do { _Pragma("unroll") for (int _i = 0; _i < 2; ++_i) \
        __builtin_amdgcn_global_load_lds((const unsigned*)((const char*)(gbase) + (voff)[_i]), (PG8_LAS unsigned*)(lds + (bufoff) + ldsw + _i * 8192), 16, 0, 0); } while (0)
#define PG8_LDA(dst, b, h) do { _Pragma("unroll") for (int m = 0; m < 4; ++m) _Pragma("unroll") for (int k = 0; k < 2; ++k) dst[m][k] = *(const PG8_LAS bf16x8*)(lds + PG8_SA(b, h) + aoff + m * 2048 + k * 1024); } while (0)
#define PG8_LDB(dst, b, h) do { _Pragma("unroll") for (int n = 0; n < 2; ++n) _Pragma("unroll") for (int k = 0; k < 2; ++k) dst[n][k] = *(const PG8_LAS bf16x8*)(lds + PG8_SB(b, h) + boff + n * 2048 + k * 1024); } while (0)
#define PG8_MMA(ai, bj, At, Bt) do { __builtin_amdgcn_s_setprio(1); _Pragma("unroll") for (int m = 0; m < 4; ++m) _Pragma("unroll") for (int n = 0; n < 2; ++n) _Pragma("unroll") for (int k = 0; k < 2; ++k) \
        acc[ai][bj][m][n] = __builtin_amdgcn_mfma_f32_16x16x32_bf16(Bt[n][k], At[m][k], acc[ai][bj][m][n], 0, 0, 0); __builtin_amdgcn_s_setprio(0); } while (0)
#define PG8_WAIT_V(n) asm volatile("s_waitcnt vmcnt(" #n ")" ::: "memory")
#define PG8_WAIT_L(n) asm volatile("s_waitcnt lgkmcnt(" #n ")" ::: "memory")
#define PG8_BAR __builtin_amdgcn_s_barrier()
#define PG8_SCHED __builtin_amdgcn_sched_barrier(0)
    Unit cur, nxt; int ui = 0;
    if (!S.next(0, cur)) return;
    f32x4 acc[2][2][4][2];
#pragma unroll
    for (int a = 0; a < 2; ++a)
#pragma unroll
        for (int b = 0; b < 2; ++b)
#pragma unroll
            for (int m = 0; m < 4; ++m)
#pragma unroll
                for (int n = 0; n < 2; ++n) acc[a][b][m][n] = (f32x4){0.f, 0.f, 0.f, 0.f};
    bf16x8 At[4][2], B0[2][2], B1[2][2];
    const char* cA = (const char*)g.A + (size_t)cur.pm * tstep; const char* cB = (const char*)g.Bt + (size_t)cur.pn * tstep;
    S.a_ready(cur);
    if constexpr (SP2) {
        PG8_STAGE(PG8_SB(0, 0), cB, voffB); PG8_STAGE(PG8_SB(0, 1), cB + hstep, voffB); PG8_STAGE(PG8_SA(0, 0), cA, voffA); PG8_STAGE(PG8_SA(0, 1), cA + hstep, voffA);
        if (wr == 1) PG8_BAR;
        PG8_WAIT_V(2); PG8_BAR;
        PG8_STAGE(PG8_SB(1, 0), cB + kstep, voffB); PG8_STAGE(PG8_SA(1, 0), cA + kstep, voffA); PG8_STAGE(PG8_SB(1, 1), cB + hstep + kstep, voffB);
        PG8_WAIT_V(6); PG8_BAR;
    } else {
        PG8_STAGE(PG8_SB(0, 0), cB, voffB); PG8_STAGE(PG8_SA(0, 0), cA, voffA); PG8_STAGE(PG8_SB(0, 1), cB + hstep, voffB); PG8_STAGE(PG8_SA(0, 1), cA + hstep, voffA);
        if (wr == 1) PG8_BAR;
        PG8_WAIT_V(4); PG8_BAR;
        PG8_STAGE(PG8_SB(1, 0), cB + kstep, voffB); PG8_STAGE(PG8_SA(1, 0), cA + kstep, voffA); PG8_STAGE(PG8_SB(1, 1), cB + hstep + kstep, voffB);
        PG8_WAIT_V(6); PG8_BAR;
    }
    for (;;) {
        const bool has_next = S.next(ui + 1, nxt);
        const char* nA = has_next ? (const char*)g.A + (size_t)nxt.pm * tstep : cA; const char* nB = has_next ? (const char*)g.Bt + (size_t)nxt.pn * tstep : cB;
        for (int t = 0; t < nt; t += 2) {
            const bool last = (t == nt - 2);
            const char* a1 = cA + (size_t)(t + 1) * kstep;
            const char* a2 = last ? nA : cA + (size_t)(t + 2) * kstep; const char* b2 = last ? nB : cB + (size_t)(t + 2) * kstep;
            const char* a3 = a2 + kstep; const char* b3 = b2 + kstep;
            if (last && has_next) S.a_ready(nxt);
            if constexpr (SP2) {
            PG8_LDB(B0, 0, 0); PG8_LDB(B1, 0, 1); PG8_SCHED; PG8_LDA(At, 0, 0); PG8_STAGE(PG8_SA(1, 1), a1 + hstep, voffA);
            PG8_WAIT_V(8); PG8_WAIT_L(0); PG8_BAR; PG8_MMA(0, 0, At, B0); PG8_MMA(0, 1, At, B1); PG8_BAR; PG8_SCHED;
            PG8_LDA(At, 0, 1); PG8_STAGE(PG8_SB(0, 0), b2, voffB); PG8_STAGE(PG8_SB(0, 1), b2 + hstep, voffB); PG8_STAGE(PG8_SA(0, 0), a2, voffA);
            PG8_WAIT_V(8); PG8_WAIT_L(0); PG8_BAR; PG8_MMA(1, 0, At, B0); PG8_MMA(1, 1, At, B1); PG8_BAR; PG8_SCHED;
            PG8_LDB(B0, 1, 0); PG8_LDB(B1, 1, 1); PG8_SCHED; PG8_LDA(At, 1, 0); PG8_STAGE(PG8_SA(0, 1), a2 + hstep, voffA);
            PG8_WAIT_V(8); PG8_WAIT_L(0); PG8_BAR; PG8_MMA(0, 0, At, B0); PG8_MMA(0, 1, At, B1); PG8_BAR; PG8_SCHED;
            PG8_LDA(At, 1, 1); PG8_STAGE(PG8_SB(1, 0), b3, voffB); PG8_STAGE(PG8_SB(1, 1), b3 + hstep, voffB); PG8_STAGE(PG8_SA(1, 0), a3, voffA);
            PG8_WAIT_V(8); PG8_WAIT_L(0); PG8_BAR; PG8_MMA(1, 0, At, B0); PG8_MMA(1, 1, At, B1); PG8_BAR; PG8_SCHED;
            } else {
            PG8_LDB(B0, 0, 0); PG8_SCHED; PG8_LDA(At, 0, 0); PG8_STAGE(PG8_SA(1, 1), a1 + hstep, voffA);
            PG8_WAIT_L(8); PG8_BAR; PG8_WAIT_L(0); PG8_MMA(0, 0, At, B0); PG8_BAR; PG8_SCHED;
            PG8_LDB(B1, 0, 1); PG8_STAGE(PG8_SB(0, 0), b2, voffB);
            PG8_BAR; PG8_WAIT_L(0); PG8_MMA(0, 1, At, B1); PG8_BAR;
            PG8_LDA(At, 0, 1); PG8_STAGE(PG8_SA(0, 0), a2, voffA);
            PG8_BAR; PG8_WAIT_L(0); PG8_MMA(1, 0, At, B0); PG8_BAR; PG8_SCHED;
            PG8_STAGE(PG8_SB(0, 1), b2 + hstep, voffB);
            PG8_WAIT_V(6); PG8_BAR; PG8_MMA(1, 1, At, B1); PG8_BAR;
            PG8_LDB(B0, 1, 0); PG8_SCHED; PG8_LDA(At, 1, 0); PG8_STAGE(PG8_SA(0, 1), a2 + hstep, voffA);
            PG8_WAIT_L(8); PG8_BAR; PG8_WAIT_L(0); PG8_MMA(0, 0, At, B0); PG8_BAR; PG8_SCHED;
            PG8_LDB(B1, 1, 1); PG8_STAGE(PG8_SB(1, 0), b3, voffB);
            PG8_BAR; PG8_WAIT_L(0); PG8_MMA(0, 1, At, B1); PG8_BAR;
            PG8_LDA(At, 1, 1); PG8_STAGE(PG8_SA(1, 0), a3, voffA);
            PG8_BAR; PG8_WAIT_L(0); PG8_MMA(1, 0, At, B0); PG8_BAR; PG8_SCHED;
            PG8_STAGE(PG8_SB(1, 1), b3 + hstep, voffB);
            PG8_WAIT_V(6); PG8_BAR; PG8_MMA(1, 1, At, B1); PG8_BAR;
            }
        }
        if constexpr (ALIGN_EPI) { if (wr == 0) PG8_BAR; }
        if constexpr (!Epi::AFTER_DRAIN) { E(acc, cur, wr, wc, fr, fq); S.done(cur); }
        if (!has_next) break;
#pragma unroll
        for (int a = 0; a < 2; ++a)
#pragma unroll
            for (int b = 0; b < 2; ++b)
#pragma unroll
                for (int m = 0; m < 4; ++m)
#pragma unroll
                    for (int n = 0; n < 2; ++n) acc[a][b][m][n] = (f32x4){0.f, 0.f, 0.f, 0.f};
        cur = nxt; cA = nA; cB = nB; ++ui;
        if constexpr (ALIGN_EPI) { if (wr == 1) PG8_BAR; }
    }
    PG8_WAIT_V(0);
    if constexpr (!ALIGN_EPI) { if (wr == 0) PG8_BAR; }
    PG8_BAR;
    if constexpr (Epi::AFTER_DRAIN) { E.fused(acc, cur, wr, wc, fr, fq, lds, wid, lane); S.done(cur); }
#undef PG8_SA
#undef PG8_SB
#undef PG8_STAGE
#undef PG8_LDA
#undef PG8_LDB
#undef PG8_MMA
#undef PG8_WAIT_V
#undef PG8_WAIT_L
#undef PG8_BAR
#undef PG8_SCHED
}
}

constexpr int NB = 8, SEQ = 4096, DM = 1024, NL = 2, FF = 4096, NPROJ = 2724, NPROJ_PAD = 2816, NTILE_PROJ = 11;
constexpr int TOK = NB * SEQ;
static_assert(TOK == pg8::TT, "token count");
constexpr float NORM_EPS = 1e-6f;
constexpr float LOG2E = 1.4426950408889634f;
constexpr int NWAVES = 8;

constexpr size_t MiB = 1u << 20;
constexpr size_t WS_CTL = 0, CTL_ZERO_BYTES = 1 * MiB;
constexpr size_t WS_MOD = 1 * MiB;
constexpr size_t WS_KMEAN = WS_MOD + 512 * 1024;
constexpr size_t WS_W = 2 * MiB;
constexpr size_t W_IN = 0, W_GATE = W_IN + (size_t)NPROJ_PAD * DM, W_BR = W_GATE + (size_t)4 * DM * DM, W_OUT = W_BR + (size_t)4 * DM * 256,
                 W_FF1 = W_OUT + (size_t)DM * DM, W_FF2 = W_FF1 + (size_t)FF * DM, W_LAYER = W_FF2 + (size_t)DM * FF;
constexpr size_t WS_MASK = 70 * MiB;
constexpr size_t WS_H = 86 * MiB;
constexpr size_t WS_Y = 150 * MiB;
constexpr size_t WS_R = 214 * MiB;
constexpr size_t WS_END = 470 * MiB;
static_assert(WS_W + 2 * W_LAYER * 2 <= WS_MASK, "weights fit");
constexpr int CW_BAR = 4096;
constexpr int CW_WQ = 131072;
constexpr int CW_NRM = CW_WQ + 4096;
constexpr int NPHASE = 22;

constexpr int RING_BYTES = 135168;
constexpr int LDSCTL_OFF = RING_BYTES;
constexpr int LDS_BYTES = 147456;

#define GAS __attribute__((address_space(1)))
#define LAS __attribute__((address_space(3)))
typedef unsigned short bf16;
typedef unsigned v4u __attribute__((ext_vector_type(4)));
typedef unsigned v2u __attribute__((ext_vector_type(2)));
typedef float f32x4 __attribute__((ext_vector_type(4)));
typedef float f32x16 __attribute__((ext_vector_type(16)));
typedef short bf16x8 __attribute__((ext_vector_type(8)));
typedef short s16x4 __attribute__((ext_vector_type(4)));
typedef GAS unsigned gu32;
#define RLX_AGENT __ATOMIC_RELAXED, __HIP_MEMORY_SCOPE_AGENT
#define LDS_WAIT() asm volatile("s_waitcnt lgkmcnt(0)" ::: "memory")
__device__ __forceinline__ unsigned f2bf(float f) { unsigned u = __builtin_bit_cast(unsigned, f); return (u + 0x7fffu + ((u >> 16) & 1u)) >> 16; }
__device__ __forceinline__ unsigned pk2(float lo, float hi) { return f2bf(lo) | (f2bf(hi) << 16); }
__device__ __forceinline__ float bf2f(unsigned short b) { return __uint_as_float((unsigned)b << 16); }
__device__ __forceinline__ float bflo(unsigned w) { return __uint_as_float(w << 16); }
__device__ __forceinline__ float bfhi(unsigned w) { return __uint_as_float(w & 0xffff0000u); }

#define XB_TMO      128
#define XB_XCNT(j)  (256  + 64 * (j))
#define XB_XSUB(j)  (1280 + 64 * (j))
#define XB_XGEN(j)  (2304 + 64 * (j))
#define XB_TOP      3328
#define XB_TOPGEN   3392
#define XCD_BAR_WORDS 3456
#define XB_SPIN_CAP (1u << 18)

__device__ __forceinline__ unsigned xb_ld(unsigned* p)              { return __hip_atomic_load(p, __ATOMIC_RELAXED, __HIP_MEMORY_SCOPE_AGENT); }
__device__ __forceinline__ unsigned xb_add(unsigned* p, unsigned v) { return __hip_atomic_fetch_add(p, v, __ATOMIC_RELAXED, __HIP_MEMORY_SCOPE_AGENT); }
__device__ __forceinline__ unsigned xb_xcc_id() { return (unsigned)__builtin_amdgcn_s_getreg((3 << 11) | 20) & 0xFu; }
#define XB_SPIN(cond, bar) do { unsigned _sp = 0; while (cond) { __builtin_amdgcn_s_sleep(1); \
    if ((++_sp & 255u) == 0u) { if (xb_ld(&(bar)[XB_TMO])) break; if (_sp > XB_SPIN_CAP) { atomicAdd(&(bar)[XB_TMO], 1u); break; } } } } while (0)

struct XcdBarrier {
    unsigned* bar; unsigned x;
    volatile LAS unsigned* st;
};

__device__ __forceinline__ XcdBarrier xcd_barrier_post(unsigned* bar, volatile LAS unsigned* st) {
    XcdBarrier b; b.bar = bar; b.x = xb_xcc_id(); b.st = st;
    if (threadIdx.x == 0) (void)xb_add(&bar[XB_XCNT(b.x)], 1u);
    return b;
}
__device__ __forceinline__ void xcd_barrier_complete(unsigned* bar, unsigned x, unsigned& nloc, unsigned& nx) {
    const unsigned G = gridDim.x * gridDim.y * gridDim.z;
    unsigned sum, cnt, mine, sp = 0u;
    for (;;) {
        sum = 0u; cnt = 0u; mine = 0u;
#pragma unroll
        for (unsigned j = 0; j < 16; ++j) { const unsigned c = xb_ld(&bar[XB_XCNT(j)]); sum += c; cnt += (c > 0u) ? 1u : 0u; mine = (j == x) ? c : mine; }
        if (sum == G) break;
        __builtin_amdgcn_s_sleep(1);
        if ((++sp & 255u) == 0u) { if (xb_ld(&bar[XB_TMO])) break; if (sp > XB_SPIN_CAP) { atomicAdd(&bar[XB_TMO], 1u); break; } }
    }
    nloc = mine > 0u ? mine : 1u; nx = cnt > 0u ? cnt : 1u;
}

__device__ __forceinline__ void xcd_barrier(const XcdBarrier& b) {
    asm volatile("s_waitcnt vmcnt(0)" ::: "memory");
    __syncthreads();
    if (threadIdx.x == 0) {
        unsigned* bar = b.bar;
        __builtin_amdgcn_s_waitcnt(0);
        unsigned nloc = b.st[0], nx = b.st[1];
        if (nloc == 0u) { xcd_barrier_complete(bar, b.x, nloc, nx); b.st[0] = nloc; b.st[1] = nx; }
        const unsigned old = xb_add(&bar[XB_XSUB(b.x)], 1u);
        const unsigned gen = old / nloc;
        if (old + 1u == (gen + 1u) * nloc) {
            __builtin_amdgcn_fence(__ATOMIC_RELEASE, "agent");
            asm volatile("s_waitcnt vmcnt(0)" ::: "memory");
            const unsigned og = xb_add(&bar[XB_TOP], 1u);
            const unsigned tg = og / nx;
            if (og + 1u == (tg + 1u) * nx) xb_add(&bar[XB_TOPGEN], 1u);
            else XB_SPIN(xb_ld(&bar[XB_TOPGEN]) == tg, bar);
            __builtin_amdgcn_fence(__ATOMIC_ACQUIRE, "agent");
            xb_add(&bar[XB_XGEN(b.x)], 1u);
            asm volatile("s_waitcnt vmcnt(0)" ::: "memory");
        } else {
            XB_SPIN(xb_ld(&bar[XB_XGEN(b.x)]) == gen, bar);
            __builtin_amdgcn_fence(__ATOMIC_ACQUIRE, "agent");
            asm volatile("s_waitcnt vmcnt(0)" ::: "memory");
        }
    }
    __syncthreads();
}

struct Args {
    const float *x, *c, *w_ada, *b_ada, *norm1_g, *w_in, *diff_lambda, *diff_subln_g, *w_pool, *pool_scale, *w_gate, *b_gate, *w_branch, *w_out, *norm2_g, *w_ff1, *w_ff2, *final_g;
    float* out; unsigned char* ws; int ph_lo, ph_hi, li, pad;
};

__device__ __forceinline__ float shx(float v, int mask, int lane) { return __int_as_float(__builtin_amdgcn_ds_bpermute((lane ^ mask) << 2, __float_as_int(v))); }
__device__ __forceinline__ unsigned shxu(unsigned v, int mask, int lane) { return (unsigned)__builtin_amdgcn_ds_bpermute((lane ^ mask) << 2, (int)v); }
__device__ __forceinline__ unsigned shupu(unsigned v, int delta, int lane) { return (unsigned)__builtin_amdgcn_ds_bpermute(((lane - delta) & 63) << 2, (int)v); }
__device__ __forceinline__ float wave_sum(float v, int lane) {
#pragma unroll
    for (int o = 1; o < 64; o <<= 1) v += shx(v, o, lane);
    return v;
}
__device__ __forceinline__ int crow(int r, int hi) { return (r & 3) + 8 * (r >> 2) + 4 * hi; }
typedef float f32x2_t __attribute__((ext_vector_type(2))); typedef __bf16 bf16x2_t __attribute__((ext_vector_type(2)));
__device__ __forceinline__ unsigned cvtpk(float lo, float hi) { f32x2_t v = {lo, hi}; bf16x2_t b = __builtin_convertvector(v, bf16x2_t); return __builtin_bit_cast(unsigned, b); }

__device__ __forceinline__ int gate_row(int br, int c) { const int pn = c >> 6, ml = c & 63; return 256 * pn + 128 * (br >> 1) + 32 * (ml >> 4) + 8 * ((ml >> 2) & 3) + 4 * (br & 1) + (ml & 3); }
__device__ __forceinline__ void p0_transpose_item(const float* W, int K, int Nsrc, int Npad, bf16* WT, int mode, int br, LAS float* scr, int item, int lane) {
    const int nblk = Npad / 32, kb = item / nblk, nb = item % nblk, k0 = 64 * kb, n0 = 32 * nb;
    const int c4 = lane & 7, kr = lane >> 3, nn = n0 + 4 * c4;
    f32x4 v[8];
#pragma unroll
    for (int i = 0; i < 8; ++i) v[i] = (nn < Nsrc) ? *(const f32x4*)(W + (size_t)(k0 + 8 * i + kr) * Nsrc + nn) : (f32x4){0.f, 0.f, 0.f, 0.f};
#pragma unroll
    for (int i = 0; i < 8; ++i) { LAS float* d = scr + (8 * i + kr) * 33 + 4 * c4; d[0] = v[i][0]; d[1] = v[i][1]; d[2] = v[i][2]; d[3] = v[i][3]; }
    LDS_WAIT(); asm volatile("" ::: "memory");
    const int c = lane & 7;
#pragma unroll
    for (int j = 0; j < 4; ++j) { const int n = (lane >> 3) + 8 * j; const LAS float* s = scr + (8 * c) * 33 + n;
        v4u o; o.x = pk2(s[0 * 33], s[1 * 33]); o.y = pk2(s[2 * 33], s[3 * 33]); o.z = pk2(s[4 * 33], s[5 * 33]); o.w = pk2(s[6 * 33], s[7 * 33]);
        const int drow = (mode == 1) ? gate_row(br, n0 + n) : (n0 + n);
        *(v4u*)(WT + (size_t)drow * K + k0 + 8 * c) = o; }
    LDS_WAIT(); asm volatile("" ::: "memory");
}

template <bool XBF16>
__device__ __forceinline__ void norm_rows_bf16(const void* X, bf16* O, const float* g, const float* mod  , int sh_idx, int sc_idx, int gw, int ngw, int lane_in) {
    int lane = lane_in; asm volatile("" : "+v"(lane));
    for (int m = gw; m < TOK; m += ngw) {
        const int b = m >> 12;
        float v[16]; float s = 0.f;
        if (XBF16) { const v4u* xr = (const v4u*)((const bf16*)X + (size_t)m * DM) + 2 * lane; const v4u a = xr[0], c = xr[1];
            v[0] = bflo(a.x); v[1] = bfhi(a.x); v[2] = bflo(a.y); v[3] = bfhi(a.y); v[4] = bflo(a.z); v[5] = bfhi(a.z); v[6] = bflo(a.w); v[7] = bfhi(a.w);
            v[8] = bflo(c.x); v[9] = bfhi(c.x); v[10] = bflo(c.y); v[11] = bfhi(c.y); v[12] = bflo(c.z); v[13] = bfhi(c.z); v[14] = bflo(c.w); v[15] = bfhi(c.w); }
        else { const f32x4* xr = (const f32x4*)((const float*)X + (size_t)m * DM) + 4 * lane;
#pragma unroll
            for (int j = 0; j < 4; ++j) { const f32x4 t = xr[j]; v[4 * j] = t.x; v[4 * j + 1] = t.y; v[4 * j + 2] = t.z; v[4 * j + 3] = t.w; } }
#pragma unroll
        for (int e = 0; e < 16; ++e) s += v[e] * v[e];
        const float rstd = 1.f / sqrtf(wave_sum(s, lane) * (1.f / DM) + NORM_EPS);
        const f32x4* gp = (const f32x4*)g + 4 * lane;
        const f32x4* shp = (const f32x4*)(mod + (size_t)b * 6144 + sh_idx * 1024) + 4 * lane;
        const f32x4* scp = (const f32x4*)(mod + (size_t)b * 6144 + sc_idx * 1024) + 4 * lane;
        float y[16];
#pragma unroll
        for (int j = 0; j < 4; ++j) { const f32x4 gg = gp[j], sh = shp[j], sc = scp[j];
#pragma unroll
            for (int e = 0; e < 4; ++e) y[4 * j + e] = v[4 * j + e] * rstd * gg[e] * (1.f + sc[e]) + sh[e]; }
        v4u o0, o1;
        o0.x = pk2(y[0], y[1]); o0.y = pk2(y[2], y[3]); o0.z = pk2(y[4], y[5]); o0.w = pk2(y[6], y[7]);
        o1.x = pk2(y[8], y[9]); o1.y = pk2(y[10], y[11]); o1.z = pk2(y[12], y[13]); o1.w = pk2(y[14], y[15]);
        v4u* op = (v4u*)(O + (size_t)m * DM) + 2 * lane; op[0] = o0; op[1] = o1;
    }
}

#ifndef ATT_PD
#define ATT_PD 2
#endif
constexpr int AT_K0 = 0, AT_KSLOT = 9216, AT_V0 = 18432, AT_VSLOT = 12288, AT_SEL = 43008, AT_KM = 44032, AT_END = 47872;
__device__ __forceinline__ s16x4 vtr(LAS const unsigned char* p) { return __builtin_bit_cast(s16x4, __builtin_amdgcn_ds_read_tr16_b64_v4i16((LAS s16x4*)p)); }

#define TRRD(dst, addr, off) asm volatile("ds_read_b64_tr_b16 %0, %1 offset:%2" : "=v"(dst) : "v"(addr), "i"(off) : "memory")
#define SBAR0() __builtin_amdgcn_sched_barrier(0)
__device__ __forceinline__ void softmax_pv(f32x16& s0, f32x16& s1, float& l, f32x16 (&o)[2], LAS const unsigned char* vbase  ) {
    const unsigned va = (unsigned)(uintptr_t)vbase;
    s16x4 vl[2][2][2], vh[2][2][2];
#pragma unroll
    for (int sub = 0; sub < 2; ++sub)
#pragma unroll
        for (int db = 0; db < 2; ++db)
#pragma unroll
            for (int s2 = 0; s2 < 2; ++s2) { TRRD(vl[db][sub][s2], va, (32 * sub + 16 * s2) * 192 + db * 64); TRRD(vh[db][sub][s2], va, (32 * sub + 16 * s2 + 8) * 192 + db * 64); }
    float la = l;
#pragma unroll
    for (int r = 0; r < 16; ++r) { s0[r] = __builtin_amdgcn_exp2f(s0[r]); la += s0[r]; }
    bf16x8 pf[2][2];
#pragma unroll
    for (int s2 = 0; s2 < 2; ++s2) { v4u a;
        a.x = cvtpk(s0[8 * s2 + 0], s0[8 * s2 + 1]); a.y = cvtpk(s0[8 * s2 + 2], s0[8 * s2 + 3]); a.z = cvtpk(s0[8 * s2 + 4], s0[8 * s2 + 5]); a.w = cvtpk(s0[8 * s2 + 6], s0[8 * s2 + 7]);
        pf[0][s2] = __builtin_bit_cast(bf16x8, a); }
    asm volatile("s_waitcnt lgkmcnt(0)" : "+v"(vl[0][0][0]), "+v"(vl[0][0][1]), "+v"(vl[0][1][0]), "+v"(vl[0][1][1]), "+v"(vl[1][0][0]), "+v"(vl[1][0][1]), "+v"(vl[1][1][0]), "+v"(vl[1][1][1]),
                                          "+v"(vh[0][0][0]), "+v"(vh[0][0][1]), "+v"(vh[0][1][0]), "+v"(vh[0][1][1]), "+v"(vh[1][0][0]), "+v"(vh[1][0][1]), "+v"(vh[1][1][0]), "+v"(vh[1][1][1]) :: "memory");
    SBAR0();
#pragma unroll
    for (int g = 0; g < 4; ++g) { const int db = g >> 1, s2 = g & 1;
        const s16x4 lo = vl[db][0][s2], hh = vh[db][0][s2];
        const bf16x8 vf = (bf16x8){lo[0], lo[1], lo[2], lo[3], hh[0], hh[1], hh[2], hh[3]};
        o[db] = __builtin_amdgcn_mfma_f32_32x32x16_bf16(vf, pf[0][s2], o[db], 0, 0, 0);
#pragma unroll
        for (int r = 4 * g; r < 4 * g + 4; ++r) { s1[r] = __builtin_amdgcn_exp2f(s1[r]); la += s1[r]; }
        SBAR0(); }
    l = la;
#pragma unroll
    for (int s2 = 0; s2 < 2; ++s2) { v4u c;
        c.x = cvtpk(s1[8 * s2 + 0], s1[8 * s2 + 1]); c.y = cvtpk(s1[8 * s2 + 2], s1[8 * s2 + 3]); c.z = cvtpk(s1[8 * s2 + 4], s1[8 * s2 + 5]); c.w = cvtpk(s1[8 * s2 + 6], s1[8 * s2 + 7]);
        pf[1][s2] = __builtin_bit_cast(bf16x8, c); }
#pragma unroll
    for (int g = 0; g < 4; ++g) { const int db = g >> 1, s2 = g & 1;
        const s16x4 lo = vl[db][1][s2], hh = vh[db][1][s2];
        const bf16x8 vf = (bf16x8){lo[0], lo[1], lo[2], lo[3], hh[0], hh[1], hh[2], hh[3]};
        o[db] = __builtin_amdgcn_mfma_f32_32x32x16_bf16(vf, pf[1][s2], o[db], 0, 0, 0); }
}
__device__ __forceinline__ void split3(float x, unsigned& h, unsigned& m, unsigned& l) {
    h = f2bf(x); const float r1 = x - __uint_as_float(h << 16); m = f2bf(r1); const float r2 = r1 - __uint_as_float(m << 16); l = f2bf(r2);
}

template <int MODE>
__device__ __forceinline__ void attn_unit(LAS unsigned char* lds, int b, int h, int qb, const bf16* Qb, const bf16* Kb, const bf16* Vb, bf16* Ob, float slope,
                                          const float* kmean, float lam, float post_scale, const float* subg, const unsigned* maskw, const unsigned* nrm  ,
                                          const int* refposg, const int* refming) {
    int tid_l = threadIdx.x; asm volatile("" : "+v"(tid_l)); const int tid = tid_l, lane = tid & 63, wid = __builtin_amdgcn_readfirstlane(tid >> 6), r32 = lane & 31, hi = lane >> 5;
    const int q = qb * 256 + wid * 32 + r32;
    const size_t rowg = (size_t)b * SEQ;
    const float c2 = slope * LOG2E;
    unsigned sel = 0u;
    bf16x8 qf[4];
#pragma unroll
    for (int ds = 0; ds < 4; ++ds) qf[ds] = *(const bf16x8*)(Qb + (rowg + q) * 256 + h * 64 + ds * 16 + hi * 8);
    const int skey = tid >> 3, sch = tid & 7;
    const bf16* ksrc = Kb + (rowg + skey) * 256 + h * 64 + sch * 8;
    const bf16* vsrc = Vb + (rowg + skey) * 256 + h * 64 + sch * 8;
    const int kdst = AT_K0 + skey * 144 + sch * 16, vdst = AT_V0 + skey * 192 + sch * 16;
    const int NT = 4 * qb + 4;
    const float Bq = __uint_as_float(nrm[b * 4 + h]), Bk = __uint_as_float(nrm[32 + b * 4 + h]);
#if defined(PROBE_NOSKIP)
    const float Dskip = 1e9f + 0.f * (Bq + Bk);
#else
    const float Dskip = (150.f + 2.f * sqrtf(Bq * Bk)) / c2;
#endif
    const int koff = r32 * 144 + hi * 16;
    const int vtoff = (4 * hi + ((lane & 15) >> 2)) * 192 + (16 * ((lane >> 4) & 1) + 4 * (lane & 3)) * 2;
    float l1 = 0.f, l2 = 0.f;
    f32x16 oA[2], oB[2];
#pragma unroll
    for (int r = 0; r < 16; ++r) { oA[0][r] = 0.f; oA[1][r] = 0.f; oB[0][r] = 0.f; oB[1][r] = 0.f; }
    const int qmin = qb * 256 + wid * 32, qmax = qmin + 31;
    constexpr int PD = ATT_PD;
    v4u kR[PD], vR[PD]; v2u mR[PD];
    int refpos = q;
    int minref = qb * 256;
    if (MODE == 2) { refpos = refposg[rowg + q]; minref = refming[b * 128 + 8 * qb];
#pragma unroll
        for (int i = 1; i < 8; ++i) { const int v = refming[b * 128 + 8 * qb + i]; minref = v < minref ? v : minref; } }
    int T0 = (int)floorf(((float)minref - Dskip) * (1.f / 64.f)); T0 = T0 < 0 ? 0 : T0; T0 = __builtin_amdgcn_readfirstlane(T0);
    const v4u k0r = *(const v4u*)(ksrc + (size_t)T0 * 64 * 256), v0r = *(const v4u*)(vsrc + (size_t)T0 * 64 * 256);
#pragma unroll
    for (int i = 0; i < PD; ++i) { kR[i] = (v4u){0u, 0u, 0u, 0u}; vR[i] = kR[i]; mR[i] = (v2u){0u, 0u};
        if (T0 + i + 1 < NT) { kR[i] = *(const v4u*)(ksrc + (size_t)(T0 + i + 1) * 64 * 256); vR[i] = *(const v4u*)(vsrc + (size_t)(T0 + i + 1) * 64 * 256);
            if (MODE == 2) mR[i] = *(const v2u*)(maskw + (rowg + q) * 128 + 2 * (T0 + i + 1)); } }
    v2u mw = (v2u){0u, 0u};
    if (MODE == 2) mw = *(const v2u*)(maskw + (rowg + q) * 128 + 2 * T0);
    if (MODE == 0) {
        LAS float* KM = (LAS float*)(lds + AT_KM); LAS unsigned* SEL = (LAS unsigned*)(lds + AT_SEL);
        for (int i = tid; i < qb * 64; i += 512) KM[i] = kmean[(size_t)((b * 4 + h) * 16) * 64 + i];
        __syncthreads();
        if (tid < 256) {
            const bf16* qrow = Qb + (rowg + qb * 256 + tid) * 256 + h * 64;
            float qv[64];
#pragma unroll
            for (int c = 0; c < 8; ++c) { const v4u w = *(const v4u*)(qrow + 8 * c);
                qv[8 * c + 0] = bflo(w.x); qv[8 * c + 1] = bfhi(w.x); qv[8 * c + 2] = bflo(w.y); qv[8 * c + 3] = bfhi(w.y);
                qv[8 * c + 4] = bflo(w.z); qv[8 * c + 5] = bfhi(w.z); qv[8 * c + 6] = bflo(w.w); qv[8 * c + 7] = bfhi(w.w); }
            float v1 = -INFINITY, v2 = -INFINITY, v3 = -INFINITY; int i1 = -1, i2 = -1, i3 = -1;
            for (int n = 0; n < qb; ++n) {
                float g = 0.f;
#pragma unroll
                for (int d = 0; d < 64; ++d) g = __builtin_fmaf(qv[d], KM[n * 64 + d], g);
                if (g > v1) { v3 = v2; i3 = i2; v2 = v1; i2 = i1; v1 = g; i1 = n; }
                else if (g > v2) { v3 = v2; i3 = i2; v2 = g; i2 = n; }
                else if (g > v3) { v3 = g; i3 = n; }
            }
            unsigned sm = 0u; if (i1 >= 0) sm |= 1u << i1; if (i2 >= 0) sm |= 1u << i2; if (i3 >= 0) sm |= 1u << i3;
            SEL[tid] = sm;
        }
        __syncthreads();
        sel = SEL[wid * 32 + r32];
    }
    *(LAS v4u*)(lds + kdst + (T0 & 1) * AT_KSLOT) = k0r; *(LAS v4u*)(lds + vdst + (T0 & 1) * AT_VSLOT) = v0r;
    bf16x8 qaug; v4u ka0, ka1;
    { unsigned a, b2, c; split3(-c2 * (float)refpos, a, b2, c);
      v4u w; if (hi == 0) { w.x = a | (b2 << 16); w.y = c | (0x3f80u << 16); w.z = 0x3f80u | (0x3f80u << 16); w.w = 0u; }
             else { w.x = 0x3f80u | (0x3f80u << 16); w.y = 0x3f80u; w.z = 0u; w.w = 0u; }
      qaug = __builtin_bit_cast(bf16x8, w);
      split3(c2 * (float)r32, a, b2, c); ka0.x = 0x3f80u | (0x3f80u << 16); ka0.y = 0x3f80u | (a << 16); ka0.z = b2 | (c << 16); ka0.w = 0u;
      split3(c2 * (float)(r32 + 32), a, b2, c); ka1.x = ka0.x; ka1.y = 0x3f80u | (a << 16); ka1.z = b2 | (c << 16); ka1.w = 0u; }
    __syncthreads();
#pragma nounroll
    for (int t0 = T0; t0 < NT; t0 += PD) {
#pragma unroll
      for (int u = 0; u < PD; ++u) { const int t = t0 + u; if (t < NT) {
        const int slot = t & 1;
        const int k0 = 64 * t;
        bool active = (k0 <= qmax);
        bool keep = true;
        if (MODE == 0) { const int n = t >> 2; if (n < qb) { keep = ((sel >> n) & 1u) != 0u; active = (__ballot(keep) != 0ull); } }
        if (active) {
            LAS const unsigned char* ks = lds + AT_K0 + slot * AT_KSLOT + koff;
            LAS const unsigned char* vb = lds + AT_V0 + slot * AT_VSLOT + vtoff;
            const int lim = q - k0 - 4 * hi;
            const bool needmask = (k0 + 63 > qmin);
            bf16x8 kaug0, kaug1;
            { unsigned a, b2, c; split3(c2 * (float)k0, a, b2, c);
              v4u w0 = ka0, w1 = ka1; if (hi) { w0.x = a | (b2 << 16); w0.y = c; w0.z = 0u; w1 = w0; }
              kaug0 = __builtin_bit_cast(bf16x8, w0); kaug1 = __builtin_bit_cast(bf16x8, w1); }
#pragma unroll
            for (int mp = 0; mp < (MODE == 1 ? 2 : 1); ++mp) {
                f32x16 s0, s1;
#pragma unroll
                for (int r = 0; r < 16; ++r) { s0[r] = 0.f; s1[r] = 0.f; }
                s0 = __builtin_amdgcn_mfma_f32_32x32x16_bf16(kaug0, qaug, s0, 0, 0, 0);
                s1 = __builtin_amdgcn_mfma_f32_32x32x16_bf16(kaug1, qaug, s1, 0, 0, 0);
#pragma unroll
                for (int dd = 0; dd < (MODE == 1 ? 2 : 4); ++dd) { const int ds = (MODE == 1) ? (2 * mp + dd) : dd;
                    const bf16x8 a0 = *(LAS const bf16x8*)(ks + ds * 32), a1 = *(LAS const bf16x8*)(ks + 32 * 144 + ds * 32);
                    s0 = __builtin_amdgcn_mfma_f32_32x32x16_bf16(a0, qf[ds], s0, 0, 0, 0);
                    s1 = __builtin_amdgcn_mfma_f32_32x32x16_bf16(a1, qf[ds], s1, 0, 0, 0); }
#if defined(PROBE_QK2X)
                { f32x16 d0, d1;
#pragma unroll
                  for (int r = 0; r < 16; ++r) { d0[r] = 0.f; d1[r] = 0.f; }
#pragma unroll
                  for (int dd = 0; dd < (MODE == 1 ? 2 : 4); ++dd) { const int ds = (MODE == 1) ? (2 * mp + dd) : dd;
                    const bf16x8 a0 = *(LAS const bf16x8*)(ks + ds * 32 + 16), a1 = *(LAS const bf16x8*)(ks + 32 * 144 + ds * 32 + 16);
                    d0 = __builtin_amdgcn_mfma_f32_32x32x16_bf16(a0, qf[ds], d0, 0, 0, 0);
                    d1 = __builtin_amdgcn_mfma_f32_32x32x16_bf16(a1, qf[ds], d1, 0, 0, 0); }
                  asm volatile("" :: "v"(d0), "v"(d1)); }
#endif
                if (MODE == 2) {
#pragma unroll
                    for (int r = 0; r < 16; ++r) { const int pos = (r & 3) + 8 * (r >> 2) + 4 * hi;
                        if (!((mw.x >> pos) & 1u)) s0[r] = -INFINITY; if (!((mw.y >> pos) & 1u)) s1[r] = -INFINITY; }
                } else {
                    if (MODE == 0 && !keep) {
#pragma unroll
                        for (int r = 0; r < 16; ++r) { s0[r] = -INFINITY; s1[r] = -INFINITY; }
                    }
                    if (needmask) {
#pragma unroll
                        for (int r = 0; r < 16; ++r) { const int ko = (r & 3) + 8 * (r >> 2);
                            if (ko > lim) s0[r] = -INFINITY; if (ko + 32 > lim) s1[r] = -INFINITY; }
                    }
                }
                if (mp == 0) softmax_pv(s0, s1, l1, oA, vb); else softmax_pv(s0, s1, l2, oB, vb);
            }
        }
        if (t + 1 < NT) { *(LAS v4u*)(lds + kdst + (slot ^ 1) * AT_KSLOT) = kR[u]; *(LAS v4u*)(lds + vdst + (slot ^ 1) * AT_VSLOT) = vR[u];
            if (MODE == 2) mw = mR[u];
            if (t + 1 + PD < NT) { kR[u] = *(const v4u*)(ksrc + (size_t)(t + 1 + PD) * 64 * 256); vR[u] = *(const v4u*)(vsrc + (size_t)(t + 1 + PD) * 64 * 256);
                if (MODE == 2) mR[u] = *(const v2u*)(maskw + (rowg + q) * 128 + 2 * (t + 1 + PD)); } }
        __syncthreads();
#if defined(PROBE_BAR2X)
        __syncthreads();
#endif
      } }
    }
    const float l1t = l1 + shx(l1, 32, lane);
    bf16* orow = Ob + (rowg + q) * 256 + h * 64 + 4 * hi;
    if (MODE == 1) {
        const float l2t = l2 + shx(l2, 32, lane);
        const float i1 = 1.f / l1t, i2 = lam / l2t;
        float ssq = 0.f;
#pragma unroll
        for (int db = 0; db < 2; ++db)
#pragma unroll
            for (int r = 0; r < 16; ++r) { const float v = oA[db][r] * i1 - oB[db][r] * i2; oA[db][r] = v; ssq += v * v; }
        ssq += shx(ssq, 32, lane);
        const float rn = post_scale / sqrtf(ssq * (1.f / 64.f) + NORM_EPS);
#pragma unroll
        for (int db = 0; db < 2; ++db)
#pragma unroll
            for (int g4 = 0; g4 < 4; ++g4) { const f32x4 gg = *(const f32x4*)(subg + 32 * db + 8 * g4 + 4 * hi);
                v2u w; w.x = cvtpk(oA[db][4 * g4 + 0] * rn * gg[0], oA[db][4 * g4 + 1] * rn * gg[1]); w.y = cvtpk(oA[db][4 * g4 + 2] * rn * gg[2], oA[db][4 * g4 + 3] * rn * gg[3]);
                *(v2u*)(orow + 32 * db + 8 * g4) = w; }
    } else {
        const float i1 = 1.f / l1t;
#pragma unroll
        for (int db = 0; db < 2; ++db)
#pragma unroll
            for (int g4 = 0; g4 < 4; ++g4) { v2u w; w.x = cvtpk(oA[db][4 * g4 + 0] * i1, oA[db][4 * g4 + 1] * i1); w.y = cvtpk(oA[db][4 * g4 + 2] * i1, oA[db][4 * g4 + 3] * i1);
                *(v2u*)(orow + 32 * db + 8 * g4) = w; }
    }
    __syncthreads();
}

constexpr int DS_HP = 1025;
constexpr int DS_HIST_BYTES = 32 * DS_HP * 4;
constexpr int DS_BP = 129;
constexpr int DS_G = 0, DS_C = 32 * DS_BP * 4, DS_AUX = DS_HIST_BYTES;
__device__ __forceinline__ float relu_asm(float x) { return __builtin_amdgcn_fmed3f(x, 0.f, __builtin_inff()); }
__device__ __forceinline__ void dsa_scores(const bf16x8 (&iqf)[4][2], const float (&w)[4], const bf16x8 k0, const bf16x8 k1, float (&sc)[16]) {
#pragma unroll
    for (int hh = 0; hh < 4; ++hh) {
        f32x16 x;
#pragma unroll
        for (int r = 0; r < 16; ++r) x[r] = 0.f;
        x = __builtin_amdgcn_mfma_f32_32x32x16_bf16(k0, iqf[hh][0], x, 0, 0, 0);
        x = __builtin_amdgcn_mfma_f32_32x32x16_bf16(k1, iqf[hh][1], x, 0, 0, 0);
#pragma unroll
        for (int r = 0; r < 16; ++r) sc[r] = (hh == 0) ? (w[0] * relu_asm(x[r])) : __builtin_fmaf(w[hh], relu_asm(x[r]), sc[r]);
    }
}
__device__ __forceinline__ unsigned dsa_mono(float s) { const unsigned bits = __float_as_uint(s); return bits ^ ((unsigned)((int)bits >> 31) | 0x80000000u); }
__device__ __forceinline__ unsigned dsa_ckey(float s, unsigned keyidx) { return (dsa_mono(s) & 0xFFFFF000u) | (4095u - keyidx); }
__device__ __forceinline__ unsigned take_low(unsigned w, unsigned n) {
    if (n >= (unsigned)__popc(w)) return w;
    unsigned res = 0u;
    while (n > 0u) { const unsigned low = w & (0u - w); res |= low; w ^= low; --n; }
    return res;
}
template <int PASS>
__device__ __forceinline__ void dsa_hist_pass(LAS unsigned* hist, const bf16x8 (&iqf)[4][2], const float (&w)[4], const bf16* kbase, int qg, int wid, int r32, int hi, int t, unsigned P1) {
    bf16x8 nk0 = *(const bf16x8*)(kbase + (size_t)wid * 32 * 256), nk1 = *(const bf16x8*)(kbase + (size_t)wid * 32 * 256 + 16);
    const unsigned rowb = (unsigned)(r32 * DS_HP * 4);
#pragma nounroll
    for (int j = wid; j <= qg; j += 8) {
        const bf16x8 k0 = nk0, k1 = nk1;
        { const int jn = (j + 8 <= qg) ? j + 8 : j; const bf16* kp = kbase + (size_t)jn * 32 * 256; nk0 = *(const bf16x8*)kp; nk1 = *(const bf16x8*)(kp + 16); }
        float sc[16]; dsa_scores(iqf, w, k0, k1, sc);
#if defined(PROBE_D1_SCORE2X)
        { float sd[16]; dsa_scores(iqf, w, k1, k0, sd);
#pragma unroll
          for (int r = 0; r < 16; ++r) asm volatile("" :: "v"(sd[r])); }
#endif
        const int lim = t - 32 * j - 4 * hi;
        const bool diag = (j == qg);
#pragma unroll
        for (int r = 0; r < 16; ++r) {
            const unsigned mono = dsa_mono(sc[r]);
            unsigned addr;
            if (PASS == 0) { addr = rowb + ((mono >> 22) << 2); if (diag && ((r & 3) + 8 * (r >> 2) > lim)) addr = rowb + 4096u; }
            else { addr = rowb + (((mono >> 12) & 1023u) << 2); if ((mono >> 22) != P1 || (diag && ((r & 3) + 8 * (r >> 2) > lim))) addr = rowb + 4096u; }
            __hip_atomic_fetch_add((LAS unsigned*)((LAS unsigned char*)hist + addr), 1u, __ATOMIC_RELAXED, __HIP_MEMORY_SCOPE_WORKGROUP);
#if defined(PROBE_D1_ATOM2X)
            __hip_atomic_fetch_add((LAS unsigned*)((LAS unsigned char*)hist + rowb + 4096u), 1u, __ATOMIC_RELAXED, __HIP_MEMORY_SCOPE_WORKGROUP);
#endif
        }
    }
}
__device__ __forceinline__ void dsa_scan(LAS unsigned* hist, LAS unsigned* AUX, int pass, int wid, int lane) {
#pragma unroll
    for (int qi = 0; qi < 4; ++qi) {
        const int qq = 4 * wid + qi;
        const unsigned K = (pass == 0) ? 256u : AUX[32 + qq];
        LAS const unsigned* hrow = hist + qq * DS_HP;
        const int wb = 1008 - 16 * lane;
        unsigned s = 0u;
#pragma unroll
        for (int i = 0; i < 16; ++i) s += hrow[wb + ((i + lane) & 15)];
        unsigned incl = s;
#pragma unroll
        for (int o = 1; o < 64; o <<= 1) { const unsigned v = shupu(incl, o, lane); if (lane >= o) incl += v; }
        const unsigned long long bal = __ballot(incl >= K);
        const int L = __builtin_amdgcn_readfirstlane(bal ? (__ffsll((long long)bal) - 1) : 0);
        const unsigned above = (unsigned)__builtin_amdgcn_readlane((int)(incl - s), L);
        const int bin = 1023 - 16 * L - (lane & 15);
        const unsigned c = (lane < 16) ? hrow[bin] : 0u;
        unsigned inc2 = c;
#pragma unroll
        for (int o = 1; o < 16; o <<= 1) { const unsigned v = shupu(inc2, o, lane); if (lane >= o) inc2 += v; }
        const unsigned long long bal2 = __ballot(lane < 16 && above + inc2 >= K);
        const int I = __builtin_amdgcn_readfirstlane(bal2 ? (__ffsll((long long)bal2) - 1) : 0);
        if (lane == I) { AUX[64 * pass + qq] = (unsigned)bin; AUX[64 * pass + 32 + qq] = K - (above + inc2 - c); }
    }
}
__device__ __forceinline__ void dsa_select_unit(LAS unsigned char* lds, int b, int qg, const bf16* IX, unsigned* MASK, int* REFPOS  , int* REFMIN  ) {
    int tid_l = threadIdx.x; asm volatile("" : "+v"(tid_l)); const int tid = tid_l, lane = tid & 63, wid = __builtin_amdgcn_readfirstlane(tid >> 6), r32 = lane & 31, hi = lane >> 5;
    const int t = 32 * qg + r32;
    const size_t rowg = (size_t)b * SEQ;
    const bf16* qrow = IX + (rowg + t) * 256;
    bf16x8 iqf[4][2];
#pragma unroll
    for (int hh = 0; hh < 4; ++hh)
#pragma unroll
        for (int ds = 0; ds < 2; ++ds) iqf[hh][ds] = *(const bf16x8*)(qrow + 32 * hh + 16 * ds + 8 * hi);
    float w[4];
    { const v2u ww = *(const v2u*)(qrow + 160); w[0] = bflo(ww.x); w[1] = bfhi(ww.x); w[2] = bflo(ww.y); w[3] = bfhi(ww.y); }
    LAS unsigned* hist = (LAS unsigned*)lds;
    LAS unsigned* AUX = (LAS unsigned*)(lds + DS_AUX);
    const bf16* kbase = IX + (rowg + r32) * 256 + 128 + 8 * hi;
    unsigned P = 0u;
    const bool all = (qg < 8);
    if (!all) {
        for (int i = tid; i < DS_HIST_BYTES / 16; i += 512) ((LAS v4u*)lds)[i] = (v4u){0u, 0u, 0u, 0u};
#if defined(PROBE_D1_ZERO2X)
        __syncthreads(); for (int i = tid; i < DS_HIST_BYTES / 16; i += 512) ((LAS v4u*)lds)[i] = (v4u){0u, 0u, 0u, 0u}; __syncthreads(); for (int i = tid; i < DS_HIST_BYTES / 16; i += 512) ((LAS v4u*)lds)[i] = (v4u){0u, 0u, 0u, 0u};
#endif
        __syncthreads();
        dsa_hist_pass<0>(hist, iqf, w, kbase, qg, wid, r32, hi, t, 0u);
        __syncthreads();
        dsa_scan(hist, AUX, 0, wid, lane);
#if defined(PROBE_D1_SCAN2X)
        __syncthreads(); dsa_scan(hist, AUX, 0, wid, lane);
#endif
        __syncthreads();
        const unsigned P1 = AUX[r32];
        for (int i = tid; i < DS_HIST_BYTES / 16; i += 512) ((LAS v4u*)lds)[i] = (v4u){0u, 0u, 0u, 0u};
        __syncthreads();
        dsa_hist_pass<1>(hist, iqf, w, kbase, qg, wid, r32, hi, t, P1);
        __syncthreads();
        dsa_scan(hist, AUX, 1, wid, lane);
#if defined(PROBE_D1_SCAN2X)
        __syncthreads(); dsa_scan(hist, AUX, 1, wid, lane);
#endif
        __syncthreads();
        P = (P1 << 10) | AUX[64 + r32];
    }
    if (all) { if (tid < 32) { AUX[64 + 32 + tid] = 0u; } }
    for (int i = tid; i < (2 * 32 * DS_BP * 4) / 16; i += 512) ((LAS v4u*)lds)[i] = (v4u){0u, 0u, 0u, 0u};
    __syncthreads();
    LAS unsigned* G = (LAS unsigned*)(lds + DS_G);
    LAS unsigned* C = (LAS unsigned*)(lds + DS_C);
    bf16x8 nk0, nk1;
    { const int j0 = (wid <= qg) ? wid : 0; nk0 = *(const bf16x8*)(kbase + (size_t)j0 * 32 * 256); nk1 = *(const bf16x8*)(kbase + (size_t)j0 * 32 * 256 + 16); }
#pragma nounroll
    for (int j = wid; j <= qg; j += 8) {
        const bf16x8 k0 = nk0, k1 = nk1;
        { const int jn = (j + 8 <= qg) ? j + 8 : j; const bf16* kp = kbase + (size_t)jn * 32 * 256; nk0 = *(const bf16x8*)kp; nk1 = *(const bf16x8*)(kp + 16); }
        float sc[16]; dsa_scores(iqf, w, k0, k1, sc);
        unsigned bg = 0u, bc = 0u;
        const int lim = t - 32 * j - 4 * hi;
#pragma unroll
        for (int r = 0; r < 16; ++r) {
            const int pos = (r & 3) + 8 * (r >> 2) + 4 * hi;
            const unsigned p22 = dsa_mono(sc[r]) >> 12;
            const bool ok = ((r & 3) + 8 * (r >> 2)) <= lim;
            if (ok && p22 > P) bg |= 1u << pos;
            if (ok && p22 == P) bc |= 1u << pos;
        }
        bg |= shxu(bg, 32, lane); bc |= shxu(bc, 32, lane);
        if (hi == 0) { G[r32 * DS_BP + j] = bg; C[r32 * DS_BP + j] = bc; }
    }
    __syncthreads();
#pragma unroll
    for (int qi = 0; qi < 4; ++qi) {
        const int qq = 4 * wid + qi;
        const unsigned K2 = AUX[64 + 32 + qq];
        const unsigned w0 = C[qq * DS_BP + 2 * lane], w1 = C[qq * DS_BP + 2 * lane + 1];
        const unsigned pc = (unsigned)__popc(w0) + (unsigned)__popc(w1);
        unsigned incl = pc;
#pragma unroll
        for (int o = 1; o < 64; o <<= 1) { const unsigned v = shupu(incl, o, lane); if (lane >= o) incl += v; }
        const unsigned pre = incl - pc;
        unsigned need = K2 > pre ? K2 - pre : 0u;
        const unsigned t0 = take_low(w0, need); need -= (unsigned)__popc(t0);
        const unsigned t1 = take_low(w1, need);
        const unsigned g0 = G[qq * DS_BP + 2 * lane] | t0, g1 = G[qq * DS_BP + 2 * lane + 1] | t1;
        G[qq * DS_BP + 2 * lane] = g0; G[qq * DS_BP + 2 * lane + 1] = g1;
        int hp = g1 ? (64 * lane + 63 - __clz((int)g1)) : (g0 ? (64 * lane + 31 - __clz((int)g0)) : -1);
#pragma unroll
        for (int o = 1; o < 64; o <<= 1) { const int v = (int)shxu((unsigned)hp, o, lane); hp = v > hp ? v : hp; }
        if (lane == 0) { REFPOS[rowg + 32 * qg + qq] = hp; AUX[128 + qq] = (unsigned)hp; }
    }
    __syncthreads();
    if (tid == 0) { int mn = 0x7fffffff; for (int i = 0; i < 32; ++i) { const int v = (int)AUX[128 + i]; mn = v < mn ? v : mn; } REFMIN[b * 128 + qg] = mn; }
    { const int qq = tid >> 4, part = tid & 15;
        unsigned* dst = MASK + (rowg + 32 * qg + qq) * 128 + part * 8;
        v4u a, c2;
        a.x = G[qq * DS_BP + part * 8 + 0]; a.y = G[qq * DS_BP + part * 8 + 1]; a.z = G[qq * DS_BP + part * 8 + 2]; a.w = G[qq * DS_BP + part * 8 + 3];
        c2.x = G[qq * DS_BP + part * 8 + 4]; c2.y = G[qq * DS_BP + part * 8 + 5]; c2.z = G[qq * DS_BP + part * 8 + 6]; c2.w = G[qq * DS_BP + part * 8 + 7];
        *(v4u*)dst = a; *(v4u*)(dst + 4) = c2; }
    __syncthreads();
}

constexpr int PL_U = 0, PL_UP = 528, PL_D = 79 * 528 + 16  , PL_DP = 257;
__device__ __forceinline__ void pool_unit(LAS unsigned char* lds, int b, int tile, const bf16* PU, const float* wpool  , const float* pscale  , bf16* YC) {
    int tid_l = threadIdx.x; asm volatile("" : "+v"(tid_l)); const int tid = tid_l, cb = __builtin_amdgcn_readfirstlane(tid >> 6), tt = tid & 63;
    const int t0 = tile * 64; const size_t rowg = (size_t)b * SEQ;
    for (int i = tid; i < 79 * 32; i += 512) { const int rr = i >> 5, ch = i & 31; const int tok = t0 - 15 + rr;
        v4u v = (v4u){0u, 0u, 0u, 0u}; if (tok >= 0) v = *(const v4u*)(PU + (rowg + tok) * 256 + ch * 8);
        *(LAS v4u*)(lds + PL_U + rr * PL_UP + ch * 16) = v; }
    __syncthreads();
    const int g = cb >> 1, wlen = 2 << g, c0 = 32 * cb, t = t0 + tt;
    const float inv = 1.f / (float)((t + 1 < wlen) ? (t + 1) : wlen);
    LAS float* Dm = (LAS float*)(lds + PL_D);
#pragma unroll
    for (int ch = 0; ch < 4; ++ch) {
        float sum[8];
#pragma unroll
        for (int e = 0; e < 8; ++e) sum[e] = 0.f;
        float self[8];
        for (int i = 0; i < wlen; ++i) {
            const v4u v = *(LAS const v4u*)(lds + PL_U + (15 + tt - i) * PL_UP + (c0 + 8 * ch) * 2);
            const float f[8] = {bflo(v.x), bfhi(v.x), bflo(v.y), bfhi(v.y), bflo(v.z), bfhi(v.z), bflo(v.w), bfhi(v.w)};
#pragma unroll
            for (int e = 0; e < 8; ++e) { sum[e] += f[e]; if (i == 0) self[e] = f[e]; }
        }
#pragma unroll
        for (int e = 0; e < 8; ++e) Dm[tt * PL_DP + c0 + 8 * ch + e] = sum[e] * inv - self[e];
    }
    __syncthreads();
    const int e0 = 32 * (cb & 1);
    float acc[32];
#pragma unroll
    for (int e = 0; e < 32; ++e) acc[e] = 0.f;
    const float* wg = wpool + (size_t)g * 4096 + e0;
    for (int c = 0; c < 64; ++c) {
        const float dv = Dm[tt * PL_DP + 64 * g + c];
        const float* wr = wg + c * 64;
#pragma unroll
        for (int e = 0; e < 32; ++e) acc[e] = __builtin_fmaf(dv, wr[e], acc[e]);
    }
    bf16* orow = YC + (rowg + t) * 256 + 64 * g + e0;
    const float* ps = pscale + 64 * g + e0;
#pragma unroll
    for (int k = 0; k < 4; ++k) { v4u o;
        o.x = pk2(acc[8 * k + 0] * ps[8 * k + 0], acc[8 * k + 1] * ps[8 * k + 1]); o.y = pk2(acc[8 * k + 2] * ps[8 * k + 2], acc[8 * k + 3] * ps[8 * k + 3]);
        o.z = pk2(acc[8 * k + 4] * ps[8 * k + 4], acc[8 * k + 5] * ps[8 * k + 5]); o.w = pk2(acc[8 * k + 6] * ps[8 * k + 6], acc[8 * k + 7] * ps[8 * k + 7]);
        *(v4u*)(orow + 8 * k) = o; }
    __syncthreads();
}
__device__ __forceinline__ void kmean_item(int item, const bf16* AK, float* KMEAN, int wid, int lane_in) {
    int lane = lane_in; asm volatile("" : "+v"(lane));
    const int combo = item * 8 + wid; const int b = combo >> 6, h = (combo >> 4) & 3, n = combo & 15;
    const int ks = lane >> 3, ch = lane & 7;
    const bf16* p = AK + ((size_t)b * SEQ + 256 * n + ks) * 256 + 64 * h + 8 * ch;
    float s[8];
#pragma unroll
    for (int e = 0; e < 8; ++e) s[e] = 0.f;
#pragma unroll 8
    for (int j = 0; j < 32; ++j) { const v4u v = *(const v4u*)(p + (size_t)j * 8 * 256);
        s[0] += bflo(v.x); s[1] += bfhi(v.x); s[2] += bflo(v.y); s[3] += bfhi(v.y); s[4] += bflo(v.z); s[5] += bfhi(v.z); s[6] += bflo(v.w); s[7] += bfhi(v.w); }
#pragma unroll
    for (int e = 0; e < 8; ++e) { s[e] += shx(s[e], 8, lane); s[e] += shx(s[e], 16, lane); s[e] += shx(s[e], 32, lane); }
    if (ks == 0) { float* o = KMEAN + (size_t)combo * 64 + 8 * ch;
        *(f32x4*)o = (f32x4){s[0], s[1], s[2], s[3]} * (1.f / 256.f); *(f32x4*)(o + 4) = (f32x4){s[4], s[5], s[6], s[7]} * (1.f / 256.f); }
}

__device__ __forceinline__ void norm_unit(LAS unsigned char* lds, int n, const bf16* PROJ, size_t TS, unsigned* NRM  ) {
    int tid_l = threadIdx.x; asm volatile("" : "+v"(tid_l)); const int tid = tid_l, lane = tid & 63, wid = __builtin_amdgcn_readfirstlane(tid >> 6);
    const int a = n >> 8, rem = n & 255, sq = rem >> 7, b = (rem >> 4) & 7, c = rem & 15;
    const int tile = (a == 0 ? 0 : (a == 1 ? 3 : 7)) + sq;
    const int row = tid >> 1, hp = tid & 1;
    float ss[2] = {0.f, 0.f};
#pragma unroll
    for (int rr = 0; rr < 1; ++rr) {
        const bf16* p = PROJ + (size_t)tile * TS + ((size_t)b * SEQ + 256 * c + row) * 256 + 128 * hp;
#pragma unroll
        for (int hh = 0; hh < 2; ++hh) { float acc = 0.f;
#pragma unroll
            for (int i = 0; i < 8; ++i) { const v4u v = *(const v4u*)(p + 64 * hh + 8 * i);
                const float f0 = bflo(v.x), f1 = bfhi(v.x), f2 = bflo(v.y), f3 = bfhi(v.y), f4 = bflo(v.z), f5 = bfhi(v.z), f6 = bflo(v.w), f7 = bfhi(v.w);
                acc += (f0 * f0 + f1 * f1) + (f2 * f2 + f3 * f3) + (f4 * f4 + f5 * f5) + (f6 * f6 + f7 * f7); }
            ss[hh] = fmaxf(ss[hh], acc); }
    }
#pragma unroll
    for (int o = 2; o < 64; o <<= 1) { ss[0] = fmaxf(ss[0], shx(ss[0], o, lane)); ss[1] = fmaxf(ss[1], shx(ss[1], o, lane)); }
    LAS float* R = (LAS float*)lds;
    if (lane < 2) { R[wid * 4 + 2 * hp] = ss[0]; R[wid * 4 + 2 * hp + 1] = ss[1]; }
    __syncthreads();
    if (tid < 4) { float m = R[tid];
#pragma unroll
        for (int w2 = 1; w2 < 8; ++w2) m = fmaxf(m, R[w2 * 4 + tid]);
        __hip_atomic_fetch_max(NRM + ((a * 2 + sq) * 8 + b) * 4 + tid, __float_as_uint(m * 1.0001f), __ATOMIC_RELAXED, __HIP_MEMORY_SCOPE_AGENT); }
    __syncthreads();
}

__device__ __forceinline__ float alibi_slope(int idx  ) { return exp2f(-8.f * (float)idx / 12.f); }

__device__ __forceinline__ void p0_adaln(const Args& A, LAS unsigned char* lds, int G) {
    int tid_l = threadIdx.x; asm volatile("" : "+v"(tid_l)); const int tid = tid_l, lane = tid & 63, wid = __builtin_amdgcn_readfirstlane(tid >> 6);
    LAS float* cact = (LAS float*)lds;
    LAS float* red = (LAS float*)(lds + 32768);
    float* MOD = (float*)(A.ws + WS_MOD);
    if ((int)blockIdx.x < 192) {
        for (int i = tid; i < 8192; i += 512) { const int bb = i >> 10, k = i & 1023; const float v = A.c[i]; cact[k * 8 + bb] = v / (1.f + __expf(-v)); }
        __syncthreads();
        for (int u = blockIdx.x; u < 192; u += G) {
            const int l = u / 96, n0 = (u % 96) * 64;
            const float* wp = A.w_ada + ((size_t)l * 1024 + 128 * wid) * 6144 + n0 + lane;
            float acc[8];
#pragma unroll
            for (int bb = 0; bb < 8; ++bb) acc[bb] = 0.f;
#pragma unroll 16
            for (int k = 0; k < 128; ++k) {
                const float wv = wp[(size_t)k * 6144];
                const f32x4 c0 = *(LAS const f32x4*)(cact + (128 * wid + k) * 8), c1 = *(LAS const f32x4*)(cact + (128 * wid + k) * 8 + 4);
                acc[0] += c0[0] * wv; acc[1] += c0[1] * wv; acc[2] += c0[2] * wv; acc[3] += c0[3] * wv;
                acc[4] += c1[0] * wv; acc[5] += c1[1] * wv; acc[6] += c1[2] * wv; acc[7] += c1[3] * wv;
            }
#pragma unroll
            for (int bb = 0; bb < 8; ++bb) red[(wid * 8 + bb) * 64 + lane] = acc[bb];
            __syncthreads();
            { const int bb = wid; float s = A.b_ada[(size_t)l * 6144 + n0 + lane];
#pragma unroll
                for (int w2 = 0; w2 < 8; ++w2) s += red[(w2 * 8 + bb) * 64 + lane];
                MOD[((size_t)l * 8 + bb) * 6144 + n0 + lane] = s; }
            __syncthreads();
        }
    }
    __syncthreads();
}
__device__ __forceinline__ void p0_weights(const Args& A, LAS unsigned char* lds, int vcu, int G, int l0, int l1) {
    int tid_l = threadIdx.x; asm volatile("" : "+v"(tid_l)); const int tid = tid_l, lane = tid & 63, wid = __builtin_amdgcn_readfirstlane(tid >> 6);
    unsigned char* ws = A.ws;
    LAS float* scr = (LAS float*)(lds + wid * 16384);
    const int gw = vcu * NWAVES + wid, NGW = G * NWAVES;
    constexpr int I_IN = 16 * (NPROJ_PAD / 32), I_G1 = 16 * 32, I_BR1 = 4 * 32, I_OUT = 16 * 32, I_F1 = 16 * 128, I_F2 = 64 * 32;
    constexpr int I_LAYER = I_IN + 4 * I_G1 + 4 * I_BR1 + I_OUT + I_F1 + I_F2;
    for (int it = l0 * I_LAYER + gw; it < l1 * I_LAYER; it += NGW) {
        const int l = it / I_LAYER; int r = it % I_LAYER;
        bf16* WL = (bf16*)(ws + WS_W) + (size_t)l * W_LAYER;
        if (r < I_IN) { p0_transpose_item(A.w_in + (size_t)l * DM * NPROJ, DM, NPROJ, NPROJ_PAD, WL + W_IN, 0, 0, scr, r, lane); continue; } r -= I_IN;
        if (r < 4 * I_G1) { const int br = r / I_G1; p0_transpose_item(A.w_gate + ((size_t)l * 4 + br) * DM * DM, DM, DM, DM, WL + W_GATE, 1, br, scr, r % I_G1, lane); continue; } r -= 4 * I_G1;
        if (r < 4 * I_BR1) { const int br = r / I_BR1; p0_transpose_item(A.w_branch + ((size_t)l * 4 + br) * 256 * DM, 256, DM, DM, WL + W_BR + (size_t)br * DM * 256, 0, 0, scr, r % I_BR1, lane); continue; } r -= 4 * I_BR1;
        if (r < I_OUT) { p0_transpose_item(A.w_out + (size_t)l * DM * DM, DM, DM, DM, WL + W_OUT, 0, 0, scr, r, lane); continue; } r -= I_OUT;
        if (r < I_F1) { p0_transpose_item(A.w_ff1 + (size_t)l * DM * FF, DM, FF, FF, WL + W_FF1, 0, 0, scr, r, lane); continue; } r -= I_F1;
        p0_transpose_item(A.w_ff2 + (size_t)l * FF * DM, FF, DM, DM, WL + W_FF2, 0, 0, scr, r, lane);
    }
    __syncthreads();
}

__device__ __forceinline__ int wq_draw(gu32* ctr) { int v = 0; if (threadIdx.x == 0) v = (int)__hip_atomic_fetch_add(ctr, 1u, RLX_AGENT); return v; }
__device__ __forceinline__ int wq_bcast(volatile LAS unsigned* slot, int v) {
    if (threadIdx.x == 0) *slot = (unsigned)v;
    __syncthreads();
    const int item = (int)*slot;
    __syncthreads();
    return item;
}

#ifndef ZG_ALIGN
#define ZG_ALIGN true
#define ZG_SP2 false
#endif
#ifndef IN_ALIGN
#define IN_ALIGN true
#define IN_SP2 true
#endif
#ifndef GT_ALIGN
#define GT_ALIGN true
#define GT_SP2 true
#endif
#ifndef WO_ALIGN
#define WO_ALIGN true
#define WO_SP2 true
#endif
#ifndef F1_ALIGN
#define F1_ALIGN true
#define F1_SP2 true
#endif
#ifndef F2_ALIGN
#define F2_ALIGN true
#define F2_SP2 true
#endif
struct ZOrder {
    pg8::StaticOrder base;
    __device__ __forceinline__ bool next(int i, pg8::Unit& u) const { if (!base.next(i, u)) return false; u.pn += 4 * (u.pm >> 7); return true; }
    __device__ __forceinline__ void a_ready(const pg8::Unit&) const {}
    __device__ __forceinline__ void done(const pg8::Unit&) const {}
};

__global__ void __launch_bounds__(NWAVES * 64, 2) hybrid_fwd(Args args) {
    extern __shared__ __attribute__((aligned(16))) unsigned char lds_raw[];
    LAS unsigned char* lds = (LAS unsigned char*)lds_raw;
#define PHASE_IDS int tid_p = threadIdx.x; asm volatile("" : "+v"(tid_p)); const int lane = tid_p & 63, wid = __builtin_amdgcn_readfirstlane(tid_p >> 6); const int gw = vcu * NWAVES + wid, ngw = G * NWAVES; (void)lane; (void)gw; (void)ngw;
    const int G = gridDim.x; const int bx = blockIdx.x; const int vcu = (G % 8 == 0) ? (bx % 8) * (G / 8) + bx / 8 : bx;
    unsigned char* ws = args.ws;
    gu32* ctl = (gu32*)(ws + WS_CTL);
    volatile LAS unsigned* MISC = (volatile LAS unsigned*)(lds + LDSCTL_OFF);
    for (int u = threadIdx.x; u < (LDS_BYTES - LDSCTL_OFF) / 4; u += NWAVES * 64) ((LAS unsigned*)(lds + LDSCTL_OFF))[u] = 0u;
    __syncthreads();
    const int lo = args.ph_lo, hi = args.ph_hi;
    XcdBarrier bar; bar.bar = (unsigned*)(ctl + CW_BAR) + args.li * XCD_BAR_WORDS; bar.x = 0; bar.st = nullptr;
    if (hi - lo > 1) bar = xcd_barrier_post((unsigned*)(ctl + CW_BAR) + args.li * XCD_BAR_WORDS, MISC + 8);
#ifndef PHASE_OFF
#define PHASE_OFF 0
#endif
#define IN(k) (lo <= (k) && (k) < hi && !((PHASE_OFF >> ((k) == 0 ? 0 : (k) == 21 ? 11 : (((k) - 1) % 10) + 1)) & 1))
#ifndef REPEAT_MASK
#define REPEAT_MASK 0
#endif
#define NREP(bit) (((REPEAT_MASK >> (bit)) & 1) ? 2 : 1)
#if defined(PROBE_SEAM2X)
#define SEAM(k) do { if (IN(k) && IN((k) + 1)) { xcd_barrier(bar); xcd_barrier(bar); } } while (0)
#else
#define SEAM(k) do { if (IN(k) && IN((k) + 1)) xcd_barrier(bar); } while (0)
#endif
    float* MOD = (float*)(ws + WS_MOD);
    float* KMEAN = (float*)(ws + WS_KMEAN);
    int* REFPOS = (int*)(ws + WS_KMEAN + 128 * 1024);
    int* REFMIN = (int*)(ws + WS_KMEAN + 256 * 1024);
    unsigned* MASK = (unsigned*)(ws + WS_MASK);
    bf16* H = (bf16*)(ws + WS_H);
    bf16* Y = (bf16*)(ws + WS_Y);
    bf16* MERGED = (bf16*)(ws + WS_Y);
    bf16* PROJ = (bf16*)(ws + WS_R);
    unsigned char* Z = ws + WS_R;
    bf16* U = (bf16*)(ws + WS_R);
    bf16* XRB = (bf16*)args.out;
    constexpr size_t TS = (size_t)TOK * 256;
    volatile LAS unsigned* wqslot = MISC + 16;

    if (IN(0)) for (int rep = 0; rep < NREP(0); ++rep) { p0_adaln(args, lds, G); }
    SEAM(0);

#pragma nounroll
    for (int l = 0; l < NL; ++l) {
        const int pb = 1 + 10 * l;
        const float* modl = MOD + (size_t)l * 8 * 6144;
        const bf16* WL = (const bf16*)(ws + WS_W) + (size_t)l * W_LAYER;
        if (IN(pb + 0)) for (int rep = 0; rep < NREP(1); ++rep) { PHASE_IDS if (l == 0) norm_rows_bf16<false>(args.x, H, args.norm1_g + (size_t)l * DM, modl, 0, 1, gw, ngw, lane); else norm_rows_bf16<true>(XRB, H, args.norm1_g + (size_t)l * DM, modl, 0, 1, gw, ngw, lane); if (l == 0) p0_weights(args, lds, vcu, G, 0, 1); }
        SEAM(pb + 0);
        if (IN(pb + 1)) for (int rep = 0; rep < NREP(2); ++rep) {
            pg8::Gemm g{H, WL + W_IN, TOK, NPROJ_PAD, DM}; pg8::StaticOrder S; S.init(TOK, NPROJ_PAD, G, bx);
            pg8::EpiProj E{PROJ, TS};
            pg8::gemm_phase<pg8::EpiProj, pg8::StaticOrder, IN_ALIGN, IN_SP2>(lds, g, S, E);
            if (l == 0 && rep == 0 && bx >= 128) p0_weights(args, lds, bx - 128, G - 128, 1, 2);
        }
        SEAM(pb + 1);
        unsigned* NRM = (unsigned*)(ctl + CW_NRM) + l * 192;
        if (IN(pb + 2)) for (int rep = 0; rep < NREP(3); ++rep) {
            gu32* ctr = ctl + CW_WQ + (l * 2 + 0 + 4 * rep) * 64;
            int raw = wq_draw(ctr);
            for (;;) {
#ifndef REPA_LO
#define REPA_LO 0
#define REPA_HI 2368
#endif
                const int item = wq_bcast(wqslot, raw) + (rep ? REPA_LO : 0);
                if (item >= (rep ? REPA_HI : 2368)) break;
                raw = wq_draw(ctr);
                if (item < 1024) { const int qg = 127 - (item >> 3), b = item & 7;
                    dsa_select_unit(lds, b, qg, PROJ + 10 * TS, MASK, REFPOS, REFMIN);
                } else if (item < 1536) { const int i2 = item - 1024; const int b = i2 >> 6, tile = i2 & 63;
                    pool_unit(lds, b, tile, PROJ + 6 * TS, args.w_pool + (size_t)l * 4 * 4096, args.pool_scale + (size_t)l * 256, Y + 2 * TS);
                } else if (item < 1600) { PHASE_IDS kmean_item(item - 1536, PROJ + 1 * TS, KMEAN, wid, lane);
                } else { norm_unit(lds, item - 1600, PROJ, TS, NRM); }
            }
        }
        SEAM(pb + 2);
        if (IN(pb + 3)) for (int rep = 0; rep < NREP(4); ++rep) {
            gu32* ctr = ctl + CW_WQ + 512 + ((l * 2 + rep) * 8) * 64;
            const float li = 0.8f - 0.6f * __expf(-0.3f * (float)l);
            const float* dl = args.diff_lambda + (size_t)l * 128;
            float d1 = 0.f, d2 = 0.f;
            for (int i = 0; i < 32; ++i) { d1 += dl[i] * dl[32 + i]; d2 += dl[64 + i] * dl[96 + i]; }
            const float lam = __expf(d1) - __expf(d2) + li;
            int raw = wq_draw(ctr);
            for (;;) {
                const int item = wq_bcast(wqslot, raw);
                if (item >= 1536) break;
                raw = wq_draw(ctr);
                const int ty = item % 3, rest = item / 3; const int qb = 15 - (rest >> 5), bh = rest & 31, b = bh >> 2, h = bh & 3;
                if (ty == 0) attn_unit<1>(lds, b, h, qb, PROJ + 3 * TS, PROJ + 4 * TS, PROJ + 5 * TS, Y + 1 * TS, alibi_slope(3 * h + 2), nullptr, lam, 1.f - li, args.diff_subln_g + (size_t)l * 64, nullptr, NRM + 64, nullptr, nullptr);
                else if (ty == 1) attn_unit<0>(lds, b, h, qb, PROJ + 0 * TS, PROJ + 1 * TS, PROJ + 2 * TS, Y + 0 * TS, alibi_slope(3 * h + 1), KMEAN, 0.f, 0.f, nullptr, nullptr, NRM, nullptr, nullptr);
                else              attn_unit<2>(lds, b, h, qb, PROJ + 7 * TS, PROJ + 8 * TS, PROJ + 9 * TS, Y + 3 * TS, alibi_slope(3 * h + 3), nullptr, 0.f, 0.f, nullptr, MASK, NRM + 128, REFPOS, REFMIN);
            }
        }
        SEAM(pb + 3);
        if (IN(pb + 4)) for (int rep = 0; rep < NREP(5); ++rep) {
            int kz = 256; asm volatile("" : "+s"(kz)); pg8::Gemm g{Y, WL + W_BR, 4 * TOK, 4096, kz}; ZOrder S; S.base.init(4 * TOK, DM, G, bx);
            pg8::EpiZ E{Z};
            pg8::gemm_phase<pg8::EpiZ, ZOrder, ZG_ALIGN, ZG_SP2>(lds, g, S, E);
        }
        SEAM(pb + 4);
        if (IN(pb + 5)) for (int rep = 0; rep < NREP(6); ++rep) {
            pg8::Gemm g{H, WL + W_GATE, TOK, 4096, DM}; pg8::StaticOrder S; S.init(TOK, 4096, G, bx);
            pg8::EpiGate E{Z, args.b_gate + (size_t)l * 4 * DM, MERGED};
            pg8::gemm_phase<pg8::EpiGate, pg8::StaticOrder, GT_ALIGN, GT_SP2>(lds, g, S, E);
        }
        SEAM(pb + 5);
        if (IN(pb + 6)) for (int rep = 0; rep < NREP(7); ++rep) {
            pg8::Gemm g{MERGED, WL + W_OUT, TOK, DM, DM}; pg8::StaticOrder S; S.init(TOK, DM, G, bx);
            if (l == 0) { pg8::EpiResid<false> E{args.x, rep ? (bf16*)(ws + WS_R) : XRB, modl + 2 * 1024};
                pg8::gemm_phase<pg8::EpiResid<false>, pg8::StaticOrder, WO_ALIGN, WO_SP2>(lds, g, S, E); }
            else { pg8::EpiResid<true> E{XRB, rep ? (bf16*)(ws + WS_R) : XRB, modl + 2 * 1024};
                pg8::gemm_phase<pg8::EpiResid<true>, pg8::StaticOrder, WO_ALIGN, WO_SP2>(lds, g, S, E); }
        }
        SEAM(pb + 6);
        if (IN(pb + 7)) for (int rep = 0; rep < NREP(8); ++rep) { PHASE_IDS norm_rows_bf16<true>(XRB, H, args.norm2_g + (size_t)l * DM, modl, 3, 4, gw, ngw, lane); }
        SEAM(pb + 7);
        if (IN(pb + 8)) for (int rep = 0; rep < NREP(9); ++rep) {
            pg8::Gemm g{H, WL + W_FF1, TOK, FF, DM}; pg8::StaticOrder S; S.init(TOK, FF, G, bx);
            pg8::EpiRelu2 E{U, FF};
            pg8::gemm_phase<pg8::EpiRelu2, pg8::StaticOrder, F1_ALIGN, F1_SP2>(lds, g, S, E);
        }
        SEAM(pb + 8);
        if (IN(pb + 9)) for (int rep = 0; rep < NREP(10); ++rep) {
            pg8::Gemm g{U, WL + W_FF2, TOK, DM, FF}; pg8::StaticOrder S; S.init(TOK, DM, G, bx);
            pg8::EpiResid<true> E{XRB, rep ? (bf16*)(ws + WS_MASK) : XRB, modl + 5 * 1024};
            pg8::gemm_phase<pg8::EpiResid<true>, pg8::StaticOrder, F2_ALIGN, F2_SP2>(lds, g, S, E);
        }
        SEAM(pb + 9);
    }
    if (IN(21)) {
        PHASE_IDS
        v4u xa[16], xb[16]; float rs[16];
        const v4u* xp = (const v4u*)(XRB + (size_t)gw * DM) + 2 * lane;
#pragma unroll
        for (int i = 0; i < 16; ++i) { xa[i] = xp[(size_t)i * ngw * (DM / 8)]; xb[i] = xp[(size_t)i * ngw * (DM / 8) + 1]; }
#pragma unroll
        for (int i = 0; i < 16; ++i) { const v4u a = xa[i], c = xb[i];
            float s = bflo(a.x) * bflo(a.x); s += bfhi(a.x) * bfhi(a.x); s += bflo(a.y) * bflo(a.y); s += bfhi(a.y) * bfhi(a.y); s += bflo(a.z) * bflo(a.z); s += bfhi(a.z) * bfhi(a.z); s += bflo(a.w) * bflo(a.w); s += bfhi(a.w) * bfhi(a.w);
            s += bflo(c.x) * bflo(c.x); s += bfhi(c.x) * bfhi(c.x); s += bflo(c.y) * bflo(c.y); s += bfhi(c.y) * bfhi(c.y); s += bflo(c.z) * bflo(c.z); s += bfhi(c.z) * bfhi(c.z); s += bflo(c.w) * bflo(c.w); s += bfhi(c.w) * bfhi(c.w);
            rs[i] = 1.f / sqrtf(wave_sum(s, lane) * (1.f / DM) + NORM_EPS); }
        xcd_barrier(bar);
#pragma unroll
        for (int i = 0; i < 16; ++i) asm volatile("" : "+v"(xa[i]), "+v"(xb[i]));
        const f32x4* gp = (const f32x4*)args.final_g + 4 * lane;
        f32x4* op = (f32x4*)(args.out + (size_t)gw * DM) + 4 * lane;
#pragma unroll
        for (int i = 0; i < 16; ++i) { const v4u a = xa[i], c = xb[i]; const float r = rs[i]; f32x4* o = op + (size_t)i * ngw * (DM / 4);
            o[0] = (f32x4){bflo(a.x), bfhi(a.x), bflo(a.y), bfhi(a.y)} * r * gp[0]; o[1] = (f32x4){bflo(a.z), bfhi(a.z), bflo(a.w), bfhi(a.w)} * r * gp[1];
            o[2] = (f32x4){bflo(c.x), bfhi(c.x), bflo(c.y), bfhi(c.y)} * r * gp[2]; o[3] = (f32x4){bflo(c.z), bfhi(c.z), bflo(c.w), bfhi(c.w)} * r * gp[3]; }
    }
#undef IN
#undef SEAM
}

#ifndef MK_SPLIT
#define MK_SPLIT 0
#endif
extern "C" void kernel_launch(void* const* d_in, const int* in_sizes, int n_in, void* d_out, int out_size, void* d_ws, size_t ws_size, hipStream_t stream) {
    static int grid = 0;
    if (grid == 0) {
        if (n_in != 18 || in_sizes[0] != TOK * DM || out_size != TOK * DM || ws_size < WS_END) { fprintf(stderr, "kernel_launch: unexpected shapes (n_in %d, in0 %d, out %d, ws %zu)\n", n_in, n_in > 0 ? in_sizes[0] : -1, out_size, ws_size); grid = -1; return; }
        int dev = 0, cus = 0, per_cu = 0;
        if (hipGetDevice(&dev) != hipSuccess || hipDeviceGetAttribute(&cus, hipDeviceAttributeMultiprocessorCount, dev) != hipSuccess) { grid = -1; return; }
        if (hipFuncSetAttribute((const void*)hybrid_fwd, hipFuncAttributeMaxDynamicSharedMemorySize, LDS_BYTES) != hipSuccess) { fprintf(stderr, "kernel_launch: hipFuncSetAttribute failed\n"); grid = -1; return; }
        if (hipOccupancyMaxActiveBlocksPerMultiprocessor(&per_cu, (const void*)hybrid_fwd, NWAVES * 64, LDS_BYTES) != hipSuccess || per_cu < 1) fprintf(stderr, "kernel_launch: occupancy query reports %d\n", per_cu);
        (void)hipGetLastError();
        grid = cus;
        if (cus != 256) { fprintf(stderr, "kernel_launch: built for 256 CUs (the final norm stages 16 rows per wave), found %d\n", cus); grid = -1; return; }
    }
    if (grid < 0) return;
    if (hipMemsetAsync((char*)d_ws + WS_CTL, 0, CTL_ZERO_BYTES, stream) != hipSuccess) return;
    Args a{};
    const float** ap = (const float**)&a;
    for (int i = 0; i < 18; ++i) ap[i] = (const float*)d_in[i];
    a.out = (float*)d_out; a.ws = (unsigned char*)d_ws; a.pad = 0;
#if MK_SPLIT
    for (int p = 0; p < NPHASE; ++p) { a.ph_lo = p; a.ph_hi = p + 1; a.li = 0;
        hipLaunchKernelGGL(hybrid_fwd, dim3(grid), dim3(NWAVES * 64), LDS_BYTES, stream, a); }
#else
    a.ph_lo = 0; a.ph_hi = NPHASE; a.li = 0;
    hipLaunchKernelGGL(hybrid_fwd, dim3(grid), dim3(NWAVES * 64), LDS_BYTES, stream, a);
#endif
}
```

```cpp
#include <hip/hip_runtime.h>
#include <cstdio>
#include <cstdint>
namespace pg8 {
#define PG8_LAS __attribute__((address_space(3)))
typedef unsigned short bf16_t;
typedef short bf16x8 __attribute__((ext_vector_type(8)));
typedef float f32x4 __attribute__((ext_vector_type(4)));
typedef unsigned u32x4 __attribute__((ext_vector_type(4)));
constexpr int BM = 256, BK = 64, HALF = 128, HTB = HALF * BK * 2  , STAGE_BYTES = 8 * HTB, NXCD = 8, WGM = 8;

__host__ __device__ __forceinline__ int lds_byte(int r, int c) { const int st = (r >> 4) * 2 + (c >> 5), rr = r & 15, cc = c & 31, ob = rr * 64 + cc * 2; return st * 1024 + (ob ^ (((ob >> 9) & 1) << 5)); }
__host__ __device__ __forceinline__ void stage_rc(int b, int& R, int& C) { const int st = b / 1024, sb = b % 1024, swz = sb ^ (((sb >> 9) & 1) << 5); R = (st >> 1) * 16 + swz / 64; C = (st & 1) * 32 + (swz % 64) / 2; }
__host__ __device__ __forceinline__ int perm32(int rho) { const int n = rho >> 4, i = rho & 15; return 8 * (i >> 2) + 4 * n + (i & 3); }

struct Unit { int pm, pn; };
struct Gemm { const bf16_t* A; const bf16_t* Bt; int M, N, K; };

struct StaticOrder {
    int nM, nN, nwg, G, c;
    __host__ __device__ void init(int M, int N, int G_, int c_) { nM = M / BM; nN = N / BM; nwg = nM * nN; G = G_; c = c_; }
    __host__ __device__ bool next(int i, Unit& u) const {
        const long L = (long)i * G + c; if (L >= nwg) return false;
        int wgid = (int)L; { const int q = nwg / NXCD, r = nwg % NXCD, xcd = wgid % NXCD, off = wgid / NXCD; wgid = (xcd < r ? xcd * (q + 1) : r * (q + 1) + (xcd - r) * q) + off; }
        const int nig = WGM * nN, gid = wgid / nig, fm = gid * WGM, gsz = (nM - fm) < WGM ? (nM - fm) : WGM;
        u.pm = fm + ((wgid % nig) % gsz); u.pn = (wgid % nig) / gsz; return true;
    }
    __device__ __forceinline__ void a_ready(const Unit&) const {}
    __device__ __forceinline__ void done(const Unit&) const {}
};

__device__ __forceinline__ unsigned cvt_pk_bf16(float lo, float hi) { unsigned r; asm volatile("v_cvt_pk_bf16_f32 %0, %1, %2" : "=v"(r) : "v"(lo), "v"(hi)); return r; }
typedef unsigned u32x2 __attribute__((ext_vector_type(2)));
constexpr int TT = 32768;
constexpr float QS64 = 0.125f * 1.4426950408889634f;
constexpr float QS32 = 0.17677669529663687f * 1.4426950408889634f;

struct EpiProj {
    static constexpr bool PERM = true, AFTER_DRAIN = false;
    bf16_t* O; size_t tile_stride;
    __device__ __forceinline__ void operator()(const f32x4 (&acc)[2][2][4][2], const Unit& u, int wr, int wc, int fr, int fq) const {
        const int row0 = u.pm * BM + wr * 64 + fr; bf16_t* base = O + (size_t)u.pn * tile_stride;
        float sc = 1.f; if (u.pn == 0 || u.pn == 7) sc = QS64; else if (u.pn == 3) sc = QS32;
        const int col0 = wc * 32 + 8 * fq;
#pragma unroll
        for (int ai = 0; ai < 2; ++ai)
#pragma unroll
            for (int m = 0; m < 4; ++m) { bf16_t* rowp = base + (size_t)(row0 + ai * HALF + m * 16) * 256 + col0;
#pragma unroll
                for (int bj = 0; bj < 2; ++bj) { const f32x4 v0 = acc[ai][bj][m][0] * sc, v1 = acc[ai][bj][m][1] * sc;
                    u32x4 w; w.x = cvt_pk_bf16(v0[0], v0[1]); w.y = cvt_pk_bf16(v0[2], v0[3]); w.z = cvt_pk_bf16(v1[0], v1[1]); w.w = cvt_pk_bf16(v1[2], v1[3]);
                    *(u32x4*)(rowp + bj * HALF) = w; } }
    }
};
struct EpiZ {
    static constexpr bool PERM = true, AFTER_DRAIN = false;
    unsigned char* O;
    __device__ __forceinline__ void operator()(const f32x4 (&acc)[2][2][4][2], const Unit& u, int wr, int wc, int fr, int fq) const {
        const int row0 = u.pm * BM + wr * 64 + fr; const int col0 = (u.pn & 3) * BM + wc * 32 + 8 * fq;
#pragma unroll
        for (int ai = 0; ai < 2; ++ai)
#pragma unroll
            for (int m = 0; m < 4; ++m) { unsigned char* rowp = O + (size_t)(row0 + ai * HALF + m * 16) * 1024 + col0;
#pragma unroll
                for (int bj = 0; bj < 2; ++bj) { const f32x4 v0 = acc[ai][bj][m][0], v1 = acc[ai][bj][m][1];
                    int w0 = __builtin_amdgcn_cvt_pk_fp8_f32(v0[0], v0[1], 0, false); w0 = __builtin_amdgcn_cvt_pk_fp8_f32(v0[2], v0[3], w0, true);
                    int w1 = __builtin_amdgcn_cvt_pk_fp8_f32(v1[0], v1[1], 0, false); w1 = __builtin_amdgcn_cvt_pk_fp8_f32(v1[2], v1[3], w1, true);
                    u32x2 w; w.x = (unsigned)w0; w.y = (unsigned)w1;
                    *(u32x2*)(rowp + bj * HALF) = w; } }
    }
};
struct EpiRelu2 {
    static constexpr bool PERM = true, AFTER_DRAIN = false;
    bf16_t* O; int ldc;
    __device__ __forceinline__ void operator()(const f32x4 (&acc)[2][2][4][2], const Unit& u, int wr, int wc, int fr, int fq) const {
        const int row0 = u.pm * BM + wr * 64 + fr; const int col0 = u.pn * BM + wc * 32 + 8 * fq;
#pragma unroll
        for (int ai = 0; ai < 2; ++ai)
#pragma unroll
            for (int m = 0; m < 4; ++m) { bf16_t* rowp = O + (size_t)(row0 + ai * HALF + m * 16) * ldc + col0;
#pragma unroll
                for (int bj = 0; bj < 2; ++bj) { f32x4 v0 = acc[ai][bj][m][0], v1 = acc[ai][bj][m][1];
#pragma unroll
                    for (int j = 0; j < 4; ++j) { const float a = fmaxf(v0[j], 0.f), b = fmaxf(v1[j], 0.f); v0[j] = a * a; v1[j] = b * b; }
                    u32x4 w; w.x = cvt_pk_bf16(v0[0], v0[1]); w.y = cvt_pk_bf16(v0[2], v0[3]); w.z = cvt_pk_bf16(v1[0], v1[1]); w.w = cvt_pk_bf16(v1[2], v1[3]);
                    *(u32x4*)(rowp + bj * HALF) = w; } }
    }
};
template <bool BASE_BF16> struct EpiResid {
    static constexpr bool PERM = true, AFTER_DRAIN = false;
    const void* base; bf16_t* out; const float* gate;
    __device__ __forceinline__ void operator()(const f32x4 (&acc)[2][2][4][2], const Unit& u, int wr, int wc, int fr, int fq) const {
        const int row0 = u.pm * BM + wr * 64 + fr; const int col0 = u.pn * BM + wc * 32 + 8 * fq;
        const float* gp = gate + (size_t)(u.pm >> 4) * 6144 + col0;
        f32x4 gv[2][2];
#pragma unroll
        for (int bj = 0; bj < 2; ++bj)
#pragma unroll
            for (int n = 0; n < 2; ++n) gv[bj][n] = *(const f32x4*)(gp + bj * HALF + n * 4);
#pragma unroll
        for (int ai = 0; ai < 2; ++ai)
#pragma unroll
            for (int m = 0; m < 4; ++m) { const size_t off = (size_t)(row0 + ai * HALF + m * 16) * 1024 + col0;
#pragma unroll
                for (int bj = 0; bj < 2; ++bj) { f32x4 b0, b1;
                    if (BASE_BF16) { const u32x4 w = *(const u32x4*)((const bf16_t*)base + off + bj * HALF);
                        b0 = (f32x4){__uint_as_float(w.x << 16), __uint_as_float(w.x & 0xffff0000u), __uint_as_float(w.y << 16), __uint_as_float(w.y & 0xffff0000u)};
                        b1 = (f32x4){__uint_as_float(w.z << 16), __uint_as_float(w.z & 0xffff0000u), __uint_as_float(w.w << 16), __uint_as_float(w.w & 0xffff0000u)}; }
                    else { b0 = *(const f32x4*)((const float*)base + off + bj * HALF); b1 = *(const f32x4*)((const float*)base + off + bj * HALF + 4); }
                    const f32x4 v0 = b0 + gv[bj][0] * acc[ai][bj][m][0], v1 = b1 + gv[bj][1] * acc[ai][bj][m][1];
                    u32x4 o; o.x = cvt_pk_bf16(v0[0], v0[1]); o.y = cvt_pk_bf16(v0[2], v0[3]); o.z = cvt_pk_bf16(v1[0], v1[1]); o.w = cvt_pk_bf16(v1[2], v1[3]);
                    *(u32x4*)(out + off + bj * HALF) = o; }
                if (m & 1) asm volatile("" ::: "memory"); }
    }
};
struct EpiGate {
    static constexpr bool PERM = true, AFTER_DRAIN = false;
    const unsigned char* Z; const float* bg; bf16_t* O;
    __device__ __forceinline__ void operator()(const f32x4 (&acc)[2][2][4][2], const Unit& u, int wr, int wc, int fr, int fq) const {
        const int row0 = u.pm * BM + wr * 64 + fr; const int mc0 = u.pn * 64 + wc * 16 + 4 * fq;
#pragma unroll
        for (int ai = 0; ai < 2; ++ai)
#pragma unroll
            for (int m = 0; m < 4; ++m) { const size_t row = (size_t)(row0 + ai * HALF + m * 16);
                f32x4 bv[2][2];
#pragma unroll
                for (int bj = 0; bj < 2; ++bj)
#pragma unroll
                    for (int n = 0; n < 2; ++n) bv[bj][n] = *(const f32x4*)(bg + (2 * bj + n) * 1024 + mc0);
                asm volatile("" ::: "memory");
                f32x4 sum = (f32x4){0.f, 0.f, 0.f, 0.f};
#pragma unroll
                for (int bj = 0; bj < 2; ++bj)
#pragma unroll
                    for (int n = 0; n < 2; ++n) { const int zr = *(const int*)(Z + ((size_t)(2 * bj + n) * TT + row) * 1024 + mc0);
                        const f32x4 x = acc[ai][bj][m][n] * (1.f / 32.f) + bv[bj][n]; f32x4 zz;
                        zz[0] = __builtin_amdgcn_cvt_f32_fp8(zr, 0); zz[1] = __builtin_amdgcn_cvt_f32_fp8(zr, 1); zz[2] = __builtin_amdgcn_cvt_f32_fp8(zr, 2); zz[3] = __builtin_amdgcn_cvt_f32_fp8(zr, 3);
#pragma unroll
                        for (int j = 0; j < 4; ++j) { const float g = __builtin_amdgcn_rcpf(1.f + __builtin_amdgcn_exp2f(-1.4426950408889634f * x[j])); sum[j] += g * zz[j]; } }
                u32x2 w; w.x = cvt_pk_bf16(sum[0], sum[1]); w.y = cvt_pk_bf16(sum[2], sum[3]);
                *(u32x2*)(O + row * 1024 + mc0) = w; }
    }
};
typedef int i32x8 __attribute__((ext_vector_type(8))); typedef int i32x4 __attribute__((ext_vector_type(4)));
__device__ __forceinline__ i32x8 cat16(bf16x8 a, bf16x8 b) { const i32x4 x = __builtin_bit_cast(i32x4, a), y = __builtin_bit_cast(i32x4, b); return __builtin_shufflevector(x, y, 0, 1, 2, 3, 4, 5, 6, 7); }
template <class Epi, class Sched, bool ALIGN_EPI = false, bool SP2 = false, bool FP8 = false>
__device__ __forceinline__ void gemm_phase(PG8_LAS unsigned char* lds, const Gemm g, const Sched& S, const Epi& E) {
    int tid_l = threadIdx.x; asm volatile("" : "+v"(tid_l)); const int tid = tid_l, wid = __builtin_amdgcn_readfirstlane(tid >> 6), lane = tid & 63, wr = wid >> 2, wc = wid & 3, fr = lane & 15, fq = lane >> 4;
    const int K = g.K, nt = K / BK;
    unsigned voffA[2], voffB[2];
#pragma unroll
    for (int i = 0; i < 2; ++i) { int R, C; stage_rc(tid * 16 + i * 8192, R, C); const int Rb = Epi::PERM ? ((R & ~31) + perm32(R & 31)) : R;
        voffA[i] = (unsigned)(R * K + C) * 2u; voffB[i] = (unsigned)(Rb * K + C) * 2u; }
    const size_t kstep = (size_t)(BK * 2);
    const size_t hstep = (size_t)HALF * K * 2;
    const size_t tstep = 2 * hstep;
    const unsigned ldsw = (unsigned)wid * 1024u;
    const int aoff = lds_byte(wr * 64 + fr, fq * 8), boff = lds_byte(wc * 32 + fr, fq * 8);
#define PG8_SA(b, h) (((b) * 2 + (h)) * HTB)
#define PG8_SB(b, h) ((4 + (b) * 2 + (h)) * HTB)
#define PG8_STAGE(bufoff, gbase, voff) do { _Pragma("unroll") for (int _i = 0; _i < 2; ++_i) \
        __builtin_amdgcn_global_load_lds((const unsigned*)((const char*)(gbase) + (voff)[_i]), (PG8_LAS unsigned*)(lds + (bufoff) + ldsw + _i * 8192), 16, 0, 0); } while (0)
#define PG8_LDA(dst, b, h) do { _Pragma("unroll") for (int m = 0; m < 4; ++m) _Pragma("unroll") for (int k = 0; k < 2; ++k) dst[m][k] = *(const PG8_LAS bf16x8*)(lds + PG8_SA(b, h) + aoff + m * 2048 + k * 1024); } while (0)
#define PG8_LDB(dst, b, h) do { _Pragma("unroll") for (int n = 0; n < 2; ++n) _Pragma("unroll") for (int k = 0; k < 2; ++k) dst[n][k] = *(const PG8_LAS bf16x8*)(lds + PG8_SB(b, h) + boff + n * 2048 + k * 1024); } while (0)
#define PG8_MMA(ai, bj, At, Bt) do { __builtin_amdgcn_s_setprio(1); _Pragma("unroll") for (int m = 0; m < 4; ++m) _Pragma("unroll") for (int n = 0; n < 2; ++n) { \
        if constexpr (FP8) { const i32x8 b8_ = cat16(Bt[n][0], Bt[n][1]), a8_ = cat16(At[m][0], At[m][1]); \
            asm volatile("v_mfma_scale_f32_16x16x128_f8f6f4 %0, %1, %2, %0, %3, %3 op_sel_hi:[0,0,0]" : "+v"(acc[ai][bj][m][n]) : "v"(b8_), "v"(a8_), "v"(sc127)); } \
        else { _Pragma("unroll") for (int k = 0; k < 2; ++k) acc[ai][bj][m][n] = __builtin_amdgcn_mfma_f32_16x16x32_bf16(Bt[n][k], At[m][k], acc[ai][bj][m][n], 0, 0, 0); } } \
        __builtin_amdgcn_s_setprio(0); } while (0)
#define PG8_WAIT_V(n) asm volatile("s_waitcnt vmcnt(" #n ")" ::: "memory")
#define PG8_WAIT_L(n) asm volatile("s_waitcnt lgkmcnt(" #n ")" ::: "memory")
#define PG8_BAR __builtin_amdgcn_s_barrier()
#define PG8_SCHED __builtin_amdgcn_sched_barrier(0)
    Unit cur, nxt; int ui = 0;
    int sc127 = 127; asm volatile("" : "+v"(sc127));
    if (!S.next(0, cur)) return;
    f32x4 acc[2][2][4][2];
#pragma unroll
    for (int a = 0; a < 2; ++a)
#pragma unroll
        for (int b = 0; b < 2; ++b)
#pragma unroll
            for (int m = 0; m < 4; ++m)
#pragma unroll
                for (int n = 0; n < 2; ++n) acc[a][b][m][n] = (f32x4){0.f, 0.f, 0.f, 0.f};
    bf16x8 At[4][2], B0[2][2], B1[2][2];
    const char* cA = (const char*)g.A + (size_t)cur.pm * tstep; const char* cB = (const char*)g.Bt + (size_t)cur.pn * tstep;
    S.a_ready(cur);
    if constexpr (SP2) {
        PG8_STAGE(PG8_SB(0, 0), cB, voffB); PG8_STAGE(PG8_SB(0, 1), cB + hstep, voffB); PG8_STAGE(PG8_SA(0, 0), cA, voffA); PG8_STAGE(PG8_SA(0, 1), cA + hstep, voffA);
        if (wr == 1) PG8_BAR;
        PG8_WAIT_V(2); PG8_BAR;
        PG8_STAGE(PG8_SB(1, 0), cB + kstep, voffB); PG8_STAGE(PG8_SA(1, 0), cA + kstep, voffA); PG8_STAGE(PG8_SB(1, 1), cB + hstep + kstep, voffB);
        PG8_WAIT_V(6); PG8_BAR;
    } else {
        PG8_STAGE(PG8_SB(0, 0), cB, voffB); PG8_STAGE(PG8_SA(0, 0), cA, voffA); PG8_STAGE(PG8_SB(0, 1), cB + hstep, voffB); PG8_STAGE(PG8_SA(0, 1), cA + hstep, voffA);
        if (wr == 1) PG8_BAR;
        PG8_WAIT_V(4); PG8_BAR;
        PG8_STAGE(PG8_SB(1, 0), cB + kstep, voffB); PG8_STAGE(PG8_SA(1, 0), cA + kstep, voffA); PG8_STAGE(PG8_SB(1, 1), cB + hstep + kstep, voffB);
        PG8_WAIT_V(6); PG8_BAR;
    }
    for (;;) {
        const bool has_next = S.next(ui + 1, nxt);
        const char* nA = has_next ? (const char*)g.A + (size_t)nxt.pm * tstep : cA; const char* nB = has_next ? (const char*)g.Bt + (size_t)nxt.pn * tstep : cB;
        for (int t = 0; t < nt; t += 2) {
            const bool last = (t == nt - 2);
            const char* a1 = cA + (size_t)(t + 1) * kstep;
            const char* a2 = last ? nA : cA + (size_t)(t + 2) * kstep; const char* b2 = last ? nB : cB + (size_t)(t + 2) * kstep;
            const char* a3 = a2 + kstep; const char* b3 = b2 + kstep;
            if (last && has_next) S.a_ready(nxt);
            if constexpr (SP2) {
            PG8_LDB(B0, 0, 0); PG8_LDB(B1, 0, 1); PG8_SCHED; PG8_LDA(At, 0, 0); PG8_STAGE(PG8_SA(1, 1), a1 + hstep, voffA);
            PG8_WAIT_V(8); PG8_WAIT_L(0); PG8_BAR; PG8_MMA(0, 0, At, B0); PG8_MMA(0, 1, At, B1); PG8_BAR; PG8_SCHED;
            PG8_LDA(At, 0, 1); PG8_STAGE(PG8_SB(0, 0), b2, voffB); PG8_STAGE(PG8_SB(0, 1), b2 + hstep, voffB); PG8_STAGE(PG8_SA(0, 0), a2, voffA);
            PG8_WAIT_V(8); PG8_WAIT_L(0); PG8_BAR; PG8_MMA(1, 0, At, B0); PG8_MMA(1, 1, At, B1); PG8_BAR; PG8_SCHED;
            PG8_LDB(B0, 1, 0); PG8_LDB(B1, 1, 1); PG8_SCHED; PG8_LDA(At, 1, 0); PG8_STAGE(PG8_SA(0, 1), a2 + hstep, voffA);
            PG8_WAIT_V(8); PG8_WAIT_L(0); PG8_BAR; PG8_MMA(0, 0, At, B0); PG8_MMA(0, 1, At, B1); PG8_BAR; PG8_SCHED;
            PG8_LDA(At, 1, 1); PG8_STAGE(PG8_SB(1, 0), b3, voffB); PG8_STAGE(PG8_SB(1, 1), b3 + hstep, voffB); PG8_STAGE(PG8_SA(1, 0), a3, voffA);
            PG8_WAIT_V(8); PG8_WAIT_L(0); PG8_BAR; PG8_MMA(1, 0, At, B0); PG8_MMA(1, 1, At, B1); PG8_BAR; PG8_SCHED;
            } else {
            PG8_LDB(B0, 0, 0); PG8_SCHED; PG8_LDA(At, 0, 0); PG8_STAGE(PG8_SA(1, 1), a1 + hstep, voffA);
            PG8_WAIT_L(8); PG8_BAR; PG8_WAIT_L(0); PG8_MMA(0, 0, At, B0); PG8_BAR; PG8_SCHED;
            PG8_LDB(B1, 0, 1); PG8_STAGE(PG8_SB(0, 0), b2, voffB);
            PG8_BAR; PG8_WAIT_L(0); PG8_MMA(0, 1, At, B1); PG8_BAR;
            PG8_LDA(At, 0, 1); PG8_STAGE(PG8_SA(0, 0), a2, voffA);
            PG8_BAR; PG8_WAIT_L(0); PG8_MMA(1, 0, At, B0); PG8_BAR; PG8_SCHED;
            PG8_STAGE(PG8_SB(0, 1), b2 + hstep, voffB);
            PG8_WAIT_V(6); PG8_BAR; PG8_MMA(1, 1, At, B1); PG8_BAR;
            PG8_LDB(B0, 1, 0); PG8_SCHED; PG8_LDA(At, 1, 0); PG8_STAGE(PG8_SA(0, 1), a2 + hstep, voffA);
            PG8_WAIT_L(8); PG8_BAR; PG8_WAIT_L(0); PG8_MMA(0, 0, At, B0); PG8_BAR; PG8_SCHED;
            PG8_LDB(B1, 1, 1); PG8_STAGE(PG8_SB(1, 0), b3, voffB);
            PG8_BAR; PG8_WAIT_L(0); PG8_MMA(0, 1, At, B1); PG8_BAR;
            PG8_LDA(At, 1, 1); PG8_STAGE(PG8_SA(1, 0), a3, voffA);
            PG8_BAR; PG8_WAIT_L(0); PG8_MMA(1, 0, At, B0); PG8_BAR; PG8_SCHED;
            PG8_STAGE(PG8_SB(1, 1), b3 + hstep, voffB);
            PG8_WAIT_V(6); PG8_BAR; PG8_MMA(1, 1, At, B1); PG8_BAR;
            }
        }
        if constexpr (ALIGN_EPI) { if (wr == 0) PG8_BAR; }
        if constexpr (FP8) asm volatile("s_nop 15\n\ts_nop 15" ::: "memory");
        if constexpr (!Epi::AFTER_DRAIN) { int t2_ = threadIdx.x; asm volatile("" : "+v"(t2_)); const int l2_ = t2_ & 63, w2_ = __builtin_amdgcn_readfirstlane(t2_ >> 6);
            E(acc, cur, w2_ >> 2, w2_ & 3, l2_ & 15, l2_ >> 4); S.done(cur); }
        if (!has_next) break;
#pragma unroll
        for (int a = 0; a < 2; ++a)
#pragma unroll
            for (int b = 0; b < 2; ++b)
#pragma unroll
                for (int m = 0; m < 4; ++m)
#pragma unroll
                    for (int n = 0; n < 2; ++n) acc[a][b][m][n] = (f32x4){0.f, 0.f, 0.f, 0.f};
        cur = nxt; cA = nA; cB = nB; ++ui;
        if constexpr (ALIGN_EPI) { if (wr == 1) PG8_BAR; }
    }
    PG8_WAIT_V(0);
    if constexpr (!ALIGN_EPI) { if (wr == 0) PG8_BAR; }
    PG8_BAR;
    if constexpr (Epi::AFTER_DRAIN) { E.fused(acc, cur, wr, wc, fr, fq, lds, wid, lane); S.done(cur); }
#undef PG8_SA
#undef PG8_SB
#undef PG8_STAGE
#undef PG8_LDA
#undef PG8_LDB
#undef PG8_MMA
#undef PG8_WAIT_V
#undef PG8_WAIT_L
#undef PG8_BAR
#undef PG8_SCHED
}
}

constexpr int NB = 8, SEQ = 4096, DM = 1024, NL = 2, FF = 4096, NPROJ = 2724, NPROJ_PAD = 2816, NTILE_PROJ = 11;
constexpr int TOK = NB * SEQ;
static_assert(TOK == pg8::TT, "token count");
constexpr float NORM_EPS = 1e-6f;
constexpr float LOG2E = 1.4426950408889634f;
constexpr int NWAVES = 8;

constexpr size_t MiB = 1u << 20;
constexpr size_t WS_CTL = 0, CTL_ZERO_BYTES = 1 * MiB;
constexpr size_t WS_MOD = 1 * MiB;
constexpr size_t WS_KMEAN = WS_MOD + 512 * 1024;
constexpr size_t WS_W = 2 * MiB;
constexpr size_t W_IN = 0, W_GATE = W_IN + (size_t)NPROJ_PAD * DM, W_BR = W_GATE + (size_t)4 * DM * DM, W_OUT = W_BR + (size_t)4 * DM * 256,
                 W_FF1 = W_OUT + (size_t)DM * DM, W_FF2 = W_FF1 + (size_t)FF * DM, W_LAYER = W_FF2 + (size_t)DM * FF;
constexpr size_t WS_MASK = 70 * MiB;
constexpr size_t WS_H = 86 * MiB;
constexpr size_t WS_Y = 150 * MiB;
constexpr size_t WS_R = 214 * MiB;
constexpr size_t WS_H8 = 470 * MiB;
constexpr size_t WS_END = 502 * MiB;
static_assert(WS_W + 2 * W_LAYER * 2 <= WS_MASK, "weights fit");
constexpr int CW_BAR = 4096;
constexpr int CW_WQ = 131072;
constexpr int CW_NRM = CW_WQ + 4096;
constexpr int NPHASE = 22;

constexpr int RING_BYTES = 135168;
constexpr int LDSCTL_OFF = RING_BYTES;
constexpr int LDS_BYTES = 147456;

#define GAS __attribute__((address_space(1)))
#define LAS __attribute__((address_space(3)))
typedef unsigned short bf16;
typedef unsigned v4u __attribute__((ext_vector_type(4)));
typedef unsigned v2u __attribute__((ext_vector_type(2)));
typedef float f32x4 __attribute__((ext_vector_type(4)));
typedef float f32x16 __attribute__((ext_vector_type(16)));
typedef short bf16x8 __attribute__((ext_vector_type(8)));
typedef short s16x4 __attribute__((ext_vector_type(4)));
typedef GAS unsigned gu32;
#define RLX_AGENT __ATOMIC_RELAXED, __HIP_MEMORY_SCOPE_AGENT
#define LDS_WAIT() asm volatile("s_waitcnt lgkmcnt(0)" ::: "memory")
__device__ __forceinline__ unsigned f2bf(float f) { unsigned u = __builtin_bit_cast(unsigned, f); return (u + 0x7fffu + ((u >> 16) & 1u)) >> 16; }
__device__ __forceinline__ unsigned pk2(float lo, float hi) { return f2bf(lo) | (f2bf(hi) << 16); }
__device__ __forceinline__ float bf2f(unsigned short b) { return __uint_as_float((unsigned)b << 16); }
__device__ __forceinline__ float bflo(unsigned w) { return __uint_as_float(w << 16); }
__device__ __forceinline__ float bfhi(unsigned w) { return __uint_as_float(w & 0xffff0000u); }

#define XB_TMO      128
#define XB_XCNT(j)  (256  + 64 * (j))
#define XB_XSUB(j)  (1280 + 64 * (j))
#define XB_XGEN(j)  (2304 + 64 * (j))
#define XB_TOP      3328
#define XB_TOPGEN   3392
#define XCD_BAR_WORDS 3456
#define XB_SPIN_CAP (1u << 18)

__device__ __forceinline__ unsigned xb_ld(unsigned* p)              { return __hip_atomic_load(p, __ATOMIC_RELAXED, __HIP_MEMORY_SCOPE_AGENT); }
__device__ __forceinline__ unsigned xb_add(unsigned* p, unsigned v) { return __hip_atomic_fetch_add(p, v, __ATOMIC_RELAXED, __HIP_MEMORY_SCOPE_AGENT); }
__device__ __forceinline__ unsigned xb_xcc_id() { return (unsigned)__builtin_amdgcn_s_getreg((3 << 11) | 20) & 0xFu; }
#define XB_SPIN(cond, bar) do { unsigned _sp = 0; while (cond) { __builtin_amdgcn_s_sleep(1); \
    if ((++_sp & 255u) == 0u) { if (xb_ld(&(bar)[XB_TMO])) break; if (_sp > XB_SPIN_CAP) { atomicAdd(&(bar)[XB_TMO], 1u); break; } } } } while (0)

struct XcdBarrier {
    unsigned* bar; unsigned x;
    volatile LAS unsigned* st;
};

__device__ __forceinline__ XcdBarrier xcd_barrier_post(unsigned* bar, volatile LAS unsigned* st) {
    XcdBarrier b; b.bar = bar; b.x = xb_xcc_id(); b.st = st;
    if (threadIdx.x == 0) (void)xb_add(&bar[XB_XCNT(b.x)], 1u);
    return b;
}
__device__ __forceinline__ void xcd_barrier_complete(unsigned* bar, unsigned x, unsigned& nloc, unsigned& nx) {
    const unsigned G = gridDim.x * gridDim.y * gridDim.z;
    unsigned sum, cnt, mine, sp = 0u;
    for (;;) {
        sum = 0u; cnt = 0u; mine = 0u;
#pragma unroll
        for (unsigned j = 0; j < 16; ++j) { const unsigned c = xb_ld(&bar[XB_XCNT(j)]); sum += c; cnt += (c > 0u) ? 1u : 0u; mine = (j == x) ? c : mine; }
        if (sum == G) break;
        __builtin_amdgcn_s_sleep(1);
        if ((++sp & 255u) == 0u) { if (xb_ld(&bar[XB_TMO])) break; if (sp > XB_SPIN_CAP) { atomicAdd(&bar[XB_TMO], 1u); break; } }
    }
    nloc = mine > 0u ? mine : 1u; nx = cnt > 0u ? cnt : 1u;
}

__device__ __forceinline__ void xcd_barrier(const XcdBarrier& b) {
    asm volatile("s_waitcnt vmcnt(0)" ::: "memory");
    __syncthreads();
    if (threadIdx.x == 0) {
        unsigned* bar = b.bar;
        __builtin_amdgcn_s_waitcnt(0);
        unsigned nloc = b.st[0], nx = b.st[1];
        if (nloc == 0u) { xcd_barrier_complete(bar, b.x, nloc, nx); b.st[0] = nloc; b.st[1] = nx; }
        const unsigned old = xb_add(&bar[XB_XSUB(b.x)], 1u);
        const unsigned gen = old / nloc;
        if (old + 1u == (gen + 1u) * nloc) {
            __builtin_amdgcn_fence(__ATOMIC_RELEASE, "agent");
            asm volatile("s_waitcnt vmcnt(0)" ::: "memory");
            const unsigned og = xb_add(&bar[XB_TOP], 1u);
            const unsigned tg = og / nx;
            if (og + 1u == (tg + 1u) * nx) xb_add(&bar[XB_TOPGEN], 1u);
            else XB_SPIN(xb_ld(&bar[XB_TOPGEN]) == tg, bar);
            __builtin_amdgcn_fence(__ATOMIC_ACQUIRE, "agent");
            xb_add(&bar[XB_XGEN(b.x)], 1u);
            asm volatile("s_waitcnt vmcnt(0)" ::: "memory");
        } else {
            XB_SPIN(xb_ld(&bar[XB_XGEN(b.x)]) == gen, bar);
            __builtin_amdgcn_fence(__ATOMIC_ACQUIRE, "agent");
            asm volatile("s_waitcnt vmcnt(0)" ::: "memory");
        }
    }
    __syncthreads();
}

struct Args {
    const float *x, *c, *w_ada, *b_ada, *norm1_g, *w_in, *diff_lambda, *diff_subln_g, *w_pool, *pool_scale, *w_gate, *b_gate, *w_branch, *w_out, *norm2_g, *w_ff1, *w_ff2, *final_g;
    float* out; unsigned char* ws; int ph_lo, ph_hi, li, pad;
};

__device__ __forceinline__ float shx(float v, int mask, int lane) { return __int_as_float(__builtin_amdgcn_ds_bpermute((lane ^ mask) << 2, __float_as_int(v))); }
__device__ __forceinline__ unsigned shxu(unsigned v, int mask, int lane) { return (unsigned)__builtin_amdgcn_ds_bpermute((lane ^ mask) << 2, (int)v); }
__device__ __forceinline__ unsigned shupu(unsigned v, int delta, int lane) { return (unsigned)__builtin_amdgcn_ds_bpermute(((lane - delta) & 63) << 2, (int)v); }
__device__ __forceinline__ float wave_sum(float v, int lane) {
#pragma unroll
    for (int o = 1; o < 64; o <<= 1) v += shx(v, o, lane);
    return v;
}
__device__ __forceinline__ int crow(int r, int hi) { return (r & 3) + 8 * (r >> 2) + 4 * hi; }
typedef float f32x2_t __attribute__((ext_vector_type(2))); typedef __bf16 bf16x2_t __attribute__((ext_vector_type(2)));
__device__ __forceinline__ unsigned cvtpk(float lo, float hi) { f32x2_t v = {lo, hi}; bf16x2_t b = __builtin_convertvector(v, bf16x2_t); return __builtin_bit_cast(unsigned, b); }

__device__ __forceinline__ int gate_row(int br, int c) { const int pn = c >> 6, ml = c & 63; return 256 * pn + 128 * (br >> 1) + 32 * (ml >> 4) + 8 * ((ml >> 2) & 3) + 4 * (br & 1) + (ml & 3); }
__device__ __forceinline__ void p0_transpose_item(const float* W, int K, int Nsrc, int Npad, bf16* WT, int mode, int br, LAS float* scr, int item, int lane) {
    const int nblk = Npad / 32, kb = item / nblk, nb = item % nblk, k0 = 64 * kb, n0 = 32 * nb;
    const int c4 = lane & 7, kr = lane >> 3, nn = n0 + 4 * c4;
    f32x4 v[8];
#pragma unroll
    for (int i = 0; i < 8; ++i) v[i] = (nn < Nsrc) ? *(const f32x4*)(W + (size_t)(k0 + 8 * i + kr) * Nsrc + nn) : (f32x4){0.f, 0.f, 0.f, 0.f};
#pragma unroll
    for (int i = 0; i < 8; ++i) { LAS float* d = scr + (8 * i + kr) * 33 + 4 * c4; d[0] = v[i][0]; d[1] = v[i][1]; d[2] = v[i][2]; d[3] = v[i][3]; }
    LDS_WAIT(); asm volatile("" ::: "memory");
    const int c = lane & 7;
#pragma unroll
    for (int j = 0; j < 4; ++j) { const int n = (lane >> 3) + 8 * j; const LAS float* s = scr + (8 * c) * 33 + n;
        v4u o; o.x = pk2(s[0 * 33], s[1 * 33]); o.y = pk2(s[2 * 33], s[3 * 33]); o.z = pk2(s[4 * 33], s[5 * 33]); o.w = pk2(s[6 * 33], s[7 * 33]);
        const int drow = (mode >= 1) ? gate_row(br, n0 + n) : (n0 + n);
        if (mode == 2) {
            int w0 = __builtin_amdgcn_cvt_pk_fp8_f32(32.f * s[0 * 33], 32.f * s[1 * 33], 0, false); w0 = __builtin_amdgcn_cvt_pk_fp8_f32(32.f * s[2 * 33], 32.f * s[3 * 33], w0, true);
            int w1 = __builtin_amdgcn_cvt_pk_fp8_f32(32.f * s[4 * 33], 32.f * s[5 * 33], 0, false); w1 = __builtin_amdgcn_cvt_pk_fp8_f32(32.f * s[6 * 33], 32.f * s[7 * 33], w1, true);
            v2u o8; o8.x = (unsigned)w0; o8.y = (unsigned)w1;
            *(v2u*)((unsigned char*)WT + (size_t)drow * K + k0 + 8 * c) = o8;
        } else *(v4u*)(WT + (size_t)drow * K + k0 + 8 * c) = o; }
    LDS_WAIT(); asm volatile("" ::: "memory");
}

template <bool XBF16>
__device__ __forceinline__ void norm_rows_bf16(const void* X, bf16* O, unsigned char* O8  , const float* g, const float* mod  , int sh_idx, int sc_idx, int gw, int ngw, int lane_in) {
    int lane = lane_in; asm volatile("" : "+v"(lane));
    constexpr int RB = 4;
    const f32x4* gp = (const f32x4*)g + 4 * lane;
    const f32x4 g0 = gp[0], g1 = gp[1], g2 = gp[2], g3 = gp[3];
    for (int m0 = gw; m0 < TOK; m0 += RB * ngw) {
        float v[RB][16];
#pragma unroll
        for (int rb = 0; rb < RB; ++rb) { const int m = m0 + rb * ngw;
            if (m < TOK) {
                if (XBF16) { const v4u* xr = (const v4u*)((const bf16*)X + (size_t)m * DM) + 2 * lane; const v4u a = xr[0], c = xr[1];
                    v[rb][0] = bflo(a.x); v[rb][1] = bfhi(a.x); v[rb][2] = bflo(a.y); v[rb][3] = bfhi(a.y); v[rb][4] = bflo(a.z); v[rb][5] = bfhi(a.z); v[rb][6] = bflo(a.w); v[rb][7] = bfhi(a.w);
                    v[rb][8] = bflo(c.x); v[rb][9] = bfhi(c.x); v[rb][10] = bflo(c.y); v[rb][11] = bfhi(c.y); v[rb][12] = bflo(c.z); v[rb][13] = bfhi(c.z); v[rb][14] = bflo(c.w); v[rb][15] = bfhi(c.w); }
                else { const f32x4* xr = (const f32x4*)((const float*)X + (size_t)m * DM) + 4 * lane;
#pragma unroll
                    for (int j = 0; j < 4; ++j) { const f32x4 t = xr[j]; v[rb][4 * j] = t.x; v[rb][4 * j + 1] = t.y; v[rb][4 * j + 2] = t.z; v[rb][4 * j + 3] = t.w; } }
            } else {
#pragma unroll
                for (int e = 0; e < 16; ++e) v[rb][e] = 0.f; } }
#pragma unroll
        for (int rb = 0; rb < RB; ++rb) { const int m = m0 + rb * ngw; if (m < TOK) {
            const int b = m >> 12;
            float s = 0.f;
#pragma unroll
            for (int e = 0; e < 16; ++e) s += v[rb][e] * v[rb][e];
            const float rstd = 1.f / sqrtf(wave_sum(s, lane) * (1.f / DM) + NORM_EPS);
            const f32x4* shp = (const f32x4*)(mod + (size_t)b * 6144 + sh_idx * 1024) + 4 * lane;
            const f32x4* scp = (const f32x4*)(mod + (size_t)b * 6144 + sc_idx * 1024) + 4 * lane;
            float y[16];
#pragma unroll
            for (int j = 0; j < 4; ++j) { const f32x4 gg = (j == 0) ? g0 : (j == 1) ? g1 : (j == 2) ? g2 : g3; const f32x4 sh = shp[j], sc = scp[j];
#pragma unroll
                for (int e = 0; e < 4; ++e) y[4 * j + e] = v[rb][4 * j + e] * rstd * gg[e] * (1.f + sc[e]) + sh[e]; }
            v4u o0, o1;
            o0.x = pk2(y[0], y[1]); o0.y = pk2(y[2], y[3]); o0.z = pk2(y[4], y[5]); o0.w = pk2(y[6], y[7]);
            o1.x = pk2(y[8], y[9]); o1.y = pk2(y[10], y[11]); o1.z = pk2(y[12], y[13]); o1.w = pk2(y[14], y[15]);
            v4u* op = (v4u*)(O + (size_t)m * DM) + 2 * lane; op[0] = o0; op[1] = o1;
            if (O8) { v4u q;
                int w = __builtin_amdgcn_cvt_pk_fp8_f32(y[0], y[1], 0, false); w = __builtin_amdgcn_cvt_pk_fp8_f32(y[2], y[3], w, true); q.x = (unsigned)w;
                w = __builtin_amdgcn_cvt_pk_fp8_f32(y[4], y[5], 0, false); w = __builtin_amdgcn_cvt_pk_fp8_f32(y[6], y[7], w, true); q.y = (unsigned)w;
                w = __builtin_amdgcn_cvt_pk_fp8_f32(y[8], y[9], 0, false); w = __builtin_amdgcn_cvt_pk_fp8_f32(y[10], y[11], w, true); q.z = (unsigned)w;
                w = __builtin_amdgcn_cvt_pk_fp8_f32(y[12], y[13], 0, false); w = __builtin_amdgcn_cvt_pk_fp8_f32(y[14], y[15], w, true); q.w = (unsigned)w;
                *((v4u*)(O8 + (size_t)m * DM) + lane) = q; } } }
    }
}

#ifndef ATT_PD
#define ATT_PD 2
#endif
constexpr int AT_K0 = 0, AT_KSLOT = 9216, AT_V0 = 18432, AT_VSLOT = 12288, AT_SEL = 43008, AT_KM = 44032, AT_END = 47872;
__device__ __forceinline__ s16x4 vtr(LAS const unsigned char* p) { return __builtin_bit_cast(s16x4, __builtin_amdgcn_ds_read_tr16_b64_v4i16((LAS s16x4*)p)); }

#define TRRD(dst, addr, off) asm volatile("ds_read_b64_tr_b16 %0, %1 offset:%2" : "=v"(dst) : "v"(addr), "i"(off) : "memory")
#define SBAR0() __builtin_amdgcn_sched_barrier(0)
__device__ __forceinline__ void softmax_pv(f32x16& s0, f32x16& s1, float& l, f32x16 (&o)[2], LAS const unsigned char* vbase  ) {
    const unsigned va = (unsigned)(uintptr_t)vbase;
    s16x4 vl[2][2][2], vh[2][2][2];
#pragma unroll
    for (int sub = 0; sub < 2; ++sub)
#pragma unroll
        for (int db = 0; db < 2; ++db)
#pragma unroll
            for (int s2 = 0; s2 < 2; ++s2) { TRRD(vl[db][sub][s2], va, (32 * sub + 16 * s2) * 192 + db * 64); TRRD(vh[db][sub][s2], va, (32 * sub + 16 * s2 + 8) * 192 + db * 64); }
    float la = l;
#pragma unroll
    for (int r = 0; r < 16; ++r) { s0[r] = __builtin_amdgcn_exp2f(s0[r]); la += s0[r]; }
    bf16x8 pf[2][2];
#pragma unroll
    for (int s2 = 0; s2 < 2; ++s2) { v4u a;
        a.x = cvtpk(s0[8 * s2 + 0], s0[8 * s2 + 1]); a.y = cvtpk(s0[8 * s2 + 2], s0[8 * s2 + 3]); a.z = cvtpk(s0[8 * s2 + 4], s0[8 * s2 + 5]); a.w = cvtpk(s0[8 * s2 + 6], s0[8 * s2 + 7]);
        pf[0][s2] = __builtin_bit_cast(bf16x8, a); }
    asm volatile("s_waitcnt lgkmcnt(0)" : "+v"(vl[0][0][0]), "+v"(vl[0][0][1]), "+v"(vl[0][1][0]), "+v"(vl[0][1][1]), "+v"(vl[1][0][0]), "+v"(vl[1][0][1]), "+v"(vl[1][1][0]), "+v"(vl[1][1][1]),
                                          "+v"(vh[0][0][0]), "+v"(vh[0][0][1]), "+v"(vh[0][1][0]), "+v"(vh[0][1][1]), "+v"(vh[1][0][0]), "+v"(vh[1][0][1]), "+v"(vh[1][1][0]), "+v"(vh[1][1][1]) :: "memory");
    SBAR0();
#pragma unroll
    for (int g = 0; g < 4; ++g) { const int db = g >> 1, s2 = g & 1;
        const s16x4 lo = vl[db][0][s2], hh = vh[db][0][s2];
        const bf16x8 vf = (bf16x8){lo[0], lo[1], lo[2], lo[3], hh[0], hh[1], hh[2], hh[3]};
        o[db] = __builtin_amdgcn_mfma_f32_32x32x16_bf16(vf, pf[0][s2], o[db], 0, 0, 0);
#pragma unroll
        for (int r = 4 * g; r < 4 * g + 4; ++r) { s1[r] = __builtin_amdgcn_exp2f(s1[r]); la += s1[r]; }
        SBAR0(); }
    l = la;
#pragma unroll
    for (int s2 = 0; s2 < 2; ++s2) { v4u c;
        c.x = cvtpk(s1[8 * s2 + 0], s1[8 * s2 + 1]); c.y = cvtpk(s1[8 * s2 + 2], s1[8 * s2 + 3]); c.z = cvtpk(s1[8 * s2 + 4], s1[8 * s2 + 5]); c.w = cvtpk(s1[8 * s2 + 6], s1[8 * s2 + 7]);
        pf[1][s2] = __builtin_bit_cast(bf16x8, c); }
#pragma unroll
    for (int g = 0; g < 4; ++g) { const int db = g >> 1, s2 = g & 1;
        const s16x4 lo = vl[db][1][s2], hh = vh[db][1][s2];
        const bf16x8 vf = (bf16x8){lo[0], lo[1], lo[2], lo[3], hh[0], hh[1], hh[2], hh[3]};
        o[db] = __builtin_amdgcn_mfma_f32_32x32x16_bf16(vf, pf[1][s2], o[db], 0, 0, 0); }
}
__device__ __forceinline__ void split3(float x, unsigned& h, unsigned& m, unsigned& l) {
    h = f2bf(x); const float r1 = x - __uint_as_float(h << 16); m = f2bf(r1); const float r2 = r1 - __uint_as_float(m << 16); l = f2bf(r2);
}

template <int MODE>
__device__ __forceinline__ void attn_unit(LAS unsigned char* lds, int b, int h, int qb, const bf16* Qb, const bf16* Kb, const bf16* Vb, bf16* Ob, float slope,
                                          const float* kmean, float lam, float post_scale, const float* subg, const unsigned* maskw, const unsigned* nrm  ,
                                          const int* refposg, const int* refming) {
    int tid_l = threadIdx.x; asm volatile("" : "+v"(tid_l)); const int tid = tid_l, lane = tid & 63, wid = __builtin_amdgcn_readfirstlane(tid >> 6), r32 = lane & 31, hi = lane >> 5;
    const int q = qb * 256 + wid * 32 + r32;
    const size_t rowg = (size_t)b * SEQ;
    const float c2 = slope * LOG2E;
    unsigned sel = 0u;
    bf16x8 qf[4];
#pragma unroll
    for (int ds = 0; ds < 4; ++ds) qf[ds] = *(const bf16x8*)(Qb + (rowg + q) * 256 + h * 64 + ds * 16 + hi * 8);
    const int skey = tid >> 3, sch = tid & 7;
    const bf16* ksrc = Kb + (rowg + skey) * 256 + h * 64 + sch * 8;
    const bf16* vsrc = Vb + (rowg + skey) * 256 + h * 64 + sch * 8;
    const int kdst = AT_K0 + skey * 144 + sch * 16, vdst = AT_V0 + skey * 192 + sch * 16;
    const int NT = 4 * qb + 4;
    const float Bq = __uint_as_float(nrm[b * 4 + h]), Bk = __uint_as_float(nrm[32 + b * 4 + h]);
#if defined(PROBE_NOSKIP)
    const float Dskip = 1e9f + 0.f * (Bq + Bk);
#else
    const float Dskip = (150.f + 2.f * sqrtf(Bq * Bk)) / c2;
#endif
    const int koff = r32 * 144 + hi * 16;
    const int vtoff = (4 * hi + ((lane & 15) >> 2)) * 192 + (16 * ((lane >> 4) & 1) + 4 * (lane & 3)) * 2;
    float l1 = 0.f, l2 = 0.f;
    f32x16 oA[2], oB[2];
#pragma unroll
    for (int r = 0; r < 16; ++r) { oA[0][r] = 0.f; oA[1][r] = 0.f; oB[0][r] = 0.f; oB[1][r] = 0.f; }
    const int qmin = qb * 256 + wid * 32, qmax = qmin + 31;
    constexpr int PD = ATT_PD;
    v4u kR[PD], vR[PD]; v2u mR[PD];
    int refpos = q;
    int minref = qb * 256;
    if (MODE == 2) { refpos = refposg[rowg + q]; minref = refming[b * 128 + 8 * qb];
#pragma unroll
        for (int i = 1; i < 8; ++i) { const int v = refming[b * 128 + 8 * qb + i]; minref = v < minref ? v : minref; } }
    int T0 = (int)floorf(((float)minref - Dskip) * (1.f / 64.f)); T0 = T0 < 0 ? 0 : T0; T0 = __builtin_amdgcn_readfirstlane(T0);
    const v4u k0r = *(const v4u*)(ksrc + (size_t)T0 * 64 * 256), v0r = *(const v4u*)(vsrc + (size_t)T0 * 64 * 256);
#pragma unroll
    for (int i = 0; i < PD; ++i) { kR[i] = (v4u){0u, 0u, 0u, 0u}; vR[i] = kR[i]; mR[i] = (v2u){0u, 0u};
        if (T0 + i + 1 < NT) { kR[i] = *(const v4u*)(ksrc + (size_t)(T0 + i + 1) * 64 * 256); vR[i] = *(const v4u*)(vsrc + (size_t)(T0 + i + 1) * 64 * 256);
            if (MODE == 2) mR[i] = *(const v2u*)(maskw + (rowg + q) * 128 + 2 * (T0 + i + 1)); } }
    v2u mw = (v2u){0u, 0u};
    if (MODE == 2) mw = *(const v2u*)(maskw + (rowg + q) * 128 + 2 * T0);
    if (MODE == 0) {
        LAS float* KM = (LAS float*)(lds + AT_KM); LAS unsigned* SEL = (LAS unsigned*)(lds + AT_SEL);
        for (int i = tid; i < qb * 64; i += 512) KM[i] = kmean[(size_t)((b * 4 + h) * 16) * 64 + i];
        __syncthreads();
        if (tid < 256) {
            const bf16* qrow = Qb + (rowg + qb * 256 + tid) * 256 + h * 64;
            float qv[64];
#pragma unroll
            for (int c = 0; c < 8; ++c) { const v4u w = *(const v4u*)(qrow + 8 * c);
                qv[8 * c + 0] = bflo(w.x); qv[8 * c + 1] = bfhi(w.x); qv[8 * c + 2] = bflo(w.y); qv[8 * c + 3] = bfhi(w.y);
                qv[8 * c + 4] = bflo(w.z); qv[8 * c + 5] = bfhi(w.z); qv[8 * c + 6] = bflo(w.w); qv[8 * c + 7] = bfhi(w.w); }
            float v1 = -INFINITY, v2 = -INFINITY, v3 = -INFINITY; int i1 = -1, i2 = -1, i3 = -1;
            for (int n = 0; n < qb; ++n) {
                float g = 0.f;
#pragma unroll
                for (int d = 0; d < 64; ++d) g = __builtin_fmaf(qv[d], KM[n * 64 + d], g);
                if (g > v1) { v3 = v2; i3 = i2; v2 = v1; i2 = i1; v1 = g; i1 = n; }
                else if (g > v2) { v3 = v2; i3 = i2; v2 = g; i2 = n; }
                else if (g > v3) { v3 = g; i3 = n; }
            }
            unsigned sm = 0u; if (i1 >= 0) sm |= 1u << i1; if (i2 >= 0) sm |= 1u << i2; if (i3 >= 0) sm |= 1u << i3;
            SEL[tid] = sm;
        }
        __syncthreads();
        sel = SEL[wid * 32 + r32];
    }
    *(LAS v4u*)(lds + kdst + (T0 & 1) * AT_KSLOT) = k0r; *(LAS v4u*)(lds + vdst + (T0 & 1) * AT_VSLOT) = v0r;
    bf16x8 qaug; v4u ka0, ka1;
    { unsigned a, b2, c; split3(-c2 * (float)refpos, a, b2, c);
      v4u w; if (hi == 0) { w.x = a | (b2 << 16); w.y = c | (0x3f80u << 16); w.z = 0x3f80u | (0x3f80u << 16); w.w = 0u; }
             else { w.x = 0x3f80u | (0x3f80u << 16); w.y = 0x3f80u; w.z = 0u; w.w = 0u; }
      qaug = __builtin_bit_cast(bf16x8, w);
      split3(c2 * (float)r32, a, b2, c); ka0.x = 0x3f80u | (0x3f80u << 16); ka0.y = 0x3f80u | (a << 16); ka0.z = b2 | (c << 16); ka0.w = 0u;
      split3(c2 * (float)(r32 + 32), a, b2, c); ka1.x = ka0.x; ka1.y = 0x3f80u | (a << 16); ka1.z = b2 | (c << 16); ka1.w = 0u; }
    __syncthreads();
#pragma nounroll
    for (int t0 = T0; t0 < NT; t0 += PD) {
#pragma unroll
      for (int u = 0; u < PD; ++u) { const int t = t0 + u; if (t < NT) {
        const int slot = t & 1;
        const int k0 = 64 * t;
        bool active = (k0 <= qmax);
        bool keep = true;
        if (MODE == 0) { const int n = t >> 2; if (n < qb) { keep = ((sel >> n) & 1u) != 0u; active = (__ballot(keep) != 0ull); } }
        if (active) {
            LAS const unsigned char* ks = lds + AT_K0 + slot * AT_KSLOT + koff;
            LAS const unsigned char* vb = lds + AT_V0 + slot * AT_VSLOT + vtoff;
            const int lim = q - k0 - 4 * hi;
            const bool needmask = (k0 + 63 > qmin);
            bf16x8 kaug0, kaug1;
            { unsigned a, b2, c; split3(c2 * (float)k0, a, b2, c);
              v4u w0 = ka0, w1 = ka1; if (hi) { w0.x = a | (b2 << 16); w0.y = c; w0.z = 0u; w1 = w0; }
              kaug0 = __builtin_bit_cast(bf16x8, w0); kaug1 = __builtin_bit_cast(bf16x8, w1); }
            f32x16 sb0, sb1;
#pragma unroll
            for (int r = 0; r < 16; ++r) { sb0[r] = 0.f; sb1[r] = 0.f; }
            sb0 = __builtin_amdgcn_mfma_f32_32x32x16_bf16(kaug0, qaug, sb0, 0, 0, 0);
            sb1 = __builtin_amdgcn_mfma_f32_32x32x16_bf16(kaug1, qaug, sb1, 0, 0, 0);
#pragma unroll
            for (int mp = 0; mp < (MODE == 1 ? 2 : 1); ++mp) {
                f32x16 s0, s1;
#pragma unroll
                for (int dd = 0; dd < (MODE == 1 ? 2 : 4); ++dd) { const int ds = (MODE == 1) ? (2 * mp + dd) : dd;
                    const bf16x8 a0 = *(LAS const bf16x8*)(ks + ds * 32), a1 = *(LAS const bf16x8*)(ks + 32 * 144 + ds * 32);
                    if (dd == 0) { s0 = __builtin_amdgcn_mfma_f32_32x32x16_bf16(a0, qf[ds], sb0, 0, 0, 0); s1 = __builtin_amdgcn_mfma_f32_32x32x16_bf16(a1, qf[ds], sb1, 0, 0, 0); }
                    else { s0 = __builtin_amdgcn_mfma_f32_32x32x16_bf16(a0, qf[ds], s0, 0, 0, 0); s1 = __builtin_amdgcn_mfma_f32_32x32x16_bf16(a1, qf[ds], s1, 0, 0, 0); } }
#if defined(PROBE_QK2X)
                { f32x16 d0, d1;
#pragma unroll
                  for (int r = 0; r < 16; ++r) { d0[r] = 0.f; d1[r] = 0.f; }
#pragma unroll
                  for (int dd = 0; dd < (MODE == 1 ? 2 : 4); ++dd) { const int ds = (MODE == 1) ? (2 * mp + dd) : dd;
                    const bf16x8 a0 = *(LAS const bf16x8*)(ks + ds * 32 + 16), a1 = *(LAS const bf16x8*)(ks + 32 * 144 + ds * 32 + 16);
                    d0 = __builtin_amdgcn_mfma_f32_32x32x16_bf16(a0, qf[ds], d0, 0, 0, 0);
                    d1 = __builtin_amdgcn_mfma_f32_32x32x16_bf16(a1, qf[ds], d1, 0, 0, 0); }
                  asm volatile("" :: "v"(d0), "v"(d1)); }
#endif
                if (MODE == 2) {
#pragma unroll
                    for (int r = 0; r < 16; ++r) { const int pos = (r & 3) + 8 * (r >> 2) + 4 * hi;
                        if (!((mw.x >> pos) & 1u)) s0[r] = -INFINITY; if (!((mw.y >> pos) & 1u)) s1[r] = -INFINITY; }
                } else {
                    if (MODE == 0 && !keep) {
#pragma unroll
                        for (int r = 0; r < 16; ++r) { s0[r] = -INFINITY; s1[r] = -INFINITY; }
                    }
                    if (needmask) {
#pragma unroll
                        for (int r = 0; r < 16; ++r) { const int ko = (r & 3) + 8 * (r >> 2);
                            if (ko > lim) s0[r] = -INFINITY; if (ko + 32 > lim) s1[r] = -INFINITY; }
                    }
                }
                if (mp == 0) softmax_pv(s0, s1, l1, oA, vb); else softmax_pv(s0, s1, l2, oB, vb);
            }
        }
        if (t + 1 < NT) { *(LAS v4u*)(lds + kdst + (slot ^ 1) * AT_KSLOT) = kR[u]; *(LAS v4u*)(lds + vdst + (slot ^ 1) * AT_VSLOT) = vR[u];
            if (MODE == 2) mw = mR[u];
            if (t + 1 + PD < NT) { kR[u] = *(const v4u*)(ksrc + (size_t)(t + 1 + PD) * 64 * 256); vR[u] = *(const v4u*)(vsrc + (size_t)(t + 1 + PD) * 64 * 256);
                if (MODE == 2) mR[u] = *(const v2u*)(maskw + (rowg + q) * 128 + 2 * (t + 1 + PD)); } }
        __syncthreads();
#if defined(PROBE_BAR2X)
        __syncthreads();
#endif
      } }
    }
    const float l1t = l1 + shx(l1, 32, lane);
    bf16* orow = Ob + (rowg + q) * 256 + h * 64 + 4 * hi;
    if (MODE == 1) {
        const float l2t = l2 + shx(l2, 32, lane);
        const float i1 = 1.f / l1t, i2 = lam / l2t;
        float ssq = 0.f;
#pragma unroll
        for (int db = 0; db < 2; ++db)
#pragma unroll
            for (int r = 0; r < 16; ++r) { const float v = oA[db][r] * i1 - oB[db][r] * i2; oA[db][r] = v; ssq += v * v; }
        ssq += shx(ssq, 32, lane);
        const float rn = post_scale / sqrtf(ssq * (1.f / 64.f) + NORM_EPS);
#pragma unroll
        for (int db = 0; db < 2; ++db)
#pragma unroll
            for (int g4 = 0; g4 < 4; ++g4) { const f32x4 gg = *(const f32x4*)(subg + 32 * db + 8 * g4 + 4 * hi);
                v2u w; w.x = cvtpk(oA[db][4 * g4 + 0] * rn * gg[0], oA[db][4 * g4 + 1] * rn * gg[1]); w.y = cvtpk(oA[db][4 * g4 + 2] * rn * gg[2], oA[db][4 * g4 + 3] * rn * gg[3]);
                *(v2u*)(orow + 32 * db + 8 * g4) = w; }
    } else {
        const float i1 = 1.f / l1t;
#pragma unroll
        for (int db = 0; db < 2; ++db)
#pragma unroll
            for (int g4 = 0; g4 < 4; ++g4) { v2u w; w.x = cvtpk(oA[db][4 * g4 + 0] * i1, oA[db][4 * g4 + 1] * i1); w.y = cvtpk(oA[db][4 * g4 + 2] * i1, oA[db][4 * g4 + 3] * i1);
                *(v2u*)(orow + 32 * db + 8 * g4) = w; }
    }
    __syncthreads();
}

constexpr int DS_HP = 1025;
constexpr int DS_HIST_BYTES = 32 * DS_HP * 4;
constexpr int DS_BP = 129;
constexpr int DS_G = 0, DS_C = 32 * DS_BP * 4, DS_AUX = DS_HIST_BYTES;
__device__ __forceinline__ float relu_asm(float x) { return __builtin_amdgcn_fmed3f(x, 0.f, __builtin_inff()); }
__device__ __forceinline__ void dsa_scores(const bf16x8 (&iqf)[4][2], const float (&w)[4], const bf16x8 k0, const bf16x8 k1, float (&sc)[16]) {
#pragma unroll
    for (int hh = 0; hh < 4; ++hh) {
        f32x16 x;
#pragma unroll
        for (int r = 0; r < 16; ++r) x[r] = 0.f;
        x = __builtin_amdgcn_mfma_f32_32x32x16_bf16(k0, iqf[hh][0], x, 0, 0, 0);
        x = __builtin_amdgcn_mfma_f32_32x32x16_bf16(k1, iqf[hh][1], x, 0, 0, 0);
#pragma unroll
        for (int r = 0; r < 16; ++r) sc[r] = (hh == 0) ? (w[0] * relu_asm(x[r])) : __builtin_fmaf(w[hh], relu_asm(x[r]), sc[r]);
    }
}
__device__ __forceinline__ unsigned dsa_mono(float s) { const unsigned bits = __float_as_uint(s); return bits ^ ((unsigned)((int)bits >> 31) | 0x80000000u); }
__device__ __forceinline__ unsigned dsa_ckey(float s, unsigned keyidx) { return (dsa_mono(s) & 0xFFFFF000u) | (4095u - keyidx); }
__device__ __forceinline__ unsigned take_low(unsigned w, unsigned n) {
    if (n >= (unsigned)__popc(w)) return w;
    unsigned res = 0u;
    while (n > 0u) { const unsigned low = w & (0u - w); res |= low; w ^= low; --n; }
    return res;
}
template <int PASS>
__device__ __forceinline__ void dsa_hist_pass(LAS unsigned* hist, const bf16x8 (&iqf)[4][2], const float (&w)[4], const bf16* kbase, int qg, int wid, int r32, int hi, int t, unsigned P1) {
    bf16x8 nk0 = *(const bf16x8*)(kbase + (size_t)wid * 32 * 256), nk1 = *(const bf16x8*)(kbase + (size_t)wid * 32 * 256 + 16);
    const unsigned rowb = (unsigned)(r32 * DS_HP * 4);
#pragma nounroll
    for (int j = wid; j <= qg; j += 8) {
        const bf16x8 k0 = nk0, k1 = nk1;
        { const int jn = (j + 8 <= qg) ? j + 8 : j; const bf16* kp = kbase + (size_t)jn * 32 * 256; nk0 = *(const bf16x8*)kp; nk1 = *(const bf16x8*)(kp + 16); }
        float sc[16]; dsa_scores(iqf, w, k0, k1, sc);
#if defined(PROBE_D1_SCORE2X)
        { float sd[16]; dsa_scores(iqf, w, k1, k0, sd);
#pragma unroll
          for (int r = 0; r < 16; ++r) asm volatile("" :: "v"(sd[r])); }
#endif
        const int lim = t - 32 * j - 4 * hi;
        const bool diag = (j == qg);
#pragma unroll
        for (int r = 0; r < 16; ++r) {
            const unsigned mono = dsa_mono(sc[r]);
            unsigned addr;
            if (PASS == 0) { addr = rowb + ((mono >> 22) << 2); if (diag && ((r & 3) + 8 * (r >> 2) > lim)) addr = rowb + 4096u; }
            else { addr = rowb + (((mono >> 12) & 1023u) << 2); if ((mono >> 22) != P1 || (diag && ((r & 3) + 8 * (r >> 2) > lim))) addr = rowb + 4096u; }
            __hip_atomic_fetch_add((LAS unsigned*)((LAS unsigned char*)hist + addr), 1u, __ATOMIC_RELAXED, __HIP_MEMORY_SCOPE_WORKGROUP);
#if defined(PROBE_D1_ATOM2X)
            __hip_atomic_fetch_add((LAS unsigned*)((LAS unsigned char*)hist + rowb + 4096u), 1u, __ATOMIC_RELAXED, __HIP_MEMORY_SCOPE_WORKGROUP);
#endif
        }
    }
}
__device__ __forceinline__ void dsa_scan(LAS unsigned* hist, LAS unsigned* AUX, int pass, int wid, int lane) {
#pragma unroll
    for (int qi = 0; qi < 4; ++qi) {
        const int qq = 4 * wid + qi;
        const unsigned K = (pass == 0) ? 256u : AUX[32 + qq];
        LAS const unsigned* hrow = hist + qq * DS_HP;
        const int wb = 1008 - 16 * lane;
        unsigned s = 0u;
#pragma unroll
        for (int i = 0; i < 16; ++i) s += hrow[wb + ((i + lane) & 15)];
        unsigned incl = s;
#pragma unroll
        for (int o = 1; o < 64; o <<= 1) { const unsigned v = shupu(incl, o, lane); if (lane >= o) incl += v; }
        const unsigned long long bal = __ballot(incl >= K);
        const int L = __builtin_amdgcn_readfirstlane(bal ? (__ffsll((long long)bal) - 1) : 0);
        const unsigned above = (unsigned)__builtin_amdgcn_readlane((int)(incl - s), L);
        const int bin = 1023 - 16 * L - (lane & 15);
        const unsigned c = (lane < 16) ? hrow[bin] : 0u;
        unsigned inc2 = c;
#pragma unroll
        for (int o = 1; o < 16; o <<= 1) { const unsigned v = shupu(inc2, o, lane); if (lane >= o) inc2 += v; }
        const unsigned long long bal2 = __ballot(lane < 16 && above + inc2 >= K);
        const int I = __builtin_amdgcn_readfirstlane(bal2 ? (__ffsll((long long)bal2) - 1) : 0);
        if (lane == I) { AUX[64 * pass + qq] = (unsigned)bin; AUX[64 * pass + 32 + qq] = K - (above + inc2 - c); }
    }
}
__device__ __forceinline__ void dsa_select_unit(LAS unsigned char* lds, int b, int qg, const bf16* IX, unsigned* MASK, int* REFPOS  , int* REFMIN  ) {
    int tid_l = threadIdx.x; asm volatile("" : "+v"(tid_l)); const int tid = tid_l, lane = tid & 63, wid = __builtin_amdgcn_readfirstlane(tid >> 6), r32 = lane & 31, hi = lane >> 5;
    const int t = 32 * qg + r32;
    const size_t rowg = (size_t)b * SEQ;
    const bf16* qrow = IX + (rowg + t) * 256;
    bf16x8 iqf[4][2];
#pragma unroll
    for (int hh = 0; hh < 4; ++hh)
#pragma unroll
        for (int ds = 0; ds < 2; ++ds) iqf[hh][ds] = *(const bf16x8*)(qrow + 32 * hh + 16 * ds + 8 * hi);
    float w[4];
    { const v2u ww = *(const v2u*)(qrow + 160); w[0] = bflo(ww.x); w[1] = bfhi(ww.x); w[2] = bflo(ww.y); w[3] = bfhi(ww.y); }
    LAS unsigned* hist = (LAS unsigned*)lds;
    LAS unsigned* AUX = (LAS unsigned*)(lds + DS_AUX);
    const bf16* kbase = IX + (rowg + r32) * 256 + 128 + 8 * hi;
    unsigned P = 0u;
    const bool all = (qg < 8);
    if (!all) {
        for (int i = tid; i < DS_HIST_BYTES / 16; i += 512) ((LAS v4u*)lds)[i] = (v4u){0u, 0u, 0u, 0u};
#if defined(PROBE_D1_ZERO2X)
        __syncthreads(); for (int i = tid; i < DS_HIST_BYTES / 16; i += 512) ((LAS v4u*)lds)[i] = (v4u){0u, 0u, 0u, 0u}; __syncthreads(); for (int i = tid; i < DS_HIST_BYTES / 16; i += 512) ((LAS v4u*)lds)[i] = (v4u){0u, 0u, 0u, 0u};
#endif
        __syncthreads();
        dsa_hist_pass<0>(hist, iqf, w, kbase, qg, wid, r32, hi, t, 0u);
        __syncthreads();
        dsa_scan(hist, AUX, 0, wid, lane);
#if defined(PROBE_D1_SCAN2X)
        __syncthreads(); dsa_scan(hist, AUX, 0, wid, lane);
#endif
        __syncthreads();
        const unsigned P1 = AUX[r32];
        for (int i = tid; i < DS_HIST_BYTES / 16; i += 512) ((LAS v4u*)lds)[i] = (v4u){0u, 0u, 0u, 0u};
        __syncthreads();
        dsa_hist_pass<1>(hist, iqf, w, kbase, qg, wid, r32, hi, t, P1);
        __syncthreads();
        dsa_scan(hist, AUX, 1, wid, lane);
#if defined(PROBE_D1_SCAN2X)
        __syncthreads(); dsa_scan(hist, AUX, 1, wid, lane);
#endif
        __syncthreads();
        P = (P1 << 10) | AUX[64 + r32];
    }
    if (all) { if (tid < 32) { AUX[64 + 32 + tid] = 0u; } }
    for (int i = tid; i < (2 * 32 * DS_BP * 4) / 16; i += 512) ((LAS v4u*)lds)[i] = (v4u){0u, 0u, 0u, 0u};
    __syncthreads();
    LAS unsigned* G = (LAS unsigned*)(lds + DS_G);
    LAS unsigned* C = (LAS unsigned*)(lds + DS_C);
    bf16x8 nk0, nk1;
    { const int j0 = (wid <= qg) ? wid : 0; nk0 = *(const bf16x8*)(kbase + (size_t)j0 * 32 * 256); nk1 = *(const bf16x8*)(kbase + (size_t)j0 * 32 * 256 + 16); }
#pragma nounroll
    for (int j = wid; j <= qg; j += 8) {
        const bf16x8 k0 = nk0, k1 = nk1;
        { const int jn = (j + 8 <= qg) ? j + 8 : j; const bf16* kp = kbase + (size_t)jn * 32 * 256; nk0 = *(const bf16x8*)kp; nk1 = *(const bf16x8*)(kp + 16); }
        float sc[16]; dsa_scores(iqf, w, k0, k1, sc);
        unsigned bg = 0u, bc = 0u;
        const int lim = t - 32 * j - 4 * hi;
#pragma unroll
        for (int r = 0; r < 16; ++r) {
            const int pos = (r & 3) + 8 * (r >> 2) + 4 * hi;
            const unsigned p22 = dsa_mono(sc[r]) >> 12;
            const bool ok = ((r & 3) + 8 * (r >> 2)) <= lim;
            if (ok && p22 > P) bg |= 1u << pos;
            if (ok && p22 == P) bc |= 1u << pos;
        }
        bg |= shxu(bg, 32, lane); bc |= shxu(bc, 32, lane);
        if (hi == 0) { G[r32 * DS_BP + j] = bg; C[r32 * DS_BP + j] = bc; }
    }
    __syncthreads();
#pragma unroll
    for (int qi = 0; qi < 4; ++qi) {
        const int qq = 4 * wid + qi;
        const unsigned K2 = AUX[64 + 32 + qq];
        const unsigned w0 = C[qq * DS_BP + 2 * lane], w1 = C[qq * DS_BP + 2 * lane + 1];
        const unsigned pc = (unsigned)__popc(w0) + (unsigned)__popc(w1);
        unsigned incl = pc;
#pragma unroll
        for (int o = 1; o < 64; o <<= 1) { const unsigned v = shupu(incl, o, lane); if (lane >= o) incl += v; }
        const unsigned pre = incl - pc;
        unsigned need = K2 > pre ? K2 - pre : 0u;
        const unsigned t0 = take_low(w0, need); need -= (unsigned)__popc(t0);
        const unsigned t1 = take_low(w1, need);
        const unsigned g0 = G[qq * DS_BP + 2 * lane] | t0, g1 = G[qq * DS_BP + 2 * lane + 1] | t1;
        G[qq * DS_BP + 2 * lane] = g0; G[qq * DS_BP + 2 * lane + 1] = g1;
        int hp = g1 ? (64 * lane + 63 - __clz((int)g1)) : (g0 ? (64 * lane + 31 - __clz((int)g0)) : -1);
#pragma unroll
        for (int o = 1; o < 64; o <<= 1) { const int v = (int)shxu((unsigned)hp, o, lane); hp = v > hp ? v : hp; }
        if (lane == 0) { REFPOS[rowg + 32 * qg + qq] = hp; AUX[128 + qq] = (unsigned)hp; }
    }
    __syncthreads();
    if (tid == 0) { int mn = 0x7fffffff; for (int i = 0; i < 32; ++i) { const int v = (int)AUX[128 + i]; mn = v < mn ? v : mn; } REFMIN[b * 128 + qg] = mn; }
    { const int qq = tid >> 4, part = tid & 15;
        unsigned* dst = MASK + (rowg + 32 * qg + qq) * 128 + part * 8;
        v4u a, c2;
        a.x = G[qq * DS_BP + part * 8 + 0]; a.y = G[qq * DS_BP + part * 8 + 1]; a.z = G[qq * DS_BP + part * 8 + 2]; a.w = G[qq * DS_BP + part * 8 + 3];
        c2.x = G[qq * DS_BP + part * 8 + 4]; c2.y = G[qq * DS_BP + part * 8 + 5]; c2.z = G[qq * DS_BP + part * 8 + 6]; c2.w = G[qq * DS_BP + part * 8 + 7];
        *(v4u*)dst = a; *(v4u*)(dst + 4) = c2; }
    __syncthreads();
}

constexpr int PL_U = 0, PL_UP = 528, PL_D = 79 * 528 + 16  , PL_DP = 257;
__device__ __forceinline__ void pool_unit(LAS unsigned char* lds, int b, int tile, const bf16* PU, const float* wpool  , const float* pscale  , bf16* YC) {
    int tid_l = threadIdx.x; asm volatile("" : "+v"(tid_l)); const int tid = tid_l, cb = __builtin_amdgcn_readfirstlane(tid >> 6), tt = tid & 63;
    const int t0 = tile * 64; const size_t rowg = (size_t)b * SEQ;
    for (int i = tid; i < 79 * 32; i += 512) { const int rr = i >> 5, ch = i & 31; const int tok = t0 - 15 + rr;
        v4u v = (v4u){0u, 0u, 0u, 0u}; if (tok >= 0) v = *(const v4u*)(PU + (rowg + tok) * 256 + ch * 8);
        *(LAS v4u*)(lds + PL_U + rr * PL_UP + ch * 16) = v; }
    __syncthreads();
    const int g = cb >> 1, wlen = 2 << g, c0 = 32 * cb, t = t0 + tt;
    const float inv = 1.f / (float)((t + 1 < wlen) ? (t + 1) : wlen);
    LAS float* Dm = (LAS float*)(lds + PL_D);
#pragma unroll
    for (int ch = 0; ch < 4; ++ch) {
        float sum[8];
#pragma unroll
        for (int e = 0; e < 8; ++e) sum[e] = 0.f;
        float self[8];
        for (int i = 0; i < wlen; ++i) {
            const v4u v = *(LAS const v4u*)(lds + PL_U + (15 + tt - i) * PL_UP + (c0 + 8 * ch) * 2);
            const float f[8] = {bflo(v.x), bfhi(v.x), bflo(v.y), bfhi(v.y), bflo(v.z), bfhi(v.z), bflo(v.w), bfhi(v.w)};
#pragma unroll
            for (int e = 0; e < 8; ++e) { sum[e] += f[e]; if (i == 0) self[e] = f[e]; }
        }
#pragma unroll
        for (int e = 0; e < 8; ++e) Dm[tt * PL_DP + c0 + 8 * ch + e] = sum[e] * inv - self[e];
    }
    __syncthreads();
    const int e0 = 32 * (cb & 1);
    float acc[32];
#pragma unroll
    for (int e = 0; e < 32; ++e) acc[e] = 0.f;
    const float* wg = wpool + (size_t)g * 4096 + e0;
    for (int c = 0; c < 64; ++c) {
        const float dv = Dm[tt * PL_DP + 64 * g + c];
        const float* wr = wg + c * 64;
#pragma unroll
        for (int e = 0; e < 32; ++e) acc[e] = __builtin_fmaf(dv, wr[e], acc[e]);
    }
    bf16* orow = YC + (rowg + t) * 256 + 64 * g + e0;
    const float* ps = pscale + 64 * g + e0;
#pragma unroll
    for (int k = 0; k < 4; ++k) { v4u o;
        o.x = pk2(acc[8 * k + 0] * ps[8 * k + 0], acc[8 * k + 1] * ps[8 * k + 1]); o.y = pk2(acc[8 * k + 2] * ps[8 * k + 2], acc[8 * k + 3] * ps[8 * k + 3]);
        o.z = pk2(acc[8 * k + 4] * ps[8 * k + 4], acc[8 * k + 5] * ps[8 * k + 5]); o.w = pk2(acc[8 * k + 6] * ps[8 * k + 6], acc[8 * k + 7] * ps[8 * k + 7]);
        *(v4u*)(orow + 8 * k) = o; }
    __syncthreads();
}
__device__ __forceinline__ void kmean_item(int item, const bf16* AK, float* KMEAN, int wid, int lane_in) {
    int lane = lane_in; asm volatile("" : "+v"(lane));
    const int combo = item * 8 + wid; const int b = combo >> 6, h = (combo >> 4) & 3, n = combo & 15;
    const int ks = lane >> 3, ch = lane & 7;
    const bf16* p = AK + ((size_t)b * SEQ + 256 * n + ks) * 256 + 64 * h + 8 * ch;
    float s[8];
#pragma unroll
    for (int e = 0; e < 8; ++e) s[e] = 0.f;
#pragma unroll 8
    for (int j = 0; j < 32; ++j) { const v4u v = *(const v4u*)(p + (size_t)j * 8 * 256);
        s[0] += bflo(v.x); s[1] += bfhi(v.x); s[2] += bflo(v.y); s[3] += bfhi(v.y); s[4] += bflo(v.z); s[5] += bfhi(v.z); s[6] += bflo(v.w); s[7] += bfhi(v.w); }
#pragma unroll
    for (int e = 0; e < 8; ++e) { s[e] += shx(s[e], 8, lane); s[e] += shx(s[e], 16, lane); s[e] += shx(s[e], 32, lane); }
    if (ks == 0) { float* o = KMEAN + (size_t)combo * 64 + 8 * ch;
        *(f32x4*)o = (f32x4){s[0], s[1], s[2], s[3]} * (1.f / 256.f); *(f32x4*)(o + 4) = (f32x4){s[4], s[5], s[6], s[7]} * (1.f / 256.f); }
}

__device__ __forceinline__ void norm_unit(LAS unsigned char* lds, int n, const bf16* PROJ, size_t TS, unsigned* NRM  ) {
    int tid_l = threadIdx.x; asm volatile("" : "+v"(tid_l)); const int tid = tid_l, lane = tid & 63, wid = __builtin_amdgcn_readfirstlane(tid >> 6);
    const int a = n >> 8, rem = n & 255, sq = rem >> 7, b = (rem >> 4) & 7, c = rem & 15;
    const int tile = (a == 0 ? 0 : (a == 1 ? 3 : 7)) + sq;
    const int row = tid >> 1, hp = tid & 1;
    float ss[2] = {0.f, 0.f};
#pragma unroll
    for (int rr = 0; rr < 1; ++rr) {
        const bf16* p = PROJ + (size_t)tile * TS + ((size_t)b * SEQ + 256 * c + row) * 256 + 128 * hp;
#pragma unroll
        for (int hh = 0; hh < 2; ++hh) { float acc = 0.f;
#pragma unroll
            for (int i = 0; i < 8; ++i) { const v4u v = *(const v4u*)(p + 64 * hh + 8 * i);
                const float f0 = bflo(v.x), f1 = bfhi(v.x), f2 = bflo(v.y), f3 = bfhi(v.y), f4 = bflo(v.z), f5 = bfhi(v.z), f6 = bflo(v.w), f7 = bfhi(v.w);
                acc += (f0 * f0 + f1 * f1) + (f2 * f2 + f3 * f3) + (f4 * f4 + f5 * f5) + (f6 * f6 + f7 * f7); }
            ss[hh] = fmaxf(ss[hh], acc); }
    }
#pragma unroll
    for (int o = 2; o < 64; o <<= 1) { ss[0] = fmaxf(ss[0], shx(ss[0], o, lane)); ss[1] = fmaxf(ss[1], shx(ss[1], o, lane)); }
    LAS float* R = (LAS float*)lds;
    if (lane < 2) { R[wid * 4 + 2 * hp] = ss[0]; R[wid * 4 + 2 * hp + 1] = ss[1]; }
    __syncthreads();
    if (tid < 4) { float m = R[tid];
#pragma unroll
        for (int w2 = 1; w2 < 8; ++w2) m = fmaxf(m, R[w2 * 4 + tid]);
        __hip_atomic_fetch_max(NRM + ((a * 2 + sq) * 8 + b) * 4 + tid, __float_as_uint(m * 1.0001f), __ATOMIC_RELAXED, __HIP_MEMORY_SCOPE_AGENT); }
    __syncthreads();
}

__device__ __forceinline__ float alibi_slope(int idx  ) { return exp2f(-8.f * (float)idx / 12.f); }

__device__ __forceinline__ void p0_adaln(const Args& A, LAS unsigned char* lds, int G) {
    int tid_l = threadIdx.x; asm volatile("" : "+v"(tid_l)); const int tid = tid_l, lane = tid & 63, wid = __builtin_amdgcn_readfirstlane(tid >> 6);
    LAS float* cact = (LAS float*)lds;
    LAS float* red = (LAS float*)(lds + 32768);
    float* MOD = (float*)(A.ws + WS_MOD);
    if ((int)blockIdx.x < 192) {
        for (int i = tid; i < 8192; i += 512) { const int bb = i >> 10, k = i & 1023; const float v = A.c[i]; cact[k * 8 + bb] = v / (1.f + __expf(-v)); }
        __syncthreads();
        for (int u = blockIdx.x; u < 192; u += G) {
            const int l = u / 96, n0 = (u % 96) * 64;
            const float* wp = A.w_ada + ((size_t)l * 1024 + 128 * wid) * 6144 + n0 + lane;
            float acc[8];
#pragma unroll
            for (int bb = 0; bb < 8; ++bb) acc[bb] = 0.f;
#pragma unroll 16
            for (int k = 0; k < 128; ++k) {
                const float wv = wp[(size_t)k * 6144];
                const f32x4 c0 = *(LAS const f32x4*)(cact + (128 * wid + k) * 8), c1 = *(LAS const f32x4*)(cact + (128 * wid + k) * 8 + 4);
                acc[0] += c0[0] * wv; acc[1] += c0[1] * wv; acc[2] += c0[2] * wv; acc[3] += c0[3] * wv;
                acc[4] += c1[0] * wv; acc[5] += c1[1] * wv; acc[6] += c1[2] * wv; acc[7] += c1[3] * wv;
            }
#pragma unroll
            for (int bb = 0; bb < 8; ++bb) red[(wid * 8 + bb) * 64 + lane] = acc[bb];
            __syncthreads();
            { const int bb = wid; float s = A.b_ada[(size_t)l * 6144 + n0 + lane];
#pragma unroll
                for (int w2 = 0; w2 < 8; ++w2) s += red[(w2 * 8 + bb) * 64 + lane];
                MOD[((size_t)l * 8 + bb) * 6144 + n0 + lane] = s; }
            __syncthreads();
        }
    }
    __syncthreads();
}
__device__ __forceinline__ void p0_weights(const Args& A, LAS unsigned char* lds, int vcu, int G, int l0, int l1) {
    int tid_l = threadIdx.x; asm volatile("" : "+v"(tid_l)); const int tid = tid_l, lane = tid & 63, wid = __builtin_amdgcn_readfirstlane(tid >> 6);
    unsigned char* ws = A.ws;
    LAS float* scr = (LAS float*)(lds + wid * 16384);
    const int gw = vcu * NWAVES + wid, NGW = G * NWAVES;
    constexpr int I_IN = 16 * (NPROJ_PAD / 32), I_G1 = 16 * 32, I_BR1 = 4 * 32, I_OUT = 16 * 32, I_F1 = 16 * 128, I_F2 = 64 * 32;
    constexpr int I_LAYER = I_IN + 4 * I_G1 + 4 * I_BR1 + I_OUT + I_F1 + I_F2;
    for (int it = l0 * I_LAYER + gw; it < l1 * I_LAYER; it += NGW) {
        const int l = it / I_LAYER; int r = it % I_LAYER;
        bf16* WL = (bf16*)(ws + WS_W) + (size_t)l * W_LAYER;
        if (r < I_IN) { p0_transpose_item(A.w_in + (size_t)l * DM * NPROJ, DM, NPROJ, NPROJ_PAD, WL + W_IN, 0, 0, scr, r, lane); continue; } r -= I_IN;
        if (r < 4 * I_G1) { const int br = r / I_G1; p0_transpose_item(A.w_gate + ((size_t)l * 4 + br) * DM * DM, DM, DM, DM, WL + W_GATE, 2, br, scr, r % I_G1, lane); continue; } r -= 4 * I_G1;
        if (r < 4 * I_BR1) { const int br = r / I_BR1; p0_transpose_item(A.w_branch + ((size_t)l * 4 + br) * 256 * DM, 256, DM, DM, WL + W_BR + (size_t)br * DM * 256, 0, 0, scr, r % I_BR1, lane); continue; } r -= 4 * I_BR1;
        if (r < I_OUT) { p0_transpose_item(A.w_out + (size_t)l * DM * DM, DM, DM, DM, WL + W_OUT, 0, 0, scr, r, lane); continue; } r -= I_OUT;
        if (r < I_F1) { p0_transpose_item(A.w_ff1 + (size_t)l * DM * FF, DM, FF, FF, WL + W_FF1, 0, 0, scr, r, lane); continue; } r -= I_F1;
        p0_transpose_item(A.w_ff2 + (size_t)l * FF * DM, FF, DM, DM, WL + W_FF2, 0, 0, scr, r, lane);
    }
    __syncthreads();
}

__device__ __forceinline__ int wq_draw(gu32* ctr) { int v = 0; if (threadIdx.x == 0) v = (int)__hip_atomic_fetch_add(ctr, 1u, RLX_AGENT); return v; }
__device__ __forceinline__ int wq_bcast(volatile LAS unsigned* slot, int v) {
    if (threadIdx.x == 0) *slot = (unsigned)v;
    __syncthreads();
    const int item = (int)*slot;
    __syncthreads();
    return item;
}

#ifndef ZG_ALIGN
#define ZG_ALIGN true
#define ZG_SP2 false
#endif
#ifndef IN_ALIGN
#define IN_ALIGN true
#define IN_SP2 true
#endif
#ifndef GT_ALIGN
#define GT_ALIGN true
#define GT_SP2 true
#endif
#ifndef WO_ALIGN
#define WO_ALIGN true
#define WO_SP2 true
#endif
#ifndef F1_ALIGN
#define F1_ALIGN true
#define F1_SP2 true
#endif
#ifndef F2_ALIGN
#define F2_ALIGN true
#define F2_SP2 true
#endif
struct ZOrder {
    pg8::StaticOrder base;
    __device__ __forceinline__ bool next(int i, pg8::Unit& u) const { if (!base.next(i, u)) return false; u.pn += 4 * (u.pm >> 7); return true; }
    __device__ __forceinline__ void a_ready(const pg8::Unit&) const {}
    __device__ __forceinline__ void done(const pg8::Unit&) const {}
};

__global__ void __launch_bounds__(NWAVES * 64, 2) hybrid_fwd(Args args) {
    extern __shared__ __attribute__((aligned(16))) unsigned char lds_raw[];
    LAS unsigned char* lds = (LAS unsigned char*)lds_raw;
#define PHASE_IDS int tid_p = threadIdx.x; asm volatile("" : "+v"(tid_p)); const int lane = tid_p & 63, wid = __builtin_amdgcn_readfirstlane(tid_p >> 6); const int gw = vcu * NWAVES + wid, ngw = G * NWAVES; (void)lane; (void)gw; (void)ngw;
    const int G = gridDim.x; const int bx = blockIdx.x; const int vcu = (G % 8 == 0) ? (bx % 8) * (G / 8) + bx / 8 : bx;
    unsigned char* ws = args.ws;
    gu32* ctl = (gu32*)(ws + WS_CTL);
    volatile LAS unsigned* MISC = (volatile LAS unsigned*)(lds + LDSCTL_OFF);
    for (int u = threadIdx.x; u < (LDS_BYTES - LDSCTL_OFF) / 4; u += NWAVES * 64) ((LAS unsigned*)(lds + LDSCTL_OFF))[u] = 0u;
    __syncthreads();
    const int lo = args.ph_lo, hi = args.ph_hi;
    XcdBarrier bar; bar.bar = (unsigned*)(ctl + CW_BAR) + args.li * XCD_BAR_WORDS; bar.x = 0; bar.st = nullptr;
    if (hi - lo > 1) bar = xcd_barrier_post((unsigned*)(ctl + CW_BAR) + args.li * XCD_BAR_WORDS, MISC + 8);
#ifndef PHASE_OFF
#define PHASE_OFF 0
#endif
#define IN(k) (lo <= (k) && (k) < hi && !((PHASE_OFF >> ((k) == 0 ? 0 : (k) == 21 ? 11 : (((k) - 1) % 10) + 1)) & 1))
#ifndef REPEAT_MASK
#define REPEAT_MASK 0
#endif
#define NREP(bit) (((REPEAT_MASK >> (bit)) & 1) ? 2 : 1)
#if defined(PROBE_SEAM2X)
#define SEAM(k) do { if (IN(k) && IN((k) + 1)) { xcd_barrier(bar); xcd_barrier(bar); } } while (0)
#else
#define SEAM(k) do { if (IN(k) && IN((k) + 1)) xcd_barrier(bar); } while (0)
#endif
    float* MOD = (float*)(ws + WS_MOD);
    float* KMEAN = (float*)(ws + WS_KMEAN);
    int* REFPOS = (int*)(ws + WS_KMEAN + 128 * 1024);
    int* REFMIN = (int*)(ws + WS_KMEAN + 256 * 1024);
    unsigned* MASK = (unsigned*)(ws + WS_MASK);
    bf16* H = (bf16*)(ws + WS_H);
    unsigned char* H8 = ws + WS_H8;
    bf16* Y = (bf16*)(ws + WS_Y);
    bf16* MERGED = (bf16*)(ws + WS_Y);
    bf16* PROJ = (bf16*)(ws + WS_R);
    unsigned char* Z = ws + WS_R;
    bf16* U = (bf16*)(ws + WS_R);
    bf16* XRB = (bf16*)args.out;
    constexpr size_t TS = (size_t)TOK * 256;
    volatile LAS unsigned* wqslot = MISC + 16;

    if (IN(0)) for (int rep = 0; rep < NREP(0); ++rep) { p0_adaln(args, lds, G); }
    SEAM(0);

#pragma nounroll
    for (int l = 0; l < NL; ++l) {
        const int pb = 1 + 10 * l;
        const float* modl = MOD + (size_t)l * 8 * 6144;
        const bf16* WL = (const bf16*)(ws + WS_W) + (size_t)l * W_LAYER;
        if (IN(pb + 0)) for (int rep = 0; rep < NREP(1); ++rep) { PHASE_IDS if (l == 0) norm_rows_bf16<false>(args.x, H, H8, args.norm1_g + (size_t)l * DM, modl, 0, 1, gw, ngw, lane); else norm_rows_bf16<true>(XRB, H, H8, args.norm1_g + (size_t)l * DM, modl, 0, 1, gw, ngw, lane); if (l == 0) p0_weights(args, lds, vcu, G, 0, 1); }
        SEAM(pb + 0);
        if (IN(pb + 1)) for (int rep = 0; rep < NREP(2); ++rep) {
            pg8::Gemm g{H, WL + W_IN, TOK, NPROJ_PAD, DM}; pg8::StaticOrder S; S.init(TOK, NPROJ_PAD, G, bx);
            pg8::EpiProj E{PROJ, TS};
            pg8::gemm_phase<pg8::EpiProj, pg8::StaticOrder, IN_ALIGN, IN_SP2>(lds, g, S, E);
            if (l == 0 && rep == 0 && bx >= 128) p0_weights(args, lds, bx - 128, G - 128, 1, 2);
        }
        SEAM(pb + 1);
        unsigned* NRM = (unsigned*)(ctl + CW_NRM) + l * 192;
        if (IN(pb + 2)) for (int rep = 0; rep < NREP(3); ++rep) {
            gu32* ctr = ctl + CW_WQ + (l * 2 + 0 + 4 * rep) * 64;
            int raw = wq_draw(ctr);
            for (;;) {
#ifndef REPA_LO
#define REPA_LO 0
#define REPA_HI 2368
#endif
                const int item = wq_bcast(wqslot, raw) + (rep ? REPA_LO : 0);
                if (item >= (rep ? REPA_HI : 2368)) break;
                raw = wq_draw(ctr);
                if (item < 1024) { const int qg = 127 - (item >> 3), b = item & 7;
                    dsa_select_unit(lds, b, qg, PROJ + 10 * TS, MASK, REFPOS, REFMIN);
                } else if (item < 1536) { const int i2 = item - 1024; const int b = i2 >> 6, tile = i2 & 63;
                    pool_unit(lds, b, tile, PROJ + 6 * TS, args.w_pool + (size_t)l * 4 * 4096, args.pool_scale + (size_t)l * 256, Y + 2 * TS);
                } else if (item < 1600) { PHASE_IDS kmean_item(item - 1536, PROJ + 1 * TS, KMEAN, wid, lane);
                } else { norm_unit(lds, item - 1600, PROJ, TS, NRM); }
            }
        }
        SEAM(pb + 2);
        if (IN(pb + 3)) for (int rep = 0; rep < NREP(4); ++rep) {
            gu32* ctr = ctl + CW_WQ + 512 + ((l * 2 + rep) * 8) * 64;
            const float li = 0.8f - 0.6f * __expf(-0.3f * (float)l);
            const float* dl = args.diff_lambda + (size_t)l * 128;
            float d1 = 0.f, d2 = 0.f;
            for (int i = 0; i < 32; ++i) { d1 += dl[i] * dl[32 + i]; d2 += dl[64 + i] * dl[96 + i]; }
            const float lam = __expf(d1) - __expf(d2) + li;
            int raw = wq_draw(ctr);
            for (;;) {
                const int item = wq_bcast(wqslot, raw);
                if (item >= 1536) break;
                raw = wq_draw(ctr);
                const int ty = item % 3, rest = item / 3; const int qb = 15 - (rest >> 5), bh = rest & 31, b = bh >> 2, h = bh & 3;
                if (ty == 0) attn_unit<1>(lds, b, h, qb, PROJ + 3 * TS, PROJ + 4 * TS, PROJ + 5 * TS, Y + 1 * TS, alibi_slope(3 * h + 2), nullptr, lam, 1.f - li, args.diff_subln_g + (size_t)l * 64, nullptr, NRM + 64, nullptr, nullptr);
                else if (ty == 1) attn_unit<0>(lds, b, h, qb, PROJ + 0 * TS, PROJ + 1 * TS, PROJ + 2 * TS, Y + 0 * TS, alibi_slope(3 * h + 1), KMEAN, 0.f, 0.f, nullptr, nullptr, NRM, nullptr, nullptr);
                else              attn_unit<2>(lds, b, h, qb, PROJ + 7 * TS, PROJ + 8 * TS, PROJ + 9 * TS, Y + 3 * TS, alibi_slope(3 * h + 3), nullptr, 0.f, 0.f, nullptr, MASK, NRM + 128, REFPOS, REFMIN);
            }
        }
        SEAM(pb + 3);
        if (IN(pb + 4)) for (int rep = 0; rep < NREP(5); ++rep) {
            int kz = 256; asm volatile("" : "+s"(kz)); pg8::Gemm g{Y, WL + W_BR, 4 * TOK, 4096, kz}; ZOrder S; S.base.init(4 * TOK, DM, G, bx);
            pg8::EpiZ E{Z};
            pg8::gemm_phase<pg8::EpiZ, ZOrder, ZG_ALIGN, ZG_SP2>(lds, g, S, E);
        }
        SEAM(pb + 4);
        if (IN(pb + 5)) for (int rep = 0; rep < NREP(6); ++rep) {
            int kg = DM / 2; asm volatile("" : "+s"(kg));
            pg8::Gemm g{(const bf16*)H8, WL + W_GATE, TOK, 4096, kg}; pg8::StaticOrder S; S.init(TOK, 4096, G, bx);
            pg8::EpiGate E{Z, args.b_gate + (size_t)l * 4 * DM, MERGED};
            pg8::gemm_phase<pg8::EpiGate, pg8::StaticOrder, GT_ALIGN, GT_SP2, true>(lds, g, S, E);
        }
        SEAM(pb + 5);
        if (IN(pb + 6)) for (int rep = 0; rep < NREP(7); ++rep) {
            pg8::Gemm g{MERGED, WL + W_OUT, TOK, DM, DM}; pg8::StaticOrder S; S.init(TOK, DM, G, bx);
            if (l == 0) { pg8::EpiResid<false> E{args.x, rep ? (bf16*)(ws + WS_R) : XRB, modl + 2 * 1024};
                pg8::gemm_phase<pg8::EpiResid<false>, pg8::StaticOrder, WO_ALIGN, WO_SP2>(lds, g, S, E); }
            else { pg8::EpiResid<true> E{XRB, rep ? (bf16*)(ws + WS_R) : XRB, modl + 2 * 1024};
                pg8::gemm_phase<pg8::EpiResid<true>, pg8::StaticOrder, WO_ALIGN, WO_SP2>(lds, g, S, E); }
        }
        SEAM(pb + 6);
        if (IN(pb + 7)) for (int rep = 0; rep < NREP(8); ++rep) { PHASE_IDS norm_rows_bf16<true>(XRB, H, nullptr, args.norm2_g + (size_t)l * DM, modl, 3, 4, gw, ngw, lane); }
        SEAM(pb + 7);
        if (IN(pb + 8)) for (int rep = 0; rep < NREP(9); ++rep) {
            pg8::Gemm g{H, WL + W_FF1, TOK, FF, DM}; pg8::StaticOrder S; S.init(TOK, FF, G, bx);
            pg8::EpiRelu2 E{U, FF};
            pg8::gemm_phase<pg8::EpiRelu2, pg8::StaticOrder, F1_ALIGN, F1_SP2>(lds, g, S, E);
        }
        SEAM(pb + 8);
        if (IN(pb + 9)) for (int rep = 0; rep < NREP(10); ++rep) {
            pg8::Gemm g{U, WL + W_FF2, TOK, DM, FF}; pg8::StaticOrder S; S.init(TOK, DM, G, bx);
            pg8::EpiResid<true> E{XRB, rep ? (bf16*)(ws + WS_MASK) : XRB, modl + 5 * 1024};
            pg8::gemm_phase<pg8::EpiResid<true>, pg8::StaticOrder, F2_ALIGN, F2_SP2>(lds, g, S, E);
        }
        SEAM(pb + 9);
    }
    if (IN(21)) {
        PHASE_IDS
        v4u xa[16], xb[16]; float rs[16];
        const v4u* xp = (const v4u*)(XRB + (size_t)gw * DM) + 2 * lane;
#pragma unroll
        for (int i = 0; i < 16; ++i) { xa[i] = xp[(size_t)i * ngw * (DM / 8)]; xb[i] = xp[(size_t)i * ngw * (DM / 8) + 1]; }
#pragma unroll
        for (int i = 0; i < 16; ++i) { const v4u a = xa[i], c = xb[i];
            float s = bflo(a.x) * bflo(a.x); s += bfhi(a.x) * bfhi(a.x); s += bflo(a.y) * bflo(a.y); s += bfhi(a.y) * bfhi(a.y); s += bflo(a.z) * bflo(a.z); s += bfhi(a.z) * bfhi(a.z); s += bflo(a.w) * bflo(a.w); s += bfhi(a.w) * bfhi(a.w);
            s += bflo(c.x) * bflo(c.x); s += bfhi(c.x) * bfhi(c.x); s += bflo(c.y) * bflo(c.y); s += bfhi(c.y) * bfhi(c.y); s += bflo(c.z) * bflo(c.z); s += bfhi(c.z) * bfhi(c.z); s += bflo(c.w) * bflo(c.w); s += bfhi(c.w) * bfhi(c.w);
            rs[i] = 1.f / sqrtf(wave_sum(s, lane) * (1.f / DM) + NORM_EPS); }
        xcd_barrier(bar);
#pragma unroll
        for (int i = 0; i < 16; ++i) asm volatile("" : "+v"(xa[i]), "+v"(xb[i]));
        const f32x4* gp = (const f32x4*)args.final_g + 4 * lane;
        f32x4* op = (f32x4*)(args.out + (size_t)gw * DM) + 4 * lane;
#pragma unroll
        for (int i = 0; i < 16; ++i) { const v4u a = xa[i], c = xb[i]; const float r = rs[i]; f32x4* o = op + (size_t)i * ngw * (DM / 4);
            o[0] = (f32x4){bflo(a.x), bfhi(a.x), bflo(a.y), bfhi(a.y)} * r * gp[0]; o[1] = (f32x4){bflo(a.z), bfhi(a.z), bflo(a.w), bfhi(a.w)} * r * gp[1];
            o[2] = (f32x4){bflo(c.x), bfhi(c.x), bflo(c.y), bfhi(c.y)} * r * gp[2]; o[3] = (f32x4){bflo(c.z), bfhi(c.z), bflo(c.w), bfhi(c.w)} * r * gp[3]; }
    }
#undef IN
#undef SEAM
}

#ifndef MK_SPLIT
#define MK_SPLIT 0
#endif
extern "C" void kernel_launch(void* const* d_in, const int* in_sizes, int n_in, void* d_out, int out_size, void* d_ws, size_t ws_size, hipStream_t stream) {
    static int grid = 0;
    if (grid == 0) {
        if (n_in != 18 || in_sizes[0] != TOK * DM || out_size != TOK * DM || ws_size < WS_END) { fprintf(stderr, "kernel_launch: unexpected shapes (n_in %d, in0 %d, out %d, ws %zu)\n", n_in, n_in > 0 ? in_sizes[0] : -1, out_size, ws_size); grid = -1; return; }
        int dev = 0, cus = 0, per_cu = 0;
        if (hipGetDevice(&dev) != hipSuccess || hipDeviceGetAttribute(&cus, hipDeviceAttributeMultiprocessorCount, dev) != hipSuccess) { grid = -1; return; }
        if (hipFuncSetAttribute((const void*)hybrid_fwd, hipFuncAttributeMaxDynamicSharedMemorySize, LDS_BYTES) != hipSuccess) { fprintf(stderr, "kernel_launch: hipFuncSetAttribute failed\n"); grid = -1; return; }
        if (hipOccupancyMaxActiveBlocksPerMultiprocessor(&per_cu, (const void*)hybrid_fwd, NWAVES * 64, LDS_BYTES) != hipSuccess || per_cu < 1) fprintf(stderr, "kernel_launch: occupancy query reports %d\n", per_cu);
        (void)hipGetLastError();
        grid = cus;
        if (cus != 256) { fprintf(stderr, "kernel_launch: built for 256 CUs (the final norm stages 16 rows per wave), found %d\n", cus); grid = -1; return; }
    }
    if (grid < 0) return;
    if (hipMemsetAsync((char*)d_ws + WS_CTL, 0, CTL_ZERO_BYTES, stream) != hipSuccess) return;
    Args a{};
    const float** ap = (const float**)&a;
    for (int i = 0; i < 18; ++i) ap[i] = (const float*)d_in[i];
    a.out = (float*)d_out; a.ws = (unsigned char*)d_ws; a.pad = 0;
#if MK_SPLIT
    for (int p = 0; p < NPHASE; ++p) { a.ph_lo = p; a.ph_hi = p + 1; a.li = 0;
        hipLaunchKernelGGL(hybrid_fwd, dim3(grid), dim3(NWAVES * 64), LDS_BYTES, stream, a); }
#else
    a.ph_lo = 0; a.ph_hi = NPHASE; a.li = 0;
    hipLaunchKernelGGL(hybrid_fwd, dim3(grid), dim3(NWAVES * 64), LDS_BYTES, stream, a);
#endif
}
```

```cpp
#include <hip/hip_runtime.h>
#include <cstdio>
#include <cstdint>
namespace pg8 {
#define PG8_LAS __attribute__((address_space(3)))
typedef unsigned short bf16_t;
typedef short bf16x8 __attribute__((ext_vector_type(8)));
typedef float f32x4 __attribute__((ext_vector_type(4)));
typedef unsigned u32x4 __attribute__((ext_vector_type(4)));
constexpr int BM = 256, BK = 64, HALF = 128, HTB = HALF * BK * 2  , STAGE_BYTES = 8 * HTB, NXCD = 8, WGM = 8;

__host__ __device__ __forceinline__ int lds_byte(int r, int c) { const int st = (r >> 4) * 2 + (c >> 5), rr = r & 15, cc = c & 31, ob = rr * 64 + cc * 2; return st * 1024 + (ob ^ (((ob >> 9) & 1) << 5)); }
__host__ __device__ __forceinline__ void stage_rc(int b, int& R, int& C) { const int st = b / 1024, sb = b % 1024, swz = sb ^ (((sb >> 9) & 1) << 5); R = (st >> 1) * 16 + swz / 64; C = (st & 1) * 32 + (swz % 64) / 2; }
__host__ __device__ __forceinline__ int perm32(int rho) { const int n = rho >> 4, i = rho & 15; return 8 * (i >> 2) + 4 * n + (i & 3); }

struct Unit { int pm, pn; };
struct Gemm { const bf16_t* A; const bf16_t* Bt; int M, N, K; };

struct StaticOrder {
    int nM, nN, nwg, G, c;
    __host__ __device__ void init(int M, int N, int G_, int c_) { nM = M / BM; nN = N / BM; nwg = nM * nN; G = G_; c = c_; }
    __host__ __device__ bool next(int i, Unit& u) const {
        const long L = (long)i * G + c; if (L >= nwg) return false;
        int wgid = (int)L; { const int q = nwg / NXCD, r = nwg % NXCD, xcd = wgid % NXCD, off = wgid / NXCD; wgid = (xcd < r ? xcd * (q + 1) : r * (q + 1) + (xcd - r) * q) + off; }
        const int nig = WGM * nN, gid = wgid / nig, fm = gid * WGM, gsz = (nM - fm) < WGM ? (nM - fm) : WGM;
        u.pm = fm + ((wgid % nig) % gsz); u.pn = (wgid % nig) / gsz; return true;
    }
    __device__ __forceinline__ void a_ready(const Unit&) const {}
    __device__ __forceinline__ void done(const Unit&) const {}
};

__device__ __forceinline__ unsigned cvt_pk_bf16(float lo, float hi) { unsigned r; asm volatile("v_cvt_pk_bf16_f32 %0, %1, %2" : "=v"(r) : "v"(lo), "v"(hi)); return r; }
typedef unsigned u32x2 __attribute__((ext_vector_type(2)));
constexpr int TT = 32768;
constexpr float QS64 = 0.125f * 1.4426950408889634f;
constexpr float QS32 = 0.17677669529663687f * 1.4426950408889634f;

struct EpiProj {
    static constexpr bool PERM = true, AFTER_DRAIN = false;
    bf16_t* O; size_t tile_stride;
    __device__ __forceinline__ void operator()(const f32x4 (&acc)[2][2][4][2], const Unit& u, int wr, int wc, int fr, int fq) const {
        const int row0 = u.pm * BM + wr * 64 + fr; bf16_t* base = O + (size_t)u.pn * tile_stride;
        float sc = 1.f; if (u.pn == 0 || u.pn == 7) sc = QS64; else if (u.pn == 3) sc = QS32;
        const int col0 = wc * 32 + 8 * fq;
#pragma unroll
        for (int ai = 0; ai < 2; ++ai)
#pragma unroll
            for (int m = 0; m < 4; ++m) { bf16_t* rowp = base + (size_t)(row0 + ai * HALF + m * 16) * 256 + col0;
#pragma unroll
                for (int bj = 0; bj < 2; ++bj) { const f32x4 v0 = acc[ai][bj][m][0] * sc, v1 = acc[ai][bj][m][1] * sc;
                    u32x4 w; w.x = cvt_pk_bf16(v0[0], v0[1]); w.y = cvt_pk_bf16(v0[2], v0[3]); w.z = cvt_pk_bf16(v1[0], v1[1]); w.w = cvt_pk_bf16(v1[2], v1[3]);
                    *(u32x4*)(rowp + bj * HALF) = w; } }
    }
};
struct EpiZ {
    static constexpr bool PERM = true, AFTER_DRAIN = false;
    unsigned char* O;
    __device__ __forceinline__ void operator()(const f32x4 (&acc)[2][2][4][2], const Unit& u, int wr, int wc, int fr, int fq) const {
        const int row0 = u.pm * BM + wr * 64 + fr; const int col0 = (u.pn & 3) * BM + wc * 32 + 8 * fq;
#pragma unroll
        for (int ai = 0; ai < 2; ++ai)
#pragma unroll
            for (int m = 0; m < 4; ++m) { unsigned char* rowp = O + (size_t)(row0 + ai * HALF + m * 16) * 1024 + col0;
#pragma unroll
                for (int bj = 0; bj < 2; ++bj) { const f32x4 v0 = acc[ai][bj][m][0], v1 = acc[ai][bj][m][1];
                    int w0 = __builtin_amdgcn_cvt_pk_fp8_f32(v0[0], v0[1], 0, false); w0 = __builtin_amdgcn_cvt_pk_fp8_f32(v0[2], v0[3], w0, true);
                    int w1 = __builtin_amdgcn_cvt_pk_fp8_f32(v1[0], v1[1], 0, false); w1 = __builtin_amdgcn_cvt_pk_fp8_f32(v1[2], v1[3], w1, true);
                    u32x2 w; w.x = (unsigned)w0; w.y = (unsigned)w1;
                    *(u32x2*)(rowp + bj * HALF) = w; } }
    }
};
struct EpiRelu2 {
    static constexpr bool PERM = true, AFTER_DRAIN = false;
    unsigned char* O; int ldc;
    __device__ __forceinline__ void operator()(const f32x4 (&acc)[2][2][4][2], const Unit& u, int wr, int wc, int fr, int fq) const {
        const int row0 = u.pm * BM + wr * 64 + fr; const int col0 = u.pn * BM + wc * 32 + 8 * fq;
#pragma unroll
        for (int ai = 0; ai < 2; ++ai)
#pragma unroll
            for (int m = 0; m < 4; ++m) { unsigned char* rowp = O + (size_t)(row0 + ai * HALF + m * 16) * ldc + col0;
#pragma unroll
                for (int bj = 0; bj < 2; ++bj) { f32x4 v0 = acc[ai][bj][m][0], v1 = acc[ai][bj][m][1];
#pragma unroll
                    for (int j = 0; j < 4; ++j) { const float a = fmaxf(v0[j], 0.f), b = fmaxf(v1[j], 0.f); v0[j] = a * a; v1[j] = b * b; }
                    int w0 = __builtin_amdgcn_cvt_pk_fp8_f32(v0[0], v0[1], 0, false); w0 = __builtin_amdgcn_cvt_pk_fp8_f32(v0[2], v0[3], w0, true);
                    int w1 = __builtin_amdgcn_cvt_pk_fp8_f32(v1[0], v1[1], 0, false); w1 = __builtin_amdgcn_cvt_pk_fp8_f32(v1[2], v1[3], w1, true);
                    u32x2 w; w.x = (unsigned)w0; w.y = (unsigned)w1;
                    *(u32x2*)(rowp + bj * HALF) = w; } }
    }
};
template <bool BASE_BF16> struct EpiResid {
    static constexpr bool PERM = true, AFTER_DRAIN = false;
    const void* base; bf16_t* out; const float* gate; float ascale;
    __device__ __forceinline__ void operator()(const f32x4 (&acc)[2][2][4][2], const Unit& u, int wr, int wc, int fr, int fq) const {
        const int row0 = u.pm * BM + wr * 64 + fr; const int col0 = u.pn * BM + wc * 32 + 8 * fq;
        const float* gp = gate + (size_t)(u.pm >> 4) * 6144 + col0;
        f32x4 gv[2][2];
#pragma unroll
        for (int bj = 0; bj < 2; ++bj)
#pragma unroll
            for (int n = 0; n < 2; ++n) gv[bj][n] = *(const f32x4*)(gp + bj * HALF + n * 4) * ascale;
#pragma unroll
        for (int ai = 0; ai < 2; ++ai)
#pragma unroll
            for (int m = 0; m < 4; ++m) { const size_t off = (size_t)(row0 + ai * HALF + m * 16) * 1024 + col0;
#pragma unroll
                for (int bj = 0; bj < 2; ++bj) { f32x4 b0, b1;
                    if (BASE_BF16) { const u32x4 w = *(const u32x4*)((const bf16_t*)base + off + bj * HALF);
                        b0 = (f32x4){__uint_as_float(w.x << 16), __uint_as_float(w.x & 0xffff0000u), __uint_as_float(w.y << 16), __uint_as_float(w.y & 0xffff0000u)};
                        b1 = (f32x4){__uint_as_float(w.z << 16), __uint_as_float(w.z & 0xffff0000u), __uint_as_float(w.w << 16), __uint_as_float(w.w & 0xffff0000u)}; }
                    else { b0 = *(const f32x4*)((const float*)base + off + bj * HALF); b1 = *(const f32x4*)((const float*)base + off + bj * HALF + 4); }
                    const f32x4 v0 = b0 + gv[bj][0] * acc[ai][bj][m][0], v1 = b1 + gv[bj][1] * acc[ai][bj][m][1];
                    u32x4 o; o.x = cvt_pk_bf16(v0[0], v0[1]); o.y = cvt_pk_bf16(v0[2], v0[3]); o.z = cvt_pk_bf16(v1[0], v1[1]); o.w = cvt_pk_bf16(v1[2], v1[3]);
                    *(u32x4*)(out + off + bj * HALF) = o; }
                if (m & 1) asm volatile("" ::: "memory"); }
    }
};
struct EpiGate {
    static constexpr bool PERM = true, AFTER_DRAIN = false;
    const unsigned char* Z; const float* bg; bf16_t* O;
    __device__ __forceinline__ void operator()(const f32x4 (&acc)[2][2][4][2], const Unit& u, int wr, int wc, int fr, int fq) const {
        const int row0 = u.pm * BM + wr * 64 + fr; const int mc0 = u.pn * 64 + wc * 16 + 4 * fq;
#pragma unroll
        for (int ai = 0; ai < 2; ++ai)
#pragma unroll
            for (int m = 0; m < 4; ++m) { const size_t row = (size_t)(row0 + ai * HALF + m * 16);
                f32x4 bv[2][2];
#pragma unroll
                for (int bj = 0; bj < 2; ++bj)
#pragma unroll
                    for (int n = 0; n < 2; ++n) bv[bj][n] = *(const f32x4*)(bg + (2 * bj + n) * 1024 + mc0);
                asm volatile("" ::: "memory");
                f32x4 sum = (f32x4){0.f, 0.f, 0.f, 0.f};
#pragma unroll
                for (int bj = 0; bj < 2; ++bj)
#pragma unroll
                    for (int n = 0; n < 2; ++n) { const int zr = *(const int*)(Z + ((size_t)(2 * bj + n) * TT + row) * 1024 + mc0);
                        const f32x4 x = acc[ai][bj][m][n] * (1.f / 32.f) + bv[bj][n]; f32x4 zz;
                        zz[0] = __builtin_amdgcn_cvt_f32_fp8(zr, 0); zz[1] = __builtin_amdgcn_cvt_f32_fp8(zr, 1); zz[2] = __builtin_amdgcn_cvt_f32_fp8(zr, 2); zz[3] = __builtin_amdgcn_cvt_f32_fp8(zr, 3);
#pragma unroll
                        for (int j = 0; j < 4; ++j) { const float g = __builtin_amdgcn_rcpf(1.f + __builtin_amdgcn_exp2f(-1.4426950408889634f * x[j])); sum[j] += g * zz[j]; } }
                u32x2 w; w.x = cvt_pk_bf16(sum[0], sum[1]); w.y = cvt_pk_bf16(sum[2], sum[3]);
                *(u32x2*)(O + row * 1024 + mc0) = w; }
    }
};
typedef int i32x8 __attribute__((ext_vector_type(8))); typedef int i32x4 __attribute__((ext_vector_type(4)));
__device__ __forceinline__ i32x8 cat16(bf16x8 a, bf16x8 b) { const i32x4 x = __builtin_bit_cast(i32x4, a), y = __builtin_bit_cast(i32x4, b); return __builtin_shufflevector(x, y, 0, 1, 2, 3, 4, 5, 6, 7); }
template <class Epi, class Sched, bool ALIGN_EPI = false, bool SP2 = false, bool FP8 = false>
__device__ __forceinline__ void gemm_phase(PG8_LAS unsigned char* lds, const Gemm g, const Sched& S, const Epi& E) {
    int tid_l = threadIdx.x; asm volatile("" : "+v"(tid_l)); const int tid = tid_l, wid = __builtin_amdgcn_readfirstlane(tid >> 6), lane = tid & 63, wr = wid >> 2, wc = wid & 3, fr = lane & 15, fq = lane >> 4;
    const int K = g.K, nt = K / BK;
    unsigned voffA[2], voffB[2];
#pragma unroll
    for (int i = 0; i < 2; ++i) { int R, C; stage_rc(tid * 16 + i * 8192, R, C); const int Rb = Epi::PERM ? ((R & ~31) + perm32(R & 31)) : R;
        voffA[i] = (unsigned)(R * K + C) * 2u; voffB[i] = (unsigned)(Rb * K + C) * 2u; }
    const size_t kstep = (size_t)(BK * 2);
    const size_t hstep = (size_t)HALF * K * 2;
    const size_t tstep = 2 * hstep;
    const unsigned ldsw = (unsigned)wid * 1024u;
    const int aoff = lds_byte(wr * 64 + fr, fq * 8), boff = lds_byte(wc * 32 + fr, fq * 8);
#define PG8_SA(b, h) (((b) * 2 + (h)) * HTB)
#define PG8_SB(b, h) ((4 + (b) * 2 + (h)) * HTB)
#define PG8_STAGE(bufoff, gbase, voff) do { _Pragma("unroll") for (int _i = 0; _i < 2; ++_i) \
        __builtin_amdgcn_global_load_lds((const unsigned*)((const char*)(gbase) + (voff)[_i]), (PG8_LAS unsigned*)(lds + (bufoff) + ldsw + _i * 8192), 16, 0, 0); } while (0)
#define PG8_LDA(dst, b, h) do { _Pragma("unroll") for (int m = 0; m < 4; ++m) _Pragma("unroll") for (int k = 0; k < 2; ++k) dst[m][k] = *(const PG8_LAS bf16x8*)(lds + PG8_SA(b, h) + aoff + m * 2048 + k * 1024); } while (0)
#define PG8_LDB(dst, b, h) do { _Pragma("unroll") for (int n = 0; n < 2; ++n) _Pragma("unroll") for (int k = 0; k < 2; ++k) dst[n][k] = *(const PG8_LAS bf16x8*)(lds + PG8_SB(b, h) + boff + n * 2048 + k * 1024); } while (0)
#define PG8_MMA(ai, bj, At, Bt) do { __builtin_amdgcn_s_setprio(1); _Pragma("unroll") for (int m = 0; m < 4; ++m) _Pragma("unroll") for (int n = 0; n < 2; ++n) { \
        if constexpr (FP8) { const i32x8 b8_ = cat16(Bt[n][0], Bt[n][1]), a8_ = cat16(At[m][0], At[m][1]); \
            asm volatile("v_mfma_scale_f32_16x16x128_f8f6f4 %0, %1, %2, %0, %3, %3 op_sel_hi:[0,0,0]" : "+v"(acc[ai][bj][m][n]) : "v"(b8_), "v"(a8_), "v"(sc127)); } \
        else { _Pragma("unroll") for (int k = 0; k < 2; ++k) acc[ai][bj][m][n] = __builtin_amdgcn_mfma_f32_16x16x32_bf16(Bt[n][k], At[m][k], acc[ai][bj][m][n], 0, 0, 0); } } \
        __builtin_amdgcn_s_setprio(0); } while (0)
#define PG8_WAIT_V(n) asm volatile("s_waitcnt vmcnt(" #n ")" ::: "memory")
#define PG8_WAIT_L(n) asm volatile("s_waitcnt lgkmcnt(" #n ")" ::: "memory")
#define PG8_BAR __builtin_amdgcn_s_barrier()
#define PG8_SCHED __builtin_amdgcn_sched_barrier(0)
    Unit cur, nxt; int ui = 0;
    int sc127 = 127; asm volatile("" : "+v"(sc127));
    if (!S.next(0, cur)) return;
    f32x4 acc[2][2][4][2];
#pragma unroll
    for (int a = 0; a < 2; ++a)
#pragma unroll
        for (int b = 0; b < 2; ++b)
#pragma unroll
            for (int m = 0; m < 4; ++m)
#pragma unroll
                for (int n = 0; n < 2; ++n) acc[a][b][m][n] = (f32x4){0.f, 0.f, 0.f, 0.f};
    bf16x8 At[4][2], B0[2][2], B1[2][2];
    const char* cA = (const char*)g.A + (size_t)cur.pm * tstep; const char* cB = (const char*)g.Bt + (size_t)cur.pn * tstep;
    S.a_ready(cur);
    if constexpr (SP2) {
        PG8_STAGE(PG8_SB(0, 0), cB, voffB); PG8_STAGE(PG8_SB(0, 1), cB + hstep, voffB); PG8_STAGE(PG8_SA(0, 0), cA, voffA); PG8_STAGE(PG8_SA(0, 1), cA + hstep, voffA);
        if (wr == 1) PG8_BAR;
        PG8_WAIT_V(2); PG8_BAR;
        PG8_STAGE(PG8_SB(1, 0), cB + kstep, voffB); PG8_STAGE(PG8_SA(1, 0), cA + kstep, voffA); PG8_STAGE(PG8_SB(1, 1), cB + hstep + kstep, voffB);
        PG8_WAIT_V(6); PG8_BAR;
    } else {
        PG8_STAGE(PG8_SB(0, 0), cB, voffB); PG8_STAGE(PG8_SA(0, 0), cA, voffA); PG8_STAGE(PG8_SB(0, 1), cB + hstep, voffB); PG8_STAGE(PG8_SA(0, 1), cA + hstep, voffA);
        if (wr == 1) PG8_BAR;
        PG8_WAIT_V(4); PG8_BAR;
        PG8_STAGE(PG8_SB(1, 0), cB + kstep, voffB); PG8_STAGE(PG8_SA(1, 0), cA + kstep, voffA); PG8_STAGE(PG8_SB(1, 1), cB + hstep + kstep, voffB);
        PG8_WAIT_V(6); PG8_BAR;
    }
    for (;;) {
        const bool has_next = S.next(ui + 1, nxt);
        const char* nA = has_next ? (const char*)g.A + (size_t)nxt.pm * tstep : cA; const char* nB = has_next ? (const char*)g.Bt + (size_t)nxt.pn * tstep : cB;
        for (int t = 0; t < nt; t += 2) {
            const bool last = (t == nt - 2);
            const char* a1 = cA + (size_t)(t + 1) * kstep;
            const char* a2 = last ? nA : cA + (size_t)(t + 2) * kstep; const char* b2 = last ? nB : cB + (size_t)(t + 2) * kstep;
            const char* a3 = a2 + kstep; const char* b3 = b2 + kstep;
            if (last && has_next) S.a_ready(nxt);
            if constexpr (SP2) {
            PG8_LDB(B0, 0, 0); PG8_LDB(B1, 0, 1); PG8_SCHED; PG8_LDA(At, 0, 0); PG8_STAGE(PG8_SA(1, 1), a1 + hstep, voffA);
            PG8_WAIT_V(8); PG8_WAIT_L(0); PG8_BAR; PG8_MMA(0, 0, At, B0); PG8_MMA(0, 1, At, B1); PG8_BAR; PG8_SCHED;
            PG8_LDA(At, 0, 1); PG8_STAGE(PG8_SB(0, 0), b2, voffB); PG8_STAGE(PG8_SB(0, 1), b2 + hstep, voffB); PG8_STAGE(PG8_SA(0, 0), a2, voffA);
            PG8_WAIT_V(8); PG8_WAIT_L(0); PG8_BAR; PG8_MMA(1, 0, At, B0); PG8_MMA(1, 1, At, B1); PG8_BAR; PG8_SCHED;
            PG8_LDB(B0, 1, 0); PG8_LDB(B1, 1, 1); PG8_SCHED; PG8_LDA(At, 1, 0); PG8_STAGE(PG8_SA(0, 1), a2 + hstep, voffA);
            PG8_WAIT_V(8); PG8_WAIT_L(0); PG8_BAR; PG8_MMA(0, 0, At, B0); PG8_MMA(0, 1, At, B1); PG8_BAR; PG8_SCHED;
            PG8_LDA(At, 1, 1); PG8_STAGE(PG8_SB(1, 0), b3, voffB); PG8_STAGE(PG8_SB(1, 1), b3 + hstep, voffB); PG8_STAGE(PG8_SA(1, 0), a3, voffA);
            PG8_WAIT_V(8); PG8_WAIT_L(0); PG8_BAR; PG8_MMA(1, 0, At, B0); PG8_MMA(1, 1, At, B1); PG8_BAR; PG8_SCHED;
            } else {
            PG8_LDB(B0, 0, 0); PG8_SCHED; PG8_LDA(At, 0, 0); PG8_STAGE(PG8_SA(1, 1), a1 + hstep, voffA);
            PG8_WAIT_L(8); PG8_BAR; PG8_WAIT_L(0); PG8_MMA(0, 0, At, B0); PG8_BAR; PG8_SCHED;
            PG8_LDB(B1, 0, 1); PG8_STAGE(PG8_SB(0, 0), b2, voffB);
            PG8_BAR; PG8_WAIT_L(0); PG8_MMA(0, 1, At, B1); PG8_BAR;
            PG8_LDA(At, 0, 1); PG8_STAGE(PG8_SA(0, 0), a2, voffA);
            PG8_BAR; PG8_WAIT_L(0); PG8_MMA(1, 0, At, B0); PG8_BAR; PG8_SCHED;
            PG8_STAGE(PG8_SB(0, 1), b2 + hstep, voffB);
            PG8_WAIT_V(6); PG8_BAR; PG8_MMA(1, 1, At, B1); PG8_BAR;
            PG8_LDB(B0, 1, 0); PG8_SCHED; PG8_LDA(At, 1, 0); PG8_STAGE(PG8_SA(0, 1), a2 + hstep, voffA);
            PG8_WAIT_L(8); PG8_BAR; PG8_WAIT_L(0); PG8_MMA(0, 0, At, B0); PG8_BAR; PG8_SCHED;
            PG8_LDB(B1, 1, 1); PG8_STAGE(PG8_SB(1, 0), b3, voffB);
            PG8_BAR; PG8_WAIT_L(0); PG8_MMA(0, 1, At, B1); PG8_BAR;
            PG8_LDA(At, 1, 1); PG8_STAGE(PG8_SA(1, 0), a3, voffA);
            PG8_BAR; PG8_WAIT_L(0); PG8_MMA(1, 0, At, B0); PG8_BAR; PG8_SCHED;
            PG8_STAGE(PG8_SB(1, 1), b3 + hstep, voffB);
            PG8_WAIT_V(6); PG8_BAR; PG8_MMA(1, 1, At, B1); PG8_BAR;
            }
        }
        if constexpr (ALIGN_EPI) { if (wr == 0) PG8_BAR; }
        if constexpr (FP8) asm volatile("s_nop 15\n\ts_nop 15" ::: "memory");
        if constexpr (!Epi::AFTER_DRAIN) { int t2_ = threadIdx.x; asm volatile("" : "+v"(t2_)); const int l2_ = t2_ & 63, w2_ = __builtin_amdgcn_readfirstlane(t2_ >> 6);
            E(acc, cur, w2_ >> 2, w2_ & 3, l2_ & 15, l2_ >> 4); S.done(cur); }
        if (!has_next) break;
#pragma unroll
        for (int a = 0; a < 2; ++a)
#pragma unroll
            for (int b = 0; b < 2; ++b)
#pragma unroll
                for (int m = 0; m < 4; ++m)
#pragma unroll
                    for (int n = 0; n < 2; ++n) acc[a][b][m][n] = (f32x4){0.f, 0.f, 0.f, 0.f};
        cur = nxt; cA = nA; cB = nB; ++ui;
        if constexpr (ALIGN_EPI) { if (wr == 1) PG8_BAR; }
    }
    PG8_WAIT_V(0);
    if constexpr (!ALIGN_EPI) { if (wr == 0) PG8_BAR; }
    PG8_BAR;
    if constexpr (Epi::AFTER_DRAIN) { E.fused(acc, cur, wr, wc, fr, fq, lds, wid, lane); S.done(cur); }
#undef PG8_SA
#undef PG8_SB
#undef PG8_STAGE
#undef PG8_LDA
#undef PG8_LDB
#undef PG8_MMA
#undef PG8_WAIT_V
#undef PG8_WAIT_L
#undef PG8_BAR
#undef PG8_SCHED
}
}

constexpr int NB = 8, SEQ = 4096, DM = 1024, NL = 2, FF = 4096, NPROJ = 2724, NPROJ_PAD = 2816, NTILE_PROJ = 11;
constexpr int TOK = NB * SEQ;
static_assert(TOK == pg8::TT, "token count");
constexpr float NORM_EPS = 1e-6f;
constexpr float LOG2E = 1.4426950408889634f;
constexpr int NWAVES = 8;

constexpr size_t MiB = 1u << 20;
constexpr size_t WS_CTL = 0, CTL_ZERO_BYTES = 1 * MiB;
constexpr size_t WS_MOD = 1 * MiB;
constexpr size_t WS_KMEAN = WS_MOD + 512 * 1024;
constexpr size_t WS_W = 2 * MiB;
constexpr size_t W_IN = 0, W_GATE = W_IN + (size_t)NPROJ_PAD * DM, W_BR = W_GATE + (size_t)4 * DM * DM, W_OUT = W_BR + (size_t)4 * DM * 256,
                 W_FF1 = W_OUT + (size_t)DM * DM, W_FF2 = W_FF1 + (size_t)FF * DM, W_LAYER = W_FF2 + (size_t)DM * FF;
constexpr size_t WS_MASK = 70 * MiB;
constexpr size_t WS_H = 86 * MiB;
constexpr size_t WS_Y = 150 * MiB;
constexpr size_t WS_R = 214 * MiB;
constexpr size_t WS_H8 = 470 * MiB;
constexpr size_t WS_END = 502 * MiB;
static_assert(WS_W + 2 * W_LAYER * 2 <= WS_MASK, "weights fit");
constexpr int CW_BAR = 4096;
constexpr int CW_WQ = 131072;
constexpr int CW_NRM = CW_WQ + 4096;
constexpr int NPHASE = 22;

constexpr int RING_BYTES = 135168;
constexpr int LDSCTL_OFF = RING_BYTES;
constexpr int LDS_BYTES = 147456;

#define GAS __attribute__((address_space(1)))
#define LAS __attribute__((address_space(3)))
typedef unsigned short bf16;
typedef unsigned v4u __attribute__((ext_vector_type(4)));
typedef unsigned v2u __attribute__((ext_vector_type(2)));
typedef float f32x4 __attribute__((ext_vector_type(4)));
typedef float f32x16 __attribute__((ext_vector_type(16)));
typedef short bf16x8 __attribute__((ext_vector_type(8)));
typedef short s16x4 __attribute__((ext_vector_type(4)));
typedef GAS unsigned gu32;
#define RLX_AGENT __ATOMIC_RELAXED, __HIP_MEMORY_SCOPE_AGENT
#define LDS_WAIT() asm volatile("s_waitcnt lgkmcnt(0)" ::: "memory")
__device__ __forceinline__ unsigned f2bf(float f) { unsigned u = __builtin_bit_cast(unsigned, f); return (u + 0x7fffu + ((u >> 16) & 1u)) >> 16; }
__device__ __forceinline__ unsigned pk2(float lo, float hi) { return f2bf(lo) | (f2bf(hi) << 16); }
__device__ __forceinline__ float bf2f(unsigned short b) { return __uint_as_float((unsigned)b << 16); }
__device__ __forceinline__ float bflo(unsigned w) { return __uint_as_float(w << 16); }
__device__ __forceinline__ float bfhi(unsigned w) { return __uint_as_float(w & 0xffff0000u); }

#define XB_TMO      128
#define XB_XCNT(j)  (256  + 64 * (j))
#define XB_XSUB(j)  (1280 + 64 * (j))
#define XB_XGEN(j)  (2304 + 64 * (j))
#define XB_TOP      3328
#define XB_TOPGEN   3392
#define XCD_BAR_WORDS 3456
#define XB_SPIN_CAP (1u << 18)

__device__ __forceinline__ unsigned xb_ld(unsigned* p)              { return __hip_atomic_load(p, __ATOMIC_RELAXED, __HIP_MEMORY_SCOPE_AGENT); }
__device__ __forceinline__ unsigned xb_add(unsigned* p, unsigned v) { return __hip_atomic_fetch_add(p, v, __ATOMIC_RELAXED, __HIP_MEMORY_SCOPE_AGENT); }
__device__ __forceinline__ unsigned xb_xcc_id() { return (unsigned)__builtin_amdgcn_s_getreg((3 << 11) | 20) & 0xFu; }
#define XB_SPIN(cond, bar) do { unsigned _sp = 0; while (cond) { __builtin_amdgcn_s_sleep(1); \
    if ((++_sp & 255u) == 0u) { if (xb_ld(&(bar)[XB_TMO])) break; if (_sp > XB_SPIN_CAP) { atomicAdd(&(bar)[XB_TMO], 1u); break; } } } } while (0)

struct XcdBarrier {
    unsigned* bar; unsigned x;
    volatile LAS unsigned* st;
};

__device__ __forceinline__ XcdBarrier xcd_barrier_post(unsigned* bar, volatile LAS unsigned* st) {
    XcdBarrier b; b.bar = bar; b.x = xb_xcc_id(); b.st = st;
    if (threadIdx.x == 0) (void)xb_add(&bar[XB_XCNT(b.x)], 1u);
    return b;
}
__device__ __forceinline__ void xcd_barrier_complete(unsigned* bar, unsigned x, unsigned& nloc, unsigned& nx) {
    const unsigned G = gridDim.x * gridDim.y * gridDim.z;
    unsigned sum, cnt, mine, sp = 0u;
    for (;;) {
        sum = 0u; cnt = 0u; mine = 0u;
#pragma unroll
        for (unsigned j = 0; j < 16; ++j) { const unsigned c = xb_ld(&bar[XB_XCNT(j)]); sum += c; cnt += (c > 0u) ? 1u : 0u; mine = (j == x) ? c : mine; }
        if (sum == G) break;
        __builtin_amdgcn_s_sleep(1);
        if ((++sp & 255u) == 0u) { if (xb_ld(&bar[XB_TMO])) break; if (sp > XB_SPIN_CAP) { atomicAdd(&bar[XB_TMO], 1u); break; } }
    }
    nloc = mine > 0u ? mine : 1u; nx = cnt > 0u ? cnt : 1u;
}

__device__ __forceinline__ void xcd_barrier(const XcdBarrier& b) {
    asm volatile("s_waitcnt vmcnt(0)" ::: "memory");
    __syncthreads();
    if (threadIdx.x == 0) {
        unsigned* bar = b.bar;
        __builtin_amdgcn_s_waitcnt(0);
        unsigned nloc = b.st[0], nx = b.st[1];
        if (nloc == 0u) { xcd_barrier_complete(bar, b.x, nloc, nx); b.st[0] = nloc; b.st[1] = nx; }
        const unsigned old = xb_add(&bar[XB_XSUB(b.x)], 1u);
        const unsigned gen = old / nloc;
        if (old + 1u == (gen + 1u) * nloc) {
            __builtin_amdgcn_fence(__ATOMIC_RELEASE, "agent");
            asm volatile("s_waitcnt vmcnt(0)" ::: "memory");
            const unsigned og = xb_add(&bar[XB_TOP], 1u);
            const unsigned tg = og / nx;
            if (og + 1u == (tg + 1u) * nx) xb_add(&bar[XB_TOPGEN], 1u);
            else XB_SPIN(xb_ld(&bar[XB_TOPGEN]) == tg, bar);
            __builtin_amdgcn_fence(__ATOMIC_ACQUIRE, "agent");
            xb_add(&bar[XB_XGEN(b.x)], 1u);
            asm volatile("s_waitcnt vmcnt(0)" ::: "memory");
        } else {
            XB_SPIN(xb_ld(&bar[XB_XGEN(b.x)]) == gen, bar);
            __builtin_amdgcn_fence(__ATOMIC_ACQUIRE, "agent");
            asm volatile("s_waitcnt vmcnt(0)" ::: "memory");
        }
    }
    __syncthreads();
}

struct Args {
    const float *x, *c, *w_ada, *b_ada, *norm1_g, *w_in, *diff_lambda, *diff_subln_g, *w_pool, *pool_scale, *w_gate, *b_gate, *w_branch, *w_out, *norm2_g, *w_ff1, *w_ff2, *final_g;
    float* out; unsigned char* ws; int ph_lo, ph_hi, li, pad;
};

__device__ __forceinline__ float shx(float v, int mask, int lane) { return __int_as_float(__builtin_amdgcn_ds_bpermute((lane ^ mask) << 2, __float_as_int(v))); }
__device__ __forceinline__ unsigned shxu(unsigned v, int mask, int lane) { return (unsigned)__builtin_amdgcn_ds_bpermute((lane ^ mask) << 2, (int)v); }
__device__ __forceinline__ unsigned shupu(unsigned v, int delta, int lane) { return (unsigned)__builtin_amdgcn_ds_bpermute(((lane - delta) & 63) << 2, (int)v); }
__device__ __forceinline__ float wave_sum(float v, int lane) {
#pragma unroll
    for (int o = 1; o < 64; o <<= 1) v += shx(v, o, lane);
    return v;
}
__device__ __forceinline__ int crow(int r, int hi) { return (r & 3) + 8 * (r >> 2) + 4 * hi; }
typedef float f32x2_t __attribute__((ext_vector_type(2))); typedef __bf16 bf16x2_t __attribute__((ext_vector_type(2)));
__device__ __forceinline__ unsigned cvtpk(float lo, float hi) { f32x2_t v = {lo, hi}; bf16x2_t b = __builtin_convertvector(v, bf16x2_t); return __builtin_bit_cast(unsigned, b); }

__device__ __forceinline__ int gate_row(int br, int c) { const int pn = c >> 6, ml = c & 63; return 256 * pn + 128 * (br >> 1) + 32 * (ml >> 4) + 8 * ((ml >> 2) & 3) + 4 * (br & 1) + (ml & 3); }
__device__ __forceinline__ void p0_transpose_item(const float* W, int K, int Nsrc, int Npad, bf16* WT, int mode, int br, LAS float* scr, int item, int lane) {
    const int nblk = Npad / 32, kb = item / nblk, nb = item % nblk, k0 = 64 * kb, n0 = 32 * nb;
    const int c4 = lane & 7, kr = lane >> 3, nn = n0 + 4 * c4;
    f32x4 v[8];
#pragma unroll
    for (int i = 0; i < 8; ++i) v[i] = (nn < Nsrc) ? *(const f32x4*)(W + (size_t)(k0 + 8 * i + kr) * Nsrc + nn) : (f32x4){0.f, 0.f, 0.f, 0.f};
#pragma unroll
    for (int i = 0; i < 8; ++i) { LAS float* d = scr + (8 * i + kr) * 33 + 4 * c4; d[0] = v[i][0]; d[1] = v[i][1]; d[2] = v[i][2]; d[3] = v[i][3]; }
    LDS_WAIT(); asm volatile("" ::: "memory");
    const int c = lane & 7;
#pragma unroll
    for (int j = 0; j < 4; ++j) { const int n = (lane >> 3) + 8 * j; const LAS float* s = scr + (8 * c) * 33 + n;
        v4u o; o.x = pk2(s[0 * 33], s[1 * 33]); o.y = pk2(s[2 * 33], s[3 * 33]); o.z = pk2(s[4 * 33], s[5 * 33]); o.w = pk2(s[6 * 33], s[7 * 33]);
        const int drow = (mode == 1 || mode == 2) ? gate_row(br, n0 + n) : (n0 + n);
        if (mode >= 2) {
            const float f8s = (mode == 2) ? 32.f : 64.f;
            int w0 = __builtin_amdgcn_cvt_pk_fp8_f32(f8s * s[0 * 33], f8s * s[1 * 33], 0, false); w0 = __builtin_amdgcn_cvt_pk_fp8_f32(f8s * s[2 * 33], f8s * s[3 * 33], w0, true);
            int w1 = __builtin_amdgcn_cvt_pk_fp8_f32(f8s * s[4 * 33], f8s * s[5 * 33], 0, false); w1 = __builtin_amdgcn_cvt_pk_fp8_f32(f8s * s[6 * 33], f8s * s[7 * 33], w1, true);
            v2u o8; o8.x = (unsigned)w0; o8.y = (unsigned)w1;
            *(v2u*)((unsigned char*)WT + (size_t)drow * K + k0 + 8 * c) = o8;
        } else *(v4u*)(WT + (size_t)drow * K + k0 + 8 * c) = o; }
    LDS_WAIT(); asm volatile("" ::: "memory");
}

template <bool XBF16>
__device__ __forceinline__ void norm_rows_bf16(const void* X, bf16* O, unsigned char* O8  , const float* g, const float* mod  , int sh_idx, int sc_idx, int gw, int ngw, int lane_in) {
    int lane = lane_in; asm volatile("" : "+v"(lane));
    constexpr int RB = 4;
    const f32x4* gp = (const f32x4*)g + 4 * lane;
    const f32x4 g0 = gp[0], g1 = gp[1], g2 = gp[2], g3 = gp[3];
    for (int m0 = gw; m0 < TOK; m0 += RB * ngw) {
        float v[RB][16];
#pragma unroll
        for (int rb = 0; rb < RB; ++rb) { const int m = m0 + rb * ngw;
            if (m < TOK) {
                if (XBF16) { const v4u* xr = (const v4u*)((const bf16*)X + (size_t)m * DM) + 2 * lane; const v4u a = xr[0], c = xr[1];
                    v[rb][0] = bflo(a.x); v[rb][1] = bfhi(a.x); v[rb][2] = bflo(a.y); v[rb][3] = bfhi(a.y); v[rb][4] = bflo(a.z); v[rb][5] = bfhi(a.z); v[rb][6] = bflo(a.w); v[rb][7] = bfhi(a.w);
                    v[rb][8] = bflo(c.x); v[rb][9] = bfhi(c.x); v[rb][10] = bflo(c.y); v[rb][11] = bfhi(c.y); v[rb][12] = bflo(c.z); v[rb][13] = bfhi(c.z); v[rb][14] = bflo(c.w); v[rb][15] = bfhi(c.w); }
                else { const f32x4* xr = (const f32x4*)((const float*)X + (size_t)m * DM) + 4 * lane;
#pragma unroll
                    for (int j = 0; j < 4; ++j) { const f32x4 t = xr[j]; v[rb][4 * j] = t.x; v[rb][4 * j + 1] = t.y; v[rb][4 * j + 2] = t.z; v[rb][4 * j + 3] = t.w; } }
            } else {
#pragma unroll
                for (int e = 0; e < 16; ++e) v[rb][e] = 0.f; } }
#pragma unroll
        for (int rb = 0; rb < RB; ++rb) { const int m = m0 + rb * ngw; if (m < TOK) {
            const int b = m >> 12;
            float s = 0.f;
#pragma unroll
            for (int e = 0; e < 16; ++e) s += v[rb][e] * v[rb][e];
            const float rstd = 1.f / sqrtf(wave_sum(s, lane) * (1.f / DM) + NORM_EPS);
            const f32x4* shp = (const f32x4*)(mod + (size_t)b * 6144 + sh_idx * 1024) + 4 * lane;
            const f32x4* scp = (const f32x4*)(mod + (size_t)b * 6144 + sc_idx * 1024) + 4 * lane;
            float y[16];
#pragma unroll
            for (int j = 0; j < 4; ++j) { const f32x4 gg = (j == 0) ? g0 : (j == 1) ? g1 : (j == 2) ? g2 : g3; const f32x4 sh = shp[j], sc = scp[j];
#pragma unroll
                for (int e = 0; e < 4; ++e) y[4 * j + e] = v[rb][4 * j + e] * rstd * gg[e] * (1.f + sc[e]) + sh[e]; }
            v4u o0, o1;
            o0.x = pk2(y[0], y[1]); o0.y = pk2(y[2], y[3]); o0.z = pk2(y[4], y[5]); o0.w = pk2(y[6], y[7]);
            o1.x = pk2(y[8], y[9]); o1.y = pk2(y[10], y[11]); o1.z = pk2(y[12], y[13]); o1.w = pk2(y[14], y[15]);
            v4u* op = (v4u*)(O + (size_t)m * DM) + 2 * lane; op[0] = o0; op[1] = o1;
            if (O8) { v4u q;
                int w = __builtin_amdgcn_cvt_pk_fp8_f32(y[0], y[1], 0, false); w = __builtin_amdgcn_cvt_pk_fp8_f32(y[2], y[3], w, true); q.x = (unsigned)w;
                w = __builtin_amdgcn_cvt_pk_fp8_f32(y[4], y[5], 0, false); w = __builtin_amdgcn_cvt_pk_fp8_f32(y[6], y[7], w, true); q.y = (unsigned)w;
                w = __builtin_amdgcn_cvt_pk_fp8_f32(y[8], y[9], 0, false); w = __builtin_amdgcn_cvt_pk_fp8_f32(y[10], y[11], w, true); q.z = (unsigned)w;
                w = __builtin_amdgcn_cvt_pk_fp8_f32(y[12], y[13], 0, false); w = __builtin_amdgcn_cvt_pk_fp8_f32(y[14], y[15], w, true); q.w = (unsigned)w;
                *((v4u*)(O8 + (size_t)m * DM) + lane) = q; } } }
    }
}

#ifndef ATT_PD
#define ATT_PD 2
#endif
constexpr int AT_K0 = 0, AT_KSLOT = 9216, AT_V0 = 18432, AT_VSLOT = 12288, AT_SEL = 43008, AT_KM = 44032, AT_END = 47872;
__device__ __forceinline__ s16x4 vtr(LAS const unsigned char* p) { return __builtin_bit_cast(s16x4, __builtin_amdgcn_ds_read_tr16_b64_v4i16((LAS s16x4*)p)); }

#define TRRD(dst, addr, off) asm volatile("ds_read_b64_tr_b16 %0, %1 offset:%2" : "=v"(dst) : "v"(addr), "i"(off) : "memory")
#define SBAR0() __builtin_amdgcn_sched_barrier(0)
__device__ __forceinline__ void softmax_pv(f32x16& s0, f32x16& s1, float& l, f32x16 (&o)[2], LAS const unsigned char* vbase  ) {
    const unsigned va = (unsigned)(uintptr_t)vbase;
    s16x4 vl[2][2][2], vh[2][2][2];
#pragma unroll
    for (int sub = 0; sub < 2; ++sub)
#pragma unroll
        for (int db = 0; db < 2; ++db)
#pragma unroll
            for (int s2 = 0; s2 < 2; ++s2) { TRRD(vl[db][sub][s2], va, (32 * sub + 16 * s2) * 192 + db * 64); TRRD(vh[db][sub][s2], va, (32 * sub + 16 * s2 + 8) * 192 + db * 64); }
    float la = l;
#pragma unroll
    for (int r = 0; r < 16; ++r) { s0[r] = __builtin_amdgcn_exp2f(s0[r]); la += s0[r]; }
    bf16x8 pf[2][2];
#pragma unroll
    for (int s2 = 0; s2 < 2; ++s2) { v4u a;
        a.x = cvtpk(s0[8 * s2 + 0], s0[8 * s2 + 1]); a.y = cvtpk(s0[8 * s2 + 2], s0[8 * s2 + 3]); a.z = cvtpk(s0[8 * s2 + 4], s0[8 * s2 + 5]); a.w = cvtpk(s0[8 * s2 + 6], s0[8 * s2 + 7]);
        pf[0][s2] = __builtin_bit_cast(bf16x8, a); }
    asm volatile("s_waitcnt lgkmcnt(0)" : "+v"(vl[0][0][0]), "+v"(vl[0][0][1]), "+v"(vl[0][1][0]), "+v"(vl[0][1][1]), "+v"(vl[1][0][0]), "+v"(vl[1][0][1]), "+v"(vl[1][1][0]), "+v"(vl[1][1][1]),
                                          "+v"(vh[0][0][0]), "+v"(vh[0][0][1]), "+v"(vh[0][1][0]), "+v"(vh[0][1][1]), "+v"(vh[1][0][0]), "+v"(vh[1][0][1]), "+v"(vh[1][1][0]), "+v"(vh[1][1][1]) :: "memory");
    SBAR0();
#pragma unroll
    for (int g = 0; g < 4; ++g) { const int db = g >> 1, s2 = g & 1;
        const s16x4 lo = vl[db][0][s2], hh = vh[db][0][s2];
        const bf16x8 vf = (bf16x8){lo[0], lo[1], lo[2], lo[3], hh[0], hh[1], hh[2], hh[3]};
        o[db] = __builtin_amdgcn_mfma_f32_32x32x16_bf16(vf, pf[0][s2], o[db], 0, 0, 0);
#pragma unroll
        for (int r = 4 * g; r < 4 * g + 4; ++r) { s1[r] = __builtin_amdgcn_exp2f(s1[r]); la += s1[r]; }
        SBAR0(); }
    l = la;
#pragma unroll
    for (int s2 = 0; s2 < 2; ++s2) { v4u c;
        c.x = cvtpk(s1[8 * s2 + 0], s1[8 * s2 + 1]); c.y = cvtpk(s1[8 * s2 + 2], s1[8 * s2 + 3]); c.z = cvtpk(s1[8 * s2 + 4], s1[8 * s2 + 5]); c.w = cvtpk(s1[8 * s2 + 6], s1[8 * s2 + 7]);
        pf[1][s2] = __builtin_bit_cast(bf16x8, c); }
#pragma unroll
    for (int g = 0; g < 4; ++g) { const int db = g >> 1, s2 = g & 1;
        const s16x4 lo = vl[db][1][s2], hh = vh[db][1][s2];
        const bf16x8 vf = (bf16x8){lo[0], lo[1], lo[2], lo[3], hh[0], hh[1], hh[2], hh[3]};
        o[db] = __builtin_amdgcn_mfma_f32_32x32x16_bf16(vf, pf[1][s2], o[db], 0, 0, 0); }
}
__device__ __forceinline__ void split3(float x, unsigned& h, unsigned& m, unsigned& l) {
    h = f2bf(x); const float r1 = x - __uint_as_float(h << 16); m = f2bf(r1); const float r2 = r1 - __uint_as_float(m << 16); l = f2bf(r2);
}

template <int MODE>
__device__ __forceinline__ void attn_unit(LAS unsigned char* lds, int b, int h, int qb, const bf16* Qb, const bf16* Kb, const bf16* Vb, bf16* Ob, float slope,
                                          const float* kmean, float lam, float post_scale, const float* subg, const unsigned* maskw, const unsigned* nrm  ,
                                          const int* refposg, const int* refming) {
    int tid_l = threadIdx.x; asm volatile("" : "+v"(tid_l)); const int tid = tid_l, lane = tid & 63, wid = __builtin_amdgcn_readfirstlane(tid >> 6), r32 = lane & 31, hi = lane >> 5;
    const int q = qb * 256 + wid * 32 + r32;
    const size_t rowg = (size_t)b * SEQ;
    const float c2 = slope * LOG2E;
    unsigned sel = 0u;
    bf16x8 qf[4];
#pragma unroll
    for (int ds = 0; ds < 4; ++ds) qf[ds] = *(const bf16x8*)(Qb + (rowg + q) * 256 + h * 64 + ds * 16 + hi * 8);
    const int skey = tid >> 3, sch = tid & 7;
    const bf16* ksrc = Kb + (rowg + skey) * 256 + h * 64 + sch * 8;
    const bf16* vsrc = Vb + (rowg + skey) * 256 + h * 64 + sch * 8;
    const int kdst = AT_K0 + skey * 144 + sch * 16, vdst = AT_V0 + skey * 192 + sch * 16;
    const int NT = 4 * qb + 4;
    const float Bq = __uint_as_float(nrm[b * 4 + h]), Bk = __uint_as_float(nrm[32 + b * 4 + h]);
#if defined(PROBE_NOSKIP)
    const float Dskip = 1e9f + 0.f * (Bq + Bk);
#else
    const float Dskip = (150.f + 2.f * sqrtf(Bq * Bk)) / c2;
#endif
    const int koff = r32 * 144 + hi * 16;
    const int vtoff = (4 * hi + ((lane & 15) >> 2)) * 192 + (16 * ((lane >> 4) & 1) + 4 * (lane & 3)) * 2;
    float l1 = 0.f, l2 = 0.f;
    f32x16 oA[2], oB[2];
#pragma unroll
    for (int r = 0; r < 16; ++r) { oA[0][r] = 0.f; oA[1][r] = 0.f; oB[0][r] = 0.f; oB[1][r] = 0.f; }
    const int qmin = qb * 256 + wid * 32, qmax = qmin + 31;
    constexpr int PD = ATT_PD;
    v4u kR[PD], vR[PD]; v2u mR[PD];
    int refpos = q;
    int minref = qb * 256;
    if (MODE == 2) { refpos = refposg[rowg + q]; minref = refming[b * 128 + 8 * qb];
#pragma unroll
        for (int i = 1; i < 8; ++i) { const int v = refming[b * 128 + 8 * qb + i]; minref = v < minref ? v : minref; } }
    int T0 = (int)floorf(((float)minref - Dskip) * (1.f / 64.f)); T0 = T0 < 0 ? 0 : T0; T0 = __builtin_amdgcn_readfirstlane(T0);
    const v4u k0r = *(const v4u*)(ksrc + (size_t)T0 * 64 * 256), v0r = *(const v4u*)(vsrc + (size_t)T0 * 64 * 256);
#pragma unroll
    for (int i = 0; i < PD; ++i) { kR[i] = (v4u){0u, 0u, 0u, 0u}; vR[i] = kR[i]; mR[i] = (v2u){0u, 0u};
        if (T0 + i + 1 < NT) { kR[i] = *(const v4u*)(ksrc + (size_t)(T0 + i + 1) * 64 * 256); vR[i] = *(const v4u*)(vsrc + (size_t)(T0 + i + 1) * 64 * 256);
            if (MODE == 2) mR[i] = *(const v2u*)(maskw + (rowg + q) * 128 + 2 * (T0 + i + 1)); } }
    v2u mw = (v2u){0u, 0u};
    if (MODE == 2) mw = *(const v2u*)(maskw + (rowg + q) * 128 + 2 * T0);
    if (MODE == 0) {
        LAS float* KM = (LAS float*)(lds + AT_KM); LAS unsigned* SEL = (LAS unsigned*)(lds + AT_SEL);
        for (int i = tid; i < qb * 64; i += 512) KM[i] = kmean[(size_t)((b * 4 + h) * 16) * 64 + i];
        __syncthreads();
        if (tid < 256) {
            const bf16* qrow = Qb + (rowg + qb * 256 + tid) * 256 + h * 64;
            float qv[64];
#pragma unroll
            for (int c = 0; c < 8; ++c) { const v4u w = *(const v4u*)(qrow + 8 * c);
                qv[8 * c + 0] = bflo(w.x); qv[8 * c + 1] = bfhi(w.x); qv[8 * c + 2] = bflo(w.y); qv[8 * c + 3] = bfhi(w.y);
                qv[8 * c + 4] = bflo(w.z); qv[8 * c + 5] = bfhi(w.z); qv[8 * c + 6] = bflo(w.w); qv[8 * c + 7] = bfhi(w.w); }
            float v1 = -INFINITY, v2 = -INFINITY, v3 = -INFINITY; int i1 = -1, i2 = -1, i3 = -1;
            for (int n = 0; n < qb; ++n) {
                float g = 0.f;
#pragma unroll
                for (int d = 0; d < 64; ++d) g = __builtin_fmaf(qv[d], KM[n * 64 + d], g);
                if (g > v1) { v3 = v2; i3 = i2; v2 = v1; i2 = i1; v1 = g; i1 = n; }
                else if (g > v2) { v3 = v2; i3 = i2; v2 = g; i2 = n; }
                else if (g > v3) { v3 = g; i3 = n; }
            }
            unsigned sm = 0u; if (i1 >= 0) sm |= 1u << i1; if (i2 >= 0) sm |= 1u << i2; if (i3 >= 0) sm |= 1u << i3;
            SEL[tid] = sm;
        }
        __syncthreads();
        sel = SEL[wid * 32 + r32];
    }
    *(LAS v4u*)(lds + kdst + (T0 & 1) * AT_KSLOT) = k0r; *(LAS v4u*)(lds + vdst + (T0 & 1) * AT_VSLOT) = v0r;
    bf16x8 qaug; v4u ka0, ka1;
    { unsigned a, b2, c; split3(-c2 * (float)refpos, a, b2, c);
      v4u w; if (hi == 0) { w.x = a | (b2 << 16); w.y = c | (0x3f80u << 16); w.z = 0x3f80u | (0x3f80u << 16); w.w = 0u; }
             else { w.x = 0x3f80u | (0x3f80u << 16); w.y = 0x3f80u; w.z = 0u; w.w = 0u; }
      qaug = __builtin_bit_cast(bf16x8, w);
      split3(c2 * (float)r32, a, b2, c); ka0.x = 0x3f80u | (0x3f80u << 16); ka0.y = 0x3f80u | (a << 16); ka0.z = b2 | (c << 16); ka0.w = 0u;
      split3(c2 * (float)(r32 + 32), a, b2, c); ka1.x = ka0.x; ka1.y = 0x3f80u | (a << 16); ka1.z = b2 | (c << 16); ka1.w = 0u; }
    __syncthreads();
#pragma nounroll
    for (int t0 = T0; t0 < NT; t0 += PD) {
#pragma unroll
      for (int u = 0; u < PD; ++u) { const int t = t0 + u; if (t < NT) {
        const int slot = t & 1;
        const int k0 = 64 * t;
        bool active = (k0 <= qmax);
        bool keep = true;
        if (MODE == 0) { const int n = t >> 2; if (n < qb) { keep = ((sel >> n) & 1u) != 0u; active = (__ballot(keep) != 0ull); } }
        if (active) {
            LAS const unsigned char* ks = lds + AT_K0 + slot * AT_KSLOT + koff;
            LAS const unsigned char* vb = lds + AT_V0 + slot * AT_VSLOT + vtoff;
            const int lim = q - k0 - 4 * hi;
            const bool needmask = (k0 + 63 > qmin);
            bf16x8 kaug0, kaug1;
            { unsigned a, b2, c; split3(c2 * (float)k0, a, b2, c);
              v4u w0 = ka0, w1 = ka1; if (hi) { w0.x = a | (b2 << 16); w0.y = c; w0.z = 0u; w1 = w0; }
              kaug0 = __builtin_bit_cast(bf16x8, w0); kaug1 = __builtin_bit_cast(bf16x8, w1); }
            f32x16 sb0, sb1;
#pragma unroll
            for (int r = 0; r < 16; ++r) { sb0[r] = 0.f; sb1[r] = 0.f; }
            sb0 = __builtin_amdgcn_mfma_f32_32x32x16_bf16(kaug0, qaug, sb0, 0, 0, 0);
            sb1 = __builtin_amdgcn_mfma_f32_32x32x16_bf16(kaug1, qaug, sb1, 0, 0, 0);
#pragma unroll
            for (int mp = 0; mp < (MODE == 1 ? 2 : 1); ++mp) {
                f32x16 s0, s1;
#pragma unroll
                for (int dd = 0; dd < (MODE == 1 ? 2 : 4); ++dd) { const int ds = (MODE == 1) ? (2 * mp + dd) : dd;
                    const bf16x8 a0 = *(LAS const bf16x8*)(ks + ds * 32), a1 = *(LAS const bf16x8*)(ks + 32 * 144 + ds * 32);
                    if (dd == 0) { s0 = __builtin_amdgcn_mfma_f32_32x32x16_bf16(a0, qf[ds], sb0, 0, 0, 0); s1 = __builtin_amdgcn_mfma_f32_32x32x16_bf16(a1, qf[ds], sb1, 0, 0, 0); }
                    else { s0 = __builtin_amdgcn_mfma_f32_32x32x16_bf16(a0, qf[ds], s0, 0, 0, 0); s1 = __builtin_amdgcn_mfma_f32_32x32x16_bf16(a1, qf[ds], s1, 0, 0, 0); } }
#if defined(PROBE_QK2X)
                { f32x16 d0, d1;
#pragma unroll
                  for (int r = 0; r < 16; ++r) { d0[r] = 0.f; d1[r] = 0.f; }
#pragma unroll
                  for (int dd = 0; dd < (MODE == 1 ? 2 : 4); ++dd) { const int ds = (MODE == 1) ? (2 * mp + dd) : dd;
                    const bf16x8 a0 = *(LAS const bf16x8*)(ks + ds * 32 + 16), a1 = *(LAS const bf16x8*)(ks + 32 * 144 + ds * 32 + 16);
                    d0 = __builtin_amdgcn_mfma_f32_32x32x16_bf16(a0, qf[ds], d0, 0, 0, 0);
                    d1 = __builtin_amdgcn_mfma_f32_32x32x16_bf16(a1, qf[ds], d1, 0, 0, 0); }
                  asm volatile("" :: "v"(d0), "v"(d1)); }
#endif
                if (MODE == 2) {
#pragma unroll
                    for (int r = 0; r < 16; ++r) { const int pos = (r & 3) + 8 * (r >> 2) + 4 * hi;
                        if (!((mw.x >> pos) & 1u)) s0[r] = -INFINITY; if (!((mw.y >> pos) & 1u)) s1[r] = -INFINITY; }
                } else {
                    if (MODE == 0 && !keep) {
#pragma unroll
                        for (int r = 0; r < 16; ++r) { s0[r] = -INFINITY; s1[r] = -INFINITY; }
                    }
                    if (needmask) {
#pragma unroll
                        for (int r = 0; r < 16; ++r) { const int ko = (r & 3) + 8 * (r >> 2);
                            if (ko > lim) s0[r] = -INFINITY; if (ko + 32 > lim) s1[r] = -INFINITY; }
                    }
                }
                if (mp == 0) softmax_pv(s0, s1, l1, oA, vb); else softmax_pv(s0, s1, l2, oB, vb);
            }
        }
        if (t + 1 < NT) { *(LAS v4u*)(lds + kdst + (slot ^ 1) * AT_KSLOT) = kR[u]; *(LAS v4u*)(lds + vdst + (slot ^ 1) * AT_VSLOT) = vR[u];
            if (MODE == 2) mw = mR[u];
            if (t + 1 + PD < NT) { kR[u] = *(const v4u*)(ksrc + (size_t)(t + 1 + PD) * 64 * 256); vR[u] = *(const v4u*)(vsrc + (size_t)(t + 1 + PD) * 64 * 256);
                if (MODE == 2) mR[u] = *(const v2u*)(maskw + (rowg + q) * 128 + 2 * (t + 1 + PD)); } }
        __syncthreads();
#if defined(PROBE_BAR2X)
        __syncthreads();
#endif
      } }
    }
    const float l1t = l1 + shx(l1, 32, lane);
    bf16* orow = Ob + (rowg + q) * 256 + h * 64 + 4 * hi;
    if (MODE == 1) {
        const float l2t = l2 + shx(l2, 32, lane);
        const float i1 = 1.f / l1t, i2 = lam / l2t;
        float ssq = 0.f;
#pragma unroll
        for (int db = 0; db < 2; ++db)
#pragma unroll
            for (int r = 0; r < 16; ++r) { const float v = oA[db][r] * i1 - oB[db][r] * i2; oA[db][r] = v; ssq += v * v; }
        ssq += shx(ssq, 32, lane);
        const float rn = post_scale / sqrtf(ssq * (1.f / 64.f) + NORM_EPS);
#pragma unroll
        for (int db = 0; db < 2; ++db)
#pragma unroll
            for (int g4 = 0; g4 < 4; ++g4) { const f32x4 gg = *(const f32x4*)(subg + 32 * db + 8 * g4 + 4 * hi);
                v2u w; w.x = cvtpk(oA[db][4 * g4 + 0] * rn * gg[0], oA[db][4 * g4 + 1] * rn * gg[1]); w.y = cvtpk(oA[db][4 * g4 + 2] * rn * gg[2], oA[db][4 * g4 + 3] * rn * gg[3]);
                *(v2u*)(orow + 32 * db + 8 * g4) = w; }
    } else {
        const float i1 = 1.f / l1t;
#pragma unroll
        for (int db = 0; db < 2; ++db)
#pragma unroll
            for (int g4 = 0; g4 < 4; ++g4) { v2u w; w.x = cvtpk(oA[db][4 * g4 + 0] * i1, oA[db][4 * g4 + 1] * i1); w.y = cvtpk(oA[db][4 * g4 + 2] * i1, oA[db][4 * g4 + 3] * i1);
                *(v2u*)(orow + 32 * db + 8 * g4) = w; }
    }
    __syncthreads();
}

constexpr int DS_HP = 1025;
constexpr int DS_HIST_BYTES = 32 * DS_HP * 4;
constexpr int DS_BP = 129;
constexpr int DS_G = 0, DS_C = 32 * DS_BP * 4, DS_AUX = DS_HIST_BYTES;
__device__ __forceinline__ float relu_asm(float x) { return __builtin_amdgcn_fmed3f(x, 0.f, __builtin_inff()); }
__device__ __forceinline__ void dsa_scores(const bf16x8 (&iqf)[4][2], const float (&w)[4], const bf16x8 k0, const bf16x8 k1, float (&sc)[16]) {
#pragma unroll
    for (int hh = 0; hh < 4; ++hh) {
        f32x16 x;
#pragma unroll
        for (int r = 0; r < 16; ++r) x[r] = 0.f;
        x = __builtin_amdgcn_mfma_f32_32x32x16_bf16(k0, iqf[hh][0], x, 0, 0, 0);
        x = __builtin_amdgcn_mfma_f32_32x32x16_bf16(k1, iqf[hh][1], x, 0, 0, 0);
#pragma unroll
        for (int r = 0; r < 16; ++r) sc[r] = (hh == 0) ? (w[0] * relu_asm(x[r])) : __builtin_fmaf(w[hh], relu_asm(x[r]), sc[r]);
    }
}
__device__ __forceinline__ unsigned dsa_mono(float s) { const unsigned bits = __float_as_uint(s); return bits ^ ((unsigned)((int)bits >> 31) | 0x80000000u); }
__device__ __forceinline__ unsigned dsa_ckey(float s, unsigned keyidx) { return (dsa_mono(s) & 0xFFFFF000u) | (4095u - keyidx); }
__device__ __forceinline__ unsigned take_low(unsigned w, unsigned n) {
    if (n >= (unsigned)__popc(w)) return w;
    unsigned res = 0u;
    while (n > 0u) { const unsigned low = w & (0u - w); res |= low; w ^= low; --n; }
    return res;
}
template <int PASS>
__device__ __forceinline__ void dsa_hist_pass(LAS unsigned* hist, const bf16x8 (&iqf)[4][2], const float (&w)[4], const bf16* kbase, int qg, int wid, int r32, int hi, int t, unsigned P1) {
    bf16x8 nk0 = *(const bf16x8*)(kbase + (size_t)wid * 32 * 256), nk1 = *(const bf16x8*)(kbase + (size_t)wid * 32 * 256 + 16);
    const unsigned rowb = (unsigned)(r32 * DS_HP * 4);
#pragma nounroll
    for (int j = wid; j <= qg; j += 8) {
        const bf16x8 k0 = nk0, k1 = nk1;
        { const int jn = (j + 8 <= qg) ? j + 8 : j; const bf16* kp = kbase + (size_t)jn * 32 * 256; nk0 = *(const bf16x8*)kp; nk1 = *(const bf16x8*)(kp + 16); }
        float sc[16]; dsa_scores(iqf, w, k0, k1, sc);
#if defined(PROBE_D1_SCORE2X)
        { float sd[16]; dsa_scores(iqf, w, k1, k0, sd);
#pragma unroll
          for (int r = 0; r < 16; ++r) asm volatile("" :: "v"(sd[r])); }
#endif
        const int lim = t - 32 * j - 4 * hi;
        const bool diag = (j == qg);
#pragma unroll
        for (int r = 0; r < 16; ++r) {
            const unsigned mono = dsa_mono(sc[r]);
            unsigned addr;
            if (PASS == 0) { addr = rowb + ((mono >> 22) << 2); if (diag && ((r & 3) + 8 * (r >> 2) > lim)) addr = rowb + 4096u; }
            else { addr = rowb + (((mono >> 12) & 1023u) << 2); if ((mono >> 22) != P1 || (diag && ((r & 3) + 8 * (r >> 2) > lim))) addr = rowb + 4096u; }
            __hip_atomic_fetch_add((LAS unsigned*)((LAS unsigned char*)hist + addr), 1u, __ATOMIC_RELAXED, __HIP_MEMORY_SCOPE_WORKGROUP);
#if defined(PROBE_D1_ATOM2X)
            __hip_atomic_fetch_add((LAS unsigned*)((LAS unsigned char*)hist + rowb + 4096u), 1u, __ATOMIC_RELAXED, __HIP_MEMORY_SCOPE_WORKGROUP);
#endif
        }
    }
}
__device__ __forceinline__ void dsa_scan(LAS unsigned* hist, LAS unsigned* AUX, int pass, int wid, int lane) {
#pragma unroll
    for (int qi = 0; qi < 4; ++qi) {
        const int qq = 4 * wid + qi;
        const unsigned K = (pass == 0) ? 256u : AUX[32 + qq];
        LAS const unsigned* hrow = hist + qq * DS_HP;
        const int wb = 1008 - 16 * lane;
        unsigned s = 0u;
#pragma unroll
        for (int i = 0; i < 16; ++i) s += hrow[wb + ((i + lane) & 15)];
        unsigned incl = s;
#pragma unroll
        for (int o = 1; o < 64; o <<= 1) { const unsigned v = shupu(incl, o, lane); if (lane >= o) incl += v; }
        const unsigned long long bal = __ballot(incl >= K);
        const int L = __builtin_amdgcn_readfirstlane(bal ? (__ffsll((long long)bal) - 1) : 0);
        const unsigned above = (unsigned)__builtin_amdgcn_readlane((int)(incl - s), L);
        const int bin = 1023 - 16 * L - (lane & 15);
        const unsigned c = (lane < 16) ? hrow[bin] : 0u;
        unsigned inc2 = c;
#pragma unroll
        for (int o = 1; o < 16; o <<= 1) { const unsigned v = shupu(inc2, o, lane); if (lane >= o) inc2 += v; }
        const unsigned long long bal2 = __ballot(lane < 16 && above + inc2 >= K);
        const int I = __builtin_amdgcn_readfirstlane(bal2 ? (__ffsll((long long)bal2) - 1) : 0);
        if (lane == I) { AUX[64 * pass + qq] = (unsigned)bin; AUX[64 * pass + 32 + qq] = K - (above + inc2 - c); }
    }
}
__device__ __forceinline__ void dsa_select_unit(LAS unsigned char* lds, int b, int qg, const bf16* IX, unsigned* MASK, int* REFPOS  , int* REFMIN  ) {
    int tid_l = threadIdx.x; asm volatile("" : "+v"(tid_l)); const int tid = tid_l, lane = tid & 63, wid = __builtin_amdgcn_readfirstlane(tid >> 6), r32 = lane & 31, hi = lane >> 5;
    const int t = 32 * qg + r32;
    const size_t rowg = (size_t)b * SEQ;
    const bf16* qrow = IX + (rowg + t) * 256;
    bf16x8 iqf[4][2];
#pragma unroll
    for (int hh = 0; hh < 4; ++hh)
#pragma unroll
        for (int ds = 0; ds < 2; ++ds) iqf[hh][ds] = *(const bf16x8*)(qrow + 32 * hh + 16 * ds + 8 * hi);
    float w[4];
    { const v2u ww = *(const v2u*)(qrow + 160); w[0] = bflo(ww.x); w[1] = bfhi(ww.x); w[2] = bflo(ww.y); w[3] = bfhi(ww.y); }
    LAS unsigned* hist = (LAS unsigned*)lds;
    LAS unsigned* AUX = (LAS unsigned*)(lds + DS_AUX);
    const bf16* kbase = IX + (rowg + r32) * 256 + 128 + 8 * hi;
    unsigned P = 0u;
    const bool all = (qg < 8);
    if (!all) {
        for (int i = tid; i < DS_HIST_BYTES / 16; i += 512) ((LAS v4u*)lds)[i] = (v4u){0u, 0u, 0u, 0u};
#if defined(PROBE_D1_ZERO2X)
        __syncthreads(); for (int i = tid; i < DS_HIST_BYTES / 16; i += 512) ((LAS v4u*)lds)[i] = (v4u){0u, 0u, 0u, 0u}; __syncthreads(); for (int i = tid; i < DS_HIST_BYTES / 16; i += 512) ((LAS v4u*)lds)[i] = (v4u){0u, 0u, 0u, 0u};
#endif
        __syncthreads();
        dsa_hist_pass<0>(hist, iqf, w, kbase, qg, wid, r32, hi, t, 0u);
        __syncthreads();
        dsa_scan(hist, AUX, 0, wid, lane);
#if defined(PROBE_D1_SCAN2X)
        __syncthreads(); dsa_scan(hist, AUX, 0, wid, lane);
#endif
        __syncthreads();
        const unsigned P1 = AUX[r32];
        for (int i = tid; i < DS_HIST_BYTES / 16; i += 512) ((LAS v4u*)lds)[i] = (v4u){0u, 0u, 0u, 0u};
        __syncthreads();
        dsa_hist_pass<1>(hist, iqf, w, kbase, qg, wid, r32, hi, t, P1);
        __syncthreads();
        dsa_scan(hist, AUX, 1, wid, lane);
#if defined(PROBE_D1_SCAN2X)
        __syncthreads(); dsa_scan(hist, AUX, 1, wid, lane);
#endif
        __syncthreads();
        P = (P1 << 10) | AUX[64 + r32];
    }
    if (all) { if (tid < 32) { AUX[64 + 32 + tid] = 0u; } }
    for (int i = tid; i < (2 * 32 * DS_BP * 4) / 16; i += 512) ((LAS v4u*)lds)[i] = (v4u){0u, 0u, 0u, 0u};
    __syncthreads();
    LAS unsigned* G = (LAS unsigned*)(lds + DS_G);
    LAS unsigned* C = (LAS unsigned*)(lds + DS_C);
    bf16x8 nk0, nk1;
    { const int j0 = (wid <= qg) ? wid : 0; nk0 = *(const bf16x8*)(kbase + (size_t)j0 * 32 * 256); nk1 = *(const bf16x8*)(kbase + (size_t)j0 * 32 * 256 + 16); }
#pragma nounroll
    for (int j = wid; j <= qg; j += 8) {
        const bf16x8 k0 = nk0, k1 = nk1;
        { const int jn = (j + 8 <= qg) ? j + 8 : j; const bf16* kp = kbase + (size_t)jn * 32 * 256; nk0 = *(const bf16x8*)kp; nk1 = *(const bf16x8*)(kp + 16); }
        float sc[16]; dsa_scores(iqf, w, k0, k1, sc);
        unsigned bg = 0u, bc = 0u;
        const int lim = t - 32 * j - 4 * hi;
#pragma unroll
        for (int r = 0; r < 16; ++r) {
            const int pos = (r & 3) + 8 * (r >> 2) + 4 * hi;
            const unsigned p22 = dsa_mono(sc[r]) >> 12;
            const bool ok = ((r & 3) + 8 * (r >> 2)) <= lim;
            if (ok && p22 > P) bg |= 1u << pos;
            if (ok && p22 == P) bc |= 1u << pos;
        }
        bg |= shxu(bg, 32, lane); bc |= shxu(bc, 32, lane);
        if (hi == 0) { G[r32 * DS_BP + j] = bg; C[r32 * DS_BP + j] = bc; }
    }
    __syncthreads();
#pragma unroll
    for (int qi = 0; qi < 4; ++qi) {
        const int qq = 4 * wid + qi;
        const unsigned K2 = AUX[64 + 32 + qq];
        const unsigned w0 = C[qq * DS_BP + 2 * lane], w1 = C[qq * DS_BP + 2 * lane + 1];
        const unsigned pc = (unsigned)__popc(w0) + (unsigned)__popc(w1);
        unsigned incl = pc;
#pragma unroll
        for (int o = 1; o < 64; o <<= 1) { const unsigned v = shupu(incl, o, lane); if (lane >= o) incl += v; }
        const unsigned pre = incl - pc;
        unsigned need = K2 > pre ? K2 - pre : 0u;
        const unsigned t0 = take_low(w0, need); need -= (unsigned)__popc(t0);
        const unsigned t1 = take_low(w1, need);
        const unsigned g0 = G[qq * DS_BP + 2 * lane] | t0, g1 = G[qq * DS_BP + 2 * lane + 1] | t1;
        G[qq * DS_BP + 2 * lane] = g0; G[qq * DS_BP + 2 * lane + 1] = g1;
        int hp = g1 ? (64 * lane + 63 - __clz((int)g1)) : (g0 ? (64 * lane + 31 - __clz((int)g0)) : -1);
#pragma unroll
        for (int o = 1; o < 64; o <<= 1) { const int v = (int)shxu((unsigned)hp, o, lane); hp = v > hp ? v : hp; }
        if (lane == 0) { REFPOS[rowg + 32 * qg + qq] = hp; AUX[128 + qq] = (unsigned)hp; }
    }
    __syncthreads();
    if (tid == 0) { int mn = 0x7fffffff; for (int i = 0; i < 32; ++i) { const int v = (int)AUX[128 + i]; mn = v < mn ? v : mn; } REFMIN[b * 128 + qg] = mn; }
    { const int qq = tid >> 4, part = tid & 15;
        unsigned* dst = MASK + (rowg + 32 * qg + qq) * 128 + part * 8;
        v4u a, c2;
        a.x = G[qq * DS_BP + part * 8 + 0]; a.y = G[qq * DS_BP + part * 8 + 1]; a.z = G[qq * DS_BP + part * 8 + 2]; a.w = G[qq * DS_BP + part * 8 + 3];
        c2.x = G[qq * DS_BP + part * 8 + 4]; c2.y = G[qq * DS_BP + part * 8 + 5]; c2.z = G[qq * DS_BP + part * 8 + 6]; c2.w = G[qq * DS_BP + part * 8 + 7];
        *(v4u*)dst = a; *(v4u*)(dst + 4) = c2; }
    __syncthreads();
}

constexpr int PL_U = 0, PL_UP = 528, PL_D = 79 * 528 + 16  , PL_DP = 257;
__device__ __forceinline__ void pool_unit(LAS unsigned char* lds, int b, int tile, const bf16* PU, const float* wpool  , const float* pscale  , bf16* YC) {
    int tid_l = threadIdx.x; asm volatile("" : "+v"(tid_l)); const int tid = tid_l, cb = __builtin_amdgcn_readfirstlane(tid >> 6), tt = tid & 63;
    const int t0 = tile * 64; const size_t rowg = (size_t)b * SEQ;
    for (int i = tid; i < 79 * 32; i += 512) { const int rr = i >> 5, ch = i & 31; const int tok = t0 - 15 + rr;
        v4u v = (v4u){0u, 0u, 0u, 0u}; if (tok >= 0) v = *(const v4u*)(PU + (rowg + tok) * 256 + ch * 8);
        *(LAS v4u*)(lds + PL_U + rr * PL_UP + ch * 16) = v; }
    __syncthreads();
    const int g = cb >> 1, wlen = 2 << g, c0 = 32 * cb, t = t0 + tt;
    const float inv = 1.f / (float)((t + 1 < wlen) ? (t + 1) : wlen);
    LAS float* Dm = (LAS float*)(lds + PL_D);
#pragma unroll
    for (int ch = 0; ch < 4; ++ch) {
        float sum[8];
#pragma unroll
        for (int e = 0; e < 8; ++e) sum[e] = 0.f;
        float self[8];
        for (int i = 0; i < wlen; ++i) {
            const v4u v = *(LAS const v4u*)(lds + PL_U + (15 + tt - i) * PL_UP + (c0 + 8 * ch) * 2);
            const float f[8] = {bflo(v.x), bfhi(v.x), bflo(v.y), bfhi(v.y), bflo(v.z), bfhi(v.z), bflo(v.w), bfhi(v.w)};
#pragma unroll
            for (int e = 0; e < 8; ++e) { sum[e] += f[e]; if (i == 0) self[e] = f[e]; }
        }
#pragma unroll
        for (int e = 0; e < 8; ++e) Dm[tt * PL_DP + c0 + 8 * ch + e] = sum[e] * inv - self[e];
    }
    __syncthreads();
    const int e0 = 32 * (cb & 1);
    float acc[32];
#pragma unroll
    for (int e = 0; e < 32; ++e) acc[e] = 0.f;
    const float* wg = wpool + (size_t)g * 4096 + e0;
    for (int c = 0; c < 64; ++c) {
        const float dv = Dm[tt * PL_DP + 64 * g + c];
        const float* wr = wg + c * 64;
#pragma unroll
        for (int e = 0; e < 32; ++e) acc[e] = __builtin_fmaf(dv, wr[e], acc[e]);
    }
    bf16* orow = YC + (rowg + t) * 256 + 64 * g + e0;
    const float* ps = pscale + 64 * g + e0;
#pragma unroll
    for (int k = 0; k < 4; ++k) { v4u o;
        o.x = pk2(acc[8 * k + 0] * ps[8 * k + 0], acc[8 * k + 1] * ps[8 * k + 1]); o.y = pk2(acc[8 * k + 2] * ps[8 * k + 2], acc[8 * k + 3] * ps[8 * k + 3]);
        o.z = pk2(acc[8 * k + 4] * ps[8 * k + 4], acc[8 * k + 5] * ps[8 * k + 5]); o.w = pk2(acc[8 * k + 6] * ps[8 * k + 6], acc[8 * k + 7] * ps[8 * k + 7]);
        *(v4u*)(orow + 8 * k) = o; }
    __syncthreads();
}
__device__ __forceinline__ void kmean_item(int item, const bf16* AK, float* KMEAN, int wid, int lane_in) {
    int lane = lane_in; asm volatile("" : "+v"(lane));
    const int combo = item * 8 + wid; const int b = combo >> 6, h = (combo >> 4) & 3, n = combo & 15;
    const int ks = lane >> 3, ch = lane & 7;
    const bf16* p = AK + ((size_t)b * SEQ + 256 * n + ks) * 256 + 64 * h + 8 * ch;
    float s[8];
#pragma unroll
    for (int e = 0; e < 8; ++e) s[e] = 0.f;
#pragma unroll 8
    for (int j = 0; j < 32; ++j) { const v4u v = *(const v4u*)(p + (size_t)j * 8 * 256);
        s[0] += bflo(v.x); s[1] += bfhi(v.x); s[2] += bflo(v.y); s[3] += bfhi(v.y); s[4] += bflo(v.z); s[5] += bfhi(v.z); s[6] += bflo(v.w); s[7] += bfhi(v.w); }
#pragma unroll
    for (int e = 0; e < 8; ++e) { s[e] += shx(s[e], 8, lane); s[e] += shx(s[e], 16, lane); s[e] += shx(s[e], 32, lane); }
    if (ks == 0) { float* o = KMEAN + (size_t)combo * 64 + 8 * ch;
        *(f32x4*)o = (f32x4){s[0], s[1], s[2], s[3]} * (1.f / 256.f); *(f32x4*)(o + 4) = (f32x4){s[4], s[5], s[6], s[7]} * (1.f / 256.f); }
}

__device__ __forceinline__ void norm_unit(LAS unsigned char* lds, int n, const bf16* PROJ, size_t TS, unsigned* NRM  ) {
    int tid_l = threadIdx.x; asm volatile("" : "+v"(tid_l)); const int tid = tid_l, lane = tid & 63, wid = __builtin_amdgcn_readfirstlane(tid >> 6);
    const int a = n >> 8, rem = n & 255, sq = rem >> 7, b = (rem >> 4) & 7, c = rem & 15;
    const int tile = (a == 0 ? 0 : (a == 1 ? 3 : 7)) + sq;
    const int row = tid >> 1, hp = tid & 1;
    float ss[2] = {0.f, 0.f};
#pragma unroll
    for (int rr = 0; rr < 1; ++rr) {
        const bf16* p = PROJ + (size_t)tile * TS + ((size_t)b * SEQ + 256 * c + row) * 256 + 128 * hp;
#pragma unroll
        for (int hh = 0; hh < 2; ++hh) { float acc = 0.f;
#pragma unroll
            for (int i = 0; i < 8; ++i) { const v4u v = *(const v4u*)(p + 64 * hh + 8 * i);
                const float f0 = bflo(v.x), f1 = bfhi(v.x), f2 = bflo(v.y), f3 = bfhi(v.y), f4 = bflo(v.z), f5 = bfhi(v.z), f6 = bflo(v.w), f7 = bfhi(v.w);
                acc += (f0 * f0 + f1 * f1) + (f2 * f2 + f3 * f3) + (f4 * f4 + f5 * f5) + (f6 * f6 + f7 * f7); }
            ss[hh] = fmaxf(ss[hh], acc); }
    }
#pragma unroll
    for (int o = 2; o < 64; o <<= 1) { ss[0] = fmaxf(ss[0], shx(ss[0], o, lane)); ss[1] = fmaxf(ss[1], shx(ss[1], o, lane)); }
    LAS float* R = (LAS float*)lds;
    if (lane < 2) { R[wid * 4 + 2 * hp] = ss[0]; R[wid * 4 + 2 * hp + 1] = ss[1]; }
    __syncthreads();
    if (tid < 4) { float m = R[tid];
#pragma unroll
        for (int w2 = 1; w2 < 8; ++w2) m = fmaxf(m, R[w2 * 4 + tid]);
        __hip_atomic_fetch_max(NRM + ((a * 2 + sq) * 8 + b) * 4 + tid, __float_as_uint(m * 1.0001f), __ATOMIC_RELAXED, __HIP_MEMORY_SCOPE_AGENT); }
    __syncthreads();
}

__device__ __forceinline__ float alibi_slope(int idx  ) { return exp2f(-8.f * (float)idx / 12.f); }

__device__ __forceinline__ void p0_adaln(const Args& A, LAS unsigned char* lds, int G) {
    int tid_l = threadIdx.x; asm volatile("" : "+v"(tid_l)); const int tid = tid_l, lane = tid & 63, wid = __builtin_amdgcn_readfirstlane(tid >> 6);
    LAS float* cact = (LAS float*)lds;
    LAS float* red = (LAS float*)(lds + 32768);
    float* MOD = (float*)(A.ws + WS_MOD);
    if ((int)blockIdx.x < 192) {
        for (int i = tid; i < 8192; i += 512) { const int bb = i >> 10, k = i & 1023; const float v = A.c[i]; cact[k * 8 + bb] = v / (1.f + __expf(-v)); }
        __syncthreads();
        for (int u = blockIdx.x; u < 192; u += G) {
            const int l = u / 96, n0 = (u % 96) * 64;
            const float* wp = A.w_ada + ((size_t)l * 1024 + 128 * wid) * 6144 + n0 + lane;
            float acc[8];
#pragma unroll
            for (int bb = 0; bb < 8; ++bb) acc[bb] = 0.f;
#pragma unroll 16
            for (int k = 0; k < 128; ++k) {
                const float wv = wp[(size_t)k * 6144];
                const f32x4 c0 = *(LAS const f32x4*)(cact + (128 * wid + k) * 8), c1 = *(LAS const f32x4*)(cact + (128 * wid + k) * 8 + 4);
                acc[0] += c0[0] * wv; acc[1] += c0[1] * wv; acc[2] += c0[2] * wv; acc[3] += c0[3] * wv;
                acc[4] += c1[0] * wv; acc[5] += c1[1] * wv; acc[6] += c1[2] * wv; acc[7] += c1[3] * wv;
            }
#pragma unroll
            for (int bb = 0; bb < 8; ++bb) red[(wid * 8 + bb) * 64 + lane] = acc[bb];
            __syncthreads();
            { const int bb = wid; float s = A.b_ada[(size_t)l * 6144 + n0 + lane];
#pragma unroll
                for (int w2 = 0; w2 < 8; ++w2) s += red[(w2 * 8 + bb) * 64 + lane];
                MOD[((size_t)l * 8 + bb) * 6144 + n0 + lane] = s; }
            __syncthreads();
        }
    }
    __syncthreads();
}
__device__ __forceinline__ void p0_weights(const Args& A, LAS unsigned char* lds, int vcu, int G, int l0, int l1) {
    int tid_l = threadIdx.x; asm volatile("" : "+v"(tid_l)); const int tid = tid_l, lane = tid & 63, wid = __builtin_amdgcn_readfirstlane(tid >> 6);
    unsigned char* ws = A.ws;
    LAS float* scr = (LAS float*)(lds + wid * 16384);
    const int gw = vcu * NWAVES + wid, NGW = G * NWAVES;
    constexpr int I_IN = 16 * (NPROJ_PAD / 32), I_G1 = 16 * 32, I_BR1 = 4 * 32, I_OUT = 16 * 32, I_F1 = 16 * 128, I_F2 = 64 * 32;
    constexpr int I_LAYER = I_IN + 4 * I_G1 + 4 * I_BR1 + I_OUT + I_F1 + I_F2;
    for (int it = l0 * I_LAYER + gw; it < l1 * I_LAYER; it += NGW) {
        const int l = it / I_LAYER; int r = it % I_LAYER;
        bf16* WL = (bf16*)(ws + WS_W) + (size_t)l * W_LAYER;
        if (r < I_IN) { p0_transpose_item(A.w_in + (size_t)l * DM * NPROJ, DM, NPROJ, NPROJ_PAD, WL + W_IN, 0, 0, scr, r, lane); continue; } r -= I_IN;
        if (r < 4 * I_G1) { const int br = r / I_G1; p0_transpose_item(A.w_gate + ((size_t)l * 4 + br) * DM * DM, DM, DM, DM, WL + W_GATE, 2, br, scr, r % I_G1, lane); continue; } r -= 4 * I_G1;
        if (r < 4 * I_BR1) { const int br = r / I_BR1; p0_transpose_item(A.w_branch + ((size_t)l * 4 + br) * 256 * DM, 256, DM, DM, WL + W_BR + (size_t)br * DM * 256, 0, 0, scr, r % I_BR1, lane); continue; } r -= 4 * I_BR1;
        if (r < I_OUT) { p0_transpose_item(A.w_out + (size_t)l * DM * DM, DM, DM, DM, WL + W_OUT, 0, 0, scr, r, lane); continue; } r -= I_OUT;
        if (r < I_F1) { p0_transpose_item(A.w_ff1 + (size_t)l * DM * FF, DM, FF, FF, WL + W_FF1, 0, 0, scr, r, lane); continue; } r -= I_F1;
        p0_transpose_item(A.w_ff2 + (size_t)l * FF * DM, FF, DM, DM, WL + W_FF2, 3, 0, scr, r, lane);
    }
    __syncthreads();
}

__device__ __forceinline__ int wq_draw(gu32* ctr) { int v = 0; if (threadIdx.x == 0) v = (int)__hip_atomic_fetch_add(ctr, 1u, RLX_AGENT); return v; }
__device__ __forceinline__ int wq_bcast(volatile LAS unsigned* slot, int v) {
    if (threadIdx.x == 0) *slot = (unsigned)v;
    __syncthreads();
    const int item = (int)*slot;
    __syncthreads();
    return item;
}

#ifndef ZG_ALIGN
#define ZG_ALIGN true
#define ZG_SP2 false
#endif
#ifndef IN_ALIGN
#define IN_ALIGN true
#define IN_SP2 true
#endif
#ifndef GT_ALIGN
#define GT_ALIGN true
#define GT_SP2 true
#endif
#ifndef WO_ALIGN
#define WO_ALIGN true
#define WO_SP2 true
#endif
#ifndef F1_ALIGN
#define F1_ALIGN true
#define F1_SP2 true
#endif
#ifndef F2_ALIGN
#define F2_ALIGN true
#define F2_SP2 true
#endif
struct ZOrder {
    pg8::StaticOrder base;
    __device__ __forceinline__ bool next(int i, pg8::Unit& u) const { if (!base.next(i, u)) return false; u.pn += 4 * (u.pm >> 7); return true; }
    __device__ __forceinline__ void a_ready(const pg8::Unit&) const {}
    __device__ __forceinline__ void done(const pg8::Unit&) const {}
};

__global__ void __launch_bounds__(NWAVES * 64, 2) hybrid_fwd(Args args) {
    extern __shared__ __attribute__((aligned(16))) unsigned char lds_raw[];
    LAS unsigned char* lds = (LAS unsigned char*)lds_raw;
#define PHASE_IDS int tid_p = threadIdx.x; asm volatile("" : "+v"(tid_p)); const int lane = tid_p & 63, wid = __builtin_amdgcn_readfirstlane(tid_p >> 6); const int gw = vcu * NWAVES + wid, ngw = G * NWAVES; (void)lane; (void)gw; (void)ngw;
    const int G = gridDim.x; const int bx = blockIdx.x; const int vcu = (G % 8 == 0) ? (bx % 8) * (G / 8) + bx / 8 : bx;
    unsigned char* ws = args.ws;
    gu32* ctl = (gu32*)(ws + WS_CTL);
    volatile LAS unsigned* MISC = (volatile LAS unsigned*)(lds + LDSCTL_OFF);
    for (int u = threadIdx.x; u < (LDS_BYTES - LDSCTL_OFF) / 4; u += NWAVES * 64) ((LAS unsigned*)(lds + LDSCTL_OFF))[u] = 0u;
    __syncthreads();
    const int lo = args.ph_lo, hi = args.ph_hi;
    XcdBarrier bar; bar.bar = (unsigned*)(ctl + CW_BAR) + args.li * XCD_BAR_WORDS; bar.x = 0; bar.st = nullptr;
    if (hi - lo > 1) bar = xcd_barrier_post((unsigned*)(ctl + CW_BAR) + args.li * XCD_BAR_WORDS, MISC + 8);
#ifndef PHASE_OFF
#define PHASE_OFF 0
#endif
#define IN(k) (lo <= (k) && (k) < hi && !((PHASE_OFF >> ((k) == 0 ? 0 : (k) == 21 ? 11 : (((k) - 1) % 10) + 1)) & 1))
#ifndef REPEAT_MASK
#define REPEAT_MASK 0
#endif
#define NREP(bit) (((REPEAT_MASK >> (bit)) & 1) ? 2 : 1)
#if defined(PROBE_SEAM2X)
#define SEAM(k) do { if (IN(k) && IN((k) + 1)) { xcd_barrier(bar); xcd_barrier(bar); } } while (0)
#else
#define SEAM(k) do { if (IN(k) && IN((k) + 1)) xcd_barrier(bar); } while (0)
#endif
    float* MOD = (float*)(ws + WS_MOD);
    float* KMEAN = (float*)(ws + WS_KMEAN);
    int* REFPOS = (int*)(ws + WS_KMEAN + 128 * 1024);
    int* REFMIN = (int*)(ws + WS_KMEAN + 256 * 1024);
    unsigned* MASK = (unsigned*)(ws + WS_MASK);
    bf16* H = (bf16*)(ws + WS_H);
    unsigned char* H8 = ws + WS_H8;
    bf16* Y = (bf16*)(ws + WS_Y);
    bf16* MERGED = (bf16*)(ws + WS_Y);
    bf16* PROJ = (bf16*)(ws + WS_R);
    unsigned char* Z = ws + WS_R;
    unsigned char* U8 = ws + WS_R;
    bf16* XRB = (bf16*)args.out;
    constexpr size_t TS = (size_t)TOK * 256;
    volatile LAS unsigned* wqslot = MISC + 16;

    if (IN(0)) for (int rep = 0; rep < NREP(0); ++rep) { p0_adaln(args, lds, G); }
    SEAM(0);

#pragma nounroll
    for (int l = 0; l < NL; ++l) {
        const int pb = 1 + 10 * l;
        const float* modl = MOD + (size_t)l * 8 * 6144;
        const bf16* WL = (const bf16*)(ws + WS_W) + (size_t)l * W_LAYER;
        if (IN(pb + 0)) for (int rep = 0; rep < NREP(1); ++rep) { PHASE_IDS if (l == 0) norm_rows_bf16<false>(args.x, H, H8, args.norm1_g + (size_t)l * DM, modl, 0, 1, gw, ngw, lane); else norm_rows_bf16<true>(XRB, H, H8, args.norm1_g + (size_t)l * DM, modl, 0, 1, gw, ngw, lane); if (l == 0) p0_weights(args, lds, vcu, G, 0, 1); }
        SEAM(pb + 0);
        if (IN(pb + 1)) for (int rep = 0; rep < NREP(2); ++rep) {
            pg8::Gemm g{H, WL + W_IN, TOK, NPROJ_PAD, DM}; pg8::StaticOrder S; S.init(TOK, NPROJ_PAD, G, bx);
            pg8::EpiProj E{PROJ, TS};
            pg8::gemm_phase<pg8::EpiProj, pg8::StaticOrder, IN_ALIGN, IN_SP2>(lds, g, S, E);
            if (l == 0 && rep == 0 && bx >= 128) p0_weights(args, lds, bx - 128, G - 128, 1, 2);
        }
        SEAM(pb + 1);
        unsigned* NRM = (unsigned*)(ctl + CW_NRM) + l * 192;
        if (IN(pb + 2)) for (int rep = 0; rep < NREP(3); ++rep) {
            gu32* ctr = ctl + CW_WQ + (l * 2 + 0 + 4 * rep) * 64;
            int raw = wq_draw(ctr);
            for (;;) {
#ifndef REPA_LO
#define REPA_LO 0
#define REPA_HI 2368
#endif
                const int item = wq_bcast(wqslot, raw) + (rep ? REPA_LO : 0);
                if (item >= (rep ? REPA_HI : 2368)) break;
                raw = wq_draw(ctr);
                if (item < 1024) { const int qg = 127 - (item >> 3), b = item & 7;
                    dsa_select_unit(lds, b, qg, PROJ + 10 * TS, MASK, REFPOS, REFMIN);
                } else if (item < 1536) { const int i2 = item - 1024; const int b = i2 >> 6, tile = i2 & 63;
                    pool_unit(lds, b, tile, PROJ + 6 * TS, args.w_pool + (size_t)l * 4 * 4096, args.pool_scale + (size_t)l * 256, Y + 2 * TS);
                } else if (item < 1600) { PHASE_IDS kmean_item(item - 1536, PROJ + 1 * TS, KMEAN, wid, lane);
                } else { norm_unit(lds, item - 1600, PROJ, TS, NRM); }
            }
        }
        SEAM(pb + 2);
        if (IN(pb + 3)) for (int rep = 0; rep < NREP(4); ++rep) {
            gu32* ctr = ctl + CW_WQ + 512 + ((l * 2 + rep) * 8) * 64;
            const float li = 0.8f - 0.6f * __expf(-0.3f * (float)l);
            const float* dl = args.diff_lambda + (size_t)l * 128;
            float d1 = 0.f, d2 = 0.f;
            for (int i = 0; i < 32; ++i) { d1 += dl[i] * dl[32 + i]; d2 += dl[64 + i] * dl[96 + i]; }
            const float lam = __expf(d1) - __expf(d2) + li;
            int raw = wq_draw(ctr);
            for (;;) {
                const int item = wq_bcast(wqslot, raw);
                if (item >= 1536) break;
                raw = wq_draw(ctr);
                const int ty = item % 3, rest = item / 3; const int qb = 15 - (rest >> 5), bh = rest & 31, b = bh >> 2, h = bh & 3;
                if (ty == 0) attn_unit<1>(lds, b, h, qb, PROJ + 3 * TS, PROJ + 4 * TS, PROJ + 5 * TS, Y + 1 * TS, alibi_slope(3 * h + 2), nullptr, lam, 1.f - li, args.diff_subln_g + (size_t)l * 64, nullptr, NRM + 64, nullptr, nullptr);
                else if (ty == 1) attn_unit<0>(lds, b, h, qb, PROJ + 0 * TS, PROJ + 1 * TS, PROJ + 2 * TS, Y + 0 * TS, alibi_slope(3 * h + 1), KMEAN, 0.f, 0.f, nullptr, nullptr, NRM, nullptr, nullptr);
                else              attn_unit<2>(lds, b, h, qb, PROJ + 7 * TS, PROJ + 8 * TS, PROJ + 9 * TS, Y + 3 * TS, alibi_slope(3 * h + 3), nullptr, 0.f, 0.f, nullptr, MASK, NRM + 128, REFPOS, REFMIN);
            }
        }
        SEAM(pb + 3);
        if (IN(pb + 4)) for (int rep = 0; rep < NREP(5); ++rep) {
            int kz = 256; asm volatile("" : "+s"(kz)); pg8::Gemm g{Y, WL + W_BR, 4 * TOK, 4096, kz}; ZOrder S; S.base.init(4 * TOK, DM, G, bx);
            pg8::EpiZ E{Z};
            pg8::gemm_phase<pg8::EpiZ, ZOrder, ZG_ALIGN, ZG_SP2>(lds, g, S, E);
        }
        SEAM(pb + 4);
        if (IN(pb + 5)) for (int rep = 0; rep < NREP(6); ++rep) {
            int kg = DM / 2; asm volatile("" : "+s"(kg));
            pg8::Gemm g{(const bf16*)H8, WL + W_GATE, TOK, 4096, kg}; pg8::StaticOrder S; S.init(TOK, 4096, G, bx);
            pg8::EpiGate E{Z, args.b_gate + (size_t)l * 4 * DM, MERGED};
            pg8::gemm_phase<pg8::EpiGate, pg8::StaticOrder, GT_ALIGN, GT_SP2, true>(lds, g, S, E);
        }
        SEAM(pb + 5);
        if (IN(pb + 6)) for (int rep = 0; rep < NREP(7); ++rep) {
            pg8::Gemm g{MERGED, WL + W_OUT, TOK, DM, DM}; pg8::StaticOrder S; S.init(TOK, DM, G, bx);
            if (l == 0) { pg8::EpiResid<false> E{args.x, rep ? (bf16*)(ws + WS_R) : XRB, modl + 2 * 1024, 1.f};
                pg8::gemm_phase<pg8::EpiResid<false>, pg8::StaticOrder, WO_ALIGN, WO_SP2>(lds, g, S, E); }
            else { pg8::EpiResid<true> E{XRB, rep ? (bf16*)(ws + WS_R) : XRB, modl + 2 * 1024, 1.f};
                pg8::gemm_phase<pg8::EpiResid<true>, pg8::StaticOrder, WO_ALIGN, WO_SP2>(lds, g, S, E); }
        }
        SEAM(pb + 6);
        if (IN(pb + 7)) for (int rep = 0; rep < NREP(8); ++rep) { PHASE_IDS norm_rows_bf16<true>(XRB, H, nullptr, args.norm2_g + (size_t)l * DM, modl, 3, 4, gw, ngw, lane); }
        SEAM(pb + 7);
        if (IN(pb + 8)) for (int rep = 0; rep < NREP(9); ++rep) {
            pg8::Gemm g{H, WL + W_FF1, TOK, FF, DM}; pg8::StaticOrder S; S.init(TOK, FF, G, bx);
            pg8::EpiRelu2 E{U8, FF};
            pg8::gemm_phase<pg8::EpiRelu2, pg8::StaticOrder, F1_ALIGN, F1_SP2>(lds, g, S, E);
        }
        SEAM(pb + 8);
        if (IN(pb + 9)) for (int rep = 0; rep < NREP(10); ++rep) {
            int kf = FF / 2; asm volatile("" : "+s"(kf));
            pg8::Gemm g{(const bf16*)U8, WL + W_FF2, TOK, DM, kf}; pg8::StaticOrder S; S.init(TOK, DM, G, bx);
            pg8::EpiResid<true> E{XRB, rep ? (bf16*)(ws + WS_MASK) : XRB, modl + 5 * 1024, 1.f / 64.f};
            pg8::gemm_phase<pg8::EpiResid<true>, pg8::StaticOrder, F2_ALIGN, F2_SP2, true>(lds, g, S, E);
        }
        SEAM(pb + 9);
    }
    if (IN(21)) {
        PHASE_IDS
        v4u xa[16], xb[16]; float rs[16];
        const v4u* xp = (const v4u*)(XRB + (size_t)gw * DM) + 2 * lane;
#pragma unroll
        for (int i = 0; i < 16; ++i) { xa[i] = xp[(size_t)i * ngw * (DM / 8)]; xb[i] = xp[(size_t)i * ngw * (DM / 8) + 1]; }
#pragma unroll
        for (int i = 0; i < 16; ++i) { const v4u a = xa[i], c = xb[i];
            float s = bflo(a.x) * bflo(a.x); s += bfhi(a.x) * bfhi(a.x); s += bflo(a.y) * bflo(a.y); s += bfhi(a.y) * bfhi(a.y); s += bflo(a.z) * bflo(a.z); s += bfhi(a.z) * bfhi(a.z); s += bflo(a.w) * bflo(a.w); s += bfhi(a.w) * bfhi(a.w);
            s += bflo(c.x) * bflo(c.x); s += bfhi(c.x) * bfhi(c.x); s += bflo(c.y) * bflo(c.y); s += bfhi(c.y) * bfhi(c.y); s += bflo(c.z) * bflo(c.z); s += bfhi(c.z) * bfhi(c.z); s += bflo(c.w) * bflo(c.w); s += bfhi(c.w) * bfhi(c.w);
            rs[i] = 1.f / sqrtf(wave_sum(s, lane) * (1.f / DM) + NORM_EPS); }
        xcd_barrier(bar);
#pragma unroll
        for (int i = 0; i < 16; ++i) asm volatile("" : "+v"(xa[i]), "+v"(xb[i]));
        const f32x4* gp = (const f32x4*)args.final_g + 4 * lane;
        f32x4* op = (f32x4*)(args.out + (size_t)gw * DM) + 4 * lane;
#pragma unroll
        for (int i = 0; i < 16; ++i) { const v4u a = xa[i], c = xb[i]; const float r = rs[i]; f32x4* o = op + (size_t)i * ngw * (DM / 4);
            o[0] = (f32x4){bflo(a.x), bfhi(a.x), bflo(a.y), bfhi(a.y)} * r * gp[0]; o[1] = (f32x4){bflo(a.z), bfhi(a.z), bflo(a.w), bfhi(a.w)} * r * gp[1];
            o[2] = (f32x4){bflo(c.x), bfhi(c.x), bflo(c.y), bfhi(c.y)} * r * gp[2]; o[3] = (f32x4){bflo(c.z), bfhi(c.z), bflo(c.w), bfhi(c.w)} * r * gp[3]; }
    }
#undef IN
#undef SEAM
}

#ifndef MK_SPLIT
#define MK_SPLIT 0
#endif
extern "C" void kernel_launch(void* const* d_in, const int* in_sizes, int n_in, void* d_out, int out_size, void* d_ws, size_t ws_size, hipStream_t stream) {
    static int grid = 0;
    if (grid == 0) {
        if (n_in != 18 || in_sizes[0] != TOK * DM || out_size != TOK * DM || ws_size < WS_END) { fprintf(stderr, "kernel_launch: unexpected shapes (n_in %d, in0 %d, out %d, ws %zu)\n", n_in, n_in > 0 ? in_sizes[0] : -1, out_size, ws_size); grid = -1; return; }
        int dev = 0, cus = 0, per_cu = 0;
        if (hipGetDevice(&dev) != hipSuccess || hipDeviceGetAttribute(&cus, hipDeviceAttributeMultiprocessorCount, dev) != hipSuccess) { grid = -1; return; }
        if (hipFuncSetAttribute((const void*)hybrid_fwd, hipFuncAttributeMaxDynamicSharedMemorySize, LDS_BYTES) != hipSuccess) { fprintf(stderr, "kernel_launch: hipFuncSetAttribute failed\n"); grid = -1; return; }
        if (hipOccupancyMaxActiveBlocksPerMultiprocessor(&per_cu, (const void*)hybrid_fwd, NWAVES * 64, LDS_BYTES) != hipSuccess || per_cu < 1) fprintf(stderr, "kernel_launch: occupancy query reports %d\n", per_cu);
        (void)hipGetLastError();
        grid = cus;
        if (cus != 256) { fprintf(stderr, "kernel_launch: built for 256 CUs (the final norm stages 16 rows per wave), found %d\n", cus); grid = -1; return; }
    }
    if (grid < 0) return;
    if (hipMemsetAsync((char*)d_ws + WS_CTL, 0, CTL_ZERO_BYTES, stream) != hipSuccess) return;
    Args a{};
    const float** ap = (const float**)&a;
    for (int i = 0; i < 18; ++i) ap[i] = (const float*)d_in[i];
    a.out = (float*)d_out; a.ws = (unsigned char*)d_ws; a.pad = 0;
#if MK_SPLIT
    for (int p = 0; p < NPHASE; ++p) { a.ph_lo = p; a.ph_hi = p + 1; a.li = 0;
        hipLaunchKernelGGL(hybrid_fwd, dim3(grid), dim3(NWAVES * 64), LDS_BYTES, stream, a); }
#else
    a.ph_lo = 0; a.ph_hi = NPHASE; a.li = 0;
    hipLaunchKernelGGL(hybrid_fwd, dim3(grid), dim3(NWAVES * 64), LDS_BYTES, stream, a);
#endif
}
```

```cpp
#include <hip/hip_runtime.h>
#include <cstdio>
#include <cstdint>
namespace pg8 {
#define PG8_LAS __attribute__((address_space(3)))
typedef unsigned short bf16_t;
typedef short bf16x8 __attribute__((ext_vector_type(8)));
typedef float f32x4 __attribute__((ext_vector_type(4)));
typedef unsigned u32x4 __attribute__((ext_vector_type(4)));
constexpr int BM = 256, BK = 64, HALF = 128, HTB = HALF * BK * 2  , STAGE_BYTES = 8 * HTB, NXCD = 8, WGM = 8;

__host__ __device__ __forceinline__ int lds_byte(int r, int c) { const int st = (r >> 4) * 2 + (c >> 5), rr = r & 15, cc = c & 31, ob = rr * 64 + cc * 2; return st * 1024 + (ob ^ (((ob >> 9) & 1) << 5)); }
__host__ __device__ __forceinline__ void stage_rc(int b, int& R, int& C) { const int st = b / 1024, sb = b % 1024, swz = sb ^ (((sb >> 9) & 1) << 5); R = (st >> 1) * 16 + swz / 64; C = (st & 1) * 32 + (swz % 64) / 2; }
__host__ __device__ __forceinline__ int perm32(int rho) { const int n = rho >> 4, i = rho & 15; return 8 * (i >> 2) + 4 * n + (i & 3); }

struct Unit { int pm, pn; };
struct Gemm { const bf16_t* A; const bf16_t* Bt; int M, N, K; };

struct StaticOrder {
    int nM, nN, nwg, G, c;
    __host__ __device__ void init(int M, int N, int G_, int c_) { nM = M / BM; nN = N / BM; nwg = nM * nN; G = G_; c = c_; }
    __host__ __device__ bool next(int i, Unit& u) const {
        const long L = (long)i * G + c; if (L >= nwg) return false;
        int wgid = (int)L; { const int q = nwg / NXCD, r = nwg % NXCD, xcd = wgid % NXCD, off = wgid / NXCD; wgid = (xcd < r ? xcd * (q + 1) : r * (q + 1) + (xcd - r) * q) + off; }
        const int nig = WGM * nN, gid = wgid / nig, fm = gid * WGM, gsz = (nM - fm) < WGM ? (nM - fm) : WGM;
        u.pm = fm + ((wgid % nig) % gsz); u.pn = (wgid % nig) / gsz; return true;
    }
    __device__ __forceinline__ void a_ready(const Unit&) const {}
    __device__ __forceinline__ void done(const Unit&) const {}
};

__device__ __forceinline__ unsigned cvt_pk_bf16(float lo, float hi) { unsigned r; asm volatile("v_cvt_pk_bf16_f32 %0, %1, %2" : "=v"(r) : "v"(lo), "v"(hi)); return r; }
typedef unsigned u32x2 __attribute__((ext_vector_type(2)));
constexpr int TT = 32768;
constexpr float QS64 = 0.125f * 1.4426950408889634f;
constexpr float QS32 = 0.17677669529663687f * 1.4426950408889634f;

template <bool F8> struct EpiProj {
    static constexpr bool PERM = true, AFTER_DRAIN = false;
    bf16_t* O; size_t tile_stride;
    __device__ __forceinline__ void operator()(const f32x4 (&acc)[2][2][4][2], const Unit& u, int wr, int wc, int fr, int fq) const {
        const int row0 = u.pm * BM + wr * 64 + fr;
        int tile; float sc = 1.f;
        if (F8) { tile = (u.pn == 0) ? 2 : (u.pn == 1) ? 5 : (u.pn == 2) ? 6 : 9; sc = 1.f / 32.f; }
        else { tile = (u.pn == 0) ? 0 : (u.pn == 1) ? 1 : (u.pn == 2) ? 3 : (u.pn == 3) ? 4 : (u.pn == 4) ? 7 : (u.pn == 5) ? 8 : 10;
               if (tile == 0 || tile == 7) sc = QS64; else if (tile == 3) sc = QS32; }
        bf16_t* base = O + (size_t)tile * tile_stride;
        const int col0 = wc * 32 + 8 * fq;
#pragma unroll
        for (int ai = 0; ai < 2; ++ai)
#pragma unroll
            for (int m = 0; m < 4; ++m) { bf16_t* rowp = base + (size_t)(row0 + ai * HALF + m * 16) * 256 + col0;
#pragma unroll
                for (int bj = 0; bj < 2; ++bj) { const f32x4 v0 = acc[ai][bj][m][0] * sc, v1 = acc[ai][bj][m][1] * sc;
                    u32x4 w; w.x = cvt_pk_bf16(v0[0], v0[1]); w.y = cvt_pk_bf16(v0[2], v0[3]); w.z = cvt_pk_bf16(v1[0], v1[1]); w.w = cvt_pk_bf16(v1[2], v1[3]);
                    *(u32x4*)(rowp + bj * HALF) = w; } }
    }
};
struct EpiZ {
    static constexpr bool PERM = true, AFTER_DRAIN = false;
    unsigned char* O;
    __device__ __forceinline__ void operator()(const f32x4 (&acc)[2][2][4][2], const Unit& u, int wr, int wc, int fr, int fq) const {
        const int row0 = u.pm * BM + wr * 64 + fr; const int col0 = (u.pn & 3) * BM + wc * 32 + 8 * fq;
#pragma unroll
        for (int ai = 0; ai < 2; ++ai)
#pragma unroll
            for (int m = 0; m < 4; ++m) { unsigned char* rowp = O + (size_t)(row0 + ai * HALF + m * 16) * 1024 + col0;
#pragma unroll
                for (int bj = 0; bj < 2; ++bj) { const f32x4 v0 = acc[ai][bj][m][0], v1 = acc[ai][bj][m][1];
                    int w0 = __builtin_amdgcn_cvt_pk_fp8_f32(v0[0], v0[1], 0, false); w0 = __builtin_amdgcn_cvt_pk_fp8_f32(v0[2], v0[3], w0, true);
                    int w1 = __builtin_amdgcn_cvt_pk_fp8_f32(v1[0], v1[1], 0, false); w1 = __builtin_amdgcn_cvt_pk_fp8_f32(v1[2], v1[3], w1, true);
                    u32x2 w; w.x = (unsigned)w0; w.y = (unsigned)w1;
                    *(u32x2*)(rowp + bj * HALF) = w; } }
    }
};
struct EpiRelu2 {
    static constexpr bool PERM = true, AFTER_DRAIN = false;
    unsigned char* O; int ldc;
    __device__ __forceinline__ void operator()(const f32x4 (&acc)[2][2][4][2], const Unit& u, int wr, int wc, int fr, int fq) const {
        const int row0 = u.pm * BM + wr * 64 + fr; const int col0 = u.pn * BM + wc * 32 + 8 * fq;
#pragma unroll
        for (int ai = 0; ai < 2; ++ai)
#pragma unroll
            for (int m = 0; m < 4; ++m) { unsigned char* rowp = O + (size_t)(row0 + ai * HALF + m * 16) * ldc + col0;
#pragma unroll
                for (int bj = 0; bj < 2; ++bj) { f32x4 v0 = acc[ai][bj][m][0], v1 = acc[ai][bj][m][1];
#pragma unroll
                    for (int j = 0; j < 4; ++j) { const float a = fmaxf(v0[j], 0.f), b = fmaxf(v1[j], 0.f); v0[j] = a * a; v1[j] = b * b; }
                    int w0 = __builtin_amdgcn_cvt_pk_fp8_f32(v0[0], v0[1], 0, false); w0 = __builtin_amdgcn_cvt_pk_fp8_f32(v0[2], v0[3], w0, true);
                    int w1 = __builtin_amdgcn_cvt_pk_fp8_f32(v1[0], v1[1], 0, false); w1 = __builtin_amdgcn_cvt_pk_fp8_f32(v1[2], v1[3], w1, true);
                    u32x2 w; w.x = (unsigned)w0; w.y = (unsigned)w1;
                    *(u32x2*)(rowp + bj * HALF) = w; } }
    }
};
template <bool BASE_BF16> struct EpiResid {
    static constexpr bool PERM = true, AFTER_DRAIN = false;
    const void* base; bf16_t* out; const float* gate; float ascale;
    __device__ __forceinline__ void operator()(const f32x4 (&acc)[2][2][4][2], const Unit& u, int wr, int wc, int fr, int fq) const {
        const int row0 = u.pm * BM + wr * 64 + fr; const int col0 = u.pn * BM + wc * 32 + 8 * fq;
        const float* gp = gate + (size_t)(u.pm >> 4) * 6144 + col0;
        f32x4 gv[2][2];
#pragma unroll
        for (int bj = 0; bj < 2; ++bj)
#pragma unroll
            for (int n = 0; n < 2; ++n) gv[bj][n] = *(const f32x4*)(gp + bj * HALF + n * 4) * ascale;
#pragma unroll
        for (int ai = 0; ai < 2; ++ai)
#pragma unroll
            for (int m = 0; m < 4; ++m) { const size_t off = (size_t)(row0 + ai * HALF + m * 16) * 1024 + col0;
#pragma unroll
                for (int bj = 0; bj < 2; ++bj) { f32x4 b0, b1;
                    if (BASE_BF16) { const u32x4 w = *(const u32x4*)((const bf16_t*)base + off + bj * HALF);
                        b0 = (f32x4){__uint_as_float(w.x << 16), __uint_as_float(w.x & 0xffff0000u), __uint_as_float(w.y << 16), __uint_as_float(w.y & 0xffff0000u)};
                        b1 = (f32x4){__uint_as_float(w.z << 16), __uint_as_float(w.z & 0xffff0000u), __uint_as_float(w.w << 16), __uint_as_float(w.w & 0xffff0000u)}; }
                    else { b0 = *(const f32x4*)((const float*)base + off + bj * HALF); b1 = *(const f32x4*)((const float*)base + off + bj * HALF + 4); }
                    const f32x4 v0 = b0 + gv[bj][0] * acc[ai][bj][m][0], v1 = b1 + gv[bj][1] * acc[ai][bj][m][1];
                    u32x4 o; o.x = cvt_pk_bf16(v0[0], v0[1]); o.y = cvt_pk_bf16(v0[2], v0[3]); o.z = cvt_pk_bf16(v1[0], v1[1]); o.w = cvt_pk_bf16(v1[2], v1[3]);
                    *(u32x4*)(out + off + bj * HALF) = o; }
                if (m & 1) asm volatile("" ::: "memory"); }
    }
};
struct EpiGate {
    static constexpr bool PERM = true, AFTER_DRAIN = false;
    const unsigned char* Z; const float* bg; bf16_t* O;
    __device__ __forceinline__ void operator()(const f32x4 (&acc)[2][2][4][2], const Unit& u, int wr, int wc, int fr, int fq) const {
        const int row0 = u.pm * BM + wr * 64 + fr; const int mc0 = u.pn * 64 + wc * 16 + 4 * fq;
#pragma unroll
        for (int ai = 0; ai < 2; ++ai)
#pragma unroll
            for (int m = 0; m < 4; ++m) { const size_t row = (size_t)(row0 + ai * HALF + m * 16);
                f32x4 bv[2][2];
#pragma unroll
                for (int bj = 0; bj < 2; ++bj)
#pragma unroll
                    for (int n = 0; n < 2; ++n) bv[bj][n] = *(const f32x4*)(bg + (2 * bj + n) * 1024 + mc0);
                asm volatile("" ::: "memory");
                f32x4 sum = (f32x4){0.f, 0.f, 0.f, 0.f};
#pragma unroll
                for (int bj = 0; bj < 2; ++bj)
#pragma unroll
                    for (int n = 0; n < 2; ++n) { const int zr = *(const int*)(Z + ((size_t)(2 * bj + n) * TT + row) * 1024 + mc0);
                        const f32x4 x = acc[ai][bj][m][n] * (1.f / 32.f) + bv[bj][n]; f32x4 zz;
                        zz[0] = __builtin_amdgcn_cvt_f32_fp8(zr, 0); zz[1] = __builtin_amdgcn_cvt_f32_fp8(zr, 1); zz[2] = __builtin_amdgcn_cvt_f32_fp8(zr, 2); zz[3] = __builtin_amdgcn_cvt_f32_fp8(zr, 3);
#pragma unroll
                        for (int j = 0; j < 4; ++j) { const float g = __builtin_amdgcn_rcpf(1.f + __builtin_amdgcn_exp2f(-1.4426950408889634f * x[j])); sum[j] += g * zz[j]; } }
                u32x2 w; w.x = cvt_pk_bf16(sum[0], sum[1]); w.y = cvt_pk_bf16(sum[2], sum[3]);
                *(u32x2*)(O + row * 1024 + mc0) = w; }
    }
};
typedef int i32x8 __attribute__((ext_vector_type(8))); typedef int i32x4 __attribute__((ext_vector_type(4)));
__device__ __forceinline__ i32x8 cat16(bf16x8 a, bf16x8 b) { const i32x4 x = __builtin_bit_cast(i32x4, a), y = __builtin_bit_cast(i32x4, b); return __builtin_shufflevector(x, y, 0, 1, 2, 3, 4, 5, 6, 7); }
template <class Epi, class Sched, bool ALIGN_EPI = false, bool SP2 = false, bool FP8 = false>
__device__ __forceinline__ void gemm_phase(PG8_LAS unsigned char* lds, const Gemm g, const Sched& S, const Epi& E) {
    int tid_l = threadIdx.x; asm volatile("" : "+v"(tid_l)); const int tid = tid_l, wid = __builtin_amdgcn_readfirstlane(tid >> 6), lane = tid & 63, wr = wid >> 2, wc = wid & 3, fr = lane & 15, fq = lane >> 4;
    const int K = g.K, nt = K / BK;
    unsigned voffA[2], voffB[2];
#pragma unroll
    for (int i = 0; i < 2; ++i) { int R, C; stage_rc(tid * 16 + i * 8192, R, C); const int Rb = Epi::PERM ? ((R & ~31) + perm32(R & 31)) : R;
        voffA[i] = (unsigned)(R * K + C) * 2u; voffB[i] = (unsigned)(Rb * K + C) * 2u; }
    const size_t kstep = (size_t)(BK * 2);
    const size_t hstep = (size_t)HALF * K * 2;
    const size_t tstep = 2 * hstep;
    const unsigned ldsw = (unsigned)wid * 1024u;
    const int aoff = lds_byte(wr * 64 + fr, fq * 8), boff = lds_byte(wc * 32 + fr, fq * 8);
#define PG8_SA(b, h) (((b) * 2 + (h)) * HTB)
#define PG8_SB(b, h) ((4 + (b) * 2 + (h)) * HTB)
#define PG8_STAGE(bufoff, gbase, voff) do { _Pragma("unroll") for (int _i = 0; _i < 2; ++_i) \
        __builtin_amdgcn_global_load_lds((const unsigned*)((const char*)(gbase) + (voff)[_i]), (PG8_LAS unsigned*)(lds + (bufoff) + ldsw + _i * 8192), 16, 0, 0); } while (0)
#define PG8_LDA(dst, b, h) do { _Pragma("unroll") for (int m = 0; m < 4; ++m) _Pragma("unroll") for (int k = 0; k < 2; ++k) dst[m][k] = *(const PG8_LAS bf16x8*)(lds + PG8_SA(b, h) + aoff + m * 2048 + k * 1024); } while (0)
#define PG8_LDB(dst, b, h) do { _Pragma("unroll") for (int n = 0; n < 2; ++n) _Pragma("unroll") for (int k = 0; k < 2; ++k) dst[n][k] = *(const PG8_LAS bf16x8*)(lds + PG8_SB(b, h) + boff + n * 2048 + k * 1024); } while (0)
#define PG8_MMA(ai, bj, At, Bt) do { __builtin_amdgcn_s_setprio(1); _Pragma("unroll") for (int m = 0; m < 4; ++m) _Pragma("unroll") for (int n = 0; n < 2; ++n) { \
        if constexpr (FP8) { const i32x8 b8_ = cat16(Bt[n][0], Bt[n][1]), a8_ = cat16(At[m][0], At[m][1]); \
            asm volatile("v_mfma_scale_f32_16x16x128_f8f6f4 %0, %1, %2, %0, %3, %3 op_sel_hi:[0,0,0]" : "+v"(acc[ai][bj][m][n]) : "v"(b8_), "v"(a8_), "v"(sc127)); } \
        else { _Pragma("unroll") for (int k = 0; k < 2; ++k) acc[ai][bj][m][n] = __builtin_amdgcn_mfma_f32_16x16x32_bf16(Bt[n][k], At[m][k], acc[ai][bj][m][n], 0, 0, 0); } } \
        __builtin_amdgcn_s_setprio(0); } while (0)
#define PG8_WAIT_V(n) asm volatile("s_waitcnt vmcnt(" #n ")" ::: "memory")
#define PG8_WAIT_L(n) asm volatile("s_waitcnt lgkmcnt(" #n ")" ::: "memory")
#define PG8_BAR __builtin_amdgcn_s_barrier()
#define PG8_SCHED __builtin_amdgcn_sched_barrier(0)
    Unit cur, nxt; int ui = 0;
    int sc127 = 127; asm volatile("" : "+v"(sc127));
    if (!S.next(0, cur)) return;
    f32x4 acc[2][2][4][2];
#pragma unroll
    for (int a = 0; a < 2; ++a)
#pragma unroll
        for (int b = 0; b < 2; ++b)
#pragma unroll
            for (int m = 0; m < 4; ++m)
#pragma unroll
                for (int n = 0; n < 2; ++n) acc[a][b][m][n] = (f32x4){0.f, 0.f, 0.f, 0.f};
    bf16x8 At[4][2], B0[2][2], B1[2][2];
    const char* cA = (const char*)g.A + (size_t)cur.pm * tstep; const char* cB = (const char*)g.Bt + (size_t)cur.pn * tstep;
    S.a_ready(cur);
    if constexpr (SP2) {
        PG8_STAGE(PG8_SB(0, 0), cB, voffB); PG8_STAGE(PG8_SB(0, 1), cB + hstep, voffB); PG8_STAGE(PG8_SA(0, 0), cA, voffA); PG8_STAGE(PG8_SA(0, 1), cA + hstep, voffA);
        if (wr == 1) PG8_BAR;
        PG8_WAIT_V(2); PG8_BAR;
        PG8_STAGE(PG8_SB(1, 0), cB + kstep, voffB); PG8_STAGE(PG8_SA(1, 0), cA + kstep, voffA); PG8_STAGE(PG8_SB(1, 1), cB + hstep + kstep, voffB);
        PG8_WAIT_V(6); PG8_BAR;
    } else {
        PG8_STAGE(PG8_SB(0, 0), cB, voffB); PG8_STAGE(PG8_SA(0, 0), cA, voffA); PG8_STAGE(PG8_SB(0, 1), cB + hstep, voffB); PG8_STAGE(PG8_SA(0, 1), cA + hstep, voffA);
        if (wr == 1) PG8_BAR;
        PG8_WAIT_V(4); PG8_BAR;
        PG8_STAGE(PG8_SB(1, 0), cB + kstep, voffB); PG8_STAGE(PG8_SA(1, 0), cA + kstep, voffA); PG8_STAGE(PG8_SB(1, 1), cB + hstep + kstep, voffB);
        PG8_WAIT_V(6); PG8_BAR;
    }
    for (;;) {
        const bool has_next = S.next(ui + 1, nxt);
        const char* nA = has_next ? (const char*)g.A + (size_t)nxt.pm * tstep : cA; const char* nB = has_next ? (const char*)g.Bt + (size_t)nxt.pn * tstep : cB;
        for (int t = 0; t < nt; t += 2) {
            const bool last = (t == nt - 2);
            const char* a1 = cA + (size_t)(t + 1) * kstep;
            const char* a2 = last ? nA : cA + (size_t)(t + 2) * kstep; const char* b2 = last ? nB : cB + (size_t)(t + 2) * kstep;
            const char* a3 = a2 + kstep; const char* b3 = b2 + kstep;
            if (last && has_next) S.a_ready(nxt);
            if constexpr (SP2) {
            PG8_LDB(B0, 0, 0); PG8_LDB(B1, 0, 1); PG8_SCHED; PG8_LDA(At, 0, 0); PG8_STAGE(PG8_SA(1, 1), a1 + hstep, voffA);
            PG8_WAIT_V(8); PG8_WAIT_L(0); PG8_BAR; PG8_MMA(0, 0, At, B0); PG8_MMA(0, 1, At, B1); PG8_BAR; PG8_SCHED;
            PG8_LDA(At, 0, 1); PG8_STAGE(PG8_SB(0, 0), b2, voffB); PG8_STAGE(PG8_SB(0, 1), b2 + hstep, voffB); PG8_STAGE(PG8_SA(0, 0), a2, voffA);
            PG8_WAIT_V(8); PG8_WAIT_L(0); PG8_BAR; PG8_MMA(1, 0, At, B0); PG8_MMA(1, 1, At, B1); PG8_BAR; PG8_SCHED;
            PG8_LDB(B0, 1, 0); PG8_LDB(B1, 1, 1); PG8_SCHED; PG8_LDA(At, 1, 0); PG8_STAGE(PG8_SA(0, 1), a2 + hstep, voffA);
            PG8_WAIT_V(8); PG8_WAIT_L(0); PG8_BAR; PG8_MMA(0, 0, At, B0); PG8_MMA(0, 1, At, B1); PG8_BAR; PG8_SCHED;
            PG8_LDA(At, 1, 1); PG8_STAGE(PG8_SB(1, 0), b3, voffB); PG8_STAGE(PG8_SB(1, 1), b3 + hstep, voffB); PG8_STAGE(PG8_SA(1, 0), a3, voffA);
            PG8_WAIT_V(8); PG8_WAIT_L(0); PG8_BAR; PG8_MMA(1, 0, At, B0); PG8_MMA(1, 1, At, B1); PG8_BAR; PG8_SCHED;
            } else {
            PG8_LDB(B0, 0, 0); PG8_SCHED; PG8_LDA(At, 0, 0); PG8_STAGE(PG8_SA(1, 1), a1 + hstep, voffA);
            PG8_WAIT_L(8); PG8_BAR; PG8_WAIT_L(0); PG8_MMA(0, 0, At, B0); PG8_BAR; PG8_SCHED;
            PG8_LDB(B1, 0, 1); PG8_STAGE(PG8_SB(0, 0), b2, voffB);
            PG8_BAR; PG8_WAIT_L(0); PG8_MMA(0, 1, At, B1); PG8_BAR;
            PG8_LDA(At, 0, 1); PG8_STAGE(PG8_SA(0, 0), a2, voffA);
            PG8_BAR; PG8_WAIT_L(0); PG8_MMA(1, 0, At, B0); PG8_BAR; PG8_SCHED;
            PG8_STAGE(PG8_SB(0, 1), b2 + hstep, voffB);
            PG8_WAIT_V(6); PG8_BAR; PG8_MMA(1, 1, At, B1); PG8_BAR;
            PG8_LDB(B0, 1, 0); PG8_SCHED; PG8_LDA(At, 1, 0); PG8_STAGE(PG8_SA(0, 1), a2 + hstep, voffA);
            PG8_WAIT_L(8); PG8_BAR; PG8_WAIT_L(0); PG8_MMA(0, 0, At, B0); PG8_BAR; PG8_SCHED;
            PG8_LDB(B1, 1, 1); PG8_STAGE(PG8_SB(1, 0), b3, voffB);
            PG8_BAR; PG8_WAIT_L(0); PG8_MMA(0, 1, At, B1); PG8_BAR;
            PG8_LDA(At, 1, 1); PG8_STAGE(PG8_SA(1, 0), a3, voffA);
            PG8_BAR; PG8_WAIT_L(0); PG8_MMA(1, 0, At, B0); PG8_BAR; PG8_SCHED;
            PG8_STAGE(PG8_SB(1, 1), b3 + hstep, voffB);
            PG8_WAIT_V(6); PG8_BAR; PG8_MMA(1, 1, At, B1); PG8_BAR;
            }
        }
        if constexpr (ALIGN_EPI) { if (wr == 0) PG8_BAR; }
        if constexpr (FP8) asm volatile("s_nop 15\n\ts_nop 15" ::: "memory");
        if constexpr (!Epi::AFTER_DRAIN) { int t2_ = threadIdx.x; asm volatile("" : "+v"(t2_)); const int l2_ = t2_ & 63, w2_ = __builtin_amdgcn_readfirstlane(t2_ >> 6);
            E(acc, cur, w2_ >> 2, w2_ & 3, l2_ & 15, l2_ >> 4); S.done(cur); }
        if (!has_next) break;
#pragma unroll
        for (int a = 0; a < 2; ++a)
#pragma unroll
            for (int b = 0; b < 2; ++b)
#pragma unroll
                for (int m = 0; m < 4; ++m)
#pragma unroll
                    for (int n = 0; n < 2; ++n) acc[a][b][m][n] = (f32x4){0.f, 0.f, 0.f, 0.f};
        cur = nxt; cA = nA; cB = nB; ++ui;
        if constexpr (ALIGN_EPI) { if (wr == 1) PG8_BAR; }
    }
    PG8_WAIT_V(0);
    if constexpr (!ALIGN_EPI) { if (wr == 0) PG8_BAR; }
    PG8_BAR;
    if constexpr (Epi::AFTER_DRAIN) { E.fused(acc, cur, wr, wc, fr, fq, lds, wid, lane); S.done(cur); }
#undef PG8_SA
#undef PG8_SB
#undef PG8_STAGE
#undef PG8_LDA
#undef PG8_LDB
#undef PG8_MMA
#undef PG8_WAIT_V
#undef PG8_WAIT_L
#undef PG8_BAR
#undef PG8_SCHED
}
}

constexpr int NB = 8, SEQ = 4096, DM = 1024, NL = 2, FF = 4096, NPROJ = 2724, NPROJ_PAD = 2816, NTILE_PROJ = 11;
constexpr int TOK = NB * SEQ;
static_assert(TOK == pg8::TT, "token count");
constexpr float NORM_EPS = 1e-6f;
constexpr float LOG2E = 1.4426950408889634f;
constexpr int NWAVES = 8;

constexpr size_t MiB = 1u << 20;
constexpr size_t WS_CTL = 0, CTL_ZERO_BYTES = 1 * MiB;
constexpr size_t WS_MOD = 1 * MiB;
constexpr size_t WS_KMEAN = WS_MOD + 512 * 1024;
constexpr size_t WS_W = 2 * MiB;
constexpr size_t W_IN = 0, W_GATE = W_IN + (size_t)NPROJ_PAD * DM, W_BR = W_GATE + (size_t)4 * DM * DM, W_OUT = W_BR + (size_t)4 * DM * 256,
                 W_FF1 = W_OUT + (size_t)DM * DM, W_FF2 = W_FF1 + (size_t)FF * DM, W_LAYER = W_FF2 + (size_t)DM * FF;
constexpr size_t WS_MASK = 70 * MiB;
constexpr size_t WS_H = 86 * MiB;
constexpr size_t WS_Y = 150 * MiB;
constexpr size_t WS_R = 214 * MiB;
constexpr size_t WS_H8 = 470 * MiB;
constexpr size_t WS_END = 502 * MiB;
static_assert(WS_W + 2 * W_LAYER * 2 <= WS_MASK, "weights fit");
constexpr int CW_BAR = 4096;
constexpr int CW_WQ = 131072;
constexpr int CW_NRM = CW_WQ + 4096;
constexpr int NPHASE = 22;

constexpr int RING_BYTES = 135168;
constexpr int LDSCTL_OFF = RING_BYTES;
constexpr int LDS_BYTES = 147456;

#define GAS __attribute__((address_space(1)))
#define LAS __attribute__((address_space(3)))
typedef unsigned short bf16;
typedef unsigned v4u __attribute__((ext_vector_type(4)));
typedef unsigned v2u __attribute__((ext_vector_type(2)));
typedef float f32x4 __attribute__((ext_vector_type(4)));
typedef float f32x16 __attribute__((ext_vector_type(16)));
typedef short bf16x8 __attribute__((ext_vector_type(8)));
typedef short s16x4 __attribute__((ext_vector_type(4)));
typedef GAS unsigned gu32;
#define RLX_AGENT __ATOMIC_RELAXED, __HIP_MEMORY_SCOPE_AGENT
#define LDS_WAIT() asm volatile("s_waitcnt lgkmcnt(0)" ::: "memory")
__device__ __forceinline__ unsigned f2bf(float f) { unsigned u = __builtin_bit_cast(unsigned, f); return (u + 0x7fffu + ((u >> 16) & 1u)) >> 16; }
__device__ __forceinline__ unsigned pk2(float lo, float hi) { return f2bf(lo) | (f2bf(hi) << 16); }
__device__ __forceinline__ float bf2f(unsigned short b) { return __uint_as_float((unsigned)b << 16); }
__device__ __forceinline__ float bflo(unsigned w) { return __uint_as_float(w << 16); }
__device__ __forceinline__ float bfhi(unsigned w) { return __uint_as_float(w & 0xffff0000u); }

#define XB_TMO      128
#define XB_XCNT(j)  (256  + 64 * (j))
#define XB_XSUB(j)  (1280 + 64 * (j))
#define XB_XGEN(j)  (2304 + 64 * (j))
#define XB_TOP      3328
#define XB_TOPGEN   3392
#define XCD_BAR_WORDS 3456
#define XB_SPIN_CAP (1u << 18)

__device__ __forceinline__ unsigned xb_ld(unsigned* p)              { return __hip_atomic_load(p, __ATOMIC_RELAXED, __HIP_MEMORY_SCOPE_AGENT); }
__device__ __forceinline__ unsigned xb_add(unsigned* p, unsigned v) { return __hip_atomic_fetch_add(p, v, __ATOMIC_RELAXED, __HIP_MEMORY_SCOPE_AGENT); }
__device__ __forceinline__ unsigned xb_xcc_id() { return (unsigned)__builtin_amdgcn_s_getreg((3 << 11) | 20) & 0xFu; }
#define XB_SPIN(cond, bar) do { unsigned _sp = 0; while (cond) { __builtin_amdgcn_s_sleep(1); \
    if ((++_sp & 255u) == 0u) { if (xb_ld(&(bar)[XB_TMO])) break; if (_sp > XB_SPIN_CAP) { atomicAdd(&(bar)[XB_TMO], 1u); break; } } } } while (0)

struct XcdBarrier {
    unsigned* bar; unsigned x;
    volatile LAS unsigned* st;
};

__device__ __forceinline__ XcdBarrier xcd_barrier_post(unsigned* bar, volatile LAS unsigned* st) {
    XcdBarrier b; b.bar = bar; b.x = xb_xcc_id(); b.st = st;
    if (threadIdx.x == 0) (void)xb_add(&bar[XB_XCNT(b.x)], 1u);
    return b;
}
__device__ __forceinline__ void xcd_barrier_complete(unsigned* bar, unsigned x, unsigned& nloc, unsigned& nx) {
    const unsigned G = gridDim.x * gridDim.y * gridDim.z;
    unsigned sum, cnt, mine, sp = 0u;
    for (;;) {
        sum = 0u; cnt = 0u; mine = 0u;
#pragma unroll
        for (unsigned j = 0; j < 16; ++j) { const unsigned c = xb_ld(&bar[XB_XCNT(j)]); sum += c; cnt += (c > 0u) ? 1u : 0u; mine = (j == x) ? c : mine; }
        if (sum == G) break;
        __builtin_amdgcn_s_sleep(1);
        if ((++sp & 255u) == 0u) { if (xb_ld(&bar[XB_TMO])) break; if (sp > XB_SPIN_CAP) { atomicAdd(&bar[XB_TMO], 1u); break; } }
    }
    nloc = mine > 0u ? mine : 1u; nx = cnt > 0u ? cnt : 1u;
}

__device__ __forceinline__ void xcd_barrier(const XcdBarrier& b) {
    asm volatile("s_waitcnt vmcnt(0)" ::: "memory");
    __syncthreads();
    if (threadIdx.x == 0) {
        unsigned* bar = b.bar;
        __builtin_amdgcn_s_waitcnt(0);
        unsigned nloc = b.st[0], nx = b.st[1];
        if (nloc == 0u) { xcd_barrier_complete(bar, b.x, nloc, nx); b.st[0] = nloc; b.st[1] = nx; }
        const unsigned old = xb_add(&bar[XB_XSUB(b.x)], 1u);
        const unsigned gen = old / nloc;
        if (old + 1u == (gen + 1u) * nloc) {
            __builtin_amdgcn_fence(__ATOMIC_RELEASE, "agent");
            asm volatile("s_waitcnt vmcnt(0)" ::: "memory");
            const unsigned og = xb_add(&bar[XB_TOP], 1u);
            const unsigned tg = og / nx;
            if (og + 1u == (tg + 1u) * nx) xb_add(&bar[XB_TOPGEN], 1u);
            else XB_SPIN(xb_ld(&bar[XB_TOPGEN]) == tg, bar);
            __builtin_amdgcn_fence(__ATOMIC_ACQUIRE, "agent");
            xb_add(&bar[XB_XGEN(b.x)], 1u);
            asm volatile("s_waitcnt vmcnt(0)" ::: "memory");
        } else {
            XB_SPIN(xb_ld(&bar[XB_XGEN(b.x)]) == gen, bar);
            __builtin_amdgcn_fence(__ATOMIC_ACQUIRE, "agent");
            asm volatile("s_waitcnt vmcnt(0)" ::: "memory");
        }
    }
    __syncthreads();
}

struct Args {
    const float *x, *c, *w_ada, *b_ada, *norm1_g, *w_in, *diff_lambda, *diff_subln_g, *w_pool, *pool_scale, *w_gate, *b_gate, *w_branch, *w_out, *norm2_g, *w_ff1, *w_ff2, *final_g;
    float* out; unsigned char* ws; int ph_lo, ph_hi, li, pad;
};

__device__ __forceinline__ float shx(float v, int mask, int lane) { return __int_as_float(__builtin_amdgcn_ds_bpermute((lane ^ mask) << 2, __float_as_int(v))); }
__device__ __forceinline__ unsigned shxu(unsigned v, int mask, int lane) { return (unsigned)__builtin_amdgcn_ds_bpermute((lane ^ mask) << 2, (int)v); }
__device__ __forceinline__ unsigned shupu(unsigned v, int delta, int lane) { return (unsigned)__builtin_amdgcn_ds_bpermute(((lane - delta) & 63) << 2, (int)v); }
__device__ __forceinline__ float wave_sum(float v, int lane) {
#pragma unroll
    for (int o = 1; o < 64; o <<= 1) v += shx(v, o, lane);
    return v;
}
__device__ __forceinline__ int crow(int r, int hi) { return (r & 3) + 8 * (r >> 2) + 4 * hi; }
typedef float f32x2_t __attribute__((ext_vector_type(2))); typedef __bf16 bf16x2_t __attribute__((ext_vector_type(2)));
__device__ __forceinline__ unsigned cvtpk(float lo, float hi) { f32x2_t v = {lo, hi}; bf16x2_t b = __builtin_convertvector(v, bf16x2_t); return __builtin_bit_cast(unsigned, b); }

__device__ __forceinline__ int gate_row(int br, int c) { const int pn = c >> 6, ml = c & 63; return 256 * pn + 128 * (br >> 1) + 32 * (ml >> 4) + 8 * ((ml >> 2) & 3) + 4 * (br & 1) + (ml & 3); }
__device__ __forceinline__ void p0_transpose_item(const float* W, int K, int Nsrc, int Npad, bf16* WT, int mode, int br, LAS float* scr, int item, int lane) {
    const int nblk = Npad / 32, kb = item / nblk, nb = item % nblk, k0 = 64 * kb, n0 = 32 * nb;
    const int c4 = lane & 7, kr = lane >> 3, nn = n0 + 4 * c4;
    f32x4 v[8];
#pragma unroll
    for (int i = 0; i < 8; ++i) v[i] = (nn < Nsrc) ? *(const f32x4*)(W + (size_t)(k0 + 8 * i + kr) * Nsrc + nn) : (f32x4){0.f, 0.f, 0.f, 0.f};
#pragma unroll
    for (int i = 0; i < 8; ++i) { LAS float* d = scr + (8 * i + kr) * 33 + 4 * c4; d[0] = v[i][0]; d[1] = v[i][1]; d[2] = v[i][2]; d[3] = v[i][3]; }
    LDS_WAIT(); asm volatile("" ::: "memory");
    const int c = lane & 7;
#pragma unroll
    for (int j = 0; j < 4; ++j) { const int n = (lane >> 3) + 8 * j; const LAS float* s = scr + (8 * c) * 33 + n;
        v4u o; o.x = pk2(s[0 * 33], s[1 * 33]); o.y = pk2(s[2 * 33], s[3 * 33]); o.z = pk2(s[4 * 33], s[5 * 33]); o.w = pk2(s[6 * 33], s[7 * 33]);
        const int drow = (mode == 1 || mode == 2) ? gate_row(br, n0 + n) : (n0 + n);
        if (mode >= 2) {
            const float f8s = (mode == 3) ? 64.f : 32.f;
            int w0 = __builtin_amdgcn_cvt_pk_fp8_f32(f8s * s[0 * 33], f8s * s[1 * 33], 0, false); w0 = __builtin_amdgcn_cvt_pk_fp8_f32(f8s * s[2 * 33], f8s * s[3 * 33], w0, true);
            int w1 = __builtin_amdgcn_cvt_pk_fp8_f32(f8s * s[4 * 33], f8s * s[5 * 33], 0, false); w1 = __builtin_amdgcn_cvt_pk_fp8_f32(f8s * s[6 * 33], f8s * s[7 * 33], w1, true);
            v2u o8; o8.x = (unsigned)w0; o8.y = (unsigned)w1;
            *(v2u*)((unsigned char*)WT + (size_t)drow * K + k0 + 8 * c) = o8;
        } else *(v4u*)(WT + (size_t)drow * K + k0 + 8 * c) = o; }
    LDS_WAIT(); asm volatile("" ::: "memory");
}

template <bool XBF16>
__device__ __forceinline__ void norm_rows_bf16(LAS unsigned char* lds, const void* X, bf16* O, unsigned char* O8  , const float* g, const float* mod  , int sh_idx, int sc_idx, int gw, int ngw, int lane_in) {
    int lane = lane_in; asm volatile("" : "+v"(lane));
    constexpr int RB = 4;
    LAS float* LA = (LAS float*)lds; LAS float* LB = LA + 8192;
    { int tf = threadIdx.x; asm volatile("" : "+v"(tf));
      for (int i = tf; i < 2048; i += 512) { const int b = i >> 8, c4 = (i & 255) * 4;
          const f32x4 gg = *(const f32x4*)(g + c4), sc = *(const f32x4*)(mod + (size_t)b * 6144 + sc_idx * 1024 + c4), sh = *(const f32x4*)(mod + (size_t)b * 6144 + sh_idx * 1024 + c4);
          *(LAS f32x4*)(LA + b * 1024 + c4) = gg * (1.f + sc); *(LAS f32x4*)(LB + b * 1024 + c4) = sh; } }
    __syncthreads();
    for (int m0 = gw; m0 < TOK; m0 += RB * ngw) {
        float v[RB][16];
#pragma unroll
        for (int rb = 0; rb < RB; ++rb) { const int m = m0 + rb * ngw;
            if (m < TOK) {
                if (XBF16) { const v4u* xr = (const v4u*)((const bf16*)X + (size_t)m * DM) + 2 * lane; const v4u a = xr[0], c = xr[1];
                    v[rb][0] = bflo(a.x); v[rb][1] = bfhi(a.x); v[rb][2] = bflo(a.y); v[rb][3] = bfhi(a.y); v[rb][4] = bflo(a.z); v[rb][5] = bfhi(a.z); v[rb][6] = bflo(a.w); v[rb][7] = bfhi(a.w);
                    v[rb][8] = bflo(c.x); v[rb][9] = bfhi(c.x); v[rb][10] = bflo(c.y); v[rb][11] = bfhi(c.y); v[rb][12] = bflo(c.z); v[rb][13] = bfhi(c.z); v[rb][14] = bflo(c.w); v[rb][15] = bfhi(c.w); }
                else { const f32x4* xr = (const f32x4*)((const float*)X + (size_t)m * DM) + 4 * lane;
#pragma unroll
                    for (int j = 0; j < 4; ++j) { const f32x4 t = xr[j]; v[rb][4 * j] = t.x; v[rb][4 * j + 1] = t.y; v[rb][4 * j + 2] = t.z; v[rb][4 * j + 3] = t.w; } }
            } else {
#pragma unroll
                for (int e = 0; e < 16; ++e) v[rb][e] = 0.f; } }
#pragma unroll
        for (int rb = 0; rb < RB; ++rb) { const int m = m0 + rb * ngw; if (m < TOK) {
            const int b = m >> 12;
            float s = 0.f;
#pragma unroll
            for (int e = 0; e < 16; ++e) s += v[rb][e] * v[rb][e];
            const float rstd = 1.f / sqrtf(wave_sum(s, lane) * (1.f / DM) + NORM_EPS);
            float y[16];
#pragma unroll
            for (int j = 0; j < 4; ++j) { const f32x4 aa = *(LAS const f32x4*)(LA + b * 1024 + 16 * lane + 4 * j), bb = *(LAS const f32x4*)(LB + b * 1024 + 16 * lane + 4 * j);
#pragma unroll
                for (int e = 0; e < 4; ++e) y[4 * j + e] = v[rb][4 * j + e] * rstd * aa[e] + bb[e]; }
            v4u o0, o1;
            o0.x = pk2(y[0], y[1]); o0.y = pk2(y[2], y[3]); o0.z = pk2(y[4], y[5]); o0.w = pk2(y[6], y[7]);
            o1.x = pk2(y[8], y[9]); o1.y = pk2(y[10], y[11]); o1.z = pk2(y[12], y[13]); o1.w = pk2(y[14], y[15]);
            v4u* op = (v4u*)(O + (size_t)m * DM) + 2 * lane; op[0] = o0; op[1] = o1;
            if (O8) { v4u q;
                int w = __builtin_amdgcn_cvt_pk_fp8_f32(y[0], y[1], 0, false); w = __builtin_amdgcn_cvt_pk_fp8_f32(y[2], y[3], w, true); q.x = (unsigned)w;
                w = __builtin_amdgcn_cvt_pk_fp8_f32(y[4], y[5], 0, false); w = __builtin_amdgcn_cvt_pk_fp8_f32(y[6], y[7], w, true); q.y = (unsigned)w;
                w = __builtin_amdgcn_cvt_pk_fp8_f32(y[8], y[9], 0, false); w = __builtin_amdgcn_cvt_pk_fp8_f32(y[10], y[11], w, true); q.z = (unsigned)w;
                w = __builtin_amdgcn_cvt_pk_fp8_f32(y[12], y[13], 0, false); w = __builtin_amdgcn_cvt_pk_fp8_f32(y[14], y[15], w, true); q.w = (unsigned)w;
                *((v4u*)(O8 + (size_t)m * DM) + lane) = q; } } }
    }
    __syncthreads();
}

#ifndef ATT_PD
#define ATT_PD 2
#endif
constexpr int AT_K0 = 0, AT_KSLOT = 9216, AT_V0 = 18432, AT_VSLOT = 12288, AT_SEL = 43008, AT_KM = 44032, AT_END = 47872;
__device__ __forceinline__ s16x4 vtr(LAS const unsigned char* p) { return __builtin_bit_cast(s16x4, __builtin_amdgcn_ds_read_tr16_b64_v4i16((LAS s16x4*)p)); }

#define TRRD(dst, addr, off) asm volatile("ds_read_b64_tr_b16 %0, %1 offset:%2" : "=v"(dst) : "v"(addr), "i"(off) : "memory")
#define SBAR0() __builtin_amdgcn_sched_barrier(0)
__device__ __forceinline__ void softmax_pv(f32x16& s0, f32x16& s1, float& l, f32x16 (&o)[2], LAS const unsigned char* vbase  ) {
    const unsigned va = (unsigned)(uintptr_t)vbase;
    s16x4 vl[2][2][2], vh[2][2][2];
#pragma unroll
    for (int sub = 0; sub < 2; ++sub)
#pragma unroll
        for (int db = 0; db < 2; ++db)
#pragma unroll
            for (int s2 = 0; s2 < 2; ++s2) { TRRD(vl[db][sub][s2], va, (32 * sub + 16 * s2) * 192 + db * 64); TRRD(vh[db][sub][s2], va, (32 * sub + 16 * s2 + 8) * 192 + db * 64); }
    float la = l;
#pragma unroll
    for (int r = 0; r < 16; ++r) { s0[r] = __builtin_amdgcn_exp2f(s0[r]); la += s0[r]; }
    bf16x8 pf[2][2];
#pragma unroll
    for (int s2 = 0; s2 < 2; ++s2) { v4u a;
        a.x = cvtpk(s0[8 * s2 + 0], s0[8 * s2 + 1]); a.y = cvtpk(s0[8 * s2 + 2], s0[8 * s2 + 3]); a.z = cvtpk(s0[8 * s2 + 4], s0[8 * s2 + 5]); a.w = cvtpk(s0[8 * s2 + 6], s0[8 * s2 + 7]);
        pf[0][s2] = __builtin_bit_cast(bf16x8, a); }
    asm volatile("s_waitcnt lgkmcnt(0)" : "+v"(vl[0][0][0]), "+v"(vl[0][0][1]), "+v"(vl[0][1][0]), "+v"(vl[0][1][1]), "+v"(vl[1][0][0]), "+v"(vl[1][0][1]), "+v"(vl[1][1][0]), "+v"(vl[1][1][1]),
                                          "+v"(vh[0][0][0]), "+v"(vh[0][0][1]), "+v"(vh[0][1][0]), "+v"(vh[0][1][1]), "+v"(vh[1][0][0]), "+v"(vh[1][0][1]), "+v"(vh[1][1][0]), "+v"(vh[1][1][1]) :: "memory");
    SBAR0();
#pragma unroll
    for (int g = 0; g < 4; ++g) { const int db = g >> 1, s2 = g & 1;
        const s16x4 lo = vl[db][0][s2], hh = vh[db][0][s2];
        const bf16x8 vf = (bf16x8){lo[0], lo[1], lo[2], lo[3], hh[0], hh[1], hh[2], hh[3]};
        o[db] = __builtin_amdgcn_mfma_f32_32x32x16_bf16(vf, pf[0][s2], o[db], 0, 0, 0);
#pragma unroll
        for (int r = 4 * g; r < 4 * g + 4; ++r) { s1[r] = __builtin_amdgcn_exp2f(s1[r]); la += s1[r]; }
        SBAR0(); }
    l = la;
#pragma unroll
    for (int s2 = 0; s2 < 2; ++s2) { v4u c;
        c.x = cvtpk(s1[8 * s2 + 0], s1[8 * s2 + 1]); c.y = cvtpk(s1[8 * s2 + 2], s1[8 * s2 + 3]); c.z = cvtpk(s1[8 * s2 + 4], s1[8 * s2 + 5]); c.w = cvtpk(s1[8 * s2 + 6], s1[8 * s2 + 7]);
        pf[1][s2] = __builtin_bit_cast(bf16x8, c); }
#pragma unroll
    for (int g = 0; g < 4; ++g) { const int db = g >> 1, s2 = g & 1;
        const s16x4 lo = vl[db][1][s2], hh = vh[db][1][s2];
        const bf16x8 vf = (bf16x8){lo[0], lo[1], lo[2], lo[3], hh[0], hh[1], hh[2], hh[3]};
        o[db] = __builtin_amdgcn_mfma_f32_32x32x16_bf16(vf, pf[1][s2], o[db], 0, 0, 0); }
}
__device__ __forceinline__ void split3(float x, unsigned& h, unsigned& m, unsigned& l) {
    h = f2bf(x); const float r1 = x - __uint_as_float(h << 16); m = f2bf(r1); const float r2 = r1 - __uint_as_float(m << 16); l = f2bf(r2);
}

template <int MODE>
__device__ __forceinline__ void attn_unit(LAS unsigned char* lds, int b, int h, int qb, const bf16* Qb, const bf16* Kb, const bf16* Vb, bf16* Ob, float slope,
                                          const float* kmean, float lam, float post_scale, const float* subg, const unsigned* maskw, const unsigned* nrm  ,
                                          const int* refposg, const int* refming) {
    int tid_l = threadIdx.x; asm volatile("" : "+v"(tid_l)); const int tid = tid_l, lane = tid & 63, wid = __builtin_amdgcn_readfirstlane(tid >> 6), r32 = lane & 31, hi = lane >> 5;
    const int q = qb * 256 + wid * 32 + r32;
    const size_t rowg = (size_t)b * SEQ;
    const float c2 = slope * LOG2E;
    unsigned sel = 0u;
    bf16x8 qf[4];
#pragma unroll
    for (int ds = 0; ds < 4; ++ds) qf[ds] = *(const bf16x8*)(Qb + (rowg + q) * 256 + h * 64 + ds * 16 + hi * 8);
    const int skey = tid >> 3, sch = tid & 7;
    const bf16* ksrc = Kb + (rowg + skey) * 256 + h * 64 + sch * 8;
    const bf16* vsrc = Vb + (rowg + skey) * 256 + h * 64 + sch * 8;
    const int kdst = AT_K0 + skey * 144 + sch * 16, vdst = AT_V0 + skey * 192 + sch * 16;
    const int NT = 4 * qb + 4;
    const float Bq = __uint_as_float(nrm[b * 4 + h]), Bk = __uint_as_float(nrm[32 + b * 4 + h]);
#if defined(PROBE_NOSKIP)
    const float Dskip = 1e9f + 0.f * (Bq + Bk);
#else
    const float Dskip = (150.f + 2.f * sqrtf(Bq * Bk)) / c2;
#endif
    const int koff = r32 * 144 + hi * 16;
    const int vtoff = (4 * hi + ((lane & 15) >> 2)) * 192 + (16 * ((lane >> 4) & 1) + 4 * (lane & 3)) * 2;
    float l1 = 0.f, l2 = 0.f;
    f32x16 oA[2], oB[2];
#pragma unroll
    for (int r = 0; r < 16; ++r) { oA[0][r] = 0.f; oA[1][r] = 0.f; oB[0][r] = 0.f; oB[1][r] = 0.f; }
    const int qmin = qb * 256 + wid * 32, qmax = qmin + 31;
    constexpr int PD = ATT_PD;
    v4u kR[PD], vR[PD]; v2u mR[PD];
    int refpos = q;
    int minref = qb * 256;
    if (MODE == 2) { refpos = refposg[rowg + q]; minref = refming[b * 128 + 8 * qb];
#pragma unroll
        for (int i = 1; i < 8; ++i) { const int v = refming[b * 128 + 8 * qb + i]; minref = v < minref ? v : minref; } }
    int T0 = (int)floorf(((float)minref - Dskip) * (1.f / 64.f)); T0 = T0 < 0 ? 0 : T0; T0 = __builtin_amdgcn_readfirstlane(T0);
    const v4u k0r = *(const v4u*)(ksrc + (size_t)T0 * 64 * 256), v0r = *(const v4u*)(vsrc + (size_t)T0 * 64 * 256);
#pragma unroll
    for (int i = 0; i < PD; ++i) { kR[i] = (v4u){0u, 0u, 0u, 0u}; vR[i] = kR[i]; mR[i] = (v2u){0u, 0u};
        if (T0 + i + 1 < NT) { kR[i] = *(const v4u*)(ksrc + (size_t)(T0 + i + 1) * 64 * 256); vR[i] = *(const v4u*)(vsrc + (size_t)(T0 + i + 1) * 64 * 256);
            if (MODE == 2) mR[i] = *(const v2u*)(maskw + (rowg + q) * 128 + 2 * (T0 + i + 1)); } }
    v2u mw = (v2u){0u, 0u};
    if (MODE == 2) mw = *(const v2u*)(maskw + (rowg + q) * 128 + 2 * T0);
    if (MODE == 0) {
        LAS float* KM = (LAS float*)(lds + AT_KM); LAS unsigned* SEL = (LAS unsigned*)(lds + AT_SEL);
        for (int i = tid; i < qb * 64; i += 512) KM[i] = kmean[(size_t)((b * 4 + h) * 16) * 64 + i];
        __syncthreads();
        if (tid < 256) {
            const bf16* qrow = Qb + (rowg + qb * 256 + tid) * 256 + h * 64;
            float qv[64];
#pragma unroll
            for (int c = 0; c < 8; ++c) { const v4u w = *(const v4u*)(qrow + 8 * c);
                qv[8 * c + 0] = bflo(w.x); qv[8 * c + 1] = bfhi(w.x); qv[8 * c + 2] = bflo(w.y); qv[8 * c + 3] = bfhi(w.y);
                qv[8 * c + 4] = bflo(w.z); qv[8 * c + 5] = bfhi(w.z); qv[8 * c + 6] = bflo(w.w); qv[8 * c + 7] = bfhi(w.w); }
            float v1 = -INFINITY, v2 = -INFINITY, v3 = -INFINITY; int i1 = -1, i2 = -1, i3 = -1;
            for (int n = 0; n < qb; ++n) {
                float g = 0.f;
#pragma unroll
                for (int d = 0; d < 64; ++d) g = __builtin_fmaf(qv[d], KM[n * 64 + d], g);
                if (g > v1) { v3 = v2; i3 = i2; v2 = v1; i2 = i1; v1 = g; i1 = n; }
                else if (g > v2) { v3 = v2; i3 = i2; v2 = g; i2 = n; }
                else if (g > v3) { v3 = g; i3 = n; }
            }
            unsigned sm = 0u; if (i1 >= 0) sm |= 1u << i1; if (i2 >= 0) sm |= 1u << i2; if (i3 >= 0) sm |= 1u << i3;
            SEL[tid] = sm;
        }
        __syncthreads();
        sel = SEL[wid * 32 + r32];
    }
    *(LAS v4u*)(lds + kdst + (T0 & 1) * AT_KSLOT) = k0r; *(LAS v4u*)(lds + vdst + (T0 & 1) * AT_VSLOT) = v0r;
    bf16x8 qaug; v4u ka0, ka1;
    { unsigned a, b2, c; split3(-c2 * (float)refpos, a, b2, c);
      v4u w; if (hi == 0) { w.x = a | (b2 << 16); w.y = c | (0x3f80u << 16); w.z = 0x3f80u | (0x3f80u << 16); w.w = 0u; }
             else { w.x = 0x3f80u | (0x3f80u << 16); w.y = 0x3f80u; w.z = 0u; w.w = 0u; }
      qaug = __builtin_bit_cast(bf16x8, w);
      split3(c2 * (float)r32, a, b2, c); ka0.x = 0x3f80u | (0x3f80u << 16); ka0.y = 0x3f80u | (a << 16); ka0.z = b2 | (c << 16); ka0.w = 0u;
      split3(c2 * (float)(r32 + 32), a, b2, c); ka1.x = ka0.x; ka1.y = 0x3f80u | (a << 16); ka1.z = b2 | (c << 16); ka1.w = 0u; }
    __syncthreads();
#pragma nounroll
    for (int t0 = T0; t0 < NT; t0 += PD) {
#pragma unroll
      for (int u = 0; u < PD; ++u) { const int t = t0 + u; if (t < NT) {
        const int slot = t & 1;
        const int k0 = 64 * t;
        bool active = (k0 <= qmax);
        bool keep = true;
        if (MODE == 0) { const int n = t >> 2; if (n < qb) { keep = ((sel >> n) & 1u) != 0u; active = (__ballot(keep) != 0ull); } }
        if (active) {
            LAS const unsigned char* ks = lds + AT_K0 + slot * AT_KSLOT + koff;
            LAS const unsigned char* vb = lds + AT_V0 + slot * AT_VSLOT + vtoff;
            const int lim = q - k0 - 4 * hi;
            const bool needmask = (k0 + 63 > qmin);
            bf16x8 kaug0, kaug1;
            { unsigned a, b2, c; split3(c2 * (float)k0, a, b2, c);
              v4u w0 = ka0, w1 = ka1; if (hi) { w0.x = a | (b2 << 16); w0.y = c; w0.z = 0u; w1 = w0; }
              kaug0 = __builtin_bit_cast(bf16x8, w0); kaug1 = __builtin_bit_cast(bf16x8, w1); }
            f32x16 sb0, sb1;
#pragma unroll
            for (int r = 0; r < 16; ++r) { sb0[r] = 0.f; sb1[r] = 0.f; }
            sb0 = __builtin_amdgcn_mfma_f32_32x32x16_bf16(kaug0, qaug, sb0, 0, 0, 0);
            sb1 = __builtin_amdgcn_mfma_f32_32x32x16_bf16(kaug1, qaug, sb1, 0, 0, 0);
#pragma unroll
            for (int mp = 0; mp < (MODE == 1 ? 2 : 1); ++mp) {
                f32x16 s0, s1;
#pragma unroll
                for (int dd = 0; dd < (MODE == 1 ? 2 : 4); ++dd) { const int ds = (MODE == 1) ? (2 * mp + dd) : dd;
                    const bf16x8 a0 = *(LAS const bf16x8*)(ks + ds * 32), a1 = *(LAS const bf16x8*)(ks + 32 * 144 + ds * 32);
                    if (dd == 0) { s0 = __builtin_amdgcn_mfma_f32_32x32x16_bf16(a0, qf[ds], sb0, 0, 0, 0); s1 = __builtin_amdgcn_mfma_f32_32x32x16_bf16(a1, qf[ds], sb1, 0, 0, 0); }
                    else { s0 = __builtin_amdgcn_mfma_f32_32x32x16_bf16(a0, qf[ds], s0, 0, 0, 0); s1 = __builtin_amdgcn_mfma_f32_32x32x16_bf16(a1, qf[ds], s1, 0, 0, 0); } }
#if defined(PROBE_QK2X)
                { f32x16 d0, d1;
#pragma unroll
                  for (int r = 0; r < 16; ++r) { d0[r] = 0.f; d1[r] = 0.f; }
#pragma unroll
                  for (int dd = 0; dd < (MODE == 1 ? 2 : 4); ++dd) { const int ds = (MODE == 1) ? (2 * mp + dd) : dd;
                    const bf16x8 a0 = *(LAS const bf16x8*)(ks + ds * 32 + 16), a1 = *(LAS const bf16x8*)(ks + 32 * 144 + ds * 32 + 16);
                    d0 = __builtin_amdgcn_mfma_f32_32x32x16_bf16(a0, qf[ds], d0, 0, 0, 0);
                    d1 = __builtin_amdgcn_mfma_f32_32x32x16_bf16(a1, qf[ds], d1, 0, 0, 0); }
                  asm volatile("" :: "v"(d0), "v"(d1)); }
#endif
                if (MODE == 2) {
#pragma unroll
                    for (int r = 0; r < 16; ++r) { const int pos = (r & 3) + 8 * (r >> 2) + 4 * hi;
                        if (!((mw.x >> pos) & 1u)) s0[r] = -INFINITY; if (!((mw.y >> pos) & 1u)) s1[r] = -INFINITY; }
                } else {
                    if (MODE == 0 && !keep) {
#pragma unroll
                        for (int r = 0; r < 16; ++r) { s0[r] = -INFINITY; s1[r] = -INFINITY; }
                    }
                    if (needmask) {
#pragma unroll
                        for (int r = 0; r < 16; ++r) { const int ko = (r & 3) + 8 * (r >> 2);
                            if (ko > lim) s0[r] = -INFINITY; if (ko + 32 > lim) s1[r] = -INFINITY; }
                    }
                }
                if (mp == 0) softmax_pv(s0, s1, l1, oA, vb); else softmax_pv(s0, s1, l2, oB, vb);
            }
        }
        if (t + 1 < NT) { *(LAS v4u*)(lds + kdst + (slot ^ 1) * AT_KSLOT) = kR[u]; *(LAS v4u*)(lds + vdst + (slot ^ 1) * AT_VSLOT) = vR[u];
            if (MODE == 2) mw = mR[u];
            if (t + 1 + PD < NT) { kR[u] = *(const v4u*)(ksrc + (size_t)(t + 1 + PD) * 64 * 256); vR[u] = *(const v4u*)(vsrc + (size_t)(t + 1 + PD) * 64 * 256);
                if (MODE == 2) mR[u] = *(const v2u*)(maskw + (rowg + q) * 128 + 2 * (t + 1 + PD)); } }
        __syncthreads();
#if defined(PROBE_BAR2X)
        __syncthreads();
#endif
      } }
    }
    const float l1t = l1 + shx(l1, 32, lane);
    bf16* orow = Ob + (rowg + q) * 256 + h * 64 + 4 * hi;
    if (MODE == 1) {
        const float l2t = l2 + shx(l2, 32, lane);
        const float i1 = 1.f / l1t, i2 = lam / l2t;
        float ssq = 0.f;
#pragma unroll
        for (int db = 0; db < 2; ++db)
#pragma unroll
            for (int r = 0; r < 16; ++r) { const float v = oA[db][r] * i1 - oB[db][r] * i2; oA[db][r] = v; ssq += v * v; }
        ssq += shx(ssq, 32, lane);
        const float rn = post_scale / sqrtf(ssq * (1.f / 64.f) + NORM_EPS);
#pragma unroll
        for (int db = 0; db < 2; ++db)
#pragma unroll
            for (int g4 = 0; g4 < 4; ++g4) { const f32x4 gg = *(const f32x4*)(subg + 32 * db + 8 * g4 + 4 * hi);
                v2u w; w.x = cvtpk(oA[db][4 * g4 + 0] * rn * gg[0], oA[db][4 * g4 + 1] * rn * gg[1]); w.y = cvtpk(oA[db][4 * g4 + 2] * rn * gg[2], oA[db][4 * g4 + 3] * rn * gg[3]);
                *(v2u*)(orow + 32 * db + 8 * g4) = w; }
    } else {
        const float i1 = 1.f / l1t;
#pragma unroll
        for (int db = 0; db < 2; ++db)
#pragma unroll
            for (int g4 = 0; g4 < 4; ++g4) { v2u w; w.x = cvtpk(oA[db][4 * g4 + 0] * i1, oA[db][4 * g4 + 1] * i1); w.y = cvtpk(oA[db][4 * g4 + 2] * i1, oA[db][4 * g4 + 3] * i1);
                *(v2u*)(orow + 32 * db + 8 * g4) = w; }
    }
    __syncthreads();
}

constexpr int DS_HP = 1025;
constexpr int DS_HIST_BYTES = 32 * DS_HP * 4;
constexpr int DS_BP = 129;
constexpr int DS_G = 0, DS_C = 32 * DS_BP * 4, DS_AUX = DS_HIST_BYTES;
__device__ __forceinline__ float relu_asm(float x) { return __builtin_amdgcn_fmed3f(x, 0.f, __builtin_inff()); }
__device__ __forceinline__ void dsa_scores(const bf16x8 (&iqf)[4][2], const float (&w)[4], const bf16x8 k0, const bf16x8 k1, float (&sc)[16]) {
#pragma unroll
    for (int hh = 0; hh < 4; ++hh) {
        f32x16 x;
#pragma unroll
        for (int r = 0; r < 16; ++r) x[r] = 0.f;
        x = __builtin_amdgcn_mfma_f32_32x32x16_bf16(k0, iqf[hh][0], x, 0, 0, 0);
        x = __builtin_amdgcn_mfma_f32_32x32x16_bf16(k1, iqf[hh][1], x, 0, 0, 0);
#pragma unroll
        for (int r = 0; r < 16; ++r) sc[r] = (hh == 0) ? (w[0] * relu_asm(x[r])) : __builtin_fmaf(w[hh], relu_asm(x[r]), sc[r]);
    }
}
__device__ __forceinline__ unsigned dsa_mono(float s) { const unsigned bits = __float_as_uint(s); return bits ^ ((unsigned)((int)bits >> 31) | 0x80000000u); }
__device__ __forceinline__ unsigned dsa_ckey(float s, unsigned keyidx) { return (dsa_mono(s) & 0xFFFFF000u) | (4095u - keyidx); }
__device__ __forceinline__ unsigned take_low(unsigned w, unsigned n) {
    if (n >= (unsigned)__popc(w)) return w;
    unsigned res = 0u;
    while (n > 0u) { const unsigned low = w & (0u - w); res |= low; w ^= low; --n; }
    return res;
}
template <int PASS>
__device__ __forceinline__ void dsa_hist_pass(LAS unsigned* hist, const bf16x8 (&iqf)[4][2], const float (&w)[4], const bf16* kbase, int qg, int wid, int r32, int hi, int t, unsigned P1) {
    bf16x8 nk0 = *(const bf16x8*)(kbase + (size_t)wid * 32 * 256), nk1 = *(const bf16x8*)(kbase + (size_t)wid * 32 * 256 + 16);
    const unsigned rowb = (unsigned)(r32 * DS_HP * 4);
#pragma nounroll
    for (int j = wid; j <= qg; j += 8) {
        const bf16x8 k0 = nk0, k1 = nk1;
        { const int jn = (j + 8 <= qg) ? j + 8 : j; const bf16* kp = kbase + (size_t)jn * 32 * 256; nk0 = *(const bf16x8*)kp; nk1 = *(const bf16x8*)(kp + 16); }
        float sc[16]; dsa_scores(iqf, w, k0, k1, sc);
#if defined(PROBE_D1_SCORE2X)
        { float sd[16]; dsa_scores(iqf, w, k1, k0, sd);
#pragma unroll
          for (int r = 0; r < 16; ++r) asm volatile("" :: "v"(sd[r])); }
#endif
        const int lim = t - 32 * j - 4 * hi;
        const bool diag = (j == qg);
#pragma unroll
        for (int r = 0; r < 16; ++r) {
            const unsigned mono = dsa_mono(sc[r]);
            unsigned addr;
            if (PASS == 0) { addr = rowb + ((mono >> 22) << 2); if (diag && ((r & 3) + 8 * (r >> 2) > lim)) addr = rowb + 4096u; }
            else { addr = rowb + (((mono >> 12) & 1023u) << 2); if ((mono >> 22) != P1 || (diag && ((r & 3) + 8 * (r >> 2) > lim))) addr = rowb + 4096u; }
            __hip_atomic_fetch_add((LAS unsigned*)((LAS unsigned char*)hist + addr), 1u, __ATOMIC_RELAXED, __HIP_MEMORY_SCOPE_WORKGROUP);
#if defined(PROBE_D1_ATOM2X)
            __hip_atomic_fetch_add((LAS unsigned*)((LAS unsigned char*)hist + rowb + 4096u), 1u, __ATOMIC_RELAXED, __HIP_MEMORY_SCOPE_WORKGROUP);
#endif
        }
    }
}
__device__ __forceinline__ void dsa_scan(LAS unsigned* hist, LAS unsigned* AUX, int pass, int wid, int lane) {
#pragma unroll
    for (int qi = 0; qi < 4; ++qi) {
        const int qq = 4 * wid + qi;
        const unsigned K = (pass == 0) ? 256u : AUX[32 + qq];
        LAS const unsigned* hrow = hist + qq * DS_HP;
        const int wb = 1008 - 16 * lane;
        unsigned s = 0u;
#pragma unroll
        for (int i = 0; i < 16; ++i) s += hrow[wb + ((i + lane) & 15)];
        unsigned incl = s;
#pragma unroll
        for (int o = 1; o < 64; o <<= 1) { const unsigned v = shupu(incl, o, lane); if (lane >= o) incl += v; }
        const unsigned long long bal = __ballot(incl >= K);
        const int L = __builtin_amdgcn_readfirstlane(bal ? (__ffsll((long long)bal) - 1) : 0);
        const unsigned above = (unsigned)__builtin_amdgcn_readlane((int)(incl - s), L);
        const int bin = 1023 - 16 * L - (lane & 15);
        const unsigned c = (lane < 16) ? hrow[bin] : 0u;
        unsigned inc2 = c;
#pragma unroll
        for (int o = 1; o < 16; o <<= 1) { const unsigned v = shupu(inc2, o, lane); if (lane >= o) inc2 += v; }
        const unsigned long long bal2 = __ballot(lane < 16 && above + inc2 >= K);
        const int I = __builtin_amdgcn_readfirstlane(bal2 ? (__ffsll((long long)bal2) - 1) : 0);
        if (lane == I) { AUX[64 * pass + qq] = (unsigned)bin; AUX[64 * pass + 32 + qq] = K - (above + inc2 - c); }
    }
}
__device__ __forceinline__ void dsa_select_unit(LAS unsigned char* lds, int b, int qg, const bf16* IX, unsigned* MASK, int* REFPOS  , int* REFMIN  ) {
    int tid_l = threadIdx.x; asm volatile("" : "+v"(tid_l)); const int tid = tid_l, lane = tid & 63, wid = __builtin_amdgcn_readfirstlane(tid >> 6), r32 = lane & 31, hi = lane >> 5;
    const int t = 32 * qg + r32;
    const size_t rowg = (size_t)b * SEQ;
    const bf16* qrow = IX + (rowg + t) * 256;
    bf16x8 iqf[4][2];
#pragma unroll
    for (int hh = 0; hh < 4; ++hh)
#pragma unroll
        for (int ds = 0; ds < 2; ++ds) iqf[hh][ds] = *(const bf16x8*)(qrow + 32 * hh + 16 * ds + 8 * hi);
    float w[4];
    { const v2u ww = *(const v2u*)(qrow + 160); w[0] = bflo(ww.x); w[1] = bfhi(ww.x); w[2] = bflo(ww.y); w[3] = bfhi(ww.y); }
    LAS unsigned* hist = (LAS unsigned*)lds;
    LAS unsigned* AUX = (LAS unsigned*)(lds + DS_AUX);
    const bf16* kbase = IX + (rowg + r32) * 256 + 128 + 8 * hi;
    unsigned P = 0u;
    const bool all = (qg < 8);
    if (!all) {
        for (int i = tid; i < DS_HIST_BYTES / 16; i += 512) ((LAS v4u*)lds)[i] = (v4u){0u, 0u, 0u, 0u};
#if defined(PROBE_D1_ZERO2X)
        __syncthreads(); for (int i = tid; i < DS_HIST_BYTES / 16; i += 512) ((LAS v4u*)lds)[i] = (v4u){0u, 0u, 0u, 0u}; __syncthreads(); for (int i = tid; i < DS_HIST_BYTES / 16; i += 512) ((LAS v4u*)lds)[i] = (v4u){0u, 0u, 0u, 0u};
#endif
        __syncthreads();
        dsa_hist_pass<0>(hist, iqf, w, kbase, qg, wid, r32, hi, t, 0u);
        __syncthreads();
        dsa_scan(hist, AUX, 0, wid, lane);
#if defined(PROBE_D1_SCAN2X)
        __syncthreads(); dsa_scan(hist, AUX, 0, wid, lane);
#endif
        __syncthreads();
        const unsigned P1 = AUX[r32];
        for (int i = tid; i < DS_HIST_BYTES / 16; i += 512) ((LAS v4u*)lds)[i] = (v4u){0u, 0u, 0u, 0u};
        __syncthreads();
        dsa_hist_pass<1>(hist, iqf, w, kbase, qg, wid, r32, hi, t, P1);
        __syncthreads();
        dsa_scan(hist, AUX, 1, wid, lane);
#if defined(PROBE_D1_SCAN2X)
        __syncthreads(); dsa_scan(hist, AUX, 1, wid, lane);
#endif
        __syncthreads();
        P = (P1 << 10) | AUX[64 + r32];
    }
    if (all) { if (tid < 32) { AUX[64 + 32 + tid] = 0u; } }
    for (int i = tid; i < (2 * 32 * DS_BP * 4) / 16; i += 512) ((LAS v4u*)lds)[i] = (v4u){0u, 0u, 0u, 0u};
    __syncthreads();
    LAS unsigned* G = (LAS unsigned*)(lds + DS_G);
    LAS unsigned* C = (LAS unsigned*)(lds + DS_C);
    bf16x8 nk0, nk1;
    { const int j0 = (wid <= qg) ? wid : 0; nk0 = *(const bf16x8*)(kbase + (size_t)j0 * 32 * 256); nk1 = *(const bf16x8*)(kbase + (size_t)j0 * 32 * 256 + 16); }
#pragma nounroll
    for (int j = wid; j <= qg; j += 8) {
        const bf16x8 k0 = nk0, k1 = nk1;
        { const int jn = (j + 8 <= qg) ? j + 8 : j; const bf16* kp = kbase + (size_t)jn * 32 * 256; nk0 = *(const bf16x8*)kp; nk1 = *(const bf16x8*)(kp + 16); }
        float sc[16]; dsa_scores(iqf, w, k0, k1, sc);
        unsigned bg = 0u, bc = 0u;
        const int lim = t - 32 * j - 4 * hi;
#pragma unroll
        for (int r = 0; r < 16; ++r) {
            const int pos = (r & 3) + 8 * (r >> 2) + 4 * hi;
            const unsigned p22 = dsa_mono(sc[r]) >> 12;
            const bool ok = ((r & 3) + 8 * (r >> 2)) <= lim;
            if (ok && p22 > P) bg |= 1u << pos;
            if (ok && p22 == P) bc |= 1u << pos;
        }
        bg |= shxu(bg, 32, lane); bc |= shxu(bc, 32, lane);
        if (hi == 0) { G[r32 * DS_BP + j] = bg; C[r32 * DS_BP + j] = bc; }
    }
    __syncthreads();
#pragma unroll
    for (int qi = 0; qi < 4; ++qi) {
        const int qq = 4 * wid + qi;
        const unsigned K2 = AUX[64 + 32 + qq];
        const unsigned w0 = C[qq * DS_BP + 2 * lane], w1 = C[qq * DS_BP + 2 * lane + 1];
        const unsigned pc = (unsigned)__popc(w0) + (unsigned)__popc(w1);
        unsigned incl = pc;
#pragma unroll
        for (int o = 1; o < 64; o <<= 1) { const unsigned v = shupu(incl, o, lane); if (lane >= o) incl += v; }
        const unsigned pre = incl - pc;
        unsigned need = K2 > pre ? K2 - pre : 0u;
        const unsigned t0 = take_low(w0, need); need -= (unsigned)__popc(t0);
        const unsigned t1 = take_low(w1, need);
        const unsigned g0 = G[qq * DS_BP + 2 * lane] | t0, g1 = G[qq * DS_BP + 2 * lane + 1] | t1;
        G[qq * DS_BP + 2 * lane] = g0; G[qq * DS_BP + 2 * lane + 1] = g1;
        int hp = g1 ? (64 * lane + 63 - __clz((int)g1)) : (g0 ? (64 * lane + 31 - __clz((int)g0)) : -1);
#pragma unroll
        for (int o = 1; o < 64; o <<= 1) { const int v = (int)shxu((unsigned)hp, o, lane); hp = v > hp ? v : hp; }
        if (lane == 0) { REFPOS[rowg + 32 * qg + qq] = hp; AUX[128 + qq] = (unsigned)hp; }
    }
    __syncthreads();
    if (tid == 0) { int mn = 0x7fffffff; for (int i = 0; i < 32; ++i) { const int v = (int)AUX[128 + i]; mn = v < mn ? v : mn; } REFMIN[b * 128 + qg] = mn; }
    { const int qq = tid >> 4, part = tid & 15;
        unsigned* dst = MASK + (rowg + 32 * qg + qq) * 128 + part * 8;
        v4u a, c2;
        a.x = G[qq * DS_BP + part * 8 + 0]; a.y = G[qq * DS_BP + part * 8 + 1]; a.z = G[qq * DS_BP + part * 8 + 2]; a.w = G[qq * DS_BP + part * 8 + 3];
        c2.x = G[qq * DS_BP + part * 8 + 4]; c2.y = G[qq * DS_BP + part * 8 + 5]; c2.z = G[qq * DS_BP + part * 8 + 6]; c2.w = G[qq * DS_BP + part * 8 + 7];
        *(v4u*)dst = a; *(v4u*)(dst + 4) = c2; }
    __syncthreads();
}

constexpr int PL_U = 0, PL_UP = 528, PL_D = 79 * 528 + 16  , PL_DP = 257;
__device__ __forceinline__ void pool_unit(LAS unsigned char* lds, int b, int tile, const bf16* PU, const float* wpool  , const float* pscale  , bf16* YC) {
    int tid_l = threadIdx.x; asm volatile("" : "+v"(tid_l)); const int tid = tid_l, cb = __builtin_amdgcn_readfirstlane(tid >> 6), tt = tid & 63;
    const int t0 = tile * 64; const size_t rowg = (size_t)b * SEQ;
    for (int i = tid; i < 79 * 32; i += 512) { const int rr = i >> 5, ch = i & 31; const int tok = t0 - 15 + rr;
        v4u v = (v4u){0u, 0u, 0u, 0u}; if (tok >= 0) v = *(const v4u*)(PU + (rowg + tok) * 256 + ch * 8);
        *(LAS v4u*)(lds + PL_U + rr * PL_UP + ch * 16) = v; }
    __syncthreads();
    const int g = cb >> 1, wlen = 2 << g, c0 = 32 * cb, t = t0 + tt;
    const float inv = 1.f / (float)((t + 1 < wlen) ? (t + 1) : wlen);
    LAS float* Dm = (LAS float*)(lds + PL_D);
#pragma unroll
    for (int ch = 0; ch < 4; ++ch) {
        float sum[8];
#pragma unroll
        for (int e = 0; e < 8; ++e) sum[e] = 0.f;
        float self[8];
        for (int i = 0; i < wlen; ++i) {
            const v4u v = *(LAS const v4u*)(lds + PL_U + (15 + tt - i) * PL_UP + (c0 + 8 * ch) * 2);
            const float f[8] = {bflo(v.x), bfhi(v.x), bflo(v.y), bfhi(v.y), bflo(v.z), bfhi(v.z), bflo(v.w), bfhi(v.w)};
#pragma unroll
            for (int e = 0; e < 8; ++e) { sum[e] += f[e]; if (i == 0) self[e] = f[e]; }
        }
#pragma unroll
        for (int e = 0; e < 8; ++e) Dm[tt * PL_DP + c0 + 8 * ch + e] = sum[e] * inv - self[e];
    }
    __syncthreads();
    const int e0 = 32 * (cb & 1);
    float acc[32];
#pragma unroll
    for (int e = 0; e < 32; ++e) acc[e] = 0.f;
    const float* wg = wpool + (size_t)g * 4096 + e0;
    for (int c = 0; c < 64; ++c) {
        const float dv = Dm[tt * PL_DP + 64 * g + c];
        const float* wr = wg + c * 64;
#pragma unroll
        for (int e = 0; e < 32; ++e) acc[e] = __builtin_fmaf(dv, wr[e], acc[e]);
    }
    bf16* orow = YC + (rowg + t) * 256 + 64 * g + e0;
    const float* ps = pscale + 64 * g + e0;
#pragma unroll
    for (int k = 0; k < 4; ++k) { v4u o;
        o.x = pk2(acc[8 * k + 0] * ps[8 * k + 0], acc[8 * k + 1] * ps[8 * k + 1]); o.y = pk2(acc[8 * k + 2] * ps[8 * k + 2], acc[8 * k + 3] * ps[8 * k + 3]);
        o.z = pk2(acc[8 * k + 4] * ps[8 * k + 4], acc[8 * k + 5] * ps[8 * k + 5]); o.w = pk2(acc[8 * k + 6] * ps[8 * k + 6], acc[8 * k + 7] * ps[8 * k + 7]);
        *(v4u*)(orow + 8 * k) = o; }
    __syncthreads();
}
__device__ __forceinline__ void kmean_item(int item, const bf16* AK, float* KMEAN, int wid, int lane_in) {
    int lane = lane_in; asm volatile("" : "+v"(lane));
    const int combo = item * 8 + wid; const int b = combo >> 6, h = (combo >> 4) & 3, n = combo & 15;
    const int ks = lane >> 3, ch = lane & 7;
    const bf16* p = AK + ((size_t)b * SEQ + 256 * n + ks) * 256 + 64 * h + 8 * ch;
    float s[8];
#pragma unroll
    for (int e = 0; e < 8; ++e) s[e] = 0.f;
#pragma unroll 8
    for (int j = 0; j < 32; ++j) { const v4u v = *(const v4u*)(p + (size_t)j * 8 * 256);
        s[0] += bflo(v.x); s[1] += bfhi(v.x); s[2] += bflo(v.y); s[3] += bfhi(v.y); s[4] += bflo(v.z); s[5] += bfhi(v.z); s[6] += bflo(v.w); s[7] += bfhi(v.w); }
#pragma unroll
    for (int e = 0; e < 8; ++e) { s[e] += shx(s[e], 8, lane); s[e] += shx(s[e], 16, lane); s[e] += shx(s[e], 32, lane); }
    if (ks == 0) { float* o = KMEAN + (size_t)combo * 64 + 8 * ch;
        *(f32x4*)o = (f32x4){s[0], s[1], s[2], s[3]} * (1.f / 256.f); *(f32x4*)(o + 4) = (f32x4){s[4], s[5], s[6], s[7]} * (1.f / 256.f); }
}

__device__ __forceinline__ void norm_unit(LAS unsigned char* lds, int n, const bf16* PROJ, size_t TS, unsigned* NRM  ) {
    int tid_l = threadIdx.x; asm volatile("" : "+v"(tid_l)); const int tid = tid_l, lane = tid & 63, wid = __builtin_amdgcn_readfirstlane(tid >> 6);
    const int a = n >> 8, rem = n & 255, sq = rem >> 7, b = (rem >> 4) & 7, c = rem & 15;
    const int tile = (a == 0 ? 0 : (a == 1 ? 3 : 7)) + sq;
    const int row = tid >> 1, hp = tid & 1;
    float ss[2] = {0.f, 0.f};
#pragma unroll
    for (int rr = 0; rr < 1; ++rr) {
        const bf16* p = PROJ + (size_t)tile * TS + ((size_t)b * SEQ + 256 * c + row) * 256 + 128 * hp;
#pragma unroll
        for (int hh = 0; hh < 2; ++hh) { float acc = 0.f;
#pragma unroll
            for (int i = 0; i < 8; ++i) { const v4u v = *(const v4u*)(p + 64 * hh + 8 * i);
                const float f0 = bflo(v.x), f1 = bfhi(v.x), f2 = bflo(v.y), f3 = bfhi(v.y), f4 = bflo(v.z), f5 = bfhi(v.z), f6 = bflo(v.w), f7 = bfhi(v.w);
                acc += (f0 * f0 + f1 * f1) + (f2 * f2 + f3 * f3) + (f4 * f4 + f5 * f5) + (f6 * f6 + f7 * f7); }
            ss[hh] = fmaxf(ss[hh], acc); }
    }
#pragma unroll
    for (int o = 2; o < 64; o <<= 1) { ss[0] = fmaxf(ss[0], shx(ss[0], o, lane)); ss[1] = fmaxf(ss[1], shx(ss[1], o, lane)); }
    LAS float* R = (LAS float*)lds;
    if (lane < 2) { R[wid * 4 + 2 * hp] = ss[0]; R[wid * 4 + 2 * hp + 1] = ss[1]; }
    __syncthreads();
    if (tid < 4) { float m = R[tid];
#pragma unroll
        for (int w2 = 1; w2 < 8; ++w2) m = fmaxf(m, R[w2 * 4 + tid]);
        __hip_atomic_fetch_max(NRM + ((a * 2 + sq) * 8 + b) * 4 + tid, __float_as_uint(m * 1.0001f), __ATOMIC_RELAXED, __HIP_MEMORY_SCOPE_AGENT); }
    __syncthreads();
}

__device__ __forceinline__ float alibi_slope(int idx  ) { return exp2f(-8.f * (float)idx / 12.f); }

__device__ __forceinline__ void p0_adaln(const Args& A, LAS unsigned char* lds, int G) {
    int tid_l = threadIdx.x; asm volatile("" : "+v"(tid_l)); const int tid = tid_l, lane = tid & 63, wid = __builtin_amdgcn_readfirstlane(tid >> 6);
    LAS float* cact = (LAS float*)lds;
    LAS float* red = (LAS float*)(lds + 32768);
    float* MOD = (float*)(A.ws + WS_MOD);
    if ((int)blockIdx.x < 192) {
        for (int i = tid; i < 8192; i += 512) { const int bb = i >> 10, k = i & 1023; const float v = A.c[i]; cact[k * 8 + bb] = v / (1.f + __expf(-v)); }
        __syncthreads();
        for (int u = blockIdx.x; u < 192; u += G) {
            const int l = u / 96, n0 = (u % 96) * 64;
            const float* wp = A.w_ada + ((size_t)l * 1024 + 128 * wid) * 6144 + n0 + lane;
            float acc[8];
#pragma unroll
            for (int bb = 0; bb < 8; ++bb) acc[bb] = 0.f;
#pragma unroll 16
            for (int k = 0; k < 128; ++k) {
                const float wv = wp[(size_t)k * 6144];
                const f32x4 c0 = *(LAS const f32x4*)(cact + (128 * wid + k) * 8), c1 = *(LAS const f32x4*)(cact + (128 * wid + k) * 8 + 4);
                acc[0] += c0[0] * wv; acc[1] += c0[1] * wv; acc[2] += c0[2] * wv; acc[3] += c0[3] * wv;
                acc[4] += c1[0] * wv; acc[5] += c1[1] * wv; acc[6] += c1[2] * wv; acc[7] += c1[3] * wv;
            }
#pragma unroll
            for (int bb = 0; bb < 8; ++bb) red[(wid * 8 + bb) * 64 + lane] = acc[bb];
            __syncthreads();
            { const int bb = wid; float s = A.b_ada[(size_t)l * 6144 + n0 + lane];
#pragma unroll
                for (int w2 = 0; w2 < 8; ++w2) s += red[(w2 * 8 + bb) * 64 + lane];
                MOD[((size_t)l * 8 + bb) * 6144 + n0 + lane] = s; }
            __syncthreads();
        }
    }
    __syncthreads();
}
__device__ __forceinline__ void p0_weights(const Args& A, LAS unsigned char* lds, int vcu, int G, int l0, int l1) {
    int tid_l = threadIdx.x; asm volatile("" : "+v"(tid_l)); const int tid = tid_l, lane = tid & 63, wid = __builtin_amdgcn_readfirstlane(tid >> 6);
    unsigned char* ws = A.ws;
    LAS float* scr = (LAS float*)(lds + wid * 16384);
    const int gw = vcu * NWAVES + wid, NGW = G * NWAVES;
    constexpr int I_IN = 16 * (NPROJ_PAD / 32), I_G1 = 16 * 32, I_BR1 = 4 * 32, I_OUT = 16 * 32, I_F1 = 16 * 128, I_F2 = 64 * 32;
    constexpr int I_LAYER = I_IN + 4 * I_G1 + 4 * I_BR1 + I_OUT + I_F1 + I_F2;
    for (int it = l0 * I_LAYER + gw; it < l1 * I_LAYER; it += NGW) {
        const int l = it / I_LAYER; int r = it % I_LAYER;
        bf16* WL = (bf16*)(ws + WS_W) + (size_t)l * W_LAYER;
        if (r < I_IN) {
            const int nb = r % (NPROJ_PAD / 32), tile = nb >> 3;
            const int i7 = (tile == 0) ? 0 : (tile == 1) ? 1 : (tile == 3) ? 2 : (tile == 4) ? 3 : (tile == 7) ? 4 : (tile == 8) ? 5 : (tile == 10) ? 6 : -1;
            if (i7 >= 0) p0_transpose_item(A.w_in + (size_t)l * DM * NPROJ, DM, NPROJ, NPROJ_PAD, WL + W_IN + (ptrdiff_t)(i7 - tile) * 256 * DM, 0, 0, scr, r, lane);
            else { const int i4 = (tile == 2) ? 0 : (tile == 5) ? 1 : (tile == 6) ? 2 : 3;
                p0_transpose_item(A.w_in + (size_t)l * DM * NPROJ, DM, NPROJ, NPROJ_PAD, (bf16*)((unsigned char*)(WL + W_IN + (size_t)7 * 256 * DM) + (ptrdiff_t)(i4 - tile) * 256 * DM), 4, 0, scr, r, lane); }
            continue; } r -= I_IN;
        if (r < 4 * I_G1) { const int br = r / I_G1; p0_transpose_item(A.w_gate + ((size_t)l * 4 + br) * DM * DM, DM, DM, DM, WL + W_GATE, 2, br, scr, r % I_G1, lane); continue; } r -= 4 * I_G1;
        if (r < 4 * I_BR1) { const int br = r / I_BR1; p0_transpose_item(A.w_branch + ((size_t)l * 4 + br) * 256 * DM, 256, DM, DM, WL + W_BR + (size_t)br * DM * 256, 0, 0, scr, r % I_BR1, lane); continue; } r -= 4 * I_BR1;
        if (r < I_OUT) { p0_transpose_item(A.w_out + (size_t)l * DM * DM, DM, DM, DM, WL + W_OUT, 0, 0, scr, r, lane); continue; } r -= I_OUT;
        if (r < I_F1) { p0_transpose_item(A.w_ff1 + (size_t)l * DM * FF, DM, FF, FF, WL + W_FF1, 0, 0, scr, r, lane); continue; } r -= I_F1;
        p0_transpose_item(A.w_ff2 + (size_t)l * FF * DM, FF, DM, DM, WL + W_FF2, 3, 0, scr, r, lane);
    }
    __syncthreads();
}

__device__ __forceinline__ int wq_draw(gu32* ctr) { int v = 0; if (threadIdx.x == 0) v = (int)__hip_atomic_fetch_add(ctr, 1u, RLX_AGENT); return v; }
__device__ __forceinline__ int wq_bcast(volatile LAS unsigned* slot, int v) {
    if (threadIdx.x == 0) *slot = (unsigned)v;
    __syncthreads();
    const int item = (int)*slot;
    __syncthreads();
    return item;
}

#ifndef ZG_ALIGN
#define ZG_ALIGN true
#define ZG_SP2 false
#endif
#ifndef IN_ALIGN
#define IN_ALIGN true
#define IN_SP2 true
#endif
#ifndef GT_ALIGN
#define GT_ALIGN true
#define GT_SP2 true
#endif
#ifndef WO_ALIGN
#define WO_ALIGN true
#define WO_SP2 true
#endif
#ifndef F1_ALIGN
#define F1_ALIGN true
#define F1_SP2 true
#endif
#ifndef F2_ALIGN
#define F2_ALIGN true
#define F2_SP2 true
#endif
struct ZOrder {
    pg8::StaticOrder base;
    __device__ __forceinline__ bool next(int i, pg8::Unit& u) const { if (!base.next(i, u)) return false; u.pn += 4 * (u.pm >> 7); return true; }
    __device__ __forceinline__ void a_ready(const pg8::Unit&) const {}
    __device__ __forceinline__ void done(const pg8::Unit&) const {}
};

__global__ void __launch_bounds__(NWAVES * 64, 2) hybrid_fwd(Args args) {
    extern __shared__ __attribute__((aligned(16))) unsigned char lds_raw[];
    LAS unsigned char* lds = (LAS unsigned char*)lds_raw;
#define PHASE_IDS int tid_p = threadIdx.x; asm volatile("" : "+v"(tid_p)); const int lane = tid_p & 63, wid = __builtin_amdgcn_readfirstlane(tid_p >> 6); const int gw = vcu * NWAVES + wid, ngw = G * NWAVES; (void)lane; (void)gw; (void)ngw;
    const int G = gridDim.x; const int bx = blockIdx.x; const int vcu = (G % 8 == 0) ? (bx % 8) * (G / 8) + bx / 8 : bx;
    unsigned char* ws = args.ws;
    gu32* ctl = (gu32*)(ws + WS_CTL);
    volatile LAS unsigned* MISC = (volatile LAS unsigned*)(lds + LDSCTL_OFF);
    for (int u = threadIdx.x; u < (LDS_BYTES - LDSCTL_OFF) / 4; u += NWAVES * 64) ((LAS unsigned*)(lds + LDSCTL_OFF))[u] = 0u;
    __syncthreads();
    const int lo = args.ph_lo, hi = args.ph_hi;
    XcdBarrier bar; bar.bar = (unsigned*)(ctl + CW_BAR) + args.li * XCD_BAR_WORDS; bar.x = 0; bar.st = nullptr;
    if (hi - lo > 1) bar = xcd_barrier_post((unsigned*)(ctl + CW_BAR) + args.li * XCD_BAR_WORDS, MISC + 8);
#ifndef PHASE_OFF
#define PHASE_OFF 0
#endif
#define IN(k) (lo <= (k) && (k) < hi && !((PHASE_OFF >> ((k) == 0 ? 0 : (k) == 21 ? 11 : (((k) - 1) % 10) + 1)) & 1))
#ifndef REPEAT_MASK
#define REPEAT_MASK 0
#endif
#define NREP(bit) (((REPEAT_MASK >> (bit)) & 1) ? 2 : 1)
#if defined(PROBE_SEAM2X)
#define SEAM(k) do { if (IN(k) && IN((k) + 1)) { xcd_barrier(bar); xcd_barrier(bar); } } while (0)
#else
#define SEAM(k) do { if (IN(k) && IN((k) + 1)) xcd_barrier(bar); } while (0)
#endif
    float* MOD = (float*)(ws + WS_MOD);
    float* KMEAN = (float*)(ws + WS_KMEAN);
    int* REFPOS = (int*)(ws + WS_KMEAN + 128 * 1024);
    int* REFMIN = (int*)(ws + WS_KMEAN + 256 * 1024);
    unsigned* MASK = (unsigned*)(ws + WS_MASK);
    bf16* H = (bf16*)(ws + WS_H);
    unsigned char* H8 = ws + WS_H8;
    bf16* Y = (bf16*)(ws + WS_Y);
    bf16* MERGED = (bf16*)(ws + WS_Y);
    bf16* PROJ = (bf16*)(ws + WS_R);
    unsigned char* Z = ws + WS_R;
    unsigned char* U8 = ws + WS_R;
    bf16* XRB = (bf16*)args.out;
    constexpr size_t TS = (size_t)TOK * 256;
    volatile LAS unsigned* wqslot = MISC + 16;

    if (IN(0)) for (int rep = 0; rep < NREP(0); ++rep) { p0_adaln(args, lds, G); }
    SEAM(0);

#pragma nounroll
    for (int l = 0; l < NL; ++l) {
        const int pb = 1 + 10 * l;
        const float* modl = MOD + (size_t)l * 8 * 6144;
        const bf16* WL = (const bf16*)(ws + WS_W) + (size_t)l * W_LAYER;
        if (IN(pb + 0)) for (int rep = 0; rep < NREP(1); ++rep) { PHASE_IDS if (l == 0) norm_rows_bf16<false>(lds, args.x, H, H8, args.norm1_g + (size_t)l * DM, modl, 0, 1, gw, ngw, lane); else norm_rows_bf16<true>(lds, XRB, H, H8, args.norm1_g + (size_t)l * DM, modl, 0, 1, gw, ngw, lane); if (l == 0) p0_weights(args, lds, vcu, G, 0, 1); }
        SEAM(pb + 0);
        if (IN(pb + 1)) for (int rep = 0; rep < NREP(2); ++rep) {
            { int k8 = DM / 2; asm volatile("" : "+s"(k8));
              pg8::Gemm g{(const bf16*)H8, (const bf16*)((const unsigned char*)(WL + W_IN + (size_t)7 * 256 * DM)), TOK, 1024, k8}; pg8::StaticOrder S; S.init(TOK, 1024, G, bx);
              pg8::EpiProj<true> E{PROJ, TS};
              pg8::gemm_phase<pg8::EpiProj<true>, pg8::StaticOrder, IN_ALIGN, IN_SP2, true>(lds, g, S, E); }
            { pg8::Gemm g{H, WL + W_IN, TOK, 1792, DM}; pg8::StaticOrder S; S.init(TOK, 1792, G, bx);
              pg8::EpiProj<false> E{PROJ, TS};
              pg8::gemm_phase<pg8::EpiProj<false>, pg8::StaticOrder, IN_ALIGN, IN_SP2>(lds, g, S, E); }
            if (l == 0 && rep == 0 && bx >= 128) p0_weights(args, lds, bx - 128, G - 128, 1, 2);
        }
        SEAM(pb + 1);
        unsigned* NRM = (unsigned*)(ctl + CW_NRM) + l * 192;
        if (IN(pb + 2)) for (int rep = 0; rep < NREP(3); ++rep) {
            gu32* ctr = ctl + CW_WQ + (l * 2 + 0 + 4 * rep) * 64;
            int raw = wq_draw(ctr);
            for (;;) {
#ifndef REPA_LO
#define REPA_LO 0
#define REPA_HI 2368
#endif
                const int item = wq_bcast(wqslot, raw) + (rep ? REPA_LO : 0);
                if (item >= (rep ? REPA_HI : 2368)) break;
                raw = wq_draw(ctr);
                if (item < 1024) { const int qg = 127 - (item >> 3), b = item & 7;
                    dsa_select_unit(lds, b, qg, PROJ + 10 * TS, MASK, REFPOS, REFMIN);
                } else if (item < 1536) { const int i2 = item - 1024; const int b = i2 >> 6, tile = i2 & 63;
                    pool_unit(lds, b, tile, PROJ + 6 * TS, args.w_pool + (size_t)l * 4 * 4096, args.pool_scale + (size_t)l * 256, Y + 2 * TS);
                } else if (item < 1600) { PHASE_IDS kmean_item(item - 1536, PROJ + 1 * TS, KMEAN, wid, lane);
                } else { norm_unit(lds, item - 1600, PROJ, TS, NRM); }
            }
        }
        SEAM(pb + 2);
        if (IN(pb + 3)) for (int rep = 0; rep < NREP(4); ++rep) {
            gu32* ctr = ctl + CW_WQ + 512 + ((l * 2 + rep) * 8) * 64;
            const float li = 0.8f - 0.6f * __expf(-0.3f * (float)l);
            const float* dl = args.diff_lambda + (size_t)l * 128;
            float d1 = 0.f, d2 = 0.f;
            for (int i = 0; i < 32; ++i) { d1 += dl[i] * dl[32 + i]; d2 += dl[64 + i] * dl[96 + i]; }
            const float lam = __expf(d1) - __expf(d2) + li;
            int raw = wq_draw(ctr);
            for (;;) {
                const int item = wq_bcast(wqslot, raw);
                if (item >= 1536) break;
                raw = wq_draw(ctr);
                const int ty = item % 3, rest = item / 3; const int qb = 15 - (rest >> 5), bh = rest & 31, b = bh >> 2, h = bh & 3;
                if (ty == 0) attn_unit<1>(lds, b, h, qb, PROJ + 3 * TS, PROJ + 4 * TS, PROJ + 5 * TS, Y + 1 * TS, alibi_slope(3 * h + 2), nullptr, lam, 1.f - li, args.diff_subln_g + (size_t)l * 64, nullptr, NRM + 64, nullptr, nullptr);
                else if (ty == 1) attn_unit<0>(lds, b, h, qb, PROJ + 0 * TS, PROJ + 1 * TS, PROJ + 2 * TS, Y + 0 * TS, alibi_slope(3 * h + 1), KMEAN, 0.f, 0.f, nullptr, nullptr, NRM, nullptr, nullptr);
                else              attn_unit<2>(lds, b, h, qb, PROJ + 7 * TS, PROJ + 8 * TS, PROJ + 9 * TS, Y + 3 * TS, alibi_slope(3 * h + 3), nullptr, 0.f, 0.f, nullptr, MASK, NRM + 128, REFPOS, REFMIN);
            }
        }
        SEAM(pb + 3);
        if (IN(pb + 4)) for (int rep = 0; rep < NREP(5); ++rep) {
            int kz = 256; asm volatile("" : "+s"(kz)); pg8::Gemm g{Y, WL + W_BR, 4 * TOK, 4096, kz}; ZOrder S; S.base.init(4 * TOK, DM, G, bx);
            pg8::EpiZ E{Z};
            pg8::gemm_phase<pg8::EpiZ, ZOrder, ZG_ALIGN, ZG_SP2>(lds, g, S, E);
        }
        SEAM(pb + 4);
        if (IN(pb + 5)) for (int rep = 0; rep < NREP(6); ++rep) {
            int kg = DM / 2; asm volatile("" : "+s"(kg));
            pg8::Gemm g{(const bf16*)H8, WL + W_GATE, TOK, 4096, kg}; pg8::StaticOrder S; S.init(TOK, 4096, G, bx);
            pg8::EpiGate E{Z, args.b_gate + (size_t)l * 4 * DM, MERGED};
            pg8::gemm_phase<pg8::EpiGate, pg8::StaticOrder, GT_ALIGN, GT_SP2, true>(lds, g, S, E);
        }
        SEAM(pb + 5);
        if (IN(pb + 6)) for (int rep = 0; rep < NREP(7); ++rep) {
            pg8::Gemm g{MERGED, WL + W_OUT, TOK, DM, DM}; pg8::StaticOrder S; S.init(TOK, DM, G, bx);
            if (l == 0) { pg8::EpiResid<false> E{args.x, rep ? (bf16*)(ws + WS_R) : XRB, modl + 2 * 1024, 1.f};
                pg8::gemm_phase<pg8::EpiResid<false>, pg8::StaticOrder, WO_ALIGN, WO_SP2>(lds, g, S, E); }
            else { pg8::EpiResid<true> E{XRB, rep ? (bf16*)(ws + WS_R) : XRB, modl + 2 * 1024, 1.f};
                pg8::gemm_phase<pg8::EpiResid<true>, pg8::StaticOrder, WO_ALIGN, WO_SP2>(lds, g, S, E); }
        }
        SEAM(pb + 6);
        if (IN(pb + 7)) for (int rep = 0; rep < NREP(8); ++rep) { PHASE_IDS norm_rows_bf16<true>(lds, XRB, H, nullptr, args.norm2_g + (size_t)l * DM, modl, 3, 4, gw, ngw, lane); }
        SEAM(pb + 7);
        if (IN(pb + 8)) for (int rep = 0; rep < NREP(9); ++rep) {
            pg8::Gemm g{H, WL + W_FF1, TOK, FF, DM}; pg8::StaticOrder S; S.init(TOK, FF, G, bx);
            pg8::EpiRelu2 E{U8, FF};
            pg8::gemm_phase<pg8::EpiRelu2, pg8::StaticOrder, F1_ALIGN, F1_SP2>(lds, g, S, E);
        }
        SEAM(pb + 8);
        if (IN(pb + 9)) for (int rep = 0; rep < NREP(10); ++rep) {
            int kf = FF / 2; asm volatile("" : "+s"(kf));
            pg8::Gemm g{(const bf16*)U8, WL + W_FF2, TOK, DM, kf}; pg8::StaticOrder S; S.init(TOK, DM, G, bx);
            pg8::EpiResid<true> E{XRB, rep ? (bf16*)(ws + WS_MASK) : XRB, modl + 5 * 1024, 1.f / 64.f};
            pg8::gemm_phase<pg8::EpiResid<true>, pg8::StaticOrder, F2_ALIGN, F2_SP2, true>(lds, g, S, E);
        }
        SEAM(pb + 9);
    }
    if (IN(21)) {
        PHASE_IDS
        v4u xa[16], xb[16]; float rs[16];
        const v4u* xp = (const v4u*)(XRB + (size_t)gw * DM) + 2 * lane;
#pragma unroll
        for (int i = 0; i < 16; ++i) { xa[i] = xp[(size_t)i * ngw * (DM / 8)]; xb[i] = xp[(size_t)i * ngw * (DM / 8) + 1]; }
#pragma unroll
        for (int i = 0; i < 16; ++i) { const v4u a = xa[i], c = xb[i];
            float s = bflo(a.x) * bflo(a.x); s += bfhi(a.x) * bfhi(a.x); s += bflo(a.y) * bflo(a.y); s += bfhi(a.y) * bfhi(a.y); s += bflo(a.z) * bflo(a.z); s += bfhi(a.z) * bfhi(a.z); s += bflo(a.w) * bflo(a.w); s += bfhi(a.w) * bfhi(a.w);
            s += bflo(c.x) * bflo(c.x); s += bfhi(c.x) * bfhi(c.x); s += bflo(c.y) * bflo(c.y); s += bfhi(c.y) * bfhi(c.y); s += bflo(c.z) * bflo(c.z); s += bfhi(c.z) * bfhi(c.z); s += bflo(c.w) * bflo(c.w); s += bfhi(c.w) * bfhi(c.w);
            rs[i] = 1.f / sqrtf(wave_sum(s, lane) * (1.f / DM) + NORM_EPS); }
        xcd_barrier(bar);
#pragma unroll
        for (int i = 0; i < 16; ++i) asm volatile("" : "+v"(xa[i]), "+v"(xb[i]));
        const f32x4* gp = (const f32x4*)args.final_g + 4 * lane;
        f32x4* op = (f32x4*)(args.out + (size_t)gw * DM) + 4 * lane;
#pragma unroll
        for (int i = 0; i < 16; ++i) { const v4u a = xa[i], c = xb[i]; const float r = rs[i]; f32x4* o = op + (size_t)i * ngw * (DM / 4);
            o[0] = (f32x4){bflo(a.x), bfhi(a.x), bflo(a.y), bfhi(a.y)} * r * gp[0]; o[1] = (f32x4){bflo(a.z), bfhi(a.z), bflo(a.w), bfhi(a.w)} * r * gp[1];
            o[2] = (f32x4){bflo(c.x), bfhi(c.x), bflo(c.y), bfhi(c.y)} * r * gp[2]; o[3] = (f32x4){bflo(c.z), bfhi(c.z), bflo(c.w), bfhi(c.w)} * r * gp[3]; }
    }
#undef IN
#undef SEAM
}

#ifndef MK_SPLIT
#define MK_SPLIT 0
#endif
extern "C" void kernel_launch(void* const* d_in, const int* in_sizes, int n_in, void* d_out, int out_size, void* d_ws, size_t ws_size, hipStream_t stream) {
    static int grid = 0;
    if (grid == 0) {
        if (n_in != 18 || in_sizes[0] != TOK * DM || out_size != TOK * DM || ws_size < WS_END) { fprintf(stderr, "kernel_launch: unexpected shapes (n_in %d, in0 %d, out %d, ws %zu)\n", n_in, n_in > 0 ? in_sizes[0] : -1, out_size, ws_size); grid = -1; return; }
        int dev = 0, cus = 0, per_cu = 0;
        if (hipGetDevice(&dev) != hipSuccess || hipDeviceGetAttribute(&cus, hipDeviceAttributeMultiprocessorCount, dev) != hipSuccess) { grid = -1; return; }
        if (hipFuncSetAttribute((const void*)hybrid_fwd, hipFuncAttributeMaxDynamicSharedMemorySize, LDS_BYTES) != hipSuccess) { fprintf(stderr, "kernel_launch: hipFuncSetAttribute failed\n"); grid = -1; return; }
        if (hipOccupancyMaxActiveBlocksPerMultiprocessor(&per_cu, (const void*)hybrid_fwd, NWAVES * 64, LDS_BYTES) != hipSuccess || per_cu < 1) fprintf(stderr, "kernel_launch: occupancy query reports %d\n", per_cu);
        (void)hipGetLastError();
        grid = cus;
        if (cus != 256) { fprintf(stderr, "kernel_launch: built for 256 CUs (the final norm stages 16 rows per wave), found %d\n", cus); grid = -1; return; }
    }
    if (grid < 0) return;
    if (hipMemsetAsync((char*)d_ws + WS_CTL, 0, CTL_ZERO_BYTES, stream) != hipSuccess) return;
    Args a{};
    const float** ap = (const float**)&a;
    for (int i = 0; i < 18; ++i) ap[i] = (const float*)d_in[i];
    a.out = (float*)d_out; a.ws = (unsigned char*)d_ws; a.pad = 0;
#if MK_SPLIT
    for (int p = 0; p < NPHASE; ++p) { a.ph_lo = p; a.ph_hi = p + 1; a.li = 0;
        hipLaunchKernelGGL(hybrid_fwd, dim3(grid), dim3(NWAVES * 64), LDS_BYTES, stream, a); }
#else
    a.ph_lo = 0; a.ph_hi = NPHASE; a.li = 0;
    hipLaunchKernelGGL(hybrid_fwd, dim3(grid), dim3(NWAVES * 64), LDS_BYTES, stream, a);
#endif
}
```

```cpp
#include <hip/hip_runtime.h>
#include <cstdio>
#include <cstdint>
namespace pg8 {
#define PG8_LAS __attribute__((address_space(3)))
typedef unsigned short bf16_t;
typedef short bf16x8 __attribute__((ext_vector_type(8)));
typedef float f32x4 __attribute__((ext_vector_type(4)));
typedef unsigned u32x4 __attribute__((ext_vector_type(4)));
constexpr int BM = 256, BK = 64, HALF = 128, HTB = HALF * BK * 2  , STAGE_BYTES = 8 * HTB, NXCD = 8, WGM = 8;

__host__ __device__ __forceinline__ int lds_byte(int r, int c) { const int st = (r >> 4) * 2 + (c >> 5), rr = r & 15, cc = c & 31, ob = rr * 64 + cc * 2; return st * 1024 + (ob ^ (((ob >> 9) & 1) << 5)); }
__host__ __device__ __forceinline__ void stage_rc(int b, int& R, int& C) { const int st = b / 1024, sb = b % 1024, swz = sb ^ (((sb >> 9) & 1) << 5); R = (st >> 1) * 16 + swz / 64; C = (st & 1) * 32 + (swz % 64) / 2; }
__host__ __device__ __forceinline__ int perm32(int rho) { const int n = rho >> 4, i = rho & 15; return 8 * (i >> 2) + 4 * n + (i & 3); }

struct Unit { int pm, pn; };
struct Gemm { const bf16_t* A; const bf16_t* Bt; int M, N, K; };

struct StaticOrder {
    int nM, nN, nwg, G, c;
    __host__ __device__ void init(int M, int N, int G_, int c_) { nM = M / BM; nN = N / BM; nwg = nM * nN; G = G_; c = c_; }
    __host__ __device__ bool next(int i, Unit& u) const {
        const long L = (long)i * G + c; if (L >= nwg) return false;
        int wgid = (int)L; { const int q = nwg / NXCD, r = nwg % NXCD, xcd = wgid % NXCD, off = wgid / NXCD; wgid = (xcd < r ? xcd * (q + 1) : r * (q + 1) + (xcd - r) * q) + off; }
        const int nig = WGM * nN, gid = wgid / nig, fm = gid * WGM, gsz = (nM - fm) < WGM ? (nM - fm) : WGM;
        u.pm = fm + ((wgid % nig) % gsz); u.pn = (wgid % nig) / gsz; return true;
    }
    __device__ __forceinline__ void a_ready(const Unit&) const {}
    __device__ __forceinline__ void done(const Unit&) const {}
};

__device__ __forceinline__ unsigned cvt_pk_bf16(float lo, float hi) { unsigned r; asm volatile("v_cvt_pk_bf16_f32 %0, %1, %2" : "=v"(r) : "v"(lo), "v"(hi)); return r; }
typedef unsigned u32x2 __attribute__((ext_vector_type(2)));
constexpr int TT = 32768;
constexpr float QS64 = 0.125f * 1.4426950408889634f;
constexpr float QS32 = 0.17677669529663687f * 1.4426950408889634f;

template <bool F8> struct EpiProj {
    static constexpr bool PERM = true, AFTER_DRAIN = false;
    bf16_t* O; size_t tile_stride;
    __device__ __forceinline__ void operator()(const f32x4 (&acc)[2][2][4][2], const Unit& u, int wr, int wc, int fr, int fq) const {
        const int row0 = u.pm * BM + wr * 64 + fr;
        int tile; float sc = 1.f;
        if (F8) { tile = (u.pn == 0) ? 2 : (u.pn == 1) ? 5 : (u.pn == 2) ? 6 : 9; sc = 1.f / 32.f; }
        else { tile = (u.pn == 0) ? 0 : (u.pn == 1) ? 1 : (u.pn == 2) ? 3 : (u.pn == 3) ? 4 : (u.pn == 4) ? 7 : (u.pn == 5) ? 8 : 10;
               if (tile == 0 || tile == 7) sc = QS64; else if (tile == 3) sc = QS32; }
        bf16_t* base = O + (size_t)tile * tile_stride;
        const int col0 = wc * 32 + 8 * fq;
#pragma unroll
        for (int ai = 0; ai < 2; ++ai)
#pragma unroll
            for (int m = 0; m < 4; ++m) { bf16_t* rowp = base + (size_t)(row0 + ai * HALF + m * 16) * 256 + col0;
#pragma unroll
                for (int bj = 0; bj < 2; ++bj) { const f32x4 v0 = acc[ai][bj][m][0] * sc, v1 = acc[ai][bj][m][1] * sc;
                    u32x4 w; w.x = cvt_pk_bf16(v0[0], v0[1]); w.y = cvt_pk_bf16(v0[2], v0[3]); w.z = cvt_pk_bf16(v1[0], v1[1]); w.w = cvt_pk_bf16(v1[2], v1[3]);
                    *(u32x4*)(rowp + bj * HALF) = w; } }
    }
};
struct EpiZ {
    static constexpr bool PERM = true, AFTER_DRAIN = false;
    unsigned char* O;
    __device__ __forceinline__ void operator()(const f32x4 (&acc)[2][2][4][2], const Unit& u, int wr, int wc, int fr, int fq) const {
        const int row0 = u.pm * BM + wr * 64 + fr; const int col0 = (u.pn & 3) * BM + wc * 32 + 8 * fq;
#pragma unroll
        for (int ai = 0; ai < 2; ++ai)
#pragma unroll
            for (int m = 0; m < 4; ++m) { unsigned char* rowp = O + (size_t)(row0 + ai * HALF + m * 16) * 1024 + col0;
#pragma unroll
                for (int bj = 0; bj < 2; ++bj) { const f32x4 v0 = acc[ai][bj][m][0], v1 = acc[ai][bj][m][1];
                    int w0 = __builtin_amdgcn_cvt_pk_fp8_f32(v0[0], v0[1], 0, false); w0 = __builtin_amdgcn_cvt_pk_fp8_f32(v0[2], v0[3], w0, true);
                    int w1 = __builtin_amdgcn_cvt_pk_fp8_f32(v1[0], v1[1], 0, false); w1 = __builtin_amdgcn_cvt_pk_fp8_f32(v1[2], v1[3], w1, true);
                    u32x2 w; w.x = (unsigned)w0; w.y = (unsigned)w1;
                    *(u32x2*)(rowp + bj * HALF) = w; } }
    }
};
struct EpiRelu2 {
    static constexpr bool PERM = true, AFTER_DRAIN = false;
    unsigned char* O; int ldc;
    __device__ __forceinline__ void operator()(const f32x4 (&acc)[2][2][4][2], const Unit& u, int wr, int wc, int fr, int fq) const {
        const int row0 = u.pm * BM + wr * 64 + fr; const int col0 = u.pn * BM + wc * 32 + 8 * fq;
#pragma unroll
        for (int ai = 0; ai < 2; ++ai)
#pragma unroll
            for (int m = 0; m < 4; ++m) { unsigned char* rowp = O + (size_t)(row0 + ai * HALF + m * 16) * ldc + col0;
#pragma unroll
                for (int bj = 0; bj < 2; ++bj) { f32x4 v0 = acc[ai][bj][m][0], v1 = acc[ai][bj][m][1];
#pragma unroll
                    for (int j = 0; j < 4; ++j) { const float a = fmaxf(v0[j], 0.f), b = fmaxf(v1[j], 0.f); v0[j] = a * a; v1[j] = b * b; }
                    int w0 = __builtin_amdgcn_cvt_pk_fp8_f32(v0[0], v0[1], 0, false); w0 = __builtin_amdgcn_cvt_pk_fp8_f32(v0[2], v0[3], w0, true);
                    int w1 = __builtin_amdgcn_cvt_pk_fp8_f32(v1[0], v1[1], 0, false); w1 = __builtin_amdgcn_cvt_pk_fp8_f32(v1[2], v1[3], w1, true);
                    u32x2 w; w.x = (unsigned)w0; w.y = (unsigned)w1;
                    *(u32x2*)(rowp + bj * HALF) = w; } }
    }
};
template <bool BASE_BF16> struct EpiResid {
    static constexpr bool PERM = true, AFTER_DRAIN = false;
    const void* base; bf16_t* out; const float* gate; float ascale;
    __device__ __forceinline__ void operator()(const f32x4 (&acc)[2][2][4][2], const Unit& u, int wr, int wc, int fr, int fq) const {
        const int row0 = u.pm * BM + wr * 64 + fr; const int col0 = u.pn * BM + wc * 32 + 8 * fq;
        const float* gp = gate + (size_t)(u.pm >> 4) * 6144 + col0;
        f32x4 gv[2][2];
#pragma unroll
        for (int bj = 0; bj < 2; ++bj)
#pragma unroll
            for (int n = 0; n < 2; ++n) gv[bj][n] = *(const f32x4*)(gp + bj * HALF + n * 4) * ascale;
#pragma unroll
        for (int ai = 0; ai < 2; ++ai)
#pragma unroll
            for (int m = 0; m < 4; ++m) { const size_t off = (size_t)(row0 + ai * HALF + m * 16) * 1024 + col0;
#pragma unroll
                for (int bj = 0; bj < 2; ++bj) { f32x4 b0, b1;
                    if (BASE_BF16) { const u32x4 w = *(const u32x4*)((const bf16_t*)base + off + bj * HALF);
                        b0 = (f32x4){__uint_as_float(w.x << 16), __uint_as_float(w.x & 0xffff0000u), __uint_as_float(w.y << 16), __uint_as_float(w.y & 0xffff0000u)};
                        b1 = (f32x4){__uint_as_float(w.z << 16), __uint_as_float(w.z & 0xffff0000u), __uint_as_float(w.w << 16), __uint_as_float(w.w & 0xffff0000u)}; }
                    else { b0 = *(const f32x4*)((const float*)base + off + bj * HALF); b1 = *(const f32x4*)((const float*)base + off + bj * HALF + 4); }
                    const f32x4 v0 = b0 + gv[bj][0] * acc[ai][bj][m][0], v1 = b1 + gv[bj][1] * acc[ai][bj][m][1];
                    u32x4 o; o.x = cvt_pk_bf16(v0[0], v0[1]); o.y = cvt_pk_bf16(v0[2], v0[3]); o.z = cvt_pk_bf16(v1[0], v1[1]); o.w = cvt_pk_bf16(v1[2], v1[3]);
                    *(u32x4*)(out + off + bj * HALF) = o; }
                if (m & 1) asm volatile("" ::: "memory"); }
    }
};
struct EpiGate {
    static constexpr bool PERM = true, AFTER_DRAIN = false;
    const unsigned char* Z; const float* bg; bf16_t* O;
    __device__ __forceinline__ void operator()(const f32x4 (&acc)[2][2][4][2], const Unit& u, int wr, int wc, int fr, int fq) const {
        const int row0 = u.pm * BM + wr * 64 + fr; const int mc0 = u.pn * 64 + wc * 16 + 4 * fq;
#pragma unroll
        for (int ai = 0; ai < 2; ++ai)
#pragma unroll
            for (int m = 0; m < 4; ++m) { const size_t row = (size_t)(row0 + ai * HALF + m * 16);
                f32x4 bv[2][2];
#pragma unroll
                for (int bj = 0; bj < 2; ++bj)
#pragma unroll
                    for (int n = 0; n < 2; ++n) bv[bj][n] = *(const f32x4*)(bg + (2 * bj + n) * 1024 + mc0);
                asm volatile("" ::: "memory");
                f32x4 sum = (f32x4){0.f, 0.f, 0.f, 0.f};
#pragma unroll
                for (int bj = 0; bj < 2; ++bj)
#pragma unroll
                    for (int n = 0; n < 2; ++n) { const int zr = *(const int*)(Z + ((size_t)(2 * bj + n) * TT + row) * 1024 + mc0);
                        const f32x4 x = acc[ai][bj][m][n] * (1.f / 32.f) + bv[bj][n]; f32x4 zz;
                        zz[0] = __builtin_amdgcn_cvt_f32_fp8(zr, 0); zz[1] = __builtin_amdgcn_cvt_f32_fp8(zr, 1); zz[2] = __builtin_amdgcn_cvt_f32_fp8(zr, 2); zz[3] = __builtin_amdgcn_cvt_f32_fp8(zr, 3);
#pragma unroll
                        for (int j = 0; j < 4; ++j) { const float g = __builtin_amdgcn_rcpf(1.f + __builtin_amdgcn_exp2f(-1.4426950408889634f * x[j])); sum[j] += g * zz[j]; } }
                u32x2 w; w.x = cvt_pk_bf16(sum[0], sum[1]); w.y = cvt_pk_bf16(sum[2], sum[3]);
                *(u32x2*)(O + row * 1024 + mc0) = w; }
    }
};
typedef int i32x8 __attribute__((ext_vector_type(8))); typedef int i32x4 __attribute__((ext_vector_type(4)));
__device__ __forceinline__ i32x8 cat16(bf16x8 a, bf16x8 b) { const i32x4 x = __builtin_bit_cast(i32x4, a), y = __builtin_bit_cast(i32x4, b); return __builtin_shufflevector(x, y, 0, 1, 2, 3, 4, 5, 6, 7); }
template <class Epi, class Sched, bool ALIGN_EPI = false, bool SP2 = false, bool FP8 = false>
__device__ __forceinline__ void gemm_phase(PG8_LAS unsigned char* lds, const Gemm g, const Sched& S, const Epi& E) {
    int tid_l = threadIdx.x; asm volatile("" : "+v"(tid_l)); const int tid = tid_l, wid = __builtin_amdgcn_readfirstlane(tid >> 6), lane = tid & 63, wr = wid >> 2, wc = wid & 3, fr = lane & 15, fq = lane >> 4;
    const int K = g.K, nt = K / BK;
    unsigned voffA[2], voffB[2];
#pragma unroll
    for (int i = 0; i < 2; ++i) { int R, C; stage_rc(tid * 16 + i * 8192, R, C); const int Rb = Epi::PERM ? ((R & ~31) + perm32(R & 31)) : R;
        voffA[i] = (unsigned)(R * K + C) * 2u; voffB[i] = (unsigned)(Rb * K + C) * 2u; }
    const size_t kstep = (size_t)(BK * 2);
    const size_t hstep = (size_t)HALF * K * 2;
    const size_t tstep = 2 * hstep;
    const unsigned ldsw = (unsigned)wid * 1024u;
    const int aoff = lds_byte(wr * 64 + fr, fq * 8), boff = lds_byte(wc * 32 + fr, fq * 8);
#define PG8_SA(b, h) (((b) * 2 + (h)) * HTB)
#define PG8_SB(b, h) ((4 + (b) * 2 + (h)) * HTB)
#define PG8_STAGE(bufoff, gbase, voff) do { _Pragma("unroll") for (int _i = 0; _i < 2; ++_i) \
        __builtin_amdgcn_global_load_lds((const unsigned*)((const char*)(gbase) + (voff)[_i]), (PG8_LAS unsigned*)(lds + (bufoff) + ldsw + _i * 8192), 16, 0, 0); } while (0)
#define PG8_LDA(dst, b, h) do { _Pragma("unroll") for (int m = 0; m < 4; ++m) _Pragma("unroll") for (int k = 0; k < 2; ++k) dst[m][k] = *(const PG8_LAS bf16x8*)(lds + PG8_SA(b, h) + aoff + m * 2048 + k * 1024); } while (0)
#define PG8_LDB(dst, b, h) do { _Pragma("unroll") for (int n = 0; n < 2; ++n) _Pragma("unroll") for (int k = 0; k < 2; ++k) dst[n][k] = *(const PG8_LAS bf16x8*)(lds + PG8_SB(b, h) + boff + n * 2048 + k * 1024); } while (0)
#define PG8_MMA(ai, bj, At, Bt) do { __builtin_amdgcn_s_setprio(1); _Pragma("unroll") for (int m = 0; m < 4; ++m) _Pragma("unroll") for (int n = 0; n < 2; ++n) { \
        if constexpr (FP8) { const i32x8 b8_ = cat16(Bt[n][0], Bt[n][1]), a8_ = cat16(At[m][0], At[m][1]); \
            asm volatile("v_mfma_scale_f32_16x16x128_f8f6f4 %0, %1, %2, %0, %3, %3 op_sel_hi:[0,0,0]" : "+v"(acc[ai][bj][m][n]) : "v"(b8_), "v"(a8_), "v"(sc127)); } \
        else { _Pragma("unroll") for (int k = 0; k < 2; ++k) acc[ai][bj][m][n] = __builtin_amdgcn_mfma_f32_16x16x32_bf16(Bt[n][k], At[m][k], acc[ai][bj][m][n], 0, 0, 0); } } \
        __builtin_amdgcn_s_setprio(0); } while (0)
#define PG8_WAIT_V(n) asm volatile("s_waitcnt vmcnt(" #n ")" ::: "memory")
#define PG8_WAIT_L(n) asm volatile("s_waitcnt lgkmcnt(" #n ")" ::: "memory")
#define PG8_BAR __builtin_amdgcn_s_barrier()
#define PG8_SCHED __builtin_amdgcn_sched_barrier(0)
    Unit cur, nxt; int ui = 0;
    int sc127 = 127; asm volatile("" : "+v"(sc127));
    if (!S.next(0, cur)) return;
    f32x4 acc[2][2][4][2];
#pragma unroll
    for (int a = 0; a < 2; ++a)
#pragma unroll
        for (int b = 0; b < 2; ++b)
#pragma unroll
            for (int m = 0; m < 4; ++m)
#pragma unroll
                for (int n = 0; n < 2; ++n) acc[a][b][m][n] = (f32x4){0.f, 0.f, 0.f, 0.f};
    bf16x8 At[4][2], B0[2][2], B1[2][2];
    const char* cA = (const char*)g.A + (size_t)cur.pm * tstep; const char* cB = (const char*)g.Bt + (size_t)cur.pn * tstep;
    S.a_ready(cur);
    if constexpr (SP2) {
        PG8_STAGE(PG8_SB(0, 0), cB, voffB); PG8_STAGE(PG8_SB(0, 1), cB + hstep, voffB); PG8_STAGE(PG8_SA(0, 0), cA, voffA); PG8_STAGE(PG8_SA(0, 1), cA + hstep, voffA);
        if (wr == 1) PG8_BAR;
        PG8_WAIT_V(2); PG8_BAR;
        PG8_STAGE(PG8_SB(1, 0), cB + kstep, voffB); PG8_STAGE(PG8_SA(1, 0), cA + kstep, voffA); PG8_STAGE(PG8_SB(1, 1), cB + hstep + kstep, voffB);
        PG8_WAIT_V(6); PG8_BAR;
    } else {
        PG8_STAGE(PG8_SB(0, 0), cB, voffB); PG8_STAGE(PG8_SA(0, 0), cA, voffA); PG8_STAGE(PG8_SB(0, 1), cB + hstep, voffB); PG8_STAGE(PG8_SA(0, 1), cA + hstep, voffA);
        if (wr == 1) PG8_BAR;
        PG8_WAIT_V(4); PG8_BAR;
        PG8_STAGE(PG8_SB(1, 0), cB + kstep, voffB); PG8_STAGE(PG8_SA(1, 0), cA + kstep, voffA); PG8_STAGE(PG8_SB(1, 1), cB + hstep + kstep, voffB);
        PG8_WAIT_V(6); PG8_BAR;
    }
    for (;;) {
        const bool has_next = S.next(ui + 1, nxt);
        const char* nA = has_next ? (const char*)g.A + (size_t)nxt.pm * tstep : cA; const char* nB = has_next ? (const char*)g.Bt + (size_t)nxt.pn * tstep : cB;
        for (int t = 0; t < nt; t += 2) {
            const bool last = (t == nt - 2);
            const char* a1 = cA + (size_t)(t + 1) * kstep;
            const char* a2 = last ? nA : cA + (size_t)(t + 2) * kstep; const char* b2 = last ? nB : cB + (size_t)(t + 2) * kstep;
            const char* a3 = a2 + kstep; const char* b3 = b2 + kstep;
            if (last && has_next) S.a_ready(nxt);
            if constexpr (SP2) {
            PG8_LDB(B0, 0, 0); PG8_LDB(B1, 0, 1); PG8_SCHED; PG8_LDA(At, 0, 0); PG8_STAGE(PG8_SA(1, 1), a1 + hstep, voffA);
            PG8_WAIT_V(8); PG8_WAIT_L(0); PG8_BAR; PG8_MMA(0, 0, At, B0); PG8_MMA(0, 1, At, B1); PG8_BAR; PG8_SCHED;
            PG8_LDA(At, 0, 1); PG8_STAGE(PG8_SB(0, 0), b2, voffB); PG8_STAGE(PG8_SB(0, 1), b2 + hstep, voffB); PG8_STAGE(PG8_SA(0, 0), a2, voffA);
            PG8_WAIT_V(8); PG8_WAIT_L(0); PG8_BAR; PG8_MMA(1, 0, At, B0); PG8_MMA(1, 1, At, B1); PG8_BAR; PG8_SCHED;
            PG8_LDB(B0, 1, 0); PG8_LDB(B1, 1, 1); PG8_SCHED; PG8_LDA(At, 1, 0); PG8_STAGE(PG8_SA(0, 1), a2 + hstep, voffA);
            PG8_WAIT_V(8); PG8_WAIT_L(0); PG8_BAR; PG8_MMA(0, 0, At, B0); PG8_MMA(0, 1, At, B1); PG8_BAR; PG8_SCHED;
            PG8_LDA(At, 1, 1); PG8_STAGE(PG8_SB(1, 0), b3, voffB); PG8_STAGE(PG8_SB(1, 1), b3 + hstep, voffB); PG8_STAGE(PG8_SA(1, 0), a3, voffA);
            PG8_WAIT_V(8); PG8_WAIT_L(0); PG8_BAR; PG8_MMA(1, 0, At, B0); PG8_MMA(1, 1, At, B1); PG8_BAR; PG8_SCHED;
            } else {
            PG8_LDB(B0, 0, 0); PG8_SCHED; PG8_LDA(At, 0, 0); PG8_STAGE(PG8_SA(1, 1), a1 + hstep, voffA);
            PG8_WAIT_L(8); PG8_BAR; PG8_WAIT_L(0); PG8_MMA(0, 0, At, B0); PG8_BAR; PG8_SCHED;
            PG8_LDB(B1, 0, 1); PG8_STAGE(PG8_SB(0, 0), b2, voffB);
            PG8_BAR; PG8_WAIT_L(0); PG8_MMA(0, 1, At, B1); PG8_BAR;
            PG8_LDA(At, 0, 1); PG8_STAGE(PG8_SA(0, 0), a2, voffA);
            PG8_BAR; PG8_WAIT_L(0); PG8_MMA(1, 0, At, B0); PG8_BAR; PG8_SCHED;
            PG8_STAGE(PG8_SB(0, 1), b2 + hstep, voffB);
            PG8_WAIT_V(6); PG8_BAR; PG8_MMA(1, 1, At, B1); PG8_BAR;
            PG8_LDB(B0, 1, 0); PG8_SCHED; PG8_LDA(At, 1, 0); PG8_STAGE(PG8_SA(0, 1), a2 + hstep, voffA);
            PG8_WAIT_L(8); PG8_BAR; PG8_WAIT_L(0); PG8_MMA(0, 0, At, B0); PG8_BAR; PG8_SCHED;
            PG8_LDB(B1, 1, 1); PG8_STAGE(PG8_SB(1, 0), b3, voffB);
            PG8_BAR; PG8_WAIT_L(0); PG8_MMA(0, 1, At, B1); PG8_BAR;
            PG8_LDA(At, 1, 1); PG8_STAGE(PG8_SA(1, 0), a3, voffA);
            PG8_BAR; PG8_WAIT_L(0); PG8_MMA(1, 0, At, B0); PG8_BAR; PG8_SCHED;
            PG8_STAGE(PG8_SB(1, 1), b3 + hstep, voffB);
            PG8_WAIT_V(6); PG8_BAR; PG8_MMA(1, 1, At, B1); PG8_BAR;
            }
        }
        if constexpr (ALIGN_EPI) { if (wr == 0) PG8_BAR; }
        if constexpr (FP8) asm volatile("s_nop 15\n\ts_nop 15\n\ts_nop 15\n\ts_nop 15" ::: "memory");
        if constexpr (!Epi::AFTER_DRAIN) { int t2_ = threadIdx.x; asm volatile("" : "+v"(t2_)); const int l2_ = t2_ & 63, w2_ = __builtin_amdgcn_readfirstlane(t2_ >> 6);
            E(acc, cur, w2_ >> 2, w2_ & 3, l2_ & 15, l2_ >> 4); S.done(cur); }
        if (!has_next) break;
#pragma unroll
        for (int a = 0; a < 2; ++a)
#pragma unroll
            for (int b = 0; b < 2; ++b)
#pragma unroll
                for (int m = 0; m < 4; ++m)
#pragma unroll
                    for (int n = 0; n < 2; ++n) acc[a][b][m][n] = (f32x4){0.f, 0.f, 0.f, 0.f};
        cur = nxt; cA = nA; cB = nB; ++ui;
        if constexpr (ALIGN_EPI) { if (wr == 1) PG8_BAR; }
    }
    PG8_WAIT_V(0);
    if constexpr (!ALIGN_EPI) { if (wr == 0) PG8_BAR; }
    PG8_BAR;
    if constexpr (Epi::AFTER_DRAIN) { E.fused(acc, cur, wr, wc, fr, fq, lds, wid, lane); S.done(cur); }
#undef PG8_SA
#undef PG8_SB
#undef PG8_STAGE
#undef PG8_LDA
#undef PG8_LDB
#undef PG8_MMA
#undef PG8_WAIT_V
#undef PG8_WAIT_L
#undef PG8_BAR
#undef PG8_SCHED
}
}

constexpr int NB = 8, SEQ = 4096, DM = 1024, NL = 2, FF = 4096, NPROJ = 2724, NPROJ_PAD = 2816, NTILE_PROJ = 11;
constexpr int TOK = NB * SEQ;
static_assert(TOK == pg8::TT, "token count");
constexpr float NORM_EPS = 1e-6f;
constexpr float LOG2E = 1.4426950408889634f;
constexpr int NWAVES = 8;

constexpr size_t MiB = 1u << 20;
constexpr size_t WS_CTL = 0, CTL_ZERO_BYTES = 1 * MiB;
constexpr size_t WS_MOD = 1 * MiB;
constexpr size_t WS_KMEAN = WS_MOD + 512 * 1024;
constexpr size_t WS_W = 2 * MiB;
constexpr size_t W_IN = 0, W_GATE = W_IN + (size_t)NPROJ_PAD * DM, W_BR = W_GATE + (size_t)4 * DM * DM, W_OUT = W_BR + (size_t)4 * DM * 256,
                 W_FF1 = W_OUT + (size_t)DM * DM, W_FF2 = W_FF1 + (size_t)FF * DM, W_LAYER = W_FF2 + (size_t)DM * FF;
constexpr size_t WS_MASK = 70 * MiB;
constexpr size_t WS_H = 86 * MiB;
constexpr size_t WS_Y = 150 * MiB;
constexpr size_t WS_R = 214 * MiB;
constexpr size_t WS_H8 = 470 * MiB;
constexpr size_t WS_END = 502 * MiB;
static_assert(WS_W + 2 * W_LAYER * 2 <= WS_MASK, "weights fit");
constexpr int CW_BAR = 4096;
constexpr int CW_WQ = 131072;
constexpr int CW_NRM = CW_WQ + 4096;
constexpr int NPHASE = 22;

constexpr int RING_BYTES = 135168;
constexpr int LDSCTL_OFF = RING_BYTES;
constexpr int LDS_BYTES = 147456;

#define GAS __attribute__((address_space(1)))
#define LAS __attribute__((address_space(3)))
typedef unsigned short bf16;
typedef unsigned v4u __attribute__((ext_vector_type(4)));
typedef unsigned v2u __attribute__((ext_vector_type(2)));
typedef float f32x4 __attribute__((ext_vector_type(4)));
typedef float f32x16 __attribute__((ext_vector_type(16)));
typedef short bf16x8 __attribute__((ext_vector_type(8)));
typedef short s16x4 __attribute__((ext_vector_type(4)));
typedef GAS unsigned gu32;
#define RLX_AGENT __ATOMIC_RELAXED, __HIP_MEMORY_SCOPE_AGENT
#define LDS_WAIT() asm volatile("s_waitcnt lgkmcnt(0)" ::: "memory")
__device__ __forceinline__ unsigned f2bf(float f) { unsigned u = __builtin_bit_cast(unsigned, f); return (u + 0x7fffu + ((u >> 16) & 1u)) >> 16; }
__device__ __forceinline__ unsigned pk2(float lo, float hi) { return f2bf(lo) | (f2bf(hi) << 16); }
__device__ __forceinline__ float bf2f(unsigned short b) { return __uint_as_float((unsigned)b << 16); }
__device__ __forceinline__ float bflo(unsigned w) { return __uint_as_float(w << 16); }
__device__ __forceinline__ float bfhi(unsigned w) { return __uint_as_float(w & 0xffff0000u); }

#define XB_TMO      128
#define XB_XCNT(j)  (256  + 64 * (j))
#define XB_XSUB(j)  (1280 + 64 * (j))
#define XB_XGEN(j)  (2304 + 64 * (j))
#define XB_TOP      3328
#define XB_TOPGEN   3392
#define XCD_BAR_WORDS 3456
#define XB_SPIN_CAP (1u << 18)

__device__ __forceinline__ unsigned xb_ld(unsigned* p)              { return __hip_atomic_load(p, __ATOMIC_RELAXED, __HIP_MEMORY_SCOPE_AGENT); }
__device__ __forceinline__ unsigned xb_add(unsigned* p, unsigned v) { return __hip_atomic_fetch_add(p, v, __ATOMIC_RELAXED, __HIP_MEMORY_SCOPE_AGENT); }
__device__ __forceinline__ unsigned xb_xcc_id() { return (unsigned)__builtin_amdgcn_s_getreg((3 << 11) | 20) & 0xFu; }
#define XB_SPIN(cond, bar) do { unsigned _sp = 0; while (cond) { __builtin_amdgcn_s_sleep(1); \
    if ((++_sp & 255u) == 0u) { if (xb_ld(&(bar)[XB_TMO])) break; if (_sp > XB_SPIN_CAP) { atomicAdd(&(bar)[XB_TMO], 1u); break; } } } } while (0)

struct XcdBarrier {
    unsigned* bar; unsigned x;
    volatile LAS unsigned* st;
};

__device__ __forceinline__ XcdBarrier xcd_barrier_post(unsigned* bar, volatile LAS unsigned* st) {
    XcdBarrier b; b.bar = bar; b.x = xb_xcc_id(); b.st = st;
    if (threadIdx.x == 0) (void)xb_add(&bar[XB_XCNT(b.x)], 1u);
    return b;
}
__device__ __forceinline__ void xcd_barrier_complete(unsigned* bar, unsigned x, unsigned& nloc, unsigned& nx) {
    const unsigned G = gridDim.x * gridDim.y * gridDim.z;
    unsigned sum, cnt, mine, sp = 0u;
    for (;;) {
        sum = 0u; cnt = 0u; mine = 0u;
#pragma unroll
        for (unsigned j = 0; j < 16; ++j) { const unsigned c = xb_ld(&bar[XB_XCNT(j)]); sum += c; cnt += (c > 0u) ? 1u : 0u; mine = (j == x) ? c : mine; }
        if (sum == G) break;
        __builtin_amdgcn_s_sleep(1);
        if ((++sp & 255u) == 0u) { if (xb_ld(&bar[XB_TMO])) break; if (sp > XB_SPIN_CAP) { atomicAdd(&bar[XB_TMO], 1u); break; } }
    }
    nloc = mine > 0u ? mine : 1u; nx = cnt > 0u ? cnt : 1u;
}

__device__ __forceinline__ void xcd_barrier(const XcdBarrier& b) {
    asm volatile("s_waitcnt vmcnt(0)" ::: "memory");
    __syncthreads();
    if (threadIdx.x == 0) {
        unsigned* bar = b.bar;
        __builtin_amdgcn_s_waitcnt(0);
        unsigned nloc = b.st[0], nx = b.st[1];
        if (nloc == 0u) { xcd_barrier_complete(bar, b.x, nloc, nx); b.st[0] = nloc; b.st[1] = nx; }
        const unsigned old = xb_add(&bar[XB_XSUB(b.x)], 1u);
        const unsigned gen = old / nloc;
        if (old + 1u == (gen + 1u) * nloc) {
            __builtin_amdgcn_fence(__ATOMIC_RELEASE, "agent");
            asm volatile("s_waitcnt vmcnt(0)" ::: "memory");
            const unsigned og = xb_add(&bar[XB_TOP], 1u);
            const unsigned tg = og / nx;
            if (og + 1u == (tg + 1u) * nx) xb_add(&bar[XB_TOPGEN], 1u);
            else XB_SPIN(xb_ld(&bar[XB_TOPGEN]) == tg, bar);
            __builtin_amdgcn_fence(__ATOMIC_ACQUIRE, "agent");
            xb_add(&bar[XB_XGEN(b.x)], 1u);
            asm volatile("s_waitcnt vmcnt(0)" ::: "memory");
        } else {
            XB_SPIN(xb_ld(&bar[XB_XGEN(b.x)]) == gen, bar);
            __builtin_amdgcn_fence(__ATOMIC_ACQUIRE, "agent");
            asm volatile("s_waitcnt vmcnt(0)" ::: "memory");
        }
    }
    __syncthreads();
}

struct Args {
    const float *x, *c, *w_ada, *b_ada, *norm1_g, *w_in, *diff_lambda, *diff_subln_g, *w_pool, *pool_scale, *w_gate, *b_gate, *w_branch, *w_out, *norm2_g, *w_ff1, *w_ff2, *final_g;
    float* out; unsigned char* ws; int ph_lo, ph_hi, li, pad;
};

__device__ __forceinline__ float shx(float v, int mask, int lane) { return __int_as_float(__builtin_amdgcn_ds_bpermute((lane ^ mask) << 2, __float_as_int(v))); }
__device__ __forceinline__ unsigned shxu(unsigned v, int mask, int lane) { return (unsigned)__builtin_amdgcn_ds_bpermute((lane ^ mask) << 2, (int)v); }
__device__ __forceinline__ unsigned shupu(unsigned v, int delta, int lane) { return (unsigned)__builtin_amdgcn_ds_bpermute(((lane - delta) & 63) << 2, (int)v); }
__device__ __forceinline__ float wave_sum(float v, int lane) {
#pragma unroll
    for (int o = 1; o < 64; o <<= 1) v += shx(v, o, lane);
    return v;
}
__device__ __forceinline__ int crow(int r, int hi) { return (r & 3) + 8 * (r >> 2) + 4 * hi; }
typedef float f32x2_t __attribute__((ext_vector_type(2))); typedef __bf16 bf16x2_t __attribute__((ext_vector_type(2)));
__device__ __forceinline__ unsigned cvtpk(float lo, float hi) { f32x2_t v = {lo, hi}; bf16x2_t b = __builtin_convertvector(v, bf16x2_t); return __builtin_bit_cast(unsigned, b); }

__device__ __forceinline__ int gate_row(int br, int c) { const int pn = c >> 6, ml = c & 63; return 256 * pn + 128 * (br >> 1) + 32 * (ml >> 4) + 8 * ((ml >> 2) & 3) + 4 * (br & 1) + (ml & 3); }
__device__ __forceinline__ void p0_transpose_item(const float* W, int K, int Nsrc, int Npad, bf16* WT, int mode, int br, LAS float* scr, int item, int lane) {
    const int nblk = Npad / 32, kb = item / nblk, nb = item % nblk, k0 = 64 * kb, n0 = 32 * nb;
    const int c4 = lane & 7, kr = lane >> 3, nn = n0 + 4 * c4;
    f32x4 v[8];
#pragma unroll
    for (int i = 0; i < 8; ++i) v[i] = (nn < Nsrc) ? *(const f32x4*)(W + (size_t)(k0 + 8 * i + kr) * Nsrc + nn) : (f32x4){0.f, 0.f, 0.f, 0.f};
#pragma unroll
    for (int i = 0; i < 8; ++i) { LAS float* d = scr + (8 * i + kr) * 33 + 4 * c4; d[0] = v[i][0]; d[1] = v[i][1]; d[2] = v[i][2]; d[3] = v[i][3]; }
    LDS_WAIT(); asm volatile("" ::: "memory");
    const int c = lane & 7;
#pragma unroll
    for (int j = 0; j < 4; ++j) { const int n = (lane >> 3) + 8 * j; const LAS float* s = scr + (8 * c) * 33 + n;
        v4u o; o.x = pk2(s[0 * 33], s[1 * 33]); o.y = pk2(s[2 * 33], s[3 * 33]); o.z = pk2(s[4 * 33], s[5 * 33]); o.w = pk2(s[6 * 33], s[7 * 33]);
        const int drow = (mode == 1 || mode == 2) ? gate_row(br, n0 + n) : (n0 + n);
        if (mode >= 2) {
            const float f8s = (mode == 3) ? 64.f : 32.f;
            int w0 = __builtin_amdgcn_cvt_pk_fp8_f32(f8s * s[0 * 33], f8s * s[1 * 33], 0, false); w0 = __builtin_amdgcn_cvt_pk_fp8_f32(f8s * s[2 * 33], f8s * s[3 * 33], w0, true);
            int w1 = __builtin_amdgcn_cvt_pk_fp8_f32(f8s * s[4 * 33], f8s * s[5 * 33], 0, false); w1 = __builtin_amdgcn_cvt_pk_fp8_f32(f8s * s[6 * 33], f8s * s[7 * 33], w1, true);
            v2u o8; o8.x = (unsigned)w0; o8.y = (unsigned)w1;
            *(v2u*)((unsigned char*)WT + (size_t)drow * K + k0 + 8 * c) = o8;
        } else *(v4u*)(WT + (size_t)drow * K + k0 + 8 * c) = o; }
    LDS_WAIT(); asm volatile("" ::: "memory");
}

template <bool XBF16>
__device__ __forceinline__ void norm_rows_bf16(LAS unsigned char* lds, const void* X, bf16* O, unsigned char* O8  , const float* g, const float* mod  , int sh_idx, int sc_idx, int gw, int ngw, int lane_in) {
    int lane = lane_in; asm volatile("" : "+v"(lane));
    constexpr int RB = 4;
    LAS float* LA = (LAS float*)lds; LAS float* LB = LA + 8192;
    { int tf = threadIdx.x; asm volatile("" : "+v"(tf));
      for (int i = tf; i < 2048; i += 512) { const int b = i >> 8, c4 = (i & 255) * 4;
          const f32x4 gg = *(const f32x4*)(g + c4), sc = *(const f32x4*)(mod + (size_t)b * 6144 + sc_idx * 1024 + c4), sh = *(const f32x4*)(mod + (size_t)b * 6144 + sh_idx * 1024 + c4);
          *(LAS f32x4*)(LA + b * 1024 + c4) = gg * (1.f + sc); *(LAS f32x4*)(LB + b * 1024 + c4) = sh; } }
    __syncthreads();
    for (int m0 = gw; m0 < TOK; m0 += RB * ngw) {
        float v[RB][16];
#pragma unroll
        for (int rb = 0; rb < RB; ++rb) { const int m = m0 + rb * ngw;
            if (m < TOK) {
                if (XBF16) { const v4u* xr = (const v4u*)((const bf16*)X + (size_t)m * DM) + 2 * lane; const v4u a = xr[0], c = xr[1];
                    v[rb][0] = bflo(a.x); v[rb][1] = bfhi(a.x); v[rb][2] = bflo(a.y); v[rb][3] = bfhi(a.y); v[rb][4] = bflo(a.z); v[rb][5] = bfhi(a.z); v[rb][6] = bflo(a.w); v[rb][7] = bfhi(a.w);
                    v[rb][8] = bflo(c.x); v[rb][9] = bfhi(c.x); v[rb][10] = bflo(c.y); v[rb][11] = bfhi(c.y); v[rb][12] = bflo(c.z); v[rb][13] = bfhi(c.z); v[rb][14] = bflo(c.w); v[rb][15] = bfhi(c.w); }
                else { const f32x4* xr = (const f32x4*)((const float*)X + (size_t)m * DM) + 4 * lane;
#pragma unroll
                    for (int j = 0; j < 4; ++j) { const f32x4 t = xr[j]; v[rb][4 * j] = t.x; v[rb][4 * j + 1] = t.y; v[rb][4 * j + 2] = t.z; v[rb][4 * j + 3] = t.w; } }
            } else {
#pragma unroll
                for (int e = 0; e < 16; ++e) v[rb][e] = 0.f; } }
#pragma unroll
        for (int rb = 0; rb < RB; ++rb) { const int m = m0 + rb * ngw; if (m < TOK) {
            const int b = m >> 12;
            float s = 0.f;
#pragma unroll
            for (int e = 0; e < 16; ++e) s += v[rb][e] * v[rb][e];
            const float rstd = 1.f / sqrtf(wave_sum(s, lane) * (1.f / DM) + NORM_EPS);
            float y[16];
#pragma unroll
            for (int j = 0; j < 4; ++j) { const f32x4 aa = *(LAS const f32x4*)(LA + b * 1024 + 16 * lane + 4 * j), bb = *(LAS const f32x4*)(LB + b * 1024 + 16 * lane + 4 * j);
#pragma unroll
                for (int e = 0; e < 4; ++e) y[4 * j + e] = v[rb][4 * j + e] * rstd * aa[e] + bb[e]; }
            v4u o0, o1;
            o0.x = pk2(y[0], y[1]); o0.y = pk2(y[2], y[3]); o0.z = pk2(y[4], y[5]); o0.w = pk2(y[6], y[7]);
            o1.x = pk2(y[8], y[9]); o1.y = pk2(y[10], y[11]); o1.z = pk2(y[12], y[13]); o1.w = pk2(y[14], y[15]);
            v4u* op = (v4u*)(O + (size_t)m * DM) + 2 * lane; op[0] = o0; op[1] = o1;
            if (O8) { v4u q;
                int w = __builtin_amdgcn_cvt_pk_fp8_f32(y[0], y[1], 0, false); w = __builtin_amdgcn_cvt_pk_fp8_f32(y[2], y[3], w, true); q.x = (unsigned)w;
                w = __builtin_amdgcn_cvt_pk_fp8_f32(y[4], y[5], 0, false); w = __builtin_amdgcn_cvt_pk_fp8_f32(y[6], y[7], w, true); q.y = (unsigned)w;
                w = __builtin_amdgcn_cvt_pk_fp8_f32(y[8], y[9], 0, false); w = __builtin_amdgcn_cvt_pk_fp8_f32(y[10], y[11], w, true); q.z = (unsigned)w;
                w = __builtin_amdgcn_cvt_pk_fp8_f32(y[12], y[13], 0, false); w = __builtin_amdgcn_cvt_pk_fp8_f32(y[14], y[15], w, true); q.w = (unsigned)w;
                *((v4u*)(O8 + (size_t)m * DM) + lane) = q; } } }
    }
    __syncthreads();
}

#ifndef ATT_PD
#define ATT_PD 2
#endif
constexpr int AT_K0 = 0, AT_KSLOT = 9216, AT_V0 = 18432, AT_VSLOT = 12288, AT_SEL = 43008, AT_KM = 44032, AT_END = 47872;
__device__ __forceinline__ s16x4 vtr(LAS const unsigned char* p) { return __builtin_bit_cast(s16x4, __builtin_amdgcn_ds_read_tr16_b64_v4i16((LAS s16x4*)p)); }

#define TRRD(dst, addr, off) asm volatile("ds_read_b64_tr_b16 %0, %1 offset:%2" : "=v"(dst) : "v"(addr), "i"(off) : "memory")
#define SBAR0() __builtin_amdgcn_sched_barrier(0)
__device__ __forceinline__ void softmax_pv(f32x16& s0, f32x16& s1, float& l, f32x16 (&o)[2], LAS const unsigned char* vbase  ) {
    const unsigned va = (unsigned)(uintptr_t)vbase;
    s16x4 vl[2][2][2], vh[2][2][2];
#pragma unroll
    for (int sub = 0; sub < 2; ++sub)
#pragma unroll
        for (int db = 0; db < 2; ++db)
#pragma unroll
            for (int s2 = 0; s2 < 2; ++s2) { TRRD(vl[db][sub][s2], va, (32 * sub + 16 * s2) * 192 + db * 64); TRRD(vh[db][sub][s2], va, (32 * sub + 16 * s2 + 8) * 192 + db * 64); }
    float la = l;
#pragma unroll
    for (int r = 0; r < 16; ++r) { s0[r] = __builtin_amdgcn_exp2f(s0[r]); la += s0[r]; }
    bf16x8 pf[2][2];
#pragma unroll
    for (int s2 = 0; s2 < 2; ++s2) { v4u a;
        a.x = cvtpk(s0[8 * s2 + 0], s0[8 * s2 + 1]); a.y = cvtpk(s0[8 * s2 + 2], s0[8 * s2 + 3]); a.z = cvtpk(s0[8 * s2 + 4], s0[8 * s2 + 5]); a.w = cvtpk(s0[8 * s2 + 6], s0[8 * s2 + 7]);
        pf[0][s2] = __builtin_bit_cast(bf16x8, a); }
    asm volatile("s_waitcnt lgkmcnt(0)" : "+v"(vl[0][0][0]), "+v"(vl[0][0][1]), "+v"(vl[0][1][0]), "+v"(vl[0][1][1]), "+v"(vl[1][0][0]), "+v"(vl[1][0][1]), "+v"(vl[1][1][0]), "+v"(vl[1][1][1]),
                                          "+v"(vh[0][0][0]), "+v"(vh[0][0][1]), "+v"(vh[0][1][0]), "+v"(vh[0][1][1]), "+v"(vh[1][0][0]), "+v"(vh[1][0][1]), "+v"(vh[1][1][0]), "+v"(vh[1][1][1]) :: "memory");
    SBAR0();
#pragma unroll
    for (int g = 0; g < 4; ++g) { const int db = g >> 1, s2 = g & 1;
        const s16x4 lo = vl[db][0][s2], hh = vh[db][0][s2];
        const bf16x8 vf = (bf16x8){lo[0], lo[1], lo[2], lo[3], hh[0], hh[1], hh[2], hh[3]};
        o[db] = __builtin_amdgcn_mfma_f32_32x32x16_bf16(vf, pf[0][s2], o[db], 0, 0, 0);
#pragma unroll
        for (int r = 4 * g; r < 4 * g + 4; ++r) { s1[r] = __builtin_amdgcn_exp2f(s1[r]); la += s1[r]; }
        SBAR0(); }
    l = la;
#pragma unroll
    for (int s2 = 0; s2 < 2; ++s2) { v4u c;
        c.x = cvtpk(s1[8 * s2 + 0], s1[8 * s2 + 1]); c.y = cvtpk(s1[8 * s2 + 2], s1[8 * s2 + 3]); c.z = cvtpk(s1[8 * s2 + 4], s1[8 * s2 + 5]); c.w = cvtpk(s1[8 * s2 + 6], s1[8 * s2 + 7]);
        pf[1][s2] = __builtin_bit_cast(bf16x8, c); }
#pragma unroll
    for (int g = 0; g < 4; ++g) { const int db = g >> 1, s2 = g & 1;
        const s16x4 lo = vl[db][1][s2], hh = vh[db][1][s2];
        const bf16x8 vf = (bf16x8){lo[0], lo[1], lo[2], lo[3], hh[0], hh[1], hh[2], hh[3]};
        o[db] = __builtin_amdgcn_mfma_f32_32x32x16_bf16(vf, pf[1][s2], o[db], 0, 0, 0); }
}
__device__ __forceinline__ void split3(float x, unsigned& h, unsigned& m, unsigned& l) {
    h = f2bf(x); const float r1 = x - __uint_as_float(h << 16); m = f2bf(r1); const float r2 = r1 - __uint_as_float(m << 16); l = f2bf(r2);
}

template <int MODE>
__device__ __forceinline__ void attn_unit(LAS unsigned char* lds, int b, int h, int qb, const bf16* Qb, const bf16* Kb, const bf16* Vb, bf16* Ob, float slope,
                                          const float* kmean, float lam, float post_scale, const float* subg, const unsigned* maskw, const unsigned* nrm  ,
                                          const int* refposg, const int* refming) {
    int tid_l = threadIdx.x; asm volatile("" : "+v"(tid_l)); const int tid = tid_l, lane = tid & 63, wid = __builtin_amdgcn_readfirstlane(tid >> 6), r32 = lane & 31, hi = lane >> 5;
    const int q = qb * 256 + wid * 32 + r32;
    const size_t rowg = (size_t)b * SEQ;
    const float c2 = slope * LOG2E;
    unsigned sel = 0u;
    bf16x8 qf[4];
#pragma unroll
    for (int ds = 0; ds < 4; ++ds) qf[ds] = *(const bf16x8*)(Qb + (rowg + q) * 256 + h * 64 + ds * 16 + hi * 8);
    const int skey = tid >> 3, sch = tid & 7;
    const bf16* ksrc = Kb + (rowg + skey) * 256 + h * 64 + sch * 8;
    const bf16* vsrc = Vb + (rowg + skey) * 256 + h * 64 + sch * 8;
    const int kdst = AT_K0 + skey * 144 + sch * 16, vdst = AT_V0 + skey * 192 + sch * 16;
    const int NT = 4 * qb + 4;
    const float Bq = __uint_as_float(nrm[b * 4 + h]), Bk = __uint_as_float(nrm[32 + b * 4 + h]);
#if defined(PROBE_NOSKIP)
    const float Dskip = 1e9f + 0.f * (Bq + Bk);
#else
    const float Dskip = (150.f + 2.f * sqrtf(Bq * Bk)) / c2;
#endif
    const int koff = r32 * 144 + hi * 16;
    const int vtoff = (4 * hi + ((lane & 15) >> 2)) * 192 + (16 * ((lane >> 4) & 1) + 4 * (lane & 3)) * 2;
    float l1 = 0.f, l2 = 0.f;
    f32x16 oA[2], oB[2];
#pragma unroll
    for (int r = 0; r < 16; ++r) { oA[0][r] = 0.f; oA[1][r] = 0.f; oB[0][r] = 0.f; oB[1][r] = 0.f; }
    const int qmin = qb * 256 + wid * 32, qmax = qmin + 31;
    constexpr int PD = ATT_PD;
    v4u kR[PD], vR[PD]; v2u mR[PD];
    int refpos = q;
    int minref = qb * 256;
    if (MODE == 2) { refpos = refposg[rowg + q]; minref = refming[b * 128 + 8 * qb];
#pragma unroll
        for (int i = 1; i < 8; ++i) { const int v = refming[b * 128 + 8 * qb + i]; minref = v < minref ? v : minref; } }
    int T0 = (int)floorf(((float)minref - Dskip) * (1.f / 64.f)); T0 = T0 < 0 ? 0 : T0; T0 = __builtin_amdgcn_readfirstlane(T0);
    const v4u k0r = *(const v4u*)(ksrc + (size_t)T0 * 64 * 256), v0r = *(const v4u*)(vsrc + (size_t)T0 * 64 * 256);
#pragma unroll
    for (int i = 0; i < PD; ++i) { kR[i] = (v4u){0u, 0u, 0u, 0u}; vR[i] = kR[i]; mR[i] = (v2u){0u, 0u};
        if (T0 + i + 1 < NT) { kR[i] = *(const v4u*)(ksrc + (size_t)(T0 + i + 1) * 64 * 256); vR[i] = *(const v4u*)(vsrc + (size_t)(T0 + i + 1) * 64 * 256);
            if (MODE == 2) mR[i] = *(const v2u*)(maskw + (rowg + q) * 128 + 2 * (T0 + i + 1)); } }
    v2u mw = (v2u){0u, 0u};
    if (MODE == 2) mw = *(const v2u*)(maskw + (rowg + q) * 128 + 2 * T0);
    if (MODE == 0) {
        LAS float* KM = (LAS float*)(lds + AT_KM); LAS unsigned* SEL = (LAS unsigned*)(lds + AT_SEL);
        for (int i = tid; i < qb * 64; i += 512) KM[i] = kmean[(size_t)((b * 4 + h) * 16) * 64 + i];
        __syncthreads();
        if (tid < 256) {
            const bf16* qrow = Qb + (rowg + qb * 256 + tid) * 256 + h * 64;
            float qv[64];
#pragma unroll
            for (int c = 0; c < 8; ++c) { const v4u w = *(const v4u*)(qrow + 8 * c);
                qv[8 * c + 0] = bflo(w.x); qv[8 * c + 1] = bfhi(w.x); qv[8 * c + 2] = bflo(w.y); qv[8 * c + 3] = bfhi(w.y);
                qv[8 * c + 4] = bflo(w.z); qv[8 * c + 5] = bfhi(w.z); qv[8 * c + 6] = bflo(w.w); qv[8 * c + 7] = bfhi(w.w); }
            float v1 = -INFINITY, v2 = -INFINITY, v3 = -INFINITY; int i1 = -1, i2 = -1, i3 = -1;
            for (int n = 0; n < qb; ++n) {
                float g = 0.f;
#pragma unroll
                for (int d = 0; d < 64; ++d) g = __builtin_fmaf(qv[d], KM[n * 64 + d], g);
                if (g > v1) { v3 = v2; i3 = i2; v2 = v1; i2 = i1; v1 = g; i1 = n; }
                else if (g > v2) { v3 = v2; i3 = i2; v2 = g; i2 = n; }
                else if (g > v3) { v3 = g; i3 = n; }
            }
            unsigned sm = 0u; if (i1 >= 0) sm |= 1u << i1; if (i2 >= 0) sm |= 1u << i2; if (i3 >= 0) sm |= 1u << i3;
            SEL[tid] = sm;
        }
        __syncthreads();
        sel = SEL[wid * 32 + r32];
    }
    *(LAS v4u*)(lds + kdst + (T0 & 1) * AT_KSLOT) = k0r; *(LAS v4u*)(lds + vdst + (T0 & 1) * AT_VSLOT) = v0r;
    bf16x8 qaug; v4u ka0, ka1;
    { unsigned a, b2, c; split3(-c2 * (float)refpos, a, b2, c);
      v4u w; if (hi == 0) { w.x = a | (b2 << 16); w.y = c | (0x3f80u << 16); w.z = 0x3f80u | (0x3f80u << 16); w.w = 0u; }
             else { w.x = 0x3f80u | (0x3f80u << 16); w.y = 0x3f80u; w.z = 0u; w.w = 0u; }
      qaug = __builtin_bit_cast(bf16x8, w);
      split3(c2 * (float)r32, a, b2, c); ka0.x = 0x3f80u | (0x3f80u << 16); ka0.y = 0x3f80u | (a << 16); ka0.z = b2 | (c << 16); ka0.w = 0u;
      split3(c2 * (float)(r32 + 32), a, b2, c); ka1.x = ka0.x; ka1.y = 0x3f80u | (a << 16); ka1.z = b2 | (c << 16); ka1.w = 0u; }
    __syncthreads();
#pragma nounroll
    for (int t0 = T0; t0 < NT; t0 += PD) {
#pragma unroll
      for (int u = 0; u < PD; ++u) { const int t = t0 + u; if (t < NT) {
        const int slot = t & 1;
        const int k0 = 64 * t;
        bool active = (k0 <= qmax);
        bool keep = true;
        if (MODE == 0) { const int n = t >> 2; if (n < qb) { keep = ((sel >> n) & 1u) != 0u; active = (__ballot(keep) != 0ull); } }
        if (active) {
            LAS const unsigned char* ks = lds + AT_K0 + slot * AT_KSLOT + koff;
            LAS const unsigned char* vb = lds + AT_V0 + slot * AT_VSLOT + vtoff;
            const int lim = q - k0 - 4 * hi;
            const bool needmask = (k0 + 63 > qmin);
            bf16x8 kaug0, kaug1;
            { unsigned a, b2, c; split3(c2 * (float)k0, a, b2, c);
              v4u w0 = ka0, w1 = ka1; if (hi) { w0.x = a | (b2 << 16); w0.y = c; w0.z = 0u; w1 = w0; }
              kaug0 = __builtin_bit_cast(bf16x8, w0); kaug1 = __builtin_bit_cast(bf16x8, w1); }
            f32x16 sb0, sb1;
#pragma unroll
            for (int r = 0; r < 16; ++r) { sb0[r] = 0.f; sb1[r] = 0.f; }
            sb0 = __builtin_amdgcn_mfma_f32_32x32x16_bf16(kaug0, qaug, sb0, 0, 0, 0);
            sb1 = __builtin_amdgcn_mfma_f32_32x32x16_bf16(kaug1, qaug, sb1, 0, 0, 0);
#pragma unroll
            for (int mp = 0; mp < (MODE == 1 ? 2 : 1); ++mp) {
                f32x16 s0, s1;
#pragma unroll
                for (int dd = 0; dd < (MODE == 1 ? 2 : 4); ++dd) { const int ds = (MODE == 1) ? (2 * mp + dd) : dd;
                    const bf16x8 a0 = *(LAS const bf16x8*)(ks + ds * 32), a1 = *(LAS const bf16x8*)(ks + 32 * 144 + ds * 32);
                    if (dd == 0) { s0 = __builtin_amdgcn_mfma_f32_32x32x16_bf16(a0, qf[ds], sb0, 0, 0, 0); s1 = __builtin_amdgcn_mfma_f32_32x32x16_bf16(a1, qf[ds], sb1, 0, 0, 0); }
                    else { s0 = __builtin_amdgcn_mfma_f32_32x32x16_bf16(a0, qf[ds], s0, 0, 0, 0); s1 = __builtin_amdgcn_mfma_f32_32x32x16_bf16(a1, qf[ds], s1, 0, 0, 0); } }
#if defined(PROBE_QK2X)
                { f32x16 d0, d1;
#pragma unroll
                  for (int r = 0; r < 16; ++r) { d0[r] = 0.f; d1[r] = 0.f; }
#pragma unroll
                  for (int dd = 0; dd < (MODE == 1 ? 2 : 4); ++dd) { const int ds = (MODE == 1) ? (2 * mp + dd) : dd;
                    const bf16x8 a0 = *(LAS const bf16x8*)(ks + ds * 32 + 16), a1 = *(LAS const bf16x8*)(ks + 32 * 144 + ds * 32 + 16);
                    d0 = __builtin_amdgcn_mfma_f32_32x32x16_bf16(a0, qf[ds], d0, 0, 0, 0);
                    d1 = __builtin_amdgcn_mfma_f32_32x32x16_bf16(a1, qf[ds], d1, 0, 0, 0); }
                  asm volatile("" :: "v"(d0), "v"(d1)); }
#endif
                if (MODE == 2) {
#pragma unroll
                    for (int r = 0; r < 16; ++r) { const int pos = (r & 3) + 8 * (r >> 2) + 4 * hi;
                        if (!((mw.x >> pos) & 1u)) s0[r] = -INFINITY; if (!((mw.y >> pos) & 1u)) s1[r] = -INFINITY; }
                } else {
                    if (MODE == 0 && !keep) {
#pragma unroll
                        for (int r = 0; r < 16; ++r) { s0[r] = -INFINITY; s1[r] = -INFINITY; }
                    }
                    if (needmask) {
#pragma unroll
                        for (int r = 0; r < 16; ++r) { const int ko = (r & 3) + 8 * (r >> 2);
                            if (ko > lim) s0[r] = -INFINITY; if (ko + 32 > lim) s1[r] = -INFINITY; }
                    }
                }
                if (mp == 0) softmax_pv(s0, s1, l1, oA, vb); else softmax_pv(s0, s1, l2, oB, vb);
            }
        }
        if (t + 1 < NT) { *(LAS v4u*)(lds + kdst + (slot ^ 1) * AT_KSLOT) = kR[u]; *(LAS v4u*)(lds + vdst + (slot ^ 1) * AT_VSLOT) = vR[u];
            if (MODE == 2) mw = mR[u];
            if (t + 1 + PD < NT) { kR[u] = *(const v4u*)(ksrc + (size_t)(t + 1 + PD) * 64 * 256); vR[u] = *(const v4u*)(vsrc + (size_t)(t + 1 + PD) * 64 * 256);
                if (MODE == 2) mR[u] = *(const v2u*)(maskw + (rowg + q) * 128 + 2 * (t + 1 + PD)); } }
        __syncthreads();
#if defined(PROBE_BAR2X)
        __syncthreads();
#endif
      } }
    }
    const float l1t = l1 + shx(l1, 32, lane);
    bf16* orow = Ob + (rowg + q) * 256 + h * 64 + 4 * hi;
    if (MODE == 1) {
        const float l2t = l2 + shx(l2, 32, lane);
        const float i1 = 1.f / l1t, i2 = lam / l2t;
        float ssq = 0.f;
#pragma unroll
        for (int db = 0; db < 2; ++db)
#pragma unroll
            for (int r = 0; r < 16; ++r) { const float v = oA[db][r] * i1 - oB[db][r] * i2; oA[db][r] = v; ssq += v * v; }
        ssq += shx(ssq, 32, lane);
        const float rn = post_scale / sqrtf(ssq * (1.f / 64.f) + NORM_EPS);
#pragma unroll
        for (int db = 0; db < 2; ++db)
#pragma unroll
            for (int g4 = 0; g4 < 4; ++g4) { const f32x4 gg = *(const f32x4*)(subg + 32 * db + 8 * g4 + 4 * hi);
                v2u w; w.x = cvtpk(oA[db][4 * g4 + 0] * rn * gg[0], oA[db][4 * g4 + 1] * rn * gg[1]); w.y = cvtpk(oA[db][4 * g4 + 2] * rn * gg[2], oA[db][4 * g4 + 3] * rn * gg[3]);
                *(v2u*)(orow + 32 * db + 8 * g4) = w; }
    } else {
        const float i1 = 1.f / l1t;
#pragma unroll
        for (int db = 0; db < 2; ++db)
#pragma unroll
            for (int g4 = 0; g4 < 4; ++g4) { v2u w; w.x = cvtpk(oA[db][4 * g4 + 0] * i1, oA[db][4 * g4 + 1] * i1); w.y = cvtpk(oA[db][4 * g4 + 2] * i1, oA[db][4 * g4 + 3] * i1);
                *(v2u*)(orow + 32 * db + 8 * g4) = w; }
    }
    __syncthreads();
}

constexpr int DS_HP = 1025;
constexpr int DS_HIST_BYTES = 32 * DS_HP * 4;
constexpr int DS_BP = 129;
constexpr int DS_G = 0, DS_C = 32 * DS_BP * 4, DS_AUX = DS_HIST_BYTES;
__device__ __forceinline__ float relu_asm(float x) { const int b = __float_as_int(x); return __int_as_float(b > 0 ? b : 0); }
__device__ __forceinline__ void dsa_scores(const bf16x8 (&iqf)[4][2], const float (&w)[4], const bf16x8 k0, const bf16x8 k1, float (&sc)[16]) {
#pragma unroll
    for (int hh = 0; hh < 4; ++hh) {
        f32x16 x;
#pragma unroll
        for (int r = 0; r < 16; ++r) x[r] = 0.f;
        x = __builtin_amdgcn_mfma_f32_32x32x16_bf16(k0, iqf[hh][0], x, 0, 0, 0);
        x = __builtin_amdgcn_mfma_f32_32x32x16_bf16(k1, iqf[hh][1], x, 0, 0, 0);
#pragma unroll
        for (int r = 0; r < 16; ++r) sc[r] = (hh == 0) ? (w[0] * relu_asm(x[r])) : __builtin_fmaf(w[hh], relu_asm(x[r]), sc[r]);
    }
}
__device__ __forceinline__ unsigned dsa_mono(float s) { const unsigned bits = __float_as_uint(s); return __builtin_amdgcn_bitop3_b32(bits, (unsigned)((int)bits >> 31), 0x80000000u, 0x1E); }
__device__ __forceinline__ unsigned dsa_ckey(float s, unsigned keyidx) { return (dsa_mono(s) & 0xFFFFF000u) | (4095u - keyidx); }
__device__ __forceinline__ unsigned take_low(unsigned w, unsigned n) {
    if (n >= (unsigned)__popc(w)) return w;
    unsigned res = 0u;
    while (n > 0u) { const unsigned low = w & (0u - w); res |= low; w ^= low; --n; }
    return res;
}
template <int PASS>
__device__ __forceinline__ void dsa_hist_pass(LAS unsigned* hist, const bf16x8 (&iqf)[4][2], const float (&w)[4], const bf16* kbase, int qg, int wid, int r32, int hi, int t, unsigned P1) {
    bf16x8 nk0 = *(const bf16x8*)(kbase + (size_t)wid * 32 * 256), nk1 = *(const bf16x8*)(kbase + (size_t)wid * 32 * 256 + 16);
    const unsigned rowb = (unsigned)(r32 * DS_HP * 4);
#pragma nounroll
    for (int j = wid; j <= qg; j += 8) {
        const bf16x8 k0 = nk0, k1 = nk1;
        { const int jn = (j + 8 <= qg) ? j + 8 : j; const bf16* kp = kbase + (size_t)jn * 32 * 256; nk0 = *(const bf16x8*)kp; nk1 = *(const bf16x8*)(kp + 16); }
        float sc[16]; dsa_scores(iqf, w, k0, k1, sc);
#if defined(PROBE_D1_SCORE2X)
        { float sd[16]; dsa_scores(iqf, w, k1, k0, sd);
#pragma unroll
          for (int r = 0; r < 16; ++r) asm volatile("" :: "v"(sd[r])); }
#endif
        const int lim = t - 32 * j - 4 * hi;
        const bool diag = (j == qg);
        if (diag) {
#pragma unroll
            for (int r = 0; r < 16; ++r) {
                const unsigned mono = dsa_mono(sc[r]);
                unsigned addr;
                if (PASS == 0) { addr = ((mono >> 22) << 2) + rowb; if ((r & 3) + 8 * (r >> 2) > lim) addr = rowb + 4096u; }
                else { addr = (((mono >> 12) & 1023u) << 2) + rowb; if ((mono >> 22) != P1 || ((r & 3) + 8 * (r >> 2) > lim)) addr = rowb + 4096u; }
                __hip_atomic_fetch_add((LAS unsigned*)((LAS unsigned char*)hist + addr), 1u, __ATOMIC_RELAXED, __HIP_MEMORY_SCOPE_WORKGROUP);
            }
        } else
#pragma unroll
        for (int r = 0; r < 16; ++r) {
            const unsigned mono = dsa_mono(sc[r]);
            unsigned addr;
            if (PASS == 0) { addr = ((mono >> 22) << 2) + rowb; }
            else { addr = (((mono >> 12) & 1023u) << 2) + rowb; if ((mono >> 22) != P1) addr = rowb + 4096u; }
            __hip_atomic_fetch_add((LAS unsigned*)((LAS unsigned char*)hist + addr), 1u, __ATOMIC_RELAXED, __HIP_MEMORY_SCOPE_WORKGROUP);
#if defined(PROBE_D1_ATOM2X)
            __hip_atomic_fetch_add((LAS unsigned*)((LAS unsigned char*)hist + rowb + 4096u), 1u, __ATOMIC_RELAXED, __HIP_MEMORY_SCOPE_WORKGROUP);
#endif
        }
    }
}
__device__ __forceinline__ void dsa_scan(LAS unsigned* hist, LAS unsigned* AUX, int pass, int wid, int lane) {
#pragma unroll
    for (int qi = 0; qi < 4; ++qi) {
        const int qq = 4 * wid + qi;
        const unsigned K = (pass == 0) ? 256u : AUX[32 + qq];
        LAS const unsigned* hrow = hist + qq * DS_HP;
        const int wb = 1008 - 16 * lane;
        unsigned s = 0u;
#pragma unroll
        for (int i = 0; i < 16; ++i) s += hrow[wb + ((i + lane) & 15)];
        unsigned incl = s;
#pragma unroll
        for (int o = 1; o < 64; o <<= 1) { const unsigned v = shupu(incl, o, lane); if (lane >= o) incl += v; }
        const unsigned long long bal = __ballot(incl >= K);
        const int L = __builtin_amdgcn_readfirstlane(bal ? (__ffsll((long long)bal) - 1) : 0);
        const unsigned above = (unsigned)__builtin_amdgcn_readlane((int)(incl - s), L);
        const int bin = 1023 - 16 * L - (lane & 15);
        const unsigned c = (lane < 16) ? hrow[bin] : 0u;
        unsigned inc2 = c;
#pragma unroll
        for (int o = 1; o < 16; o <<= 1) { const unsigned v = shupu(inc2, o, lane); if (lane >= o) inc2 += v; }
        const unsigned long long bal2 = __ballot(lane < 16 && above + inc2 >= K);
        const int I = __builtin_amdgcn_readfirstlane(bal2 ? (__ffsll((long long)bal2) - 1) : 0);
        if (lane == I) { AUX[64 * pass + qq] = (unsigned)bin; AUX[64 * pass + 32 + qq] = K - (above + inc2 - c); }
    }
}
__device__ __forceinline__ void dsa_select_unit(LAS unsigned char* lds, int b, int qg, const bf16* IX, unsigned* MASK, int* REFPOS  , int* REFMIN  ) {
    int tid_l = threadIdx.x; asm volatile("" : "+v"(tid_l)); const int tid = tid_l, lane = tid & 63, wid = __builtin_amdgcn_readfirstlane(tid >> 6), r32 = lane & 31, hi = lane >> 5;
    const int t = 32 * qg + r32;
    const size_t rowg = (size_t)b * SEQ;
    const bf16* qrow = IX + (rowg + t) * 256;
    bf16x8 iqf[4][2];
#pragma unroll
    for (int hh = 0; hh < 4; ++hh)
#pragma unroll
        for (int ds = 0; ds < 2; ++ds) iqf[hh][ds] = *(const bf16x8*)(qrow + 32 * hh + 16 * ds + 8 * hi);
    float w[4];
    { const v2u ww = *(const v2u*)(qrow + 160); w[0] = bflo(ww.x); w[1] = bfhi(ww.x); w[2] = bflo(ww.y); w[3] = bfhi(ww.y); }
    LAS unsigned* hist = (LAS unsigned*)lds;
    LAS unsigned* AUX = (LAS unsigned*)(lds + DS_AUX);
    const bf16* kbase = IX + (rowg + r32) * 256 + 128 + 8 * hi;
    unsigned P = 0u;
    const bool all = (qg < 8);
    if (!all) {
        for (int i = tid; i < DS_HIST_BYTES / 16; i += 512) ((LAS v4u*)lds)[i] = (v4u){0u, 0u, 0u, 0u};
#if defined(PROBE_D1_ZERO2X)
        __syncthreads(); for (int i = tid; i < DS_HIST_BYTES / 16; i += 512) ((LAS v4u*)lds)[i] = (v4u){0u, 0u, 0u, 0u}; __syncthreads(); for (int i = tid; i < DS_HIST_BYTES / 16; i += 512) ((LAS v4u*)lds)[i] = (v4u){0u, 0u, 0u, 0u};
#endif
        __syncthreads();
        dsa_hist_pass<0>(hist, iqf, w, kbase, qg, wid, r32, hi, t, 0u);
        __syncthreads();
        dsa_scan(hist, AUX, 0, wid, lane);
#if defined(PROBE_D1_SCAN2X)
        __syncthreads(); dsa_scan(hist, AUX, 0, wid, lane);
#endif
        __syncthreads();
        const unsigned P1 = AUX[r32];
        for (int i = tid; i < DS_HIST_BYTES / 16; i += 512) ((LAS v4u*)lds)[i] = (v4u){0u, 0u, 0u, 0u};
        __syncthreads();
        dsa_hist_pass<1>(hist, iqf, w, kbase, qg, wid, r32, hi, t, P1);
        __syncthreads();
        dsa_scan(hist, AUX, 1, wid, lane);
#if defined(PROBE_D1_SCAN2X)
        __syncthreads(); dsa_scan(hist, AUX, 1, wid, lane);
#endif
        __syncthreads();
        P = (P1 << 10) | AUX[64 + r32];
    }
    if (all) { if (tid < 32) { AUX[64 + 32 + tid] = 0u; } }
    for (int i = tid; i < (2 * 32 * DS_BP * 4) / 16; i += 512) ((LAS v4u*)lds)[i] = (v4u){0u, 0u, 0u, 0u};
    __syncthreads();
    LAS unsigned* G = (LAS unsigned*)(lds + DS_G);
    LAS unsigned* C = (LAS unsigned*)(lds + DS_C);
    bf16x8 nk0, nk1;
    { const int j0 = (wid <= qg) ? wid : 0; nk0 = *(const bf16x8*)(kbase + (size_t)j0 * 32 * 256); nk1 = *(const bf16x8*)(kbase + (size_t)j0 * 32 * 256 + 16); }
#pragma nounroll
    for (int j = wid; j <= qg; j += 8) {
        const bf16x8 k0 = nk0, k1 = nk1;
        { const int jn = (j + 8 <= qg) ? j + 8 : j; const bf16* kp = kbase + (size_t)jn * 32 * 256; nk0 = *(const bf16x8*)kp; nk1 = *(const bf16x8*)(kp + 16); }
        float sc[16]; dsa_scores(iqf, w, k0, k1, sc);
        unsigned bg = 0u, bc = 0u;
        const int lim = t - 32 * j - 4 * hi;
#pragma unroll
        for (int r = 0; r < 16; ++r) {
            const int pos = (r & 3) + 8 * (r >> 2) + 4 * hi;
            const unsigned p22 = dsa_mono(sc[r]) >> 12;
            const bool ok = ((r & 3) + 8 * (r >> 2)) <= lim;
            if (ok && p22 > P) bg |= 1u << pos;
            if (ok && p22 == P) bc |= 1u << pos;
        }
        bg |= shxu(bg, 32, lane); bc |= shxu(bc, 32, lane);
        if (hi == 0) { G[r32 * DS_BP + j] = bg; C[r32 * DS_BP + j] = bc; }
    }
    __syncthreads();
#pragma unroll
    for (int qi = 0; qi < 4; ++qi) {
        const int qq = 4 * wid + qi;
        const unsigned K2 = AUX[64 + 32 + qq];
        const unsigned w0 = C[qq * DS_BP + 2 * lane], w1 = C[qq * DS_BP + 2 * lane + 1];
        const unsigned pc = (unsigned)__popc(w0) + (unsigned)__popc(w1);
        unsigned incl = pc;
#pragma unroll
        for (int o = 1; o < 64; o <<= 1) { const unsigned v = shupu(incl, o, lane); if (lane >= o) incl += v; }
        const unsigned pre = incl - pc;
        unsigned need = K2 > pre ? K2 - pre : 0u;
        const unsigned t0 = take_low(w0, need); need -= (unsigned)__popc(t0);
        const unsigned t1 = take_low(w1, need);
        const unsigned g0 = G[qq * DS_BP + 2 * lane] | t0, g1 = G[qq * DS_BP + 2 * lane + 1] | t1;
        G[qq * DS_BP + 2 * lane] = g0; G[qq * DS_BP + 2 * lane + 1] = g1;
        int hp = g1 ? (64 * lane + 63 - __clz((int)g1)) : (g0 ? (64 * lane + 31 - __clz((int)g0)) : -1);
#pragma unroll
        for (int o = 1; o < 64; o <<= 1) { const int v = (int)shxu((unsigned)hp, o, lane); hp = v > hp ? v : hp; }
        if (lane == 0) { REFPOS[rowg + 32 * qg + qq] = hp; AUX[128 + qq] = (unsigned)hp; }
    }
    __syncthreads();
    if (tid == 0) { int mn = 0x7fffffff; for (int i = 0; i < 32; ++i) { const int v = (int)AUX[128 + i]; mn = v < mn ? v : mn; } REFMIN[b * 128 + qg] = mn; }
    { const int qq = tid >> 4, part = tid & 15;
        unsigned* dst = MASK + (rowg + 32 * qg + qq) * 128 + part * 8;
        v4u a, c2;
        a.x = G[qq * DS_BP + part * 8 + 0]; a.y = G[qq * DS_BP + part * 8 + 1]; a.z = G[qq * DS_BP + part * 8 + 2]; a.w = G[qq * DS_BP + part * 8 + 3];
        c2.x = G[qq * DS_BP + part * 8 + 4]; c2.y = G[qq * DS_BP + part * 8 + 5]; c2.z = G[qq * DS_BP + part * 8 + 6]; c2.w = G[qq * DS_BP + part * 8 + 7];
        *(v4u*)dst = a; *(v4u*)(dst + 4) = c2; }
    __syncthreads();
}

constexpr int PL_U = 0, PL_UP = 528, PL_D = 79 * 528 + 16  , PL_DP = 257;
__device__ __forceinline__ void pool_unit(LAS unsigned char* lds, int b, int tile, const bf16* PU, const float* wpool  , const float* pscale  , bf16* YC) {
    int tid_l = threadIdx.x; asm volatile("" : "+v"(tid_l)); const int tid = tid_l, cb = __builtin_amdgcn_readfirstlane(tid >> 6), tt = tid & 63;
    const int t0 = tile * 64; const size_t rowg = (size_t)b * SEQ;
    for (int i = tid; i < 79 * 32; i += 512) { const int rr = i >> 5, ch = i & 31; const int tok = t0 - 15 + rr;
        v4u v = (v4u){0u, 0u, 0u, 0u}; if (tok >= 0) v = *(const v4u*)(PU + (rowg + tok) * 256 + ch * 8);
        *(LAS v4u*)(lds + PL_U + rr * PL_UP + ch * 16) = v; }
    __syncthreads();
    const int g = cb >> 1, wlen = 2 << g, c0 = 32 * cb, t = t0 + tt;
    const float inv = 1.f / (float)((t + 1 < wlen) ? (t + 1) : wlen);
    LAS float* Dm = (LAS float*)(lds + PL_D);
#pragma unroll
    for (int ch = 0; ch < 4; ++ch) {
        float sum[8];
#pragma unroll
        for (int e = 0; e < 8; ++e) sum[e] = 0.f;
        float self[8];
        for (int i = 0; i < wlen; ++i) {
            const v4u v = *(LAS const v4u*)(lds + PL_U + (15 + tt - i) * PL_UP + (c0 + 8 * ch) * 2);
            const float f[8] = {bflo(v.x), bfhi(v.x), bflo(v.y), bfhi(v.y), bflo(v.z), bfhi(v.z), bflo(v.w), bfhi(v.w)};
#pragma unroll
            for (int e = 0; e < 8; ++e) { sum[e] += f[e]; if (i == 0) self[e] = f[e]; }
        }
#pragma unroll
        for (int e = 0; e < 8; ++e) Dm[tt * PL_DP + c0 + 8 * ch + e] = sum[e] * inv - self[e];
    }
    __syncthreads();
    const int e0 = 32 * (cb & 1);
    float acc[32];
#pragma unroll
    for (int e = 0; e < 32; ++e) acc[e] = 0.f;
    const float* wg = wpool + (size_t)g * 4096 + e0;
    for (int c = 0; c < 64; ++c) {
        const float dv = Dm[tt * PL_DP + 64 * g + c];
        const float* wr = wg + c * 64;
#pragma unroll
        for (int e = 0; e < 32; ++e) acc[e] = __builtin_fmaf(dv, wr[e], acc[e]);
    }
    bf16* orow = YC + (rowg + t) * 256 + 64 * g + e0;
    const float* ps = pscale + 64 * g + e0;
#pragma unroll
    for (int k = 0; k < 4; ++k) { v4u o;
        o.x = pk2(acc[8 * k + 0] * ps[8 * k + 0], acc[8 * k + 1] * ps[8 * k + 1]); o.y = pk2(acc[8 * k + 2] * ps[8 * k + 2], acc[8 * k + 3] * ps[8 * k + 3]);
        o.z = pk2(acc[8 * k + 4] * ps[8 * k + 4], acc[8 * k + 5] * ps[8 * k + 5]); o.w = pk2(acc[8 * k + 6] * ps[8 * k + 6], acc[8 * k + 7] * ps[8 * k + 7]);
        *(v4u*)(orow + 8 * k) = o; }
    __syncthreads();
}
__device__ __forceinline__ void kmean_item(int item, const bf16* AK, float* KMEAN, int wid, int lane_in) {
    int lane = lane_in; asm volatile("" : "+v"(lane));
    const int combo = item * 8 + wid; const int b = combo >> 6, h = (combo >> 4) & 3, n = combo & 15;
    const int ks = lane >> 3, ch = lane & 7;
    const bf16* p = AK + ((size_t)b * SEQ + 256 * n + ks) * 256 + 64 * h + 8 * ch;
    float s[8];
#pragma unroll
    for (int e = 0; e < 8; ++e) s[e] = 0.f;
#pragma unroll 8
    for (int j = 0; j < 32; ++j) { const v4u v = *(const v4u*)(p + (size_t)j * 8 * 256);
        s[0] += bflo(v.x); s[1] += bfhi(v.x); s[2] += bflo(v.y); s[3] += bfhi(v.y); s[4] += bflo(v.z); s[5] += bfhi(v.z); s[6] += bflo(v.w); s[7] += bfhi(v.w); }
#pragma unroll
    for (int e = 0; e < 8; ++e) { s[e] += shx(s[e], 8, lane); s[e] += shx(s[e], 16, lane); s[e] += shx(s[e], 32, lane); }
    if (ks == 0) { float* o = KMEAN + (size_t)combo * 64 + 8 * ch;
        *(f32x4*)o = (f32x4){s[0], s[1], s[2], s[3]} * (1.f / 256.f); *(f32x4*)(o + 4) = (f32x4){s[4], s[5], s[6], s[7]} * (1.f / 256.f); }
}

__device__ __forceinline__ void norm_unit(LAS unsigned char* lds, int n, const bf16* PROJ, size_t TS, unsigned* NRM  ) {
    int tid_l = threadIdx.x; asm volatile("" : "+v"(tid_l)); const int tid = tid_l, lane = tid & 63, wid = __builtin_amdgcn_readfirstlane(tid >> 6);
    const int a = n >> 8, rem = n & 255, sq = rem >> 7, b = (rem >> 4) & 7, c = rem & 15;
    const int tile = (a == 0 ? 0 : (a == 1 ? 3 : 7)) + sq;
    const int row = tid >> 1, hp = tid & 1;
    float ss[2] = {0.f, 0.f};
#pragma unroll
    for (int rr = 0; rr < 1; ++rr) {
        const bf16* p = PROJ + (size_t)tile * TS + ((size_t)b * SEQ + 256 * c + row) * 256 + 128 * hp;
#pragma unroll
        for (int hh = 0; hh < 2; ++hh) { float acc = 0.f;
#pragma unroll
            for (int i = 0; i < 8; ++i) { const v4u v = *(const v4u*)(p + 64 * hh + 8 * i);
                const float f0 = bflo(v.x), f1 = bfhi(v.x), f2 = bflo(v.y), f3 = bfhi(v.y), f4 = bflo(v.z), f5 = bfhi(v.z), f6 = bflo(v.w), f7 = bfhi(v.w);
                acc += (f0 * f0 + f1 * f1) + (f2 * f2 + f3 * f3) + (f4 * f4 + f5 * f5) + (f6 * f6 + f7 * f7); }
            ss[hh] = fmaxf(ss[hh], acc); }
    }
#pragma unroll
    for (int o = 2; o < 64; o <<= 1) { ss[0] = fmaxf(ss[0], shx(ss[0], o, lane)); ss[1] = fmaxf(ss[1], shx(ss[1], o, lane)); }
    LAS float* R = (LAS float*)lds;
    if (lane < 2) { R[wid * 4 + 2 * hp] = ss[0]; R[wid * 4 + 2 * hp + 1] = ss[1]; }
    __syncthreads();
    if (tid < 4) { float m = R[tid];
#pragma unroll
        for (int w2 = 1; w2 < 8; ++w2) m = fmaxf(m, R[w2 * 4 + tid]);
        __hip_atomic_fetch_max(NRM + ((a * 2 + sq) * 8 + b) * 4 + tid, __float_as_uint(m * 1.0001f), __ATOMIC_RELAXED, __HIP_MEMORY_SCOPE_AGENT); }
    __syncthreads();
}

__device__ __forceinline__ float alibi_slope(int idx  ) { return exp2f(-8.f * (float)idx / 12.f); }

__device__ __forceinline__ void p0_adaln(const Args& A, LAS unsigned char* lds, int G) {
    int tid_l = threadIdx.x; asm volatile("" : "+v"(tid_l)); const int tid = tid_l, lane = tid & 63, wid = __builtin_amdgcn_readfirstlane(tid >> 6);
    LAS float* cact = (LAS float*)lds;
    LAS float* red = (LAS float*)(lds + 32768);
    float* MOD = (float*)(A.ws + WS_MOD);
    if ((int)blockIdx.x < 192) {
        for (int i = tid; i < 8192; i += 512) { const int bb = i >> 10, k = i & 1023; const float v = A.c[i]; cact[k * 8 + bb] = v / (1.f + __expf(-v)); }
        __syncthreads();
        for (int u = blockIdx.x; u < 192; u += G) {
            const int l = u / 96, n0 = (u % 96) * 64;
            const float* wp = A.w_ada + ((size_t)l * 1024 + 128 * wid) * 6144 + n0 + lane;
            float acc[8];
#pragma unroll
            for (int bb = 0; bb < 8; ++bb) acc[bb] = 0.f;
#pragma unroll 16
            for (int k = 0; k < 128; ++k) {
                const float wv = wp[(size_t)k * 6144];
                const f32x4 c0 = *(LAS const f32x4*)(cact + (128 * wid + k) * 8), c1 = *(LAS const f32x4*)(cact + (128 * wid + k) * 8 + 4);
                acc[0] += c0[0] * wv; acc[1] += c0[1] * wv; acc[2] += c0[2] * wv; acc[3] += c0[3] * wv;
                acc[4] += c1[0] * wv; acc[5] += c1[1] * wv; acc[6] += c1[2] * wv; acc[7] += c1[3] * wv;
            }
#pragma unroll
            for (int bb = 0; bb < 8; ++bb) red[(wid * 8 + bb) * 64 + lane] = acc[bb];
            __syncthreads();
            { const int bb = wid; float s = A.b_ada[(size_t)l * 6144 + n0 + lane];
#pragma unroll
                for (int w2 = 0; w2 < 8; ++w2) s += red[(w2 * 8 + bb) * 64 + lane];
                MOD[((size_t)l * 8 + bb) * 6144 + n0 + lane] = s; }
            __syncthreads();
        }
    }
    __syncthreads();
}
__device__ __forceinline__ void p0_weights(const Args& A, LAS unsigned char* lds, int vcu, int G, int l0, int l1) {
    int tid_l = threadIdx.x; asm volatile("" : "+v"(tid_l)); const int tid = tid_l, lane = tid & 63, wid = __builtin_amdgcn_readfirstlane(tid >> 6);
    unsigned char* ws = A.ws;
    LAS float* scr = (LAS float*)(lds + wid * 16384);
    const int gw = vcu * NWAVES + wid, NGW = G * NWAVES;
    constexpr int I_IN = 16 * (NPROJ_PAD / 32), I_G1 = 16 * 32, I_BR1 = 4 * 32, I_OUT = 16 * 32, I_F1 = 16 * 128, I_F2 = 64 * 32;
    constexpr int I_LAYER = I_IN + 4 * I_G1 + 4 * I_BR1 + I_OUT + I_F1 + I_F2;
    for (int it = l0 * I_LAYER + gw; it < l1 * I_LAYER; it += NGW) {
        const int l = it / I_LAYER; int r = it % I_LAYER;
        bf16* WL = (bf16*)(ws + WS_W) + (size_t)l * W_LAYER;
        if (r < I_IN) {
            const int nb = r % (NPROJ_PAD / 32), tile = nb >> 3;
            const int i7 = (tile == 0) ? 0 : (tile == 1) ? 1 : (tile == 3) ? 2 : (tile == 4) ? 3 : (tile == 7) ? 4 : (tile == 8) ? 5 : (tile == 10) ? 6 : -1;
            if (i7 >= 0) p0_transpose_item(A.w_in + (size_t)l * DM * NPROJ, DM, NPROJ, NPROJ_PAD, WL + W_IN + (ptrdiff_t)(i7 - tile) * 256 * DM, 0, 0, scr, r, lane);
            else { const int i4 = (tile == 2) ? 0 : (tile == 5) ? 1 : (tile == 6) ? 2 : 3;
                p0_transpose_item(A.w_in + (size_t)l * DM * NPROJ, DM, NPROJ, NPROJ_PAD, (bf16*)((unsigned char*)(WL + W_IN + (size_t)7 * 256 * DM) + (ptrdiff_t)(i4 - tile) * 256 * DM), 4, 0, scr, r, lane); }
            continue; } r -= I_IN;
        if (r < 4 * I_G1) { const int br = r / I_G1; p0_transpose_item(A.w_gate + ((size_t)l * 4 + br) * DM * DM, DM, DM, DM, WL + W_GATE, 2, br, scr, r % I_G1, lane); continue; } r -= 4 * I_G1;
        if (r < 4 * I_BR1) { const int br = r / I_BR1; p0_transpose_item(A.w_branch + ((size_t)l * 4 + br) * 256 * DM, 256, DM, DM, WL + W_BR + (size_t)br * DM * 256, 0, 0, scr, r % I_BR1, lane); continue; } r -= 4 * I_BR1;
        if (r < I_OUT) { p0_transpose_item(A.w_out + (size_t)l * DM * DM, DM, DM, DM, WL + W_OUT, 0, 0, scr, r, lane); continue; } r -= I_OUT;
        if (r < I_F1) { p0_transpose_item(A.w_ff1 + (size_t)l * DM * FF, DM, FF, FF, WL + W_FF1, 0, 0, scr, r, lane); continue; } r -= I_F1;
        p0_transpose_item(A.w_ff2 + (size_t)l * FF * DM, FF, DM, DM, WL + W_FF2, 3, 0, scr, r, lane);
    }
    __syncthreads();
}

__device__ __forceinline__ int wq_draw(gu32* ctr) { int v = 0; if (threadIdx.x == 0) v = (int)__hip_atomic_fetch_add(ctr, 1u, RLX_AGENT); return v; }
__device__ __forceinline__ int wq_bcast(volatile LAS unsigned* slot, int v) {
    if (threadIdx.x == 0) *slot = (unsigned)v;
    __syncthreads();
    const int item = (int)*slot;
    __syncthreads();
    return item;
}

#ifndef ZG_ALIGN
#define ZG_ALIGN true
#define ZG_SP2 false
#endif
#ifndef IN_ALIGN
#define IN_ALIGN true
#define IN_SP2 true
#endif
#ifndef GT_ALIGN
#define GT_ALIGN true
#define GT_SP2 false
#endif
#ifndef WO_ALIGN
#define WO_ALIGN true
#define WO_SP2 true
#endif
#ifndef F1_ALIGN
#define F1_ALIGN true
#define F1_SP2 true
#endif
#ifndef F2_ALIGN
#define F2_ALIGN true
#define F2_SP2 true
#endif
struct ZOrder {
    pg8::StaticOrder base;
    __device__ __forceinline__ bool next(int i, pg8::Unit& u) const { if (!base.next(i, u)) return false; u.pn += 4 * (u.pm >> 7); return true; }
    __device__ __forceinline__ void a_ready(const pg8::Unit&) const {}
    __device__ __forceinline__ void done(const pg8::Unit&) const {}
};

__global__ void __launch_bounds__(NWAVES * 64, 2) hybrid_fwd(Args args) {
    extern __shared__ __attribute__((aligned(16))) unsigned char lds_raw[];
    LAS unsigned char* lds = (LAS unsigned char*)lds_raw;
#define PHASE_IDS int tid_p = threadIdx.x; asm volatile("" : "+v"(tid_p)); const int lane = tid_p & 63, wid = __builtin_amdgcn_readfirstlane(tid_p >> 6); const int gw = vcu * NWAVES + wid, ngw = G * NWAVES; (void)lane; (void)gw; (void)ngw;
    const int G = gridDim.x; const int bx = blockIdx.x; const int vcu = (G % 8 == 0) ? (bx % 8) * (G / 8) + bx / 8 : bx;
    unsigned char* ws = args.ws;
    gu32* ctl = (gu32*)(ws + WS_CTL);
    volatile LAS unsigned* MISC = (volatile LAS unsigned*)(lds + LDSCTL_OFF);
    for (int u = threadIdx.x; u < (LDS_BYTES - LDSCTL_OFF) / 4; u += NWAVES * 64) ((LAS unsigned*)(lds + LDSCTL_OFF))[u] = 0u;
    __syncthreads();
    const int lo = args.ph_lo, hi = args.ph_hi;
    XcdBarrier bar; bar.bar = (unsigned*)(ctl + CW_BAR) + args.li * XCD_BAR_WORDS; bar.x = 0; bar.st = nullptr;
    if (hi - lo > 1) bar = xcd_barrier_post((unsigned*)(ctl + CW_BAR) + args.li * XCD_BAR_WORDS, MISC + 8);
#ifndef PHASE_OFF
#define PHASE_OFF 0
#endif
#define IN(k) (lo <= (k) && (k) < hi && !((PHASE_OFF >> ((k) == 0 ? 0 : (k) == 21 ? 11 : (((k) - 1) % 10) + 1)) & 1))
#ifndef REPEAT_MASK
#define REPEAT_MASK 0
#endif
#define NREP(bit) (((REPEAT_MASK >> (bit)) & 1) ? 2 : 1)
#if defined(PROBE_SEAM2X)
#define SEAM(k) do { if (IN(k) && IN((k) + 1)) { xcd_barrier(bar); xcd_barrier(bar); } } while (0)
#else
#define SEAM(k) do { if (IN(k) && IN((k) + 1)) xcd_barrier(bar); } while (0)
#endif
    float* MOD = (float*)(ws + WS_MOD);
    float* KMEAN = (float*)(ws + WS_KMEAN);
    int* REFPOS = (int*)(ws + WS_KMEAN + 128 * 1024);
    int* REFMIN = (int*)(ws + WS_KMEAN + 256 * 1024);
    unsigned* MASK = (unsigned*)(ws + WS_MASK);
    bf16* H = (bf16*)(ws + WS_H);
    unsigned char* H8 = ws + WS_H8;
    bf16* Y = (bf16*)(ws + WS_Y);
    bf16* MERGED = (bf16*)(ws + WS_Y);
    bf16* PROJ = (bf16*)(ws + WS_R);
    unsigned char* Z = ws + WS_R;
    unsigned char* U8 = ws + WS_R;
    bf16* XRB = (bf16*)args.out;
    constexpr size_t TS = (size_t)TOK * 256;
    volatile LAS unsigned* wqslot = MISC + 16;

    if (IN(0)) for (int rep = 0; rep < NREP(0); ++rep) { p0_adaln(args, lds, G); }
    SEAM(0);

#pragma nounroll
    for (int l = 0; l < NL; ++l) {
        const int pb = 1 + 10 * l;
        const float* modl = MOD + (size_t)l * 8 * 6144;
        const bf16* WL = (const bf16*)(ws + WS_W) + (size_t)l * W_LAYER;
        if (IN(pb + 0)) for (int rep = 0; rep < NREP(1); ++rep) { PHASE_IDS if (l == 0) norm_rows_bf16<false>(lds, args.x, H, H8, args.norm1_g + (size_t)l * DM, modl, 0, 1, gw, ngw, lane); else norm_rows_bf16<true>(lds, XRB, H, H8, args.norm1_g + (size_t)l * DM, modl, 0, 1, gw, ngw, lane); if (l == 0) p0_weights(args, lds, vcu, G, 0, 1); }
        SEAM(pb + 0);
        if (IN(pb + 1)) for (int rep = 0; rep < NREP(2); ++rep) {
            { int k8 = DM / 2; asm volatile("" : "+s"(k8));
              pg8::Gemm g{(const bf16*)H8, (const bf16*)((const unsigned char*)(WL + W_IN + (size_t)7 * 256 * DM)), TOK, 1024, k8}; pg8::StaticOrder S; S.init(TOK, 1024, G, bx);
              pg8::EpiProj<true> E{PROJ, TS};
              pg8::gemm_phase<pg8::EpiProj<true>, pg8::StaticOrder, IN_ALIGN, IN_SP2, true>(lds, g, S, E); }
            { pg8::Gemm g{H, WL + W_IN, TOK, 1792, DM}; pg8::StaticOrder S; S.init(TOK, 1792, G, bx);
              pg8::EpiProj<false> E{PROJ, TS};
              pg8::gemm_phase<pg8::EpiProj<false>, pg8::StaticOrder, IN_ALIGN, IN_SP2>(lds, g, S, E); }
            if (l == 0 && rep == 0 && bx >= 128) p0_weights(args, lds, bx - 128, G - 128, 1, 2);
        }
        SEAM(pb + 1);
        unsigned* NRM = (unsigned*)(ctl + CW_NRM) + l * 192;
        if (IN(pb + 2)) for (int rep = 0; rep < NREP(3); ++rep) {
            gu32* ctr = ctl + CW_WQ + (l * 2 + 0 + 4 * rep) * 64;
            int raw = wq_draw(ctr);
            for (;;) {
#ifndef REPA_LO
#define REPA_LO 0
#define REPA_HI 2368
#endif
                const int item = wq_bcast(wqslot, raw) + (rep ? REPA_LO : 0);
                if (item >= (rep ? REPA_HI : 2368)) break;
                raw = wq_draw(ctr);
                if (item < 1024) { const int qg = 127 - (item >> 3), b = item & 7;
                    dsa_select_unit(lds, b, qg, PROJ + 10 * TS, MASK, REFPOS, REFMIN);
                } else if (item < 1536) { const int i2 = item - 1024; const int b = i2 >> 6, tile = i2 & 63;
                    pool_unit(lds, b, tile, PROJ + 6 * TS, args.w_pool + (size_t)l * 4 * 4096, args.pool_scale + (size_t)l * 256, Y + 2 * TS);
                } else if (item < 1600) { PHASE_IDS kmean_item(item - 1536, PROJ + 1 * TS, KMEAN, wid, lane);
                } else { norm_unit(lds, item - 1600, PROJ, TS, NRM); }
            }
        }
        SEAM(pb + 2);
        if (IN(pb + 3)) for (int rep = 0; rep < NREP(4); ++rep) {
            gu32* ctr = ctl + CW_WQ + 512 + ((l * 2 + rep) * 8) * 64;
            const float li = 0.8f - 0.6f * __expf(-0.3f * (float)l);
            const float* dl = args.diff_lambda + (size_t)l * 128;
            float d1 = 0.f, d2 = 0.f;
            for (int i = 0; i < 32; ++i) { d1 += dl[i] * dl[32 + i]; d2 += dl[64 + i] * dl[96 + i]; }
            const float lam = __expf(d1) - __expf(d2) + li;
            int raw = wq_draw(ctr);
            for (;;) {
                const int item = wq_bcast(wqslot, raw);
                if (item >= 1536) break;
                raw = wq_draw(ctr);
                const int ty = item % 3, rest = item / 3; const int qb = 15 - (rest >> 5), bh = rest & 31, b = bh >> 2, h = bh & 3;
                if (ty == 0) attn_unit<1>(lds, b, h, qb, PROJ + 3 * TS, PROJ + 4 * TS, PROJ + 5 * TS, Y + 1 * TS, alibi_slope(3 * h + 2), nullptr, lam, 1.f - li, args.diff_subln_g + (size_t)l * 64, nullptr, NRM + 64, nullptr, nullptr);
                else if (ty == 1) attn_unit<0>(lds, b, h, qb, PROJ + 0 * TS, PROJ + 1 * TS, PROJ + 2 * TS, Y + 0 * TS, alibi_slope(3 * h + 1), KMEAN, 0.f, 0.f, nullptr, nullptr, NRM, nullptr, nullptr);
                else              attn_unit<2>(lds, b, h, qb, PROJ + 7 * TS, PROJ + 8 * TS, PROJ + 9 * TS, Y + 3 * TS, alibi_slope(3 * h + 3), nullptr, 0.f, 0.f, nullptr, MASK, NRM + 128, REFPOS, REFMIN);
            }
        }
        SEAM(pb + 3);
        if (IN(pb + 4)) for (int rep = 0; rep < NREP(5); ++rep) {
            int kz = 256; asm volatile("" : "+s"(kz)); pg8::Gemm g{Y, WL + W_BR, 4 * TOK, 4096, kz}; ZOrder S; S.base.init(4 * TOK, DM, G, bx);
            pg8::EpiZ E{Z};
            pg8::gemm_phase<pg8::EpiZ, ZOrder, ZG_ALIGN, ZG_SP2>(lds, g, S, E);
        }
        SEAM(pb + 4);
        if (IN(pb + 5)) for (int rep = 0; rep < NREP(6); ++rep) {
            int kg = DM / 2; asm volatile("" : "+s"(kg));
            pg8::Gemm g{(const bf16*)H8, WL + W_GATE, TOK, 4096, kg}; pg8::StaticOrder S; S.init(TOK, 4096, G, bx);
            pg8::EpiGate E{Z, args.b_gate + (size_t)l * 4 * DM, MERGED};
            pg8::gemm_phase<pg8::EpiGate, pg8::StaticOrder, GT_ALIGN, GT_SP2, true>(lds, g, S, E);
        }
        SEAM(pb + 5);
        if (IN(pb + 6)) for (int rep = 0; rep < NREP(7); ++rep) {
            pg8::Gemm g{MERGED, WL + W_OUT, TOK, DM, DM}; pg8::StaticOrder S; S.init(TOK, DM, G, bx);
            if (l == 0) { pg8::EpiResid<false> E{args.x, rep ? (bf16*)(ws + WS_R) : XRB, modl + 2 * 1024, 1.f};
                pg8::gemm_phase<pg8::EpiResid<false>, pg8::StaticOrder, WO_ALIGN, WO_SP2>(lds, g, S, E); }
            else { pg8::EpiResid<true> E{XRB, rep ? (bf16*)(ws + WS_R) : XRB, modl + 2 * 1024, 1.f};
                pg8::gemm_phase<pg8::EpiResid<true>, pg8::StaticOrder, WO_ALIGN, WO_SP2>(lds, g, S, E); }
        }
        SEAM(pb + 6);
        if (IN(pb + 7)) for (int rep = 0; rep < NREP(8); ++rep) { PHASE_IDS norm_rows_bf16<true>(lds, XRB, H, nullptr, args.norm2_g + (size_t)l * DM, modl, 3, 4, gw, ngw, lane); }
        SEAM(pb + 7);
        if (IN(pb + 8)) for (int rep = 0; rep < NREP(9); ++rep) {
            pg8::Gemm g{H, WL + W_FF1, TOK, FF, DM}; pg8::StaticOrder S; S.init(TOK, FF, G, bx);
            pg8::EpiRelu2 E{U8, FF};
            pg8::gemm_phase<pg8::EpiRelu2, pg8::StaticOrder, F1_ALIGN, F1_SP2>(lds, g, S, E);
        }
        SEAM(pb + 8);
        if (IN(pb + 9)) for (int rep = 0; rep < NREP(10); ++rep) {
            int kf = FF / 2; asm volatile("" : "+s"(kf));
            pg8::Gemm g{(const bf16*)U8, WL + W_FF2, TOK, DM, kf}; pg8::StaticOrder S; S.init(TOK, DM, G, bx);
            pg8::EpiResid<true> E{XRB, rep ? (bf16*)(ws + WS_MASK) : XRB, modl + 5 * 1024, 1.f / 64.f};
            pg8::gemm_phase<pg8::EpiResid<true>, pg8::StaticOrder, F2_ALIGN, F2_SP2, true>(lds, g, S, E);
        }
        SEAM(pb + 9);
    }
    if (IN(21)) {
        PHASE_IDS
        v4u xa[16], xb[16]; float rs[16];
        const v4u* xp = (const v4u*)(XRB + (size_t)gw * DM) + 2 * lane;
#pragma unroll
        for (int i = 0; i < 16; ++i) { xa[i] = xp[(size_t)i * ngw * (DM / 8)]; xb[i] = xp[(size_t)i * ngw * (DM / 8) + 1]; }
#pragma unroll
        for (int i = 0; i < 16; ++i) { const v4u a = xa[i], c = xb[i];
            float s = bflo(a.x) * bflo(a.x); s += bfhi(a.x) * bfhi(a.x); s += bflo(a.y) * bflo(a.y); s += bfhi(a.y) * bfhi(a.y); s += bflo(a.z) * bflo(a.z); s += bfhi(a.z) * bfhi(a.z); s += bflo(a.w) * bflo(a.w); s += bfhi(a.w) * bfhi(a.w);
            s += bflo(c.x) * bflo(c.x); s += bfhi(c.x) * bfhi(c.x); s += bflo(c.y) * bflo(c.y); s += bfhi(c.y) * bfhi(c.y); s += bflo(c.z) * bflo(c.z); s += bfhi(c.z) * bfhi(c.z); s += bflo(c.w) * bflo(c.w); s += bfhi(c.w) * bfhi(c.w);
            rs[i] = 1.f / sqrtf(wave_sum(s, lane) * (1.f / DM) + NORM_EPS); }
        xcd_barrier(bar);
#pragma unroll
        for (int i = 0; i < 16; ++i) asm volatile("" : "+v"(xa[i]), "+v"(xb[i]));
        const f32x4* gp = (const f32x4*)args.final_g + 4 * lane;
        f32x4* op = (f32x4*)(args.out + (size_t)gw * DM) + 4 * lane;
#pragma unroll
        for (int i = 0; i < 16; ++i) { const v4u a = xa[i], c = xb[i]; const float r = rs[i]; f32x4* o = op + (size_t)i * ngw * (DM / 4);
            o[0] = (f32x4){bflo(a.x), bfhi(a.x), bflo(a.y), bfhi(a.y)} * r * gp[0]; o[1] = (f32x4){bflo(a.z), bfhi(a.z), bflo(a.w), bfhi(a.w)} * r * gp[1];
            o[2] = (f32x4){bflo(c.x), bfhi(c.x), bflo(c.y), bfhi(c.y)} * r * gp[2]; o[3] = (f32x4){bflo(c.z), bfhi(c.z), bflo(c.w), bfhi(c.w)} * r * gp[3]; }
    }
#undef IN
#undef SEAM
}

#ifndef MK_SPLIT
#define MK_SPLIT 0
#endif
extern "C" void kernel_launch(void* const* d_in, const int* in_sizes, int n_in, void* d_out, int out_size, void* d_ws, size_t ws_size, hipStream_t stream) {
    static int grid = 0;
    if (grid == 0) {
        if (n_in != 18 || in_sizes[0] != TOK * DM || out_size != TOK * DM || ws_size < WS_END) { fprintf(stderr, "kernel_launch: unexpected shapes (n_in %d, in0 %d, out %d, ws %zu)\n", n_in, n_in > 0 ? in_sizes[0] : -1, out_size, ws_size); grid = -1; return; }
        int dev = 0, cus = 0, per_cu = 0;
        if (hipGetDevice(&dev) != hipSuccess || hipDeviceGetAttribute(&cus, hipDeviceAttributeMultiprocessorCount, dev) != hipSuccess) { grid = -1; return; }
        if (hipFuncSetAttribute((const void*)hybrid_fwd, hipFuncAttributeMaxDynamicSharedMemorySize, LDS_BYTES) != hipSuccess) { fprintf(stderr, "kernel_launch: hipFuncSetAttribute failed\n"); grid = -1; return; }
        if (hipOccupancyMaxActiveBlocksPerMultiprocessor(&per_cu, (const void*)hybrid_fwd, NWAVES * 64, LDS_BYTES) != hipSuccess || per_cu < 1) fprintf(stderr, "kernel_launch: occupancy query reports %d\n", per_cu);
        (void)hipGetLastError();
        grid = cus;
        if (cus != 256) { fprintf(stderr, "kernel_launch: built for 256 CUs (the final norm stages 16 rows per wave), found %d\n", cus); grid = -1; return; }
    }
    if (grid < 0) return;
    if (hipMemsetAsync((char*)d_ws + WS_CTL, 0, CTL_ZERO_BYTES, stream) != hipSuccess) return;
    Args a{};
    const float** ap = (const float**)&a;
    for (int i = 0; i < 18; ++i) ap[i] = (const float*)d_in[i];
    a.out = (float*)d_out; a.ws = (unsigned char*)d_ws; a.pad = 0;
#if MK_SPLIT
    for (int p = 0; p < NPHASE; ++p) { a.ph_lo = p; a.ph_hi = p + 1; a.li = 0;
        hipLaunchKernelGGL(hybrid_fwd, dim3(grid), dim3(NWAVES * 64), LDS_BYTES, stream, a); }
#else
    a.ph_lo = 0; a.ph_hi = NPHASE; a.li = 0;
    hipLaunchKernelGGL(hybrid_fwd, dim3(grid), dim3(NWAVES * 64), LDS_BYTES, stream, a);
#endif
}
```

```cpp
#include <hip/hip_runtime.h>
#include <cstdio>
#include <cstdint>
namespace pg8 {
#define PG8_LAS __attribute__((address_space(3)))
typedef unsigned short bf16_t;
typedef short bf16x8 __attribute__((ext_vector_type(8)));
typedef float f32x4 __attribute__((ext_vector_type(4)));
typedef unsigned u32x4 __attribute__((ext_vector_type(4)));
constexpr int BM = 256, BK = 64, HALF = 128, HTB = HALF * BK * 2  , STAGE_BYTES = 8 * HTB, NXCD = 8, WGM = 8;

__host__ __device__ __forceinline__ int lds_byte(int r, int c) { const int st = (r >> 4) * 2 + (c >> 5), rr = r & 15, cc = c & 31, ob = rr * 64 + cc * 2; return st * 1024 + (ob ^ (((ob >> 9) & 1) << 5)); }
__host__ __device__ __forceinline__ void stage_rc(int b, int& R, int& C) { const int st = b / 1024, sb = b % 1024, swz = sb ^ (((sb >> 9) & 1) << 5); R = (st >> 1) * 16 + swz / 64; C = (st & 1) * 32 + (swz % 64) / 2; }
__host__ __device__ __forceinline__ int perm32(int rho) { const int n = rho >> 4, i = rho & 15; return 8 * (i >> 2) + 4 * n + (i & 3); }

struct Unit { int pm, pn; };
struct Gemm { const bf16_t* A; const bf16_t* Bt; int M, N, K; };

struct StaticOrder {
    int nM, nN, nwg, G, c;
    __host__ __device__ void init(int M, int N, int G_, int c_) { nM = M / BM; nN = N / BM; nwg = nM * nN; G = G_; c = c_; }
    __host__ __device__ bool next(int i, Unit& u) const {
        const long L = (long)i * G + c; if (L >= nwg) return false;
        int wgid = (int)L; { const int q = nwg / NXCD, r = nwg % NXCD, xcd = wgid % NXCD, off = wgid / NXCD; wgid = (xcd < r ? xcd * (q + 1) : r * (q + 1) + (xcd - r) * q) + off; }
        const int nig = WGM * nN, gid = wgid / nig, fm = gid * WGM, gsz = (nM - fm) < WGM ? (nM - fm) : WGM;
        u.pm = fm + ((wgid % nig) % gsz); u.pn = (wgid % nig) / gsz; return true;
    }
    __device__ __forceinline__ void a_ready(const Unit&) const {}
    __device__ __forceinline__ void done(const Unit&) const {}
};

__device__ __forceinline__ unsigned cvt_pk_bf16(float lo, float hi) { unsigned r; asm volatile("v_cvt_pk_bf16_f32 %0, %1, %2" : "=v"(r) : "v"(lo), "v"(hi)); return r; }
typedef unsigned u32x2 __attribute__((ext_vector_type(2)));
constexpr int TT = 32768;
constexpr float QS64 = 0.125f * 1.4426950408889634f;
constexpr float QS32 = 0.17677669529663687f * 1.4426950408889634f;

template <bool F8> struct EpiProj {
    static constexpr bool PERM = true, AFTER_DRAIN = false;
    bf16_t* O; size_t tile_stride;
    __device__ __forceinline__ void operator()(const f32x4 (&acc)[2][2][4][2], const Unit& u, int wr, int wc, int fr, int fq) const {
        const int row0 = u.pm * BM + wr * 64 + fr;
        int tile; float sc = 1.f;
        if (F8) { tile = (u.pn == 0) ? 2 : (u.pn == 1) ? 5 : (u.pn == 2) ? 6 : 9; sc = 1.f / 32.f; }
        else { tile = (u.pn == 0) ? 0 : (u.pn == 1) ? 1 : (u.pn == 2) ? 3 : (u.pn == 3) ? 4 : (u.pn == 4) ? 7 : (u.pn == 5) ? 8 : 10;
               if (tile == 0 || tile == 7) sc = QS64; else if (tile == 3) sc = QS32; }
        bf16_t* base = O + (size_t)tile * tile_stride;
        const int col0 = wc * 32 + 8 * fq;
#pragma unroll
        for (int ai = 0; ai < 2; ++ai)
#pragma unroll
            for (int m = 0; m < 4; ++m) { bf16_t* rowp = base + (size_t)(row0 + ai * HALF + m * 16) * 256 + col0;
#pragma unroll
                for (int bj = 0; bj < 2; ++bj) { const f32x4 v0 = acc[ai][bj][m][0] * sc, v1 = acc[ai][bj][m][1] * sc;
                    u32x4 w; w.x = cvt_pk_bf16(v0[0], v0[1]); w.y = cvt_pk_bf16(v0[2], v0[3]); w.z = cvt_pk_bf16(v1[0], v1[1]); w.w = cvt_pk_bf16(v1[2], v1[3]);
                    *(u32x4*)(rowp + bj * HALF) = w; } }
    }
};
struct EpiZ {
    static constexpr bool PERM = true, AFTER_DRAIN = false;
    unsigned char* O;
    __device__ __forceinline__ void operator()(const f32x4 (&acc)[2][2][4][2], const Unit& u, int wr, int wc, int fr, int fq) const {
        const int row0 = u.pm * BM + wr * 64 + fr; const int col0 = (u.pn & 3) * BM + wc * 32 + 8 * fq;
#pragma unroll
        for (int ai = 0; ai < 2; ++ai)
#pragma unroll
            for (int m = 0; m < 4; ++m) { unsigned char* rowp = O + (size_t)(row0 + ai * HALF + m * 16) * 1024 + col0;
#pragma unroll
                for (int bj = 0; bj < 2; ++bj) { const f32x4 v0 = acc[ai][bj][m][0], v1 = acc[ai][bj][m][1];
                    int w0 = __builtin_amdgcn_cvt_pk_fp8_f32(v0[0], v0[1], 0, false); w0 = __builtin_amdgcn_cvt_pk_fp8_f32(v0[2], v0[3], w0, true);
                    int w1 = __builtin_amdgcn_cvt_pk_fp8_f32(v1[0], v1[1], 0, false); w1 = __builtin_amdgcn_cvt_pk_fp8_f32(v1[2], v1[3], w1, true);
                    u32x2 w; w.x = (unsigned)w0; w.y = (unsigned)w1;
                    *(u32x2*)(rowp + bj * HALF) = w; } }
    }
};
struct EpiRelu2 {
    static constexpr bool PERM = true, AFTER_DRAIN = false;
    unsigned char* O; int ldc;
    __device__ __forceinline__ void operator()(const f32x4 (&acc)[2][2][4][2], const Unit& u, int wr, int wc, int fr, int fq) const {
        const int row0 = u.pm * BM + wr * 64 + fr; const int col0 = u.pn * BM + wc * 32 + 8 * fq;
#pragma unroll
        for (int ai = 0; ai < 2; ++ai)
#pragma unroll
            for (int m = 0; m < 4; ++m) { unsigned char* rowp = O + (size_t)(row0 + ai * HALF + m * 16) * ldc + col0;
#pragma unroll
                for (int bj = 0; bj < 2; ++bj) { f32x4 v0 = acc[ai][bj][m][0], v1 = acc[ai][bj][m][1];
#pragma unroll
                    for (int j = 0; j < 4; ++j) { const float a = fmaxf(v0[j], 0.f), b = fmaxf(v1[j], 0.f); v0[j] = a * a; v1[j] = b * b; }
                    int w0 = __builtin_amdgcn_cvt_pk_fp8_f32(v0[0], v0[1], 0, false); w0 = __builtin_amdgcn_cvt_pk_fp8_f32(v0[2], v0[3], w0, true);
                    int w1 = __builtin_amdgcn_cvt_pk_fp8_f32(v1[0], v1[1], 0, false); w1 = __builtin_amdgcn_cvt_pk_fp8_f32(v1[2], v1[3], w1, true);
                    u32x2 w; w.x = (unsigned)w0; w.y = (unsigned)w1;
                    *(u32x2*)(rowp + bj * HALF) = w; } }
    }
};
template <bool BASE_BF16> struct EpiResid {
    static constexpr bool PERM = true, AFTER_DRAIN = false;
    const void* base; bf16_t* out; const float* gate; float ascale;
    __device__ __forceinline__ void operator()(const f32x4 (&acc)[2][2][4][2], const Unit& u, int wr, int wc, int fr, int fq) const {
        const int row0 = u.pm * BM + wr * 64 + fr; const int col0 = u.pn * BM + wc * 32 + 8 * fq;
        const float* gp = gate + (size_t)(u.pm >> 4) * 6144 + col0;
        f32x4 gv[2][2];
#pragma unroll
        for (int bj = 0; bj < 2; ++bj)
#pragma unroll
            for (int n = 0; n < 2; ++n) gv[bj][n] = *(const f32x4*)(gp + bj * HALF + n * 4) * ascale;
#pragma unroll
        for (int ai = 0; ai < 2; ++ai)
#pragma unroll
            for (int m = 0; m < 4; ++m) { const size_t off = (size_t)(row0 + ai * HALF + m * 16) * 1024 + col0;
#pragma unroll
                for (int bj = 0; bj < 2; ++bj) { f32x4 b0, b1;
                    if (BASE_BF16) { const u32x4 w = *(const u32x4*)((const bf16_t*)base + off + bj * HALF);
                        b0 = (f32x4){__uint_as_float(w.x << 16), __uint_as_float(w.x & 0xffff0000u), __uint_as_float(w.y << 16), __uint_as_float(w.y & 0xffff0000u)};
                        b1 = (f32x4){__uint_as_float(w.z << 16), __uint_as_float(w.z & 0xffff0000u), __uint_as_float(w.w << 16), __uint_as_float(w.w & 0xffff0000u)}; }
                    else { b0 = *(const f32x4*)((const float*)base + off + bj * HALF); b1 = *(const f32x4*)((const float*)base + off + bj * HALF + 4); }
                    const f32x4 v0 = b0 + gv[bj][0] * acc[ai][bj][m][0], v1 = b1 + gv[bj][1] * acc[ai][bj][m][1];
                    u32x4 o; o.x = cvt_pk_bf16(v0[0], v0[1]); o.y = cvt_pk_bf16(v0[2], v0[3]); o.z = cvt_pk_bf16(v1[0], v1[1]); o.w = cvt_pk_bf16(v1[2], v1[3]);
                    *(u32x4*)(out + off + bj * HALF) = o; }
                if (m & 1) asm volatile("" ::: "memory"); }
    }
};
struct EpiGate {
    static constexpr bool PERM = true, AFTER_DRAIN = false;
    const unsigned char* Z; const float* bg; bf16_t* O;
    __device__ __forceinline__ void operator()(const f32x4 (&acc)[2][2][4][2], const Unit& u, int wr, int wc, int fr, int fq) const {
        const int row0 = u.pm * BM + wr * 64 + fr; const int mc0 = u.pn * 64 + wc * 16 + 4 * fq;
#pragma unroll
        for (int ai = 0; ai < 2; ++ai)
#pragma unroll
            for (int m = 0; m < 4; ++m) { const size_t row = (size_t)(row0 + ai * HALF + m * 16);
                f32x4 bv[2][2];
#pragma unroll
                for (int bj = 0; bj < 2; ++bj)
#pragma unroll
                    for (int n = 0; n < 2; ++n) bv[bj][n] = *(const f32x4*)(bg + (2 * bj + n) * 1024 + mc0);
                asm volatile("" ::: "memory");
                f32x4 sum = (f32x4){0.f, 0.f, 0.f, 0.f};
#pragma unroll
                for (int bj = 0; bj < 2; ++bj)
#pragma unroll
                    for (int n = 0; n < 2; ++n) { const int zr = *(const int*)(Z + ((size_t)(2 * bj + n) * TT + row) * 1024 + mc0);
                        const f32x4 x = acc[ai][bj][m][n] * (1.f / 32.f) + bv[bj][n]; f32x4 zz;
                        zz[0] = __builtin_amdgcn_cvt_f32_fp8(zr, 0); zz[1] = __builtin_amdgcn_cvt_f32_fp8(zr, 1); zz[2] = __builtin_amdgcn_cvt_f32_fp8(zr, 2); zz[3] = __builtin_amdgcn_cvt_f32_fp8(zr, 3);
#pragma unroll
                        for (int j = 0; j < 4; ++j) { const float g = __builtin_amdgcn_rcpf(1.f + __builtin_amdgcn_exp2f(-1.4426950408889634f * x[j])); sum[j] += g * zz[j]; } }
                u32x2 w; w.x = cvt_pk_bf16(sum[0], sum[1]); w.y = cvt_pk_bf16(sum[2], sum[3]);
                *(u32x2*)(O + row * 1024 + mc0) = w; }
    }
};
typedef int i32x8 __attribute__((ext_vector_type(8))); typedef int i32x4 __attribute__((ext_vector_type(4)));
__device__ __forceinline__ i32x8 cat16(bf16x8 a, bf16x8 b) { const i32x4 x = __builtin_bit_cast(i32x4, a), y = __builtin_bit_cast(i32x4, b); return __builtin_shufflevector(x, y, 0, 1, 2, 3, 4, 5, 6, 7); }
template <class Epi, class Sched, bool ALIGN_EPI = false, bool SP2 = false, bool FP8 = false>
__device__ __forceinline__ void gemm_phase(PG8_LAS unsigned char* lds, const Gemm g, const Sched& S, const Epi& E) {
    int tid_l = threadIdx.x; asm volatile("" : "+v"(tid_l)); const int tid = tid_l, wid = __builtin_amdgcn_readfirstlane(tid >> 6), lane = tid & 63, wr = wid >> 2, wc = wid & 3, fr = lane & 15, fq = lane >> 4;
    const int K = g.K, nt = K / BK;
    unsigned voffA[2], voffB[2];
#pragma unroll
    for (int i = 0; i < 2; ++i) { int R, C; stage_rc(tid * 16 + i * 8192, R, C); const int Rb = Epi::PERM ? ((R & ~31) + perm32(R & 31)) : R;
        voffA[i] = (unsigned)(R * K + C) * 2u; voffB[i] = (unsigned)(Rb * K + C) * 2u; }
    const size_t kstep = (size_t)(BK * 2);
    const size_t hstep = (size_t)HALF * K * 2;
    const size_t tstep = 2 * hstep;
    const unsigned ldsw = (unsigned)wid * 1024u;
    const int aoff = lds_byte(wr * 64 + fr, fq * 8), boff = lds_byte(wc * 32 + fr, fq * 8);
#define PG8_SA(b, h) (((b) * 2 + (h)) * HTB)
#define PG8_SB(b, h) ((4 + (b) * 2 + (h)) * HTB)
#define PG8_STAGE(bufoff, gbase, voff) do { _Pragma("unroll") for (int _i = 0; _i < 2; ++_i) \
        __builtin_amdgcn_global_load_lds((const unsigned*)((const char*)(gbase) + (voff)[_i]), (PG8_LAS unsigned*)(lds + (bufoff) + ldsw + _i * 8192), 16, 0, 0); } while (0)
#define PG8_LDA(dst, b, h) do { _Pragma("unroll") for (int m = 0; m < 4; ++m) _Pragma("unroll") for (int k = 0; k < 2; ++k) dst[m][k] = *(const PG8_LAS bf16x8*)(lds + PG8_SA(b, h) + aoff + m * 2048 + k * 1024); } while (0)
#define PG8_LDB(dst, b, h) do { _Pragma("unroll") for (int n = 0; n < 2; ++n) _Pragma("unroll") for (int k = 0; k < 2; ++k) dst[n][k] = *(const PG8_LAS bf16x8*)(lds + PG8_SB(b, h) + boff + n * 2048 + k * 1024); } while (0)
#define PG8_MMA(ai, bj, At, Bt) do { __builtin_amdgcn_s_setprio(1); _Pragma("unroll") for (int m = 0; m < 4; ++m) _Pragma("unroll") for (int n = 0; n < 2; ++n) { \
        if constexpr (FP8) { const i32x8 b8_ = cat16(Bt[n][0], Bt[n][1]), a8_ = cat16(At[m][0], At[m][1]); \
            asm volatile("v_mfma_scale_f32_16x16x128_f8f6f4 %0, %1, %2, %0, %3, %3 op_sel_hi:[0,0,0]" : "+v"(acc[ai][bj][m][n]) : "v"(b8_), "v"(a8_), "v"(sc127)); } \
        else { _Pragma("unroll") for (int k = 0; k < 2; ++k) acc[ai][bj][m][n] = __builtin_amdgcn_mfma_f32_16x16x32_bf16(Bt[n][k], At[m][k], acc[ai][bj][m][n], 0, 0, 0); } } \
        __builtin_amdgcn_s_setprio(0); } while (0)
#define PG8_WAIT_V(n) asm volatile("s_waitcnt vmcnt(" #n ")" ::: "memory")
#define PG8_WAIT_L(n) asm volatile("s_waitcnt lgkmcnt(" #n ")" ::: "memory")
#define PG8_BAR __builtin_amdgcn_s_barrier()
#define PG8_SCHED __builtin_amdgcn_sched_barrier(0)
    Unit cur, nxt; int ui = 0;
    int sc127 = 127; asm volatile("" : "+v"(sc127));
    if (!S.next(0, cur)) return;
    f32x4 acc[2][2][4][2];
#pragma unroll
    for (int a = 0; a < 2; ++a)
#pragma unroll
        for (int b = 0; b < 2; ++b)
#pragma unroll
            for (int m = 0; m < 4; ++m)
#pragma unroll
                for (int n = 0; n < 2; ++n) acc[a][b][m][n] = (f32x4){0.f, 0.f, 0.f, 0.f};
    bf16x8 At[4][2], B0[2][2], B1[2][2];
    const char* cA = (const char*)g.A + (size_t)cur.pm * tstep; const char* cB = (const char*)g.Bt + (size_t)cur.pn * tstep;
    S.a_ready(cur);
    if constexpr (SP2) {
        PG8_STAGE(PG8_SB(0, 0), cB, voffB); PG8_STAGE(PG8_SB(0, 1), cB + hstep, voffB); PG8_STAGE(PG8_SA(0, 0), cA, voffA); PG8_STAGE(PG8_SA(0, 1), cA + hstep, voffA);
        if (wr == 1) PG8_BAR;
        PG8_WAIT_V(2); PG8_BAR;
        PG8_STAGE(PG8_SB(1, 0), cB + kstep, voffB); PG8_STAGE(PG8_SA(1, 0), cA + kstep, voffA); PG8_STAGE(PG8_SB(1, 1), cB + hstep + kstep, voffB);
        PG8_WAIT_V(6); PG8_BAR;
    } else {
        PG8_STAGE(PG8_SB(0, 0), cB, voffB); PG8_STAGE(PG8_SA(0, 0), cA, voffA); PG8_STAGE(PG8_SB(0, 1), cB + hstep, voffB); PG8_STAGE(PG8_SA(0, 1), cA + hstep, voffA);
        if (wr == 1) PG8_BAR;
        PG8_WAIT_V(4); PG8_BAR;
        PG8_STAGE(PG8_SB(1, 0), cB + kstep, voffB); PG8_STAGE(PG8_SA(1, 0), cA + kstep, voffA); PG8_STAGE(PG8_SB(1, 1), cB + hstep + kstep, voffB);
        PG8_WAIT_V(6); PG8_BAR;
    }
    for (;;) {
        const bool has_next = S.next(ui + 1, nxt);
        const char* nA = has_next ? (const char*)g.A + (size_t)nxt.pm * tstep : cA; const char* nB = has_next ? (const char*)g.Bt + (size_t)nxt.pn * tstep : cB;
        for (int t = 0; t < nt; t += 2) {
            const bool last = (t == nt - 2);
            const char* a1 = cA + (size_t)(t + 1) * kstep;
            const char* a2 = last ? nA : cA + (size_t)(t + 2) * kstep; const char* b2 = last ? nB : cB + (size_t)(t + 2) * kstep;
            const char* a3 = a2 + kstep; const char* b3 = b2 + kstep;
            if (last && has_next) S.a_ready(nxt);
            if constexpr (SP2) {
            PG8_LDB(B0, 0, 0); PG8_LDB(B1, 0, 1); PG8_SCHED; PG8_LDA(At, 0, 0); PG8_STAGE(PG8_SA(1, 1), a1 + hstep, voffA);
            PG8_WAIT_V(8); PG8_WAIT_L(0); PG8_BAR; PG8_MMA(0, 0, At, B0); PG8_MMA(0, 1, At, B1); PG8_BAR; PG8_SCHED;
            PG8_LDA(At, 0, 1); PG8_STAGE(PG8_SB(0, 0), b2, voffB); PG8_STAGE(PG8_SB(0, 1), b2 + hstep, voffB); PG8_STAGE(PG8_SA(0, 0), a2, voffA);
            PG8_WAIT_V(8); PG8_WAIT_L(0); PG8_BAR; PG8_MMA(1, 0, At, B0); PG8_MMA(1, 1, At, B1); PG8_BAR; PG8_SCHED;
            PG8_LDB(B0, 1, 0); PG8_LDB(B1, 1, 1); PG8_SCHED; PG8_LDA(At, 1, 0); PG8_STAGE(PG8_SA(0, 1), a2 + hstep, voffA);
            PG8_WAIT_V(8); PG8_WAIT_L(0); PG8_BAR; PG8_MMA(0, 0, At, B0); PG8_MMA(0, 1, At, B1); PG8_BAR; PG8_SCHED;
            PG8_LDA(At, 1, 1); PG8_STAGE(PG8_SB(1, 0), b3, voffB); PG8_STAGE(PG8_SB(1, 1), b3 + hstep, voffB); PG8_STAGE(PG8_SA(1, 0), a3, voffA);
            PG8_WAIT_V(8); PG8_WAIT_L(0); PG8_BAR; PG8_MMA(1, 0, At, B0); PG8_MMA(1, 1, At, B1); PG8_BAR; PG8_SCHED;
            } else {
            PG8_LDB(B0, 0, 0); PG8_SCHED; PG8_LDA(At, 0, 0); PG8_STAGE(PG8_SA(1, 1), a1 + hstep, voffA);
            PG8_WAIT_L(8); PG8_BAR; PG8_WAIT_L(0); PG8_MMA(0, 0, At, B0); PG8_BAR; PG8_SCHED;
            PG8_LDB(B1, 0, 1); PG8_STAGE(PG8_SB(0, 0), b2, voffB);
            PG8_BAR; PG8_WAIT_L(0); PG8_MMA(0, 1, At, B1); PG8_BAR;
            PG8_LDA(At, 0, 1); PG8_STAGE(PG8_SA(0, 0), a2, voffA);
            PG8_BAR; PG8_WAIT_L(0); PG8_MMA(1, 0, At, B0); PG8_BAR; PG8_SCHED;
            PG8_STAGE(PG8_SB(0, 1), b2 + hstep, voffB);
            PG8_WAIT_V(6); PG8_BAR; PG8_MMA(1, 1, At, B1); PG8_BAR;
            PG8_LDB(B0, 1, 0); PG8_SCHED; PG8_LDA(At, 1, 0); PG8_STAGE(PG8_SA(0, 1), a2 + hstep, voffA);
            PG8_WAIT_L(8); PG8_BAR; PG8_WAIT_L(0); PG8_MMA(0, 0, At, B0); PG8_BAR; PG8_SCHED;
            PG8_LDB(B1, 1, 1); PG8_STAGE(PG8_SB(1, 0), b3, voffB);
            PG8_BAR; PG8_WAIT_L(0); PG8_MMA(0, 1, At, B1); PG8_BAR;
            PG8_LDA(At, 1, 1); PG8_STAGE(PG8_SA(1, 0), a3, voffA);
            PG8_BAR; PG8_WAIT_L(0); PG8_MMA(1, 0, At, B0); PG8_BAR; PG8_SCHED;
            PG8_STAGE(PG8_SB(1, 1), b3 + hstep, voffB);
            PG8_WAIT_V(6); PG8_BAR; PG8_MMA(1, 1, At, B1); PG8_BAR;
            }
        }
        if constexpr (ALIGN_EPI) { if (wr == 0) PG8_BAR; }
        if constexpr (FP8) asm volatile("s_nop 15\n\ts_nop 15\n\ts_nop 15\n\ts_nop 15" ::: "memory");
        if constexpr (!Epi::AFTER_DRAIN) { int t2_ = threadIdx.x; asm volatile("" : "+v"(t2_)); const int l2_ = t2_ & 63, w2_ = __builtin_amdgcn_readfirstlane(t2_ >> 6);
            E(acc, cur, w2_ >> 2, w2_ & 3, l2_ & 15, l2_ >> 4); S.done(cur); }
        if (!has_next) break;
#pragma unroll
        for (int a = 0; a < 2; ++a)
#pragma unroll
            for (int b = 0; b < 2; ++b)
#pragma unroll
                for (int m = 0; m < 4; ++m)
#pragma unroll
                    for (int n = 0; n < 2; ++n) acc[a][b][m][n] = (f32x4){0.f, 0.f, 0.f, 0.f};
        cur = nxt; cA = nA; cB = nB; ++ui;
        if constexpr (ALIGN_EPI) { if (wr == 1) PG8_BAR; }
    }
    PG8_WAIT_V(0);
    if constexpr (!ALIGN_EPI) { if (wr == 0) PG8_BAR; }
    PG8_BAR;
    if constexpr (Epi::AFTER_DRAIN) { E.fused(acc, cur, wr, wc, fr, fq, lds, wid, lane); S.done(cur); }
#undef PG8_SA
#undef PG8_SB
#undef PG8_STAGE
#undef PG8_LDA
#undef PG8_LDB
#undef PG8_MMA
#undef PG8_WAIT_V
#undef PG8_WAIT_L
#undef PG8_BAR
#undef PG8_SCHED
}
}

constexpr int NB = 8, SEQ = 4096, DM = 1024, NL = 2, FF = 4096, NPROJ = 2724, NPROJ_PAD = 2816, NTILE_PROJ = 11;
constexpr int TOK = NB * SEQ;
static_assert(TOK == pg8::TT, "token count");
constexpr float NORM_EPS = 1e-6f;
constexpr float LOG2E = 1.4426950408889634f;
constexpr int NWAVES = 8;

constexpr size_t MiB = 1u << 20;
constexpr size_t WS_CTL = 0, CTL_ZERO_BYTES = 1 * MiB;
constexpr size_t WS_MOD = 1 * MiB;
constexpr size_t WS_KMEAN = WS_MOD + 512 * 1024;
constexpr size_t WS_WPT = WS_KMEAN + 384 * 1024;
constexpr size_t WS_W = 2 * MiB;
constexpr size_t W_IN = 0, W_GATE = W_IN + (size_t)NPROJ_PAD * DM, W_BR = W_GATE + (size_t)4 * DM * DM, W_OUT = W_BR + (size_t)4 * DM * 256,
                 W_FF1 = W_OUT + (size_t)DM * DM, W_FF2 = W_FF1 + (size_t)FF * DM, W_LAYER = W_FF2 + (size_t)DM * FF;
constexpr size_t WS_MASK = 70 * MiB;
constexpr size_t WS_H = 86 * MiB;
constexpr size_t WS_Y = 150 * MiB;
constexpr size_t WS_R = 214 * MiB;
constexpr size_t WS_H8 = 470 * MiB;
constexpr size_t WS_END = 502 * MiB;
static_assert(WS_W + 2 * W_LAYER * 2 <= WS_MASK, "weights fit");
constexpr int CW_BAR = 4096;
constexpr int CW_WQ = 131072;
constexpr int CW_NRM = CW_WQ + 4096;
constexpr int NPHASE = 22;

constexpr int RING_BYTES = 135168;
constexpr int LDSCTL_OFF = RING_BYTES;
constexpr int LDS_BYTES = 147456;

#define GAS __attribute__((address_space(1)))
#define LAS __attribute__((address_space(3)))
typedef unsigned short bf16;
typedef unsigned v4u __attribute__((ext_vector_type(4)));
typedef unsigned v2u __attribute__((ext_vector_type(2)));
typedef float f32x4 __attribute__((ext_vector_type(4)));
typedef float f32x16 __attribute__((ext_vector_type(16)));
typedef short bf16x8 __attribute__((ext_vector_type(8)));
typedef short s16x4 __attribute__((ext_vector_type(4)));
typedef GAS unsigned gu32;
#define RLX_AGENT __ATOMIC_RELAXED, __HIP_MEMORY_SCOPE_AGENT
#define LDS_WAIT() asm volatile("s_waitcnt lgkmcnt(0)" ::: "memory")
__device__ __forceinline__ unsigned f2bf(float f) { unsigned u = __builtin_bit_cast(unsigned, f); return (u + 0x7fffu + ((u >> 16) & 1u)) >> 16; }
__device__ __forceinline__ unsigned pk2(float lo, float hi) { return f2bf(lo) | (f2bf(hi) << 16); }
__device__ __forceinline__ float bf2f(unsigned short b) { return __uint_as_float((unsigned)b << 16); }
__device__ __forceinline__ float bflo(unsigned w) { return __uint_as_float(w << 16); }
__device__ __forceinline__ float bfhi(unsigned w) { return __uint_as_float(w & 0xffff0000u); }

#define XB_TMO      128
#define XB_XCNT(j)  (256  + 64 * (j))
#define XB_XSUB(j)  (1280 + 64 * (j))
#define XB_XGEN(j)  (2304 + 64 * (j))
#define XB_TOP      3328
#define XB_TOPGEN   3392
#define XCD_BAR_WORDS 3456
#define XB_SPIN_CAP (1u << 18)

__device__ __forceinline__ unsigned xb_ld(unsigned* p)              { return __hip_atomic_load(p, __ATOMIC_RELAXED, __HIP_MEMORY_SCOPE_AGENT); }
__device__ __forceinline__ unsigned xb_add(unsigned* p, unsigned v) { return __hip_atomic_fetch_add(p, v, __ATOMIC_RELAXED, __HIP_MEMORY_SCOPE_AGENT); }
__device__ __forceinline__ unsigned xb_xcc_id() { return (unsigned)__builtin_amdgcn_s_getreg((3 << 11) | 20) & 0xFu; }
#define XB_SPIN(cond, bar) do { unsigned _sp = 0; while (cond) { __builtin_amdgcn_s_sleep(1); \
    if ((++_sp & 255u) == 0u) { if (xb_ld(&(bar)[XB_TMO])) break; if (_sp > XB_SPIN_CAP) { atomicAdd(&(bar)[XB_TMO], 1u); break; } } } } while (0)

struct XcdBarrier {
    unsigned* bar; unsigned x;
    volatile LAS unsigned* st;
};

__device__ __forceinline__ XcdBarrier xcd_barrier_post(unsigned* bar, volatile LAS unsigned* st) {
    XcdBarrier b; b.bar = bar; b.x = xb_xcc_id(); b.st = st;
    if (threadIdx.x == 0) (void)xb_add(&bar[XB_XCNT(b.x)], 1u);
    return b;
}
__device__ __forceinline__ void xcd_barrier_complete(unsigned* bar, unsigned x, unsigned& nloc, unsigned& nx) {
    const unsigned G = gridDim.x * gridDim.y * gridDim.z;
    unsigned sum, cnt, mine, sp = 0u;
    for (;;) {
        sum = 0u; cnt = 0u; mine = 0u;
#pragma unroll
        for (unsigned j = 0; j < 16; ++j) { const unsigned c = xb_ld(&bar[XB_XCNT(j)]); sum += c; cnt += (c > 0u) ? 1u : 0u; mine = (j == x) ? c : mine; }
        if (sum == G) break;
        __builtin_amdgcn_s_sleep(1);
        if ((++sp & 255u) == 0u) { if (xb_ld(&bar[XB_TMO])) break; if (sp > XB_SPIN_CAP) { atomicAdd(&bar[XB_TMO], 1u); break; } }
    }
    nloc = mine > 0u ? mine : 1u; nx = cnt > 0u ? cnt : 1u;
}

__device__ __forceinline__ void xcd_barrier(const XcdBarrier& b) {
    asm volatile("s_waitcnt vmcnt(0)" ::: "memory");
    __syncthreads();
    if (threadIdx.x == 0) {
        unsigned* bar = b.bar;
        __builtin_amdgcn_s_waitcnt(0);
        unsigned nloc = b.st[0], nx = b.st[1];
        if (nloc == 0u) { xcd_barrier_complete(bar, b.x, nloc, nx); b.st[0] = nloc; b.st[1] = nx; }
        const unsigned old = xb_add(&bar[XB_XSUB(b.x)], 1u);
        const unsigned gen = old / nloc;
        if (old + 1u == (gen + 1u) * nloc) {
            __builtin_amdgcn_fence(__ATOMIC_RELEASE, "agent");
            asm volatile("s_waitcnt vmcnt(0)" ::: "memory");
            const unsigned og = xb_add(&bar[XB_TOP], 1u);
            const unsigned tg = og / nx;
            if (og + 1u == (tg + 1u) * nx) xb_add(&bar[XB_TOPGEN], 1u);
            else XB_SPIN(xb_ld(&bar[XB_TOPGEN]) == tg, bar);
            __builtin_amdgcn_fence(__ATOMIC_ACQUIRE, "agent");
            xb_add(&bar[XB_XGEN(b.x)], 1u);
            asm volatile("s_waitcnt vmcnt(0)" ::: "memory");
        } else {
            XB_SPIN(xb_ld(&bar[XB_XGEN(b.x)]) == gen, bar);
            __builtin_amdgcn_fence(__ATOMIC_ACQUIRE, "agent");
            asm volatile("s_waitcnt vmcnt(0)" ::: "memory");
        }
    }
    __syncthreads();
}

struct Args {
    const float *x, *c, *w_ada, *b_ada, *norm1_g, *w_in, *diff_lambda, *diff_subln_g, *w_pool, *pool_scale, *w_gate, *b_gate, *w_branch, *w_out, *norm2_g, *w_ff1, *w_ff2, *final_g;
    float* out; unsigned char* ws; int ph_lo, ph_hi, li, pad;
};

__device__ __forceinline__ float shx(float v, int mask, int lane) { return __int_as_float(__builtin_amdgcn_ds_bpermute((lane ^ mask) << 2, __float_as_int(v))); }
__device__ __forceinline__ unsigned shxu(unsigned v, int mask, int lane) { return (unsigned)__builtin_amdgcn_ds_bpermute((lane ^ mask) << 2, (int)v); }
__device__ __forceinline__ unsigned shupu(unsigned v, int delta, int lane) { return (unsigned)__builtin_amdgcn_ds_bpermute(((lane - delta) & 63) << 2, (int)v); }
__device__ __forceinline__ float wave_sum(float v, int lane) {
#pragma unroll
    for (int o = 1; o < 64; o <<= 1) v += shx(v, o, lane);
    return v;
}
__device__ __forceinline__ int crow(int r, int hi) { return (r & 3) + 8 * (r >> 2) + 4 * hi; }
typedef float f32x2_t __attribute__((ext_vector_type(2))); typedef __bf16 bf16x2_t __attribute__((ext_vector_type(2)));
__device__ __forceinline__ unsigned cvtpk(float lo, float hi) { f32x2_t v = {lo, hi}; bf16x2_t b = __builtin_convertvector(v, bf16x2_t); return __builtin_bit_cast(unsigned, b); }

__device__ __forceinline__ int gate_row(int br, int c) { const int pn = c >> 6, ml = c & 63; return 256 * pn + 128 * (br >> 1) + 32 * (ml >> 4) + 8 * ((ml >> 2) & 3) + 4 * (br & 1) + (ml & 3); }
__device__ __forceinline__ void p0_transpose_item(const float* W, int K, int Nsrc, int Npad, bf16* WT, int mode, int br, LAS float* scr, int item, int lane) {
    const int nblk = Npad / 32, kb = item / nblk, nb = item % nblk, k0 = 64 * kb, n0 = 32 * nb;
    const int c4 = lane & 7, kr = lane >> 3, nn = n0 + 4 * c4;
    f32x4 v[8];
#pragma unroll
    for (int i = 0; i < 8; ++i) v[i] = (nn < Nsrc) ? *(const f32x4*)(W + (size_t)(k0 + 8 * i + kr) * Nsrc + nn) : (f32x4){0.f, 0.f, 0.f, 0.f};
#pragma unroll
    for (int i = 0; i < 8; ++i) { LAS float* d = scr + (8 * i + kr) * 33 + 4 * c4; d[0] = v[i][0]; d[1] = v[i][1]; d[2] = v[i][2]; d[3] = v[i][3]; }
    LDS_WAIT(); asm volatile("" ::: "memory");
    const int c = lane & 7;
#pragma unroll
    for (int j = 0; j < 4; ++j) { const int n = (lane >> 3) + 8 * j; const LAS float* s = scr + (8 * c) * 33 + n;
        v4u o; o.x = pk2(s[0 * 33], s[1 * 33]); o.y = pk2(s[2 * 33], s[3 * 33]); o.z = pk2(s[4 * 33], s[5 * 33]); o.w = pk2(s[6 * 33], s[7 * 33]);
        const int drow = (mode == 1 || mode == 2) ? gate_row(br, n0 + n) : (n0 + n);
        if (mode >= 2) {
            const float f8s = (mode == 3) ? 64.f : 32.f;
            int w0 = __builtin_amdgcn_cvt_pk_fp8_f32(f8s * s[0 * 33], f8s * s[1 * 33], 0, false); w0 = __builtin_amdgcn_cvt_pk_fp8_f32(f8s * s[2 * 33], f8s * s[3 * 33], w0, true);
            int w1 = __builtin_amdgcn_cvt_pk_fp8_f32(f8s * s[4 * 33], f8s * s[5 * 33], 0, false); w1 = __builtin_amdgcn_cvt_pk_fp8_f32(f8s * s[6 * 33], f8s * s[7 * 33], w1, true);
            v2u o8; o8.x = (unsigned)w0; o8.y = (unsigned)w1;
            *(v2u*)((unsigned char*)WT + (size_t)drow * K + k0 + 8 * c) = o8;
        } else *(v4u*)(WT + (size_t)drow * K + k0 + 8 * c) = o; }
    LDS_WAIT(); asm volatile("" ::: "memory");
}

template <bool XBF16>
__device__ __forceinline__ void norm_rows_bf16(LAS unsigned char* lds, const void* X, bf16* O, unsigned char* O8  , const float* g, const float* mod  , int sh_idx, int sc_idx, int gw, int ngw, int lane_in) {
    int lane = lane_in; asm volatile("" : "+v"(lane));
    constexpr int RB = 4;
    LAS float* LA = (LAS float*)lds; LAS float* LB = LA + 8192;
    { int tf = threadIdx.x; asm volatile("" : "+v"(tf));
      for (int i = tf; i < 2048; i += 512) { const int b = i >> 8, c4 = (i & 255) * 4;
          const f32x4 gg = *(const f32x4*)(g + c4), sc = *(const f32x4*)(mod + (size_t)b * 6144 + sc_idx * 1024 + c4), sh = *(const f32x4*)(mod + (size_t)b * 6144 + sh_idx * 1024 + c4);
          *(LAS f32x4*)(LA + b * 1024 + c4) = gg * (1.f + sc); *(LAS f32x4*)(LB + b * 1024 + c4) = sh; } }
    __syncthreads();
    for (int m0 = gw; m0 < TOK; m0 += RB * ngw) {
        float v[RB][16];
#pragma unroll
        for (int rb = 0; rb < RB; ++rb) { const int m = m0 + rb * ngw;
            if (m < TOK) {
                if (XBF16) { const v4u* xr = (const v4u*)((const bf16*)X + (size_t)m * DM) + 2 * lane; const v4u a = xr[0], c = xr[1];
                    v[rb][0] = bflo(a.x); v[rb][1] = bfhi(a.x); v[rb][2] = bflo(a.y); v[rb][3] = bfhi(a.y); v[rb][4] = bflo(a.z); v[rb][5] = bfhi(a.z); v[rb][6] = bflo(a.w); v[rb][7] = bfhi(a.w);
                    v[rb][8] = bflo(c.x); v[rb][9] = bfhi(c.x); v[rb][10] = bflo(c.y); v[rb][11] = bfhi(c.y); v[rb][12] = bflo(c.z); v[rb][13] = bfhi(c.z); v[rb][14] = bflo(c.w); v[rb][15] = bfhi(c.w); }
                else { const f32x4* xr = (const f32x4*)((const float*)X + (size_t)m * DM) + 4 * lane;
#pragma unroll
                    for (int j = 0; j < 4; ++j) { const f32x4 t = xr[j]; v[rb][4 * j] = t.x; v[rb][4 * j + 1] = t.y; v[rb][4 * j + 2] = t.z; v[rb][4 * j + 3] = t.w; } }
            } else {
#pragma unroll
                for (int e = 0; e < 16; ++e) v[rb][e] = 0.f; } }
#pragma unroll
        for (int rb = 0; rb < RB; ++rb) { const int m = m0 + rb * ngw; if (m < TOK) {
            const int b = m >> 12;
            float s = 0.f;
#pragma unroll
            for (int e = 0; e < 16; ++e) s += v[rb][e] * v[rb][e];
            const float rstd = 1.f / sqrtf(wave_sum(s, lane) * (1.f / DM) + NORM_EPS);
            float y[16];
#pragma unroll
            for (int j = 0; j < 4; ++j) { const f32x4 aa = *(LAS const f32x4*)(LA + b * 1024 + 16 * lane + 4 * j), bb = *(LAS const f32x4*)(LB + b * 1024 + 16 * lane + 4 * j);
#pragma unroll
                for (int e = 0; e < 4; ++e) y[4 * j + e] = v[rb][4 * j + e] * rstd * aa[e] + bb[e]; }
            v4u o0, o1;
            o0.x = pk2(y[0], y[1]); o0.y = pk2(y[2], y[3]); o0.z = pk2(y[4], y[5]); o0.w = pk2(y[6], y[7]);
            o1.x = pk2(y[8], y[9]); o1.y = pk2(y[10], y[11]); o1.z = pk2(y[12], y[13]); o1.w = pk2(y[14], y[15]);
            v4u* op = (v4u*)(O + (size_t)m * DM) + 2 * lane; op[0] = o0; op[1] = o1;
            if (O8) { v4u q;
                int w = __builtin_amdgcn_cvt_pk_fp8_f32(y[0], y[1], 0, false); w = __builtin_amdgcn_cvt_pk_fp8_f32(y[2], y[3], w, true); q.x = (unsigned)w;
                w = __builtin_amdgcn_cvt_pk_fp8_f32(y[4], y[5], 0, false); w = __builtin_amdgcn_cvt_pk_fp8_f32(y[6], y[7], w, true); q.y = (unsigned)w;
                w = __builtin_amdgcn_cvt_pk_fp8_f32(y[8], y[9], 0, false); w = __builtin_amdgcn_cvt_pk_fp8_f32(y[10], y[11], w, true); q.z = (unsigned)w;
                w = __builtin_amdgcn_cvt_pk_fp8_f32(y[12], y[13], 0, false); w = __builtin_amdgcn_cvt_pk_fp8_f32(y[14], y[15], w, true); q.w = (unsigned)w;
                *((v4u*)(O8 + (size_t)m * DM) + lane) = q; } } }
    }
    __syncthreads();
}

#ifndef ATT_PD
#define ATT_PD 2
#endif
constexpr int AT_K0 = 0, AT_KSLOT = 9216, AT_V0 = 18432, AT_VSLOT = 12288, AT_SEL = 43008, AT_KM = 44032, AT_END = 47872;
__device__ __forceinline__ s16x4 vtr(LAS const unsigned char* p) { return __builtin_bit_cast(s16x4, __builtin_amdgcn_ds_read_tr16_b64_v4i16((LAS s16x4*)p)); }

#define TRRD(dst, addr, off) asm volatile("ds_read_b64_tr_b16 %0, %1 offset:%2" : "=v"(dst) : "v"(addr), "i"(off) : "memory")
#define SBAR0() __builtin_amdgcn_sched_barrier(0)
__device__ __forceinline__ void softmax_pv(f32x16& s0, f32x16& s1, float& l, f32x16 (&o)[2], LAS const unsigned char* vbase  ) {
    const unsigned va = (unsigned)(uintptr_t)vbase;
    s16x4 vl[2][2][2], vh[2][2][2];
#pragma unroll
    for (int sub = 0; sub < 2; ++sub)
#pragma unroll
        for (int db = 0; db < 2; ++db)
#pragma unroll
            for (int s2 = 0; s2 < 2; ++s2) { TRRD(vl[db][sub][s2], va, (32 * sub + 16 * s2) * 192 + db * 64); TRRD(vh[db][sub][s2], va, (32 * sub + 16 * s2 + 8) * 192 + db * 64); }
    float la = l;
#pragma unroll
    for (int r = 0; r < 16; ++r) { s0[r] = __builtin_amdgcn_exp2f(s0[r]); la += s0[r]; }
    bf16x8 pf[2][2];
#pragma unroll
    for (int s2 = 0; s2 < 2; ++s2) { v4u a;
        a.x = cvtpk(s0[8 * s2 + 0], s0[8 * s2 + 1]); a.y = cvtpk(s0[8 * s2 + 2], s0[8 * s2 + 3]); a.z = cvtpk(s0[8 * s2 + 4], s0[8 * s2 + 5]); a.w = cvtpk(s0[8 * s2 + 6], s0[8 * s2 + 7]);
        pf[0][s2] = __builtin_bit_cast(bf16x8, a); }
    asm volatile("s_waitcnt lgkmcnt(0)" : "+v"(vl[0][0][0]), "+v"(vl[0][0][1]), "+v"(vl[0][1][0]), "+v"(vl[0][1][1]), "+v"(vl[1][0][0]), "+v"(vl[1][0][1]), "+v"(vl[1][1][0]), "+v"(vl[1][1][1]),
                                          "+v"(vh[0][0][0]), "+v"(vh[0][0][1]), "+v"(vh[0][1][0]), "+v"(vh[0][1][1]), "+v"(vh[1][0][0]), "+v"(vh[1][0][1]), "+v"(vh[1][1][0]), "+v"(vh[1][1][1]) :: "memory");
    SBAR0();
#pragma unroll
    for (int g = 0; g < 4; ++g) { const int db = g >> 1, s2 = g & 1;
        const s16x4 lo = vl[db][0][s2], hh = vh[db][0][s2];
        const bf16x8 vf = (bf16x8){lo[0], lo[1], lo[2], lo[3], hh[0], hh[1], hh[2], hh[3]};
        o[db] = __builtin_amdgcn_mfma_f32_32x32x16_bf16(vf, pf[0][s2], o[db], 0, 0, 0);
#pragma unroll
        for (int r = 4 * g; r < 4 * g + 4; ++r) { s1[r] = __builtin_amdgcn_exp2f(s1[r]); la += s1[r]; }
        SBAR0(); }
    l = la;
#pragma unroll
    for (int s2 = 0; s2 < 2; ++s2) { v4u c;
        c.x = cvtpk(s1[8 * s2 + 0], s1[8 * s2 + 1]); c.y = cvtpk(s1[8 * s2 + 2], s1[8 * s2 + 3]); c.z = cvtpk(s1[8 * s2 + 4], s1[8 * s2 + 5]); c.w = cvtpk(s1[8 * s2 + 6], s1[8 * s2 + 7]);
        pf[1][s2] = __builtin_bit_cast(bf16x8, c); }
#pragma unroll
    for (int g = 0; g < 4; ++g) { const int db = g >> 1, s2 = g & 1;
        const s16x4 lo = vl[db][1][s2], hh = vh[db][1][s2];
        const bf16x8 vf = (bf16x8){lo[0], lo[1], lo[2], lo[3], hh[0], hh[1], hh[2], hh[3]};
        o[db] = __builtin_amdgcn_mfma_f32_32x32x16_bf16(vf, pf[1][s2], o[db], 0, 0, 0); }
}
__device__ __forceinline__ void split3(float x, unsigned& h, unsigned& m, unsigned& l) {
    h = f2bf(x); const float r1 = x - __uint_as_float(h << 16); m = f2bf(r1); const float r2 = r1 - __uint_as_float(m << 16); l = f2bf(r2);
}

template <int MODE>
__device__ __forceinline__ void attn_unit(LAS unsigned char* lds, int b, int h, int qb, const bf16* Qb, const bf16* Kb, const bf16* Vb, bf16* Ob, float slope,
                                          const float* kmean, float lam, float post_scale, const float* subg, const unsigned* maskw, const unsigned* nrm  ,
                                          const int* refposg, const int* refming) {
    int tid_l = threadIdx.x; asm volatile("" : "+v"(tid_l)); const int tid = tid_l, lane = tid & 63, wid = __builtin_amdgcn_readfirstlane(tid >> 6), r32 = lane & 31, hi = lane >> 5;
    const int q = qb * 256 + wid * 32 + r32;
    const size_t rowg = (size_t)b * SEQ;
    const float c2 = slope * LOG2E;
    unsigned sel = 0u;
    bf16x8 qf[4];
#pragma unroll
    for (int ds = 0; ds < 4; ++ds) qf[ds] = *(const bf16x8*)(Qb + (rowg + q) * 256 + h * 64 + ds * 16 + hi * 8);
    const int skey = tid >> 3, sch = tid & 7;
    const bf16* ksrc = Kb + (rowg + skey) * 256 + h * 64 + sch * 8;
    const bf16* vsrc = Vb + (rowg + skey) * 256 + h * 64 + sch * 8;
    const int kdst = AT_K0 + skey * 144 + sch * 16, vdst = AT_V0 + skey * 192 + sch * 16;
    const int NT = 4 * qb + 4;
    const float Bq = __uint_as_float(nrm[b * 4 + h]), Bk = __uint_as_float(nrm[32 + b * 4 + h]);
#if defined(PROBE_NOSKIP)
    const float Dskip = 1e9f + 0.f * (Bq + Bk);
#else
    const float Dskip = (150.f + 2.f * sqrtf(Bq * Bk)) / c2;
#endif
    const int koff = r32 * 144 + hi * 16;
    const int vtoff = (4 * hi + ((lane & 15) >> 2)) * 192 + (16 * ((lane >> 4) & 1) + 4 * (lane & 3)) * 2;
    float l1 = 0.f, l2 = 0.f;
    f32x16 oA[2], oB[2];
#pragma unroll
    for (int r = 0; r < 16; ++r) { oA[0][r] = 0.f; oA[1][r] = 0.f; oB[0][r] = 0.f; oB[1][r] = 0.f; }
    const int qmin = qb * 256 + wid * 32, qmax = qmin + 31;
    constexpr int PD = ATT_PD;
    v4u kR[PD], vR[PD]; v2u mR[PD];
    int refpos = q;
    int minref = qb * 256;
    if (MODE == 2) { refpos = refposg[rowg + q]; minref = refming[b * 128 + 8 * qb];
#pragma unroll
        for (int i = 1; i < 8; ++i) { const int v = refming[b * 128 + 8 * qb + i]; minref = v < minref ? v : minref; } }
    int T0 = (int)floorf(((float)minref - Dskip) * (1.f / 64.f)); T0 = T0 < 0 ? 0 : T0; T0 = __builtin_amdgcn_readfirstlane(T0);
    const v4u k0r = *(const v4u*)(ksrc + (size_t)T0 * 64 * 256), v0r = *(const v4u*)(vsrc + (size_t)T0 * 64 * 256);
#pragma unroll
    for (int i = 0; i < PD; ++i) { kR[i] = (v4u){0u, 0u, 0u, 0u}; vR[i] = kR[i]; mR[i] = (v2u){0u, 0u};
        if (T0 + i + 1 < NT) { kR[i] = *(const v4u*)(ksrc + (size_t)(T0 + i + 1) * 64 * 256); vR[i] = *(const v4u*)(vsrc + (size_t)(T0 + i + 1) * 64 * 256);
            if (MODE == 2) mR[i] = *(const v2u*)(maskw + (rowg + q) * 128 + 2 * (T0 + i + 1)); } }
    v2u mw = (v2u){0u, 0u};
    if (MODE == 2) mw = *(const v2u*)(maskw + (rowg + q) * 128 + 2 * T0);
    if (MODE == 0) {
        LAS float* KM = (LAS float*)(lds + AT_KM); LAS unsigned* SEL = (LAS unsigned*)(lds + AT_SEL);
        for (int i = tid; i < qb * 64; i += 512) KM[i] = kmean[(size_t)((b * 4 + h) * 16) * 64 + i];
        __syncthreads();
        if (tid < 256) {
            const bf16* qrow = Qb + (rowg + qb * 256 + tid) * 256 + h * 64;
            float qv[64];
#pragma unroll
            for (int c = 0; c < 8; ++c) { const v4u w = *(const v4u*)(qrow + 8 * c);
                qv[8 * c + 0] = bflo(w.x); qv[8 * c + 1] = bfhi(w.x); qv[8 * c + 2] = bflo(w.y); qv[8 * c + 3] = bfhi(w.y);
                qv[8 * c + 4] = bflo(w.z); qv[8 * c + 5] = bfhi(w.z); qv[8 * c + 6] = bflo(w.w); qv[8 * c + 7] = bfhi(w.w); }
            float v1 = -INFINITY, v2 = -INFINITY, v3 = -INFINITY; int i1 = -1, i2 = -1, i3 = -1;
            for (int n = 0; n < qb; ++n) {
                float g = 0.f;
#pragma unroll
                for (int d = 0; d < 64; ++d) g = __builtin_fmaf(qv[d], KM[n * 64 + d], g);
                if (g > v1) { v3 = v2; i3 = i2; v2 = v1; i2 = i1; v1 = g; i1 = n; }
                else if (g > v2) { v3 = v2; i3 = i2; v2 = g; i2 = n; }
                else if (g > v3) { v3 = g; i3 = n; }
            }
            unsigned sm = 0u; if (i1 >= 0) sm |= 1u << i1; if (i2 >= 0) sm |= 1u << i2; if (i3 >= 0) sm |= 1u << i3;
            SEL[tid] = sm;
        }
        __syncthreads();
        sel = SEL[wid * 32 + r32];
    }
    *(LAS v4u*)(lds + kdst + (T0 & 1) * AT_KSLOT) = k0r; *(LAS v4u*)(lds + vdst + (T0 & 1) * AT_VSLOT) = v0r;
    bf16x8 qaug; v4u ka0, ka1;
    { unsigned a, b2, c; split3(-c2 * (float)refpos, a, b2, c);
      v4u w; if (hi == 0) { w.x = a | (b2 << 16); w.y = c | (0x3f80u << 16); w.z = 0x3f80u | (0x3f80u << 16); w.w = 0u; }
             else { w.x = 0x3f80u | (0x3f80u << 16); w.y = 0x3f80u; w.z = 0u; w.w = 0u; }
      qaug = __builtin_bit_cast(bf16x8, w);
      split3(c2 * (float)r32, a, b2, c); ka0.x = 0x3f80u | (0x3f80u << 16); ka0.y = 0x3f80u | (a << 16); ka0.z = b2 | (c << 16); ka0.w = 0u;
      split3(c2 * (float)(r32 + 32), a, b2, c); ka1.x = ka0.x; ka1.y = 0x3f80u | (a << 16); ka1.z = b2 | (c << 16); ka1.w = 0u; }
    __syncthreads();
#pragma nounroll
    for (int t0 = T0; t0 < NT; t0 += PD) {
#pragma unroll
      for (int u = 0; u < PD; ++u) { const int t = t0 + u; if (t < NT) {
        const int slot = t & 1;
        const int k0 = 64 * t;
        bool active = (k0 <= qmax);
        bool keep = true;
        if (MODE == 0) { const int n = t >> 2; if (n < qb) { keep = ((sel >> n) & 1u) != 0u; active = (__ballot(keep) != 0ull); } }
        if (active) {
            LAS const unsigned char* ks = lds + AT_K0 + slot * AT_KSLOT + koff;
            LAS const unsigned char* vb = lds + AT_V0 + slot * AT_VSLOT + vtoff;
            const int lim = q - k0 - 4 * hi;
            const bool needmask = (k0 + 63 > qmin);
            bf16x8 kaug0, kaug1;
            { unsigned a, b2, c; split3(c2 * (float)k0, a, b2, c);
              v4u w0 = ka0, w1 = ka1; if (hi) { w0.x = a | (b2 << 16); w0.y = c; w0.z = 0u; w1 = w0; }
              kaug0 = __builtin_bit_cast(bf16x8, w0); kaug1 = __builtin_bit_cast(bf16x8, w1); }
            f32x16 sb0, sb1;
#pragma unroll
            for (int r = 0; r < 16; ++r) { sb0[r] = 0.f; sb1[r] = 0.f; }
            sb0 = __builtin_amdgcn_mfma_f32_32x32x16_bf16(kaug0, qaug, sb0, 0, 0, 0);
            sb1 = __builtin_amdgcn_mfma_f32_32x32x16_bf16(kaug1, qaug, sb1, 0, 0, 0);
#pragma unroll
            for (int mp = 0; mp < (MODE == 1 ? 2 : 1); ++mp) {
                f32x16 s0, s1;
#pragma unroll
                for (int dd = 0; dd < (MODE == 1 ? 2 : 4); ++dd) { const int ds = (MODE == 1) ? (2 * mp + dd) : dd;
                    const bf16x8 a0 = *(LAS const bf16x8*)(ks + ds * 32), a1 = *(LAS const bf16x8*)(ks + 32 * 144 + ds * 32);
                    if (dd == 0) { s0 = __builtin_amdgcn_mfma_f32_32x32x16_bf16(a0, qf[ds], sb0, 0, 0, 0); s1 = __builtin_amdgcn_mfma_f32_32x32x16_bf16(a1, qf[ds], sb1, 0, 0, 0); }
                    else { s0 = __builtin_amdgcn_mfma_f32_32x32x16_bf16(a0, qf[ds], s0, 0, 0, 0); s1 = __builtin_amdgcn_mfma_f32_32x32x16_bf16(a1, qf[ds], s1, 0, 0, 0); } }
#if defined(PROBE_QK2X)
                { f32x16 d0, d1;
#pragma unroll
                  for (int r = 0; r < 16; ++r) { d0[r] = 0.f; d1[r] = 0.f; }
#pragma unroll
                  for (int dd = 0; dd < (MODE == 1 ? 2 : 4); ++dd) { const int ds = (MODE == 1) ? (2 * mp + dd) : dd;
                    const bf16x8 a0 = *(LAS const bf16x8*)(ks + ds * 32 + 16), a1 = *(LAS const bf16x8*)(ks + 32 * 144 + ds * 32 + 16);
                    d0 = __builtin_amdgcn_mfma_f32_32x32x16_bf16(a0, qf[ds], d0, 0, 0, 0);
                    d1 = __builtin_amdgcn_mfma_f32_32x32x16_bf16(a1, qf[ds], d1, 0, 0, 0); }
                  asm volatile("" :: "v"(d0), "v"(d1)); }
#endif
                if (MODE == 2) {
#pragma unroll
                    for (int r = 0; r < 16; ++r) { const int pos = (r & 3) + 8 * (r >> 2) + 4 * hi;
                        if (!((mw.x >> pos) & 1u)) s0[r] = -INFINITY; if (!((mw.y >> pos) & 1u)) s1[r] = -INFINITY; }
                } else {
                    if (MODE == 0 && !keep) {
#pragma unroll
                        for (int r = 0; r < 16; ++r) { s0[r] = -INFINITY; s1[r] = -INFINITY; }
                    }
                    if (needmask) {
#pragma unroll
                        for (int r = 0; r < 16; ++r) { const int ko = (r & 3) + 8 * (r >> 2);
                            if (ko > lim) s0[r] = -INFINITY; if (ko + 32 > lim) s1[r] = -INFINITY; }
                    }
                }
                if (mp == 0) softmax_pv(s0, s1, l1, oA, vb); else softmax_pv(s0, s1, l2, oB, vb);
            }
        }
        if (t + 1 < NT) { *(LAS v4u*)(lds + kdst + (slot ^ 1) * AT_KSLOT) = kR[u]; *(LAS v4u*)(lds + vdst + (slot ^ 1) * AT_VSLOT) = vR[u];
            if (MODE == 2) mw = mR[u];
            if (t + 1 + PD < NT) { kR[u] = *(const v4u*)(ksrc + (size_t)(t + 1 + PD) * 64 * 256); vR[u] = *(const v4u*)(vsrc + (size_t)(t + 1 + PD) * 64 * 256);
                if (MODE == 2) mR[u] = *(const v2u*)(maskw + (rowg + q) * 128 + 2 * (t + 1 + PD)); } }
        __syncthreads();
#if defined(PROBE_BAR2X)
        __syncthreads();
#endif
      } }
    }
    const float l1t = l1 + shx(l1, 32, lane);
    bf16* orow = Ob + (rowg + q) * 256 + h * 64 + 4 * hi;
    if (MODE == 1) {
        const float l2t = l2 + shx(l2, 32, lane);
        const float i1 = 1.f / l1t, i2 = lam / l2t;
        float ssq = 0.f;
#pragma unroll
        for (int db = 0; db < 2; ++db)
#pragma unroll
            for (int r = 0; r < 16; ++r) { const float v = oA[db][r] * i1 - oB[db][r] * i2; oA[db][r] = v; ssq += v * v; }
        ssq += shx(ssq, 32, lane);
        const float rn = post_scale / sqrtf(ssq * (1.f / 64.f) + NORM_EPS);
#pragma unroll
        for (int db = 0; db < 2; ++db)
#pragma unroll
            for (int g4 = 0; g4 < 4; ++g4) { const f32x4 gg = *(const f32x4*)(subg + 32 * db + 8 * g4 + 4 * hi);
                v2u w; w.x = cvtpk(oA[db][4 * g4 + 0] * rn * gg[0], oA[db][4 * g4 + 1] * rn * gg[1]); w.y = cvtpk(oA[db][4 * g4 + 2] * rn * gg[2], oA[db][4 * g4 + 3] * rn * gg[3]);
                *(v2u*)(orow + 32 * db + 8 * g4) = w; }
    } else {
        const float i1 = 1.f / l1t;
#pragma unroll
        for (int db = 0; db < 2; ++db)
#pragma unroll
            for (int g4 = 0; g4 < 4; ++g4) { v2u w; w.x = cvtpk(oA[db][4 * g4 + 0] * i1, oA[db][4 * g4 + 1] * i1); w.y = cvtpk(oA[db][4 * g4 + 2] * i1, oA[db][4 * g4 + 3] * i1);
                *(v2u*)(orow + 32 * db + 8 * g4) = w; }
    }
    __syncthreads();
}

constexpr int DS_HP = 1025;
constexpr int DS_HIST_BYTES = 32 * DS_HP * 4;
constexpr int DS_BP = 129;
constexpr int DS_G = 0, DS_C = 32 * DS_BP * 4, DS_AUX = DS_HIST_BYTES;
__device__ __forceinline__ float relu_asm(float x) { const int b = __float_as_int(x); return __int_as_float(b > 0 ? b : 0); }
__device__ __forceinline__ void dsa_scores(const bf16x8 (&iqf)[4][2], const float (&w)[4], const bf16x8 k0, const bf16x8 k1, float (&sc)[16]) {
#pragma unroll
    for (int hh = 0; hh < 4; ++hh) {
        f32x16 x;
#pragma unroll
        for (int r = 0; r < 16; ++r) x[r] = 0.f;
        x = __builtin_amdgcn_mfma_f32_32x32x16_bf16(k0, iqf[hh][0], x, 0, 0, 0);
        x = __builtin_amdgcn_mfma_f32_32x32x16_bf16(k1, iqf[hh][1], x, 0, 0, 0);
#pragma unroll
        for (int r = 0; r < 16; ++r) sc[r] = (hh == 0) ? (w[0] * relu_asm(x[r])) : __builtin_fmaf(w[hh], relu_asm(x[r]), sc[r]);
    }
}
__device__ __forceinline__ unsigned dsa_mono(float s) { const unsigned bits = __float_as_uint(s); return __builtin_amdgcn_bitop3_b32(bits, (unsigned)((int)bits >> 31), 0x80000000u, 0x1E); }
__device__ __forceinline__ unsigned dsa_ckey(float s, unsigned keyidx) { return (dsa_mono(s) & 0xFFFFF000u) | (4095u - keyidx); }
__device__ __forceinline__ unsigned take_low(unsigned w, unsigned n) {
    if (n >= (unsigned)__popc(w)) return w;
    unsigned res = 0u;
    while (n > 0u) { const unsigned low = w & (0u - w); res |= low; w ^= low; --n; }
    return res;
}
template <int PASS>
__device__ __forceinline__ void dsa_hist_pass(LAS unsigned* hist, const bf16x8 (&iqf)[4][2], const float (&w)[4], const bf16* kbase, int qg, int wid, int r32, int hi, int t, unsigned P1) {
    bf16x8 nk0 = *(const bf16x8*)(kbase + (size_t)wid * 32 * 256), nk1 = *(const bf16x8*)(kbase + (size_t)wid * 32 * 256 + 16);
    const unsigned rowb = (unsigned)(r32 * DS_HP * 4);
#pragma nounroll
    for (int j = wid; j <= qg; j += 8) {
        const bf16x8 k0 = nk0, k1 = nk1;
        { const int jn = (j + 8 <= qg) ? j + 8 : j; const bf16* kp = kbase + (size_t)jn * 32 * 256; nk0 = *(const bf16x8*)kp; nk1 = *(const bf16x8*)(kp + 16); }
        float sc[16]; dsa_scores(iqf, w, k0, k1, sc);
#if defined(PROBE_D1_SCORE2X)
        { float sd[16]; dsa_scores(iqf, w, k1, k0, sd);
#pragma unroll
          for (int r = 0; r < 16; ++r) asm volatile("" :: "v"(sd[r])); }
#endif
        const int lim = t - 32 * j - 4 * hi;
        const bool diag = (j == qg);
        if (diag) {
#pragma unroll
            for (int r = 0; r < 16; ++r) {
                const unsigned mono = dsa_mono(sc[r]);
                unsigned addr;
                if (PASS == 0) { addr = ((mono >> 22) << 2) + rowb; if ((r & 3) + 8 * (r >> 2) > lim) addr = rowb + 4096u; }
                else { addr = (((mono >> 12) & 1023u) << 2) + rowb; if ((mono >> 22) != P1 || ((r & 3) + 8 * (r >> 2) > lim)) addr = rowb + 4096u; }
                __hip_atomic_fetch_add((LAS unsigned*)((LAS unsigned char*)hist + addr), 1u, __ATOMIC_RELAXED, __HIP_MEMORY_SCOPE_WORKGROUP);
            }
        } else
#pragma unroll
        for (int r = 0; r < 16; ++r) {
            const unsigned mono = dsa_mono(sc[r]);
            unsigned addr;
            if (PASS == 0) { addr = ((mono >> 22) << 2) + rowb; }
            else { addr = (((mono >> 12) & 1023u) << 2) + rowb; if ((mono >> 22) != P1) addr = rowb + 4096u; }
            __hip_atomic_fetch_add((LAS unsigned*)((LAS unsigned char*)hist + addr), 1u, __ATOMIC_RELAXED, __HIP_MEMORY_SCOPE_WORKGROUP);
#if defined(PROBE_D1_ATOM2X)
            __hip_atomic_fetch_add((LAS unsigned*)((LAS unsigned char*)hist + rowb + 4096u), 1u, __ATOMIC_RELAXED, __HIP_MEMORY_SCOPE_WORKGROUP);
#endif
        }
    }
}
__device__ __forceinline__ void dsa_scan(LAS unsigned* hist, LAS unsigned* AUX, int pass, int wid, int lane) {
#pragma unroll
    for (int qi = 0; qi < 4; ++qi) {
        const int qq = 4 * wid + qi;
        const unsigned K = (pass == 0) ? 256u : AUX[32 + qq];
        LAS const unsigned* hrow = hist + qq * DS_HP;
        const int wb = 1008 - 16 * lane;
        unsigned s = 0u;
#pragma unroll
        for (int i = 0; i < 16; ++i) s += hrow[wb + ((i + lane) & 15)];
        unsigned incl = s;
#pragma unroll
        for (int o = 1; o < 64; o <<= 1) { const unsigned v = shupu(incl, o, lane); if (lane >= o) incl += v; }
        const unsigned long long bal = __ballot(incl >= K);
        const int L = __builtin_amdgcn_readfirstlane(bal ? (__ffsll((long long)bal) - 1) : 0);
        const unsigned above = (unsigned)__builtin_amdgcn_readlane((int)(incl - s), L);
        const int bin = 1023 - 16 * L - (lane & 15);
        const unsigned c = (lane < 16) ? hrow[bin] : 0u;
        unsigned inc2 = c;
#pragma unroll
        for (int o = 1; o < 16; o <<= 1) { const unsigned v = shupu(inc2, o, lane); if (lane >= o) inc2 += v; }
        const unsigned long long bal2 = __ballot(lane < 16 && above + inc2 >= K);
        const int I = __builtin_amdgcn_readfirstlane(bal2 ? (__ffsll((long long)bal2) - 1) : 0);
        if (lane == I) { AUX[64 * pass + qq] = (unsigned)bin; AUX[64 * pass + 32 + qq] = K - (above + inc2 - c); }
    }
}
__device__ __forceinline__ void dsa_select_unit(LAS unsigned char* lds, int b, int qg, const bf16* IX, unsigned* MASK, int* REFPOS  , int* REFMIN  ) {
    int tid_l = threadIdx.x; asm volatile("" : "+v"(tid_l)); const int tid = tid_l, lane = tid & 63, wid = __builtin_amdgcn_readfirstlane(tid >> 6), r32 = lane & 31, hi = lane >> 5;
    const int t = 32 * qg + r32;
    const size_t rowg = (size_t)b * SEQ;
    const bf16* qrow = IX + (rowg + t) * 256;
    bf16x8 iqf[4][2];
#pragma unroll
    for (int hh = 0; hh < 4; ++hh)
#pragma unroll
        for (int ds = 0; ds < 2; ++ds) iqf[hh][ds] = *(const bf16x8*)(qrow + 32 * hh + 16 * ds + 8 * hi);
    float w[4];
    { const v2u ww = *(const v2u*)(qrow + 160); w[0] = bflo(ww.x); w[1] = bfhi(ww.x); w[2] = bflo(ww.y); w[3] = bfhi(ww.y); }
    LAS unsigned* hist = (LAS unsigned*)lds;
    LAS unsigned* AUX = (LAS unsigned*)(lds + DS_AUX);
    const bf16* kbase = IX + (rowg + r32) * 256 + 128 + 8 * hi;
    unsigned P = 0u;
    const bool all = (qg < 8);
    if (!all) {
        for (int i = tid; i < DS_HIST_BYTES / 16; i += 512) ((LAS v4u*)lds)[i] = (v4u){0u, 0u, 0u, 0u};
#if defined(PROBE_D1_ZERO2X)
        __syncthreads(); for (int i = tid; i < DS_HIST_BYTES / 16; i += 512) ((LAS v4u*)lds)[i] = (v4u){0u, 0u, 0u, 0u}; __syncthreads(); for (int i = tid; i < DS_HIST_BYTES / 16; i += 512) ((LAS v4u*)lds)[i] = (v4u){0u, 0u, 0u, 0u};
#endif
        __syncthreads();
        dsa_hist_pass<0>(hist, iqf, w, kbase, qg, wid, r32, hi, t, 0u);
        __syncthreads();
        dsa_scan(hist, AUX, 0, wid, lane);
#if defined(PROBE_D1_SCAN2X)
        __syncthreads(); dsa_scan(hist, AUX, 0, wid, lane);
#endif
        __syncthreads();
        const unsigned P1 = AUX[r32];
        for (int i = tid; i < DS_HIST_BYTES / 16; i += 512) ((LAS v4u*)lds)[i] = (v4u){0u, 0u, 0u, 0u};
        __syncthreads();
        dsa_hist_pass<1>(hist, iqf, w, kbase, qg, wid, r32, hi, t, P1);
        __syncthreads();
        dsa_scan(hist, AUX, 1, wid, lane);
#if defined(PROBE_D1_SCAN2X)
        __syncthreads(); dsa_scan(hist, AUX, 1, wid, lane);
#endif
        __syncthreads();
        P = (P1 << 10) | AUX[64 + r32];
    }
    if (all) { if (tid < 32) { AUX[64 + 32 + tid] = 0u; } }
    for (int i = tid; i < (2 * 32 * DS_BP * 4) / 16; i += 512) ((LAS v4u*)lds)[i] = (v4u){0u, 0u, 0u, 0u};
    __syncthreads();
    LAS unsigned* G = (LAS unsigned*)(lds + DS_G);
    LAS unsigned* C = (LAS unsigned*)(lds + DS_C);
    bf16x8 nk0, nk1;
    { const int j0 = (wid <= qg) ? wid : 0; nk0 = *(const bf16x8*)(kbase + (size_t)j0 * 32 * 256); nk1 = *(const bf16x8*)(kbase + (size_t)j0 * 32 * 256 + 16); }
#pragma nounroll
    for (int j = wid; j <= qg; j += 8) {
        const bf16x8 k0 = nk0, k1 = nk1;
        { const int jn = (j + 8 <= qg) ? j + 8 : j; const bf16* kp = kbase + (size_t)jn * 32 * 256; nk0 = *(const bf16x8*)kp; nk1 = *(const bf16x8*)(kp + 16); }
        float sc[16]; dsa_scores(iqf, w, k0, k1, sc);
        unsigned bg = 0u, bc = 0u;
        const int lim = t - 32 * j - 4 * hi;
#pragma unroll
        for (int r = 0; r < 16; ++r) {
            const int pos = (r & 3) + 8 * (r >> 2) + 4 * hi;
            const unsigned p22 = dsa_mono(sc[r]) >> 12;
            const bool ok = ((r & 3) + 8 * (r >> 2)) <= lim;
            if (ok && p22 > P) bg |= 1u << pos;
            if (ok && p22 == P) bc |= 1u << pos;
        }
        bg |= shxu(bg, 32, lane); bc |= shxu(bc, 32, lane);
        if (hi == 0) { G[r32 * DS_BP + j] = bg; C[r32 * DS_BP + j] = bc; }
    }
    __syncthreads();
#pragma unroll
    for (int qi = 0; qi < 4; ++qi) {
        const int qq = 4 * wid + qi;
        const unsigned K2 = AUX[64 + 32 + qq];
        const unsigned w0 = C[qq * DS_BP + 2 * lane], w1 = C[qq * DS_BP + 2 * lane + 1];
        const unsigned pc = (unsigned)__popc(w0) + (unsigned)__popc(w1);
        unsigned incl = pc;
#pragma unroll
        for (int o = 1; o < 64; o <<= 1) { const unsigned v = shupu(incl, o, lane); if (lane >= o) incl += v; }
        const unsigned pre = incl - pc;
        unsigned need = K2 > pre ? K2 - pre : 0u;
        const unsigned t0 = take_low(w0, need); need -= (unsigned)__popc(t0);
        const unsigned t1 = take_low(w1, need);
        const unsigned g0 = G[qq * DS_BP + 2 * lane] | t0, g1 = G[qq * DS_BP + 2 * lane + 1] | t1;
        G[qq * DS_BP + 2 * lane] = g0; G[qq * DS_BP + 2 * lane + 1] = g1;
        int hp = g1 ? (64 * lane + 63 - __clz((int)g1)) : (g0 ? (64 * lane + 31 - __clz((int)g0)) : -1);
#pragma unroll
        for (int o = 1; o < 64; o <<= 1) { const int v = (int)shxu((unsigned)hp, o, lane); hp = v > hp ? v : hp; }
        if (lane == 0) { REFPOS[rowg + 32 * qg + qq] = hp; AUX[128 + qq] = (unsigned)hp; }
    }
    __syncthreads();
    if (tid == 0) { int mn = 0x7fffffff; for (int i = 0; i < 32; ++i) { const int v = (int)AUX[128 + i]; mn = v < mn ? v : mn; } REFMIN[b * 128 + qg] = mn; }
    { const int qq = tid >> 4, part = tid & 15;
        unsigned* dst = MASK + (rowg + 32 * qg + qq) * 128 + part * 8;
        v4u a, c2;
        a.x = G[qq * DS_BP + part * 8 + 0]; a.y = G[qq * DS_BP + part * 8 + 1]; a.z = G[qq * DS_BP + part * 8 + 2]; a.w = G[qq * DS_BP + part * 8 + 3];
        c2.x = G[qq * DS_BP + part * 8 + 4]; c2.y = G[qq * DS_BP + part * 8 + 5]; c2.z = G[qq * DS_BP + part * 8 + 6]; c2.w = G[qq * DS_BP + part * 8 + 7];
        *(v4u*)dst = a; *(v4u*)(dst + 4) = c2; }
    __syncthreads();
}

constexpr int PL_U = 0, PL_UP = 528, PL_D = 79 * 528 + 16  , PL_DP = 260;
__device__ __forceinline__ void pool_unit(LAS unsigned char* lds, int b, int tile, const bf16* PU, const bf16* wpt  , const float* pscale  , bf16* YC) {
    int tid_l = threadIdx.x; asm volatile("" : "+v"(tid_l)); const int tid = tid_l, cb = __builtin_amdgcn_readfirstlane(tid >> 6), tt = tid & 63;
    const int t0 = tile * 64; const size_t rowg = (size_t)b * SEQ;
    for (int i = tid; i < 79 * 32; i += 512) { const int rr = i >> 5, ch = i & 31; const int tok = t0 - 15 + rr;
        v4u v = (v4u){0u, 0u, 0u, 0u}; if (tok >= 0) v = *(const v4u*)(PU + (rowg + tok) * 256 + ch * 8);
        *(LAS v4u*)(lds + PL_U + rr * PL_UP + ch * 16) = v; }
    const int gq = cb & 3, th = cb >> 2, r32 = tt & 31, hi = tt >> 5;
    bf16x8 wf[2][4];
#pragma unroll
    for (int n = 0; n < 2; ++n)
#pragma unroll
        for (int ks = 0; ks < 4; ++ks) wf[n][ks] = *(const bf16x8*)(wpt + ((size_t)gq * 64 + r32 + 32 * n) * 64 + 16 * ks + 8 * hi);
    __syncthreads();
    { const int g = cb >> 1, wlen = 2 << g, c0 = 32 * cb, t = t0 + tt;
      const float inv = 1.f / (float)((t + 1 < wlen) ? (t + 1) : wlen);
      LAS float* Dm = (LAS float*)(lds + PL_D);
#pragma unroll
      for (int ch = 0; ch < 4; ++ch) {
        float sum[8], self[8];
#pragma unroll
        for (int e = 0; e < 8; ++e) { sum[e] = 0.f; self[e] = 0.f; }
        for (int i = 0; i < wlen; ++i) {
            const v4u v = *(LAS const v4u*)(lds + PL_U + (15 + tt - i) * PL_UP + (c0 + 8 * ch) * 2);
            const float f[8] = {bflo(v.x), bfhi(v.x), bflo(v.y), bfhi(v.y), bflo(v.z), bfhi(v.z), bflo(v.w), bfhi(v.w)};
#pragma unroll
            for (int e = 0; e < 8; ++e) { sum[e] += f[e]; if (i == 0) self[e] = f[e]; }
        }
        *(LAS f32x4*)(Dm + tt * PL_DP + c0 + 8 * ch) = (f32x4){sum[0] * inv - self[0], sum[1] * inv - self[1], sum[2] * inv - self[2], sum[3] * inv - self[3]};
        *(LAS f32x4*)(Dm + tt * PL_DP + c0 + 8 * ch + 4) = (f32x4){sum[4] * inv - self[4], sum[5] * inv - self[5], sum[6] * inv - self[6], sum[7] * inv - self[7]};
      } }
    __syncthreads();
    { LAS const float* dr = (LAS const float*)(lds + PL_D) + (32 * th + r32) * PL_DP + 64 * gq + 8 * hi;
      f32x16 acc[2];
#pragma unroll
      for (int r = 0; r < 16; ++r) { acc[0][r] = 0.f; acc[1][r] = 0.f; }
#pragma unroll
      for (int ks = 0; ks < 4; ++ks) { const f32x4 d0 = *(LAS const f32x4*)(dr + 16 * ks), d1 = *(LAS const f32x4*)(dr + 16 * ks + 4);
          v4u a; a.x = cvtpk(d0.x, d0.y); a.y = cvtpk(d0.z, d0.w); a.z = cvtpk(d1.x, d1.y); a.w = cvtpk(d1.z, d1.w);
          const bf16x8 af = __builtin_bit_cast(bf16x8, a);
          acc[0] = __builtin_amdgcn_mfma_f32_32x32x16_bf16(af, wf[0][ks], acc[0], 0, 0, 0);
          acc[1] = __builtin_amdgcn_mfma_f32_32x32x16_bf16(af, wf[1][ks], acc[1], 0, 0, 0); }
#pragma unroll
      for (int n = 0; n < 2; ++n) { const int och = 64 * gq + 32 * n + r32; const float psc = pscale[och];
          bf16* ob = YC + (rowg + t0 + 32 * th + 4 * hi) * 256 + och;
#pragma unroll
          for (int r = 0; r < 16; ++r) ob[(size_t)((r & 3) + 8 * (r >> 2)) * 256] = (bf16)f2bf(acc[n][r] * psc); } }
    __syncthreads();
}
__device__ __forceinline__ void kmean_item(int item, const bf16* AK, float* KMEAN, int wid, int lane_in) {
    int lane = lane_in; asm volatile("" : "+v"(lane));
    const int combo = item * 8 + wid; const int b = combo >> 6, h = (combo >> 4) & 3, n = combo & 15;
    const int ks = lane >> 3, ch = lane & 7;
    const bf16* p = AK + ((size_t)b * SEQ + 256 * n + ks) * 256 + 64 * h + 8 * ch;
    float s[8];
#pragma unroll
    for (int e = 0; e < 8; ++e) s[e] = 0.f;
#pragma unroll 8
    for (int j = 0; j < 32; ++j) { const v4u v = *(const v4u*)(p + (size_t)j * 8 * 256);
        s[0] += bflo(v.x); s[1] += bfhi(v.x); s[2] += bflo(v.y); s[3] += bfhi(v.y); s[4] += bflo(v.z); s[5] += bfhi(v.z); s[6] += bflo(v.w); s[7] += bfhi(v.w); }
#pragma unroll
    for (int e = 0; e < 8; ++e) { s[e] += shx(s[e], 8, lane); s[e] += shx(s[e], 16, lane); s[e] += shx(s[e], 32, lane); }
    if (ks == 0) { float* o = KMEAN + (size_t)combo * 64 + 8 * ch;
        *(f32x4*)o = (f32x4){s[0], s[1], s[2], s[3]} * (1.f / 256.f); *(f32x4*)(o + 4) = (f32x4){s[4], s[5], s[6], s[7]} * (1.f / 256.f); }
}

__device__ __forceinline__ void norm_unit(LAS unsigned char* lds, int n, const bf16* PROJ, size_t TS, unsigned* NRM  ) {
    int tid_l = threadIdx.x; asm volatile("" : "+v"(tid_l)); const int tid = tid_l, lane = tid & 63, wid = __builtin_amdgcn_readfirstlane(tid >> 6);
    const int a = n >> 8, rem = n & 255, sq = rem >> 7, b = (rem >> 4) & 7, c = rem & 15;
    const int tile = (a == 0 ? 0 : (a == 1 ? 3 : 7)) + sq;
    const int row = tid >> 1, hp = tid & 1;
    float ss[2] = {0.f, 0.f};
#pragma unroll
    for (int rr = 0; rr < 1; ++rr) {
        const bf16* p = PROJ + (size_t)tile * TS + ((size_t)b * SEQ + 256 * c + row) * 256 + 128 * hp;
#pragma unroll
        for (int hh = 0; hh < 2; ++hh) { float acc = 0.f;
#pragma unroll
            for (int i = 0; i < 8; ++i) { const v4u v = *(const v4u*)(p + 64 * hh + 8 * i);
                const float f0 = bflo(v.x), f1 = bfhi(v.x), f2 = bflo(v.y), f3 = bfhi(v.y), f4 = bflo(v.z), f5 = bfhi(v.z), f6 = bflo(v.w), f7 = bfhi(v.w);
                acc += (f0 * f0 + f1 * f1) + (f2 * f2 + f3 * f3) + (f4 * f4 + f5 * f5) + (f6 * f6 + f7 * f7); }
            ss[hh] = fmaxf(ss[hh], acc); }
    }
#pragma unroll
    for (int o = 2; o < 64; o <<= 1) { ss[0] = fmaxf(ss[0], shx(ss[0], o, lane)); ss[1] = fmaxf(ss[1], shx(ss[1], o, lane)); }
    LAS float* R = (LAS float*)lds;
    if (lane < 2) { R[wid * 4 + 2 * hp] = ss[0]; R[wid * 4 + 2 * hp + 1] = ss[1]; }
    __syncthreads();
    if (tid < 4) { float m = R[tid];
#pragma unroll
        for (int w2 = 1; w2 < 8; ++w2) m = fmaxf(m, R[w2 * 4 + tid]);
        __hip_atomic_fetch_max(NRM + ((a * 2 + sq) * 8 + b) * 4 + tid, __float_as_uint(m * 1.0001f), __ATOMIC_RELAXED, __HIP_MEMORY_SCOPE_AGENT); }
    __syncthreads();
}

__device__ __forceinline__ float alibi_slope(int idx  ) { return exp2f(-8.f * (float)idx / 12.f); }

__device__ __forceinline__ void p0_adaln(const Args& A, LAS unsigned char* lds, int G) {
    int tid_l = threadIdx.x; asm volatile("" : "+v"(tid_l)); const int tid = tid_l, lane = tid & 63, wid = __builtin_amdgcn_readfirstlane(tid >> 6);
    LAS float* cact = (LAS float*)lds;
    LAS float* red = (LAS float*)(lds + 32768);
    float* MOD = (float*)(A.ws + WS_MOD);
    if ((int)blockIdx.x < 192) {
        for (int i = tid; i < 8192; i += 512) { const int bb = i >> 10, k = i & 1023; const float v = A.c[i]; cact[k * 8 + bb] = v / (1.f + __expf(-v)); }
        __syncthreads();
        for (int u = blockIdx.x; u < 192; u += G) {
            const int l = u / 96, n0 = (u % 96) * 64;
            const float* wp = A.w_ada + ((size_t)l * 1024 + 128 * wid) * 6144 + n0 + lane;
            float acc[8];
#pragma unroll
            for (int bb = 0; bb < 8; ++bb) acc[bb] = 0.f;
#pragma unroll 16
            for (int k = 0; k < 128; ++k) {
                const float wv = wp[(size_t)k * 6144];
                const f32x4 c0 = *(LAS const f32x4*)(cact + (128 * wid + k) * 8), c1 = *(LAS const f32x4*)(cact + (128 * wid + k) * 8 + 4);
                acc[0] += c0[0] * wv; acc[1] += c0[1] * wv; acc[2] += c0[2] * wv; acc[3] += c0[3] * wv;
                acc[4] += c1[0] * wv; acc[5] += c1[1] * wv; acc[6] += c1[2] * wv; acc[7] += c1[3] * wv;
            }
#pragma unroll
            for (int bb = 0; bb < 8; ++bb) red[(wid * 8 + bb) * 64 + lane] = acc[bb];
            __syncthreads();
            { const int bb = wid; float s = A.b_ada[(size_t)l * 6144 + n0 + lane];
#pragma unroll
                for (int w2 = 0; w2 < 8; ++w2) s += red[(w2 * 8 + bb) * 64 + lane];
                MOD[((size_t)l * 8 + bb) * 6144 + n0 + lane] = s; }
            __syncthreads();
        }
    }
    __syncthreads();
}
__device__ __forceinline__ void p0_weights(const Args& A, LAS unsigned char* lds, int vcu, int G, int l0, int l1) {
    int tid_l = threadIdx.x; asm volatile("" : "+v"(tid_l)); const int tid = tid_l, lane = tid & 63, wid = __builtin_amdgcn_readfirstlane(tid >> 6);
    unsigned char* ws = A.ws;
    LAS float* scr = (LAS float*)(lds + wid * 16384);
    const int gw = vcu * NWAVES + wid, NGW = G * NWAVES;
    constexpr int I_IN = 16 * (NPROJ_PAD / 32), I_G1 = 16 * 32, I_BR1 = 4 * 32, I_OUT = 16 * 32, I_F1 = 16 * 128, I_F2 = 64 * 32;
    constexpr int I_LAYER = I_IN + 4 * I_G1 + 4 * I_BR1 + I_OUT + I_F1 + I_F2;
    for (int it = l0 * I_LAYER + gw; it < l1 * I_LAYER; it += NGW) {
        const int l = it / I_LAYER; int r = it % I_LAYER;
        bf16* WL = (bf16*)(ws + WS_W) + (size_t)l * W_LAYER;
        if (r < I_IN) {
            const int nb = r % (NPROJ_PAD / 32), tile = nb >> 3;
            const int i7 = (tile == 0) ? 0 : (tile == 1) ? 1 : (tile == 3) ? 2 : (tile == 4) ? 3 : (tile == 7) ? 4 : (tile == 8) ? 5 : (tile == 10) ? 6 : -1;
            if (i7 >= 0) p0_transpose_item(A.w_in + (size_t)l * DM * NPROJ, DM, NPROJ, NPROJ_PAD, WL + W_IN + (ptrdiff_t)(i7 - tile) * 256 * DM, 0, 0, scr, r, lane);
            else { const int i4 = (tile == 2) ? 0 : (tile == 5) ? 1 : (tile == 6) ? 2 : 3;
                p0_transpose_item(A.w_in + (size_t)l * DM * NPROJ, DM, NPROJ, NPROJ_PAD, (bf16*)((unsigned char*)(WL + W_IN + (size_t)7 * 256 * DM) + (ptrdiff_t)(i4 - tile) * 256 * DM), 4, 0, scr, r, lane); }
            continue; } r -= I_IN;
        if (r < 4 * I_G1) { const int br = r / I_G1; p0_transpose_item(A.w_gate + ((size_t)l * 4 + br) * DM * DM, DM, DM, DM, WL + W_GATE, 2, br, scr, r % I_G1, lane); continue; } r -= 4 * I_G1;
        if (r < 4 * I_BR1) { const int br = r / I_BR1; p0_transpose_item(A.w_branch + ((size_t)l * 4 + br) * 256 * DM, 256, DM, DM, WL + W_BR + (size_t)br * DM * 256, 0, 0, scr, r % I_BR1, lane); continue; } r -= 4 * I_BR1;
        if (r < I_OUT) { p0_transpose_item(A.w_out + (size_t)l * DM * DM, DM, DM, DM, WL + W_OUT, 0, 0, scr, r, lane); continue; } r -= I_OUT;
        if (r < I_F1) { p0_transpose_item(A.w_ff1 + (size_t)l * DM * FF, DM, FF, FF, WL + W_FF1, 0, 0, scr, r, lane); continue; } r -= I_F1;
        p0_transpose_item(A.w_ff2 + (size_t)l * FF * DM, FF, DM, DM, WL + W_FF2, 3, 0, scr, r, lane);
    }
    { bf16* WPT = (bf16*)(ws + WS_WPT);
      const int i = gw * 64 + lane;
      if (i < 16384 && l1 == l0 + 1) { const int j = l0 * 16384 + i, g = (i >> 12) & 3, e = (i >> 6) & 63, c = i & 63;
          WPT[j] = (bf16)f2bf(A.w_pool[((size_t)(l0 * 4 + g) * 64 + c) * 64 + e]); } }
    __syncthreads();
}

__device__ __forceinline__ int wq_draw(gu32* ctr) { int v = 0; if (threadIdx.x == 0) v = (int)__hip_atomic_fetch_add(ctr, 1u, RLX_AGENT); return v; }
__device__ __forceinline__ int wq_bcast(volatile LAS unsigned* slot, int v) {
    if (threadIdx.x == 0) *slot = (unsigned)v;
    __syncthreads();
    const int item = (int)*slot;
    __syncthreads();
    return item;
}

#ifndef ZG_ALIGN
#define ZG_ALIGN true
#define ZG_SP2 false
#endif
#ifndef IN_ALIGN
#define IN_ALIGN true
#define IN_SP2 true
#endif
#ifndef GT_ALIGN
#define GT_ALIGN true
#define GT_SP2 false
#endif
#ifndef WO_ALIGN
#define WO_ALIGN true
#define WO_SP2 true
#endif
#ifndef F1_ALIGN
#define F1_ALIGN true
#define F1_SP2 true
#endif
#ifndef F2_ALIGN
#define F2_ALIGN true
#define F2_SP2 true
#endif
struct ZOrder {
    pg8::StaticOrder base;
    __device__ __forceinline__ bool next(int i, pg8::Unit& u) const { if (!base.next(i, u)) return false; u.pn += 4 * (u.pm >> 7); return true; }
    __device__ __forceinline__ void a_ready(const pg8::Unit&) const {}
    __device__ __forceinline__ void done(const pg8::Unit&) const {}
};

__global__ void __launch_bounds__(NWAVES * 64, 2) hybrid_fwd(Args args) {
    extern __shared__ __attribute__((aligned(16))) unsigned char lds_raw[];
    LAS unsigned char* lds = (LAS unsigned char*)lds_raw;
#define PHASE_IDS int tid_p = threadIdx.x; asm volatile("" : "+v"(tid_p)); const int lane = tid_p & 63, wid = __builtin_amdgcn_readfirstlane(tid_p >> 6); const int gw = vcu * NWAVES + wid, ngw = G * NWAVES; (void)lane; (void)gw; (void)ngw;
    const int G = gridDim.x; const int bx = blockIdx.x; const int vcu = (G % 8 == 0) ? (bx % 8) * (G / 8) + bx / 8 : bx;
    unsigned char* ws = args.ws;
    gu32* ctl = (gu32*)(ws + WS_CTL);
    volatile LAS unsigned* MISC = (volatile LAS unsigned*)(lds + LDSCTL_OFF);
    for (int u = threadIdx.x; u < (LDS_BYTES - LDSCTL_OFF) / 4; u += NWAVES * 64) ((LAS unsigned*)(lds + LDSCTL_OFF))[u] = 0u;
    __syncthreads();
    const int lo = args.ph_lo, hi = args.ph_hi;
    XcdBarrier bar; bar.bar = (unsigned*)(ctl + CW_BAR) + args.li * XCD_BAR_WORDS; bar.x = 0; bar.st = nullptr;
    if (hi - lo > 1) bar = xcd_barrier_post((unsigned*)(ctl + CW_BAR) + args.li * XCD_BAR_WORDS, MISC + 8);
#ifndef PHASE_OFF
#define PHASE_OFF 0
#endif
#define IN(k) (lo <= (k) && (k) < hi && !((PHASE_OFF >> ((k) == 0 ? 0 : (k) == 21 ? 11 : (((k) - 1) % 10) + 1)) & 1))
#ifndef REPEAT_MASK
#define REPEAT_MASK 0
#endif
#define NREP(bit) (((REPEAT_MASK >> (bit)) & 1) ? 2 : 1)
#if defined(PROBE_SEAM2X)
#define SEAM(k) do { if (IN(k) && IN((k) + 1)) { xcd_barrier(bar); xcd_barrier(bar); } } while (0)
#else
#define SEAM(k) do { if (IN(k) && IN((k) + 1)) xcd_barrier(bar); } while (0)
#endif
    float* MOD = (float*)(ws + WS_MOD);
    float* KMEAN = (float*)(ws + WS_KMEAN);
    int* REFPOS = (int*)(ws + WS_KMEAN + 128 * 1024);
    int* REFMIN = (int*)(ws + WS_KMEAN + 256 * 1024);
    unsigned* MASK = (unsigned*)(ws + WS_MASK);
    bf16* H = (bf16*)(ws + WS_H);
    unsigned char* H8 = ws + WS_H8;
    bf16* Y = (bf16*)(ws + WS_Y);
    bf16* MERGED = (bf16*)(ws + WS_Y);
    bf16* PROJ = (bf16*)(ws + WS_R);
    unsigned char* Z = ws + WS_R;
    unsigned char* U8 = ws + WS_R;
    bf16* XRB = (bf16*)args.out;
    constexpr size_t TS = (size_t)TOK * 256;
    volatile LAS unsigned* wqslot = MISC + 16;

    if (IN(0)) for (int rep = 0; rep < NREP(0); ++rep) { p0_adaln(args, lds, G); }
    SEAM(0);

#pragma nounroll
    for (int l = 0; l < NL; ++l) {
        const int pb = 1 + 10 * l;
        const float* modl = MOD + (size_t)l * 8 * 6144;
        const bf16* WL = (const bf16*)(ws + WS_W) + (size_t)l * W_LAYER;
        if (IN(pb + 0)) for (int rep = 0; rep < NREP(1); ++rep) { PHASE_IDS if (l == 0) norm_rows_bf16<false>(lds, args.x, H, H8, args.norm1_g + (size_t)l * DM, modl, 0, 1, gw, ngw, lane); else norm_rows_bf16<true>(lds, XRB, H, H8, args.norm1_g + (size_t)l * DM, modl, 0, 1, gw, ngw, lane); if (l == 0) p0_weights(args, lds, vcu, G, 0, 1); }
        SEAM(pb + 0);
        if (IN(pb + 1)) for (int rep = 0; rep < NREP(2); ++rep) {
            { int k8 = DM / 2; asm volatile("" : "+s"(k8));
              pg8::Gemm g{(const bf16*)H8, (const bf16*)((const unsigned char*)(WL + W_IN + (size_t)7 * 256 * DM)), TOK, 1024, k8}; pg8::StaticOrder S; S.init(TOK, 1024, G, bx);
              pg8::EpiProj<true> E{PROJ, TS};
              pg8::gemm_phase<pg8::EpiProj<true>, pg8::StaticOrder, IN_ALIGN, IN_SP2, true>(lds, g, S, E); }
            { pg8::Gemm g{H, WL + W_IN, TOK, 1792, DM}; pg8::StaticOrder S; S.init(TOK, 1792, G, bx);
              pg8::EpiProj<false> E{PROJ, TS};
              pg8::gemm_phase<pg8::EpiProj<false>, pg8::StaticOrder, IN_ALIGN, IN_SP2>(lds, g, S, E); }
            if (l == 0 && rep == 0 && bx >= 128) p0_weights(args, lds, bx - 128, G - 128, 1, 2);
        }
        SEAM(pb + 1);
        unsigned* NRM = (unsigned*)(ctl + CW_NRM) + l * 192;
        if (IN(pb + 2)) for (int rep = 0; rep < NREP(3); ++rep) {
            gu32* ctr = ctl + CW_WQ + (l * 2 + 0 + 4 * rep) * 64;
            int raw = wq_draw(ctr);
            for (;;) {
#ifndef REPA_LO
#define REPA_LO 0
#define REPA_HI 2368
#endif
                const int item = wq_bcast(wqslot, raw) + (rep ? REPA_LO : 0);
                if (item >= (rep ? REPA_HI : 2368)) break;
                raw = wq_draw(ctr);
                if (item < 1024) { const int qg = 127 - (item >> 3), b = item & 7;
                    dsa_select_unit(lds, b, qg, PROJ + 10 * TS, MASK, REFPOS, REFMIN);
                } else if (item < 1536) { const int i2 = item - 1024; const int b = i2 >> 6, tile = i2 & 63;
                    pool_unit(lds, b, tile, PROJ + 6 * TS, (const bf16*)(ws + WS_WPT) + (size_t)l * 16384, args.pool_scale + (size_t)l * 256, Y + 2 * TS);
                } else if (item < 1600) { PHASE_IDS kmean_item(item - 1536, PROJ + 1 * TS, KMEAN, wid, lane);
                } else { norm_unit(lds, item - 1600, PROJ, TS, NRM); }
            }
        }
        SEAM(pb + 2);
        if (IN(pb + 3)) for (int rep = 0; rep < NREP(4); ++rep) {
            gu32* ctr = ctl + CW_WQ + 512 + ((l * 2 + rep) * 8) * 64;
            const float li = 0.8f - 0.6f * __expf(-0.3f * (float)l);
            const float* dl = args.diff_lambda + (size_t)l * 128;
            float d1 = 0.f, d2 = 0.f;
            for (int i = 0; i < 32; ++i) { d1 += dl[i] * dl[32 + i]; d2 += dl[64 + i] * dl[96 + i]; }
            const float lam = __expf(d1) - __expf(d2) + li;
            int raw = wq_draw(ctr);
            for (;;) {
                const int item = wq_bcast(wqslot, raw);
                if (item >= 1536) break;
                raw = wq_draw(ctr);
                const int ty = item % 3, rest = item / 3; const int qb = 15 - (rest >> 5), bh = rest & 31, b = bh >> 2, h = bh & 3;
                if (ty == 0) attn_unit<1>(lds, b, h, qb, PROJ + 3 * TS, PROJ + 4 * TS, PROJ + 5 * TS, Y + 1 * TS, alibi_slope(3 * h + 2), nullptr, lam, 1.f - li, args.diff_subln_g + (size_t)l * 64, nullptr, NRM + 64, nullptr, nullptr);
                else if (ty == 1) attn_unit<0>(lds, b, h, qb, PROJ + 0 * TS, PROJ + 1 * TS, PROJ + 2 * TS, Y + 0 * TS, alibi_slope(3 * h + 1), KMEAN, 0.f, 0.f, nullptr, nullptr, NRM, nullptr, nullptr);
                else              attn_unit<2>(lds, b, h, qb, PROJ + 7 * TS, PROJ + 8 * TS, PROJ + 9 * TS, Y + 3 * TS, alibi_slope(3 * h + 3), nullptr, 0.f, 0.f, nullptr, MASK, NRM + 128, REFPOS, REFMIN);
            }
        }
        SEAM(pb + 3);
        if (IN(pb + 4)) for (int rep = 0; rep < NREP(5); ++rep) {
            int kz = 256; asm volatile("" : "+s"(kz)); pg8::Gemm g{Y, WL + W_BR, 4 * TOK, 4096, kz}; ZOrder S; S.base.init(4 * TOK, DM, G, bx);
            pg8::EpiZ E{Z};
            pg8::gemm_phase<pg8::EpiZ, ZOrder, ZG_ALIGN, ZG_SP2>(lds, g, S, E);
        }
        SEAM(pb + 4);
        if (IN(pb + 5)) for (int rep = 0; rep < NREP(6); ++rep) {
            int kg = DM / 2; asm volatile("" : "+s"(kg));
            pg8::Gemm g{(const bf16*)H8, WL + W_GATE, TOK, 4096, kg}; pg8::StaticOrder S; S.init(TOK, 4096, G, bx);
            pg8::EpiGate E{Z, args.b_gate + (size_t)l * 4 * DM, MERGED};
            pg8::gemm_phase<pg8::EpiGate, pg8::StaticOrder, GT_ALIGN, GT_SP2, true>(lds, g, S, E);
        }
        SEAM(pb + 5);
        if (IN(pb + 6)) for (int rep = 0; rep < NREP(7); ++rep) {
            pg8::Gemm g{MERGED, WL + W_OUT, TOK, DM, DM}; pg8::StaticOrder S; S.init(TOK, DM, G, bx);
            if (l == 0) { pg8::EpiResid<false> E{args.x, rep ? (bf16*)(ws + WS_R) : XRB, modl + 2 * 1024, 1.f};
                pg8::gemm_phase<pg8::EpiResid<false>, pg8::StaticOrder, WO_ALIGN, WO_SP2>(lds, g, S, E); }
            else { pg8::EpiResid<true> E{XRB, rep ? (bf16*)(ws + WS_R) : XRB, modl + 2 * 1024, 1.f};
                pg8::gemm_phase<pg8::EpiResid<true>, pg8::StaticOrder, WO_ALIGN, WO_SP2>(lds, g, S, E); }
        }
        SEAM(pb + 6);
        if (IN(pb + 7)) for (int rep = 0; rep < NREP(8); ++rep) { PHASE_IDS norm_rows_bf16<true>(lds, XRB, H, nullptr, args.norm2_g + (size_t)l * DM, modl, 3, 4, gw, ngw, lane); }
        SEAM(pb + 7);
        if (IN(pb + 8)) for (int rep = 0; rep < NREP(9); ++rep) {
            pg8::Gemm g{H, WL + W_FF1, TOK, FF, DM}; pg8::StaticOrder S; S.init(TOK, FF, G, bx);
            pg8::EpiRelu2 E{U8, FF};
            pg8::gemm_phase<pg8::EpiRelu2, pg8::StaticOrder, F1_ALIGN, F1_SP2>(lds, g, S, E);
        }
        SEAM(pb + 8);
        if (IN(pb + 9)) for (int rep = 0; rep < NREP(10); ++rep) {
            int kf = FF / 2; asm volatile("" : "+s"(kf));
            pg8::Gemm g{(const bf16*)U8, WL + W_FF2, TOK, DM, kf}; pg8::StaticOrder S; S.init(TOK, DM, G, bx);
            pg8::EpiResid<true> E{XRB, rep ? (bf16*)(ws + WS_MASK) : XRB, modl + 5 * 1024, 1.f / 64.f};
            pg8::gemm_phase<pg8::EpiResid<true>, pg8::StaticOrder, F2_ALIGN, F2_SP2, true>(lds, g, S, E);
        }
        SEAM(pb + 9);
    }
    if (IN(21)) {
        PHASE_IDS
        v4u xa[16], xb[16]; float rs[16];
        const v4u* xp = (const v4u*)(XRB + (size_t)gw * DM) + 2 * lane;
#pragma unroll
        for (int i = 0; i < 16; ++i) { xa[i] = xp[(size_t)i * ngw * (DM / 8)]; xb[i] = xp[(size_t)i * ngw * (DM / 8) + 1]; }
#pragma unroll
        for (int i = 0; i < 16; ++i) { const v4u a = xa[i], c = xb[i];
            float s = bflo(a.x) * bflo(a.x); s += bfhi(a.x) * bfhi(a.x); s += bflo(a.y) * bflo(a.y); s += bfhi(a.y) * bfhi(a.y); s += bflo(a.z) * bflo(a.z); s += bfhi(a.z) * bfhi(a.z); s += bflo(a.w) * bflo(a.w); s += bfhi(a.w) * bfhi(a.w);
            s += bflo(c.x) * bflo(c.x); s += bfhi(c.x) * bfhi(c.x); s += bflo(c.y) * bflo(c.y); s += bfhi(c.y) * bfhi(c.y); s += bflo(c.z) * bflo(c.z); s += bfhi(c.z) * bfhi(c.z); s += bflo(c.w) * bflo(c.w); s += bfhi(c.w) * bfhi(c.w);
            rs[i] = 1.f / sqrtf(wave_sum(s, lane) * (1.f / DM) + NORM_EPS); }
        xcd_barrier(bar);
#pragma unroll
        for (int i = 0; i < 16; ++i) asm volatile("" : "+v"(xa[i]), "+v"(xb[i]));
        const f32x4* gp = (const f32x4*)args.final_g + 4 * lane;
        f32x4* op = (f32x4*)(args.out + (size_t)gw * DM) + 4 * lane;
#pragma unroll
        for (int i = 0; i < 16; ++i) { const v4u a = xa[i], c = xb[i]; const float r = rs[i]; f32x4* o = op + (size_t)i * ngw * (DM / 4);
            o[0] = (f32x4){bflo(a.x), bfhi(a.x), bflo(a.y), bfhi(a.y)} * r * gp[0]; o[1] = (f32x4){bflo(a.z), bfhi(a.z), bflo(a.w), bfhi(a.w)} * r * gp[1];
            o[2] = (f32x4){bflo(c.x), bfhi(c.x), bflo(c.y), bfhi(c.y)} * r * gp[2]; o[3] = (f32x4){bflo(c.z), bfhi(c.z), bflo(c.w), bfhi(c.w)} * r * gp[3]; }
    }
#undef IN
#undef SEAM
}

#ifndef MK_SPLIT
#define MK_SPLIT 0
#endif
extern "C" void kernel_launch(void* const* d_in, const int* in_sizes, int n_in, void* d_out, int out_size, void* d_ws, size_t ws_size, hipStream_t stream) {
    static int grid = 0;
    if (grid == 0) {
        if (n_in != 18 || in_sizes[0] != TOK * DM || out_size != TOK * DM || ws_size < WS_END) { fprintf(stderr, "kernel_launch: unexpected shapes (n_in %d, in0 %d, out %d, ws %zu)\n", n_in, n_in > 0 ? in_sizes[0] : -1, out_size, ws_size); grid = -1; return; }
        int dev = 0, cus = 0, per_cu = 0;
        if (hipGetDevice(&dev) != hipSuccess || hipDeviceGetAttribute(&cus, hipDeviceAttributeMultiprocessorCount, dev) != hipSuccess) { grid = -1; return; }
        if (hipFuncSetAttribute((const void*)hybrid_fwd, hipFuncAttributeMaxDynamicSharedMemorySize, LDS_BYTES) != hipSuccess) { fprintf(stderr, "kernel_launch: hipFuncSetAttribute failed\n"); grid = -1; return; }
        if (hipOccupancyMaxActiveBlocksPerMultiprocessor(&per_cu, (const void*)hybrid_fwd, NWAVES * 64, LDS_BYTES) != hipSuccess || per_cu < 1) fprintf(stderr, "kernel_launch: occupancy query reports %d\n", per_cu);
        (void)hipGetLastError();
        grid = cus;
        if (cus != 256) { fprintf(stderr, "kernel_launch: built for 256 CUs (the final norm stages 16 rows per wave), found %d\n", cus); grid = -1; return; }
    }
    if (grid < 0) return;
    if (hipMemsetAsync((char*)d_ws + WS_CTL, 0, CTL_ZERO_BYTES, stream) != hipSuccess) return;
    Args a{};
    const float** ap = (const float**)&a;
    for (int i = 0; i < 18; ++i) ap[i] = (const float*)d_in[i];
    a.out = (float*)d_out; a.ws = (unsigned char*)d_ws; a.pad = 0;
#if MK_SPLIT
    for (int p = 0; p < NPHASE; ++p) { a.ph_lo = p; a.ph_hi = p + 1; a.li = 0;
        hipLaunchKernelGGL(hybrid_fwd, dim3(grid), dim3(NWAVES * 64), LDS_BYTES, stream, a); }
#else
    a.ph_lo = 0; a.ph_hi = NPHASE; a.li = 0;
    hipLaunchKernelGGL(hybrid_fwd, dim3(grid), dim3(NWAVES * 64), LDS_BYTES, stream, a);
#endif
}
```
